# Optimizing an MI355X kernel written in HIP

```python
import math
import jax, jax.numpy as jnp
from jax import lax
import numpy as np

D_MODEL = 1024
BATCH = 8
SEQ = 4096
DEPTH = 2

N_META = 16
D_MIX = D_MODEL
CONV_DIM = D_MIX // 4
ATT_HEAD_DIM = 64
ATT_DIM = D_MIX // 2
ATT_HEADS = ATT_DIM // ATT_HEAD_DIM
SSM_DIM = D_MIX - CONV_DIM - ATT_DIM
SSM_GROUP = 16
SSM_GROUPS = SSM_DIM // SSM_GROUP
SSM_STATE = 64
CONV_WIDTH = 31
BLOCK_Q = 128
N_EXPERT_GROUPS = 4
EXPERTS_PER_GROUP = 4
N_EXPERTS = N_EXPERT_GROUPS * EXPERTS_PER_GROUP
TOP_K_INNER = 2
D_FF_EXPERT = D_MODEL // 4
EPS = 1e-6
NEG_BIG = -1e30

IN_WIDTHS = (CONV_DIM, CONV_DIM, ATT_DIM, ATT_DIM, ATT_DIM, ATT_HEADS, SSM_DIM)
IN_SPLITS = tuple(int(v) for v in np.cumsum(IN_WIDTHS)[:-1])
D_IN = int(sum(IN_WIDTHS))

kernel_name = "hymba_conformer_fox_s5_hiermoe"


def rms_norm(x, g):
    xf = x.astype(jnp.float32)
    y = xf * lax.rsqrt(jnp.mean(xf * xf, axis=-1, keepdims=True) + EPS)
    return (y * g.astype(jnp.float32)).astype(x.dtype)


def conformer_conv(a, gate, w_dw, b_dw, ln_g, ln_b):
    u = a * jax.nn.sigmoid(gate)
    u_pad = jnp.pad(u, ((0, 0), (CONV_WIDTH - 1, 0), (0, 0)))
    y = lax.conv_general_dilated(
        u_pad, w_dw[:, None, :].astype(u.dtype), window_strides=(1,), padding="VALID",
        dimension_numbers=("NWC", "WIO", "NWC"), feature_group_count=CONV_DIM)
    y = y.astype(jnp.float32) + b_dw.astype(jnp.float32)
    mu = jnp.mean(y, axis=-1, keepdims=True)
    var = jnp.mean(jnp.square(y - mu), axis=-1, keepdims=True)
    y = (y - mu) * lax.rsqrt(var + EPS) * ln_g.astype(jnp.float32) + ln_b.astype(jnp.float32)
    return jax.nn.silu(y).astype(a.dtype)


def forgetting_attention(q, k, v, f_logit):
    bsz, t_len = q.shape[0], q.shape[1]
    pad = BLOCK_Q - N_META
    l_len = t_len + pad
    n_blocks = l_len // BLOCK_Q
    cum = jnp.cumsum(jax.nn.log_sigmoid(f_logit.astype(jnp.float32)), axis=1)
    padt = lambda z: jnp.pad(z, ((0, 0), (pad, 0)) + ((0, 0),) * (z.ndim - 2))
    q, k, v, cum = padt(q), padt(k), padt(v), padt(cum)
    cum_k = cum.transpose(0, 2, 1)
    qb = q.reshape(bsz, n_blocks, BLOCK_Q, ATT_HEADS, ATT_HEAD_DIM).transpose(1, 0, 2, 3, 4)
    cqb = cum_k.reshape(bsz, ATT_HEADS, n_blocks, BLOCK_Q).transpose(2, 0, 1, 3)
    kpos = jnp.arange(l_len)
    scale = ATT_HEAD_DIM ** -0.5

    def one_block(args):
        i, qi, ci = args
        s = jnp.einsum("bqhd,bkhd->bhqk", qi, k, preferred_element_type=jnp.float32) * scale
        s = s + ci[..., None] - cum_k[:, :, None, :]
        qpos = i * BLOCK_Q + jnp.arange(BLOCK_Q)
        mask = (kpos[None, :] <= qpos[:, None]) & (kpos[None, :] >= pad)
        s = jnp.where(mask[None, None], s, NEG_BIG)
        p = jax.nn.softmax(s, axis=-1)
        return jnp.einsum("bhqk,bkhd->bqhd", p.astype(v.dtype), v)

    out = lax.map(one_block, (jnp.arange(n_blocks), qb, cqb))
    out = out.transpose(1, 0, 2, 3, 4).reshape(bsz, l_len, ATT_DIM)
    return out[:, pad:]


def _cplx_combine(e1, e2):
    a1r, a1i, b1r, b1i = e1
    a2r, a2i, b2r, b2i = e2
    ar = a2r * a1r - a2i * a1i
    ai = a2r * a1i + a2i * a1r
    br = a2r * b1r - a2i * b1i + b2r
    bi = a2r * b1i + a2i * b1r + b2i
    return ar, ai, br, bi


def s5_mixer(u, lam_re, lam_im, log_dt, b_re, b_im, c_re, c_im, d_skip, glu_w, glu_b):
    bsz, t_len = u.shape[0], u.shape[1]
    ug = u.reshape(bsz, t_len, SSM_GROUPS, SSM_GROUP).astype(jnp.float32)
    dt = jnp.exp(log_dt.astype(jnp.float32))[:, None]
    lr, li = lam_re.astype(jnp.float32), lam_im.astype(jnp.float32)
    mag = jnp.exp(lr * dt)
    ab_re, ab_im = mag * jnp.cos(li * dt), mag * jnp.sin(li * dt)
    nr, ni = ab_re - 1.0, ab_im
    den = lr * lr + li * li
    f_re, f_im = (nr * lr + ni * li) / den, (ni * lr - nr * li) / den
    br, bi = b_re.astype(jnp.float32), b_im.astype(jnp.float32)
    bb_re = f_re[..., None] * br - f_im[..., None] * bi
    bb_im = f_re[..., None] * bi + f_im[..., None] * br
    bu_re = jnp.einsum("btgh,gph->tbgp", ug, bb_re)
    bu_im = jnp.einsum("btgh,gph->tbgp", ug, bb_im)
    a_re = jnp.broadcast_to(ab_re[None, None], (t_len, 1, SSM_GROUPS, SSM_STATE))
    a_im = jnp.broadcast_to(ab_im[None, None], (t_len, 1, SSM_GROUPS, SSM_STATE))
    _, _, x_re, x_im = lax.associative_scan(_cplx_combine, (a_re, a_im, bu_re, bu_im), axis=0)
    y = (jnp.einsum("gho,tbgo->btgh", c_re.astype(jnp.float32), x_re)
         - jnp.einsum("gho,tbgo->btgh", c_im.astype(jnp.float32), x_im))
    y = y + d_skip.astype(jnp.float32).reshape(SSM_GROUPS, SSM_GROUP) * ug
    zg = jax.nn.gelu(y)
    gate = jnp.einsum("btgh,ghk->btgk", zg, glu_w.astype(jnp.float32)) + glu_b.astype(jnp.float32)
    out = zg * jax.nn.sigmoid(gate)
    return out.reshape(bsz, t_len, SSM_DIM).astype(u.dtype)


def hier_moe(h, wg, bg, we, be, w1, w3, w2):
    bsz, t_len, d = h.shape
    t = h.reshape(-1, d)
    lg = (t @ wg).astype(jnp.float32) + bg.astype(jnp.float32)
    pg = jax.nn.softmax(lg, axis=-1)
    g_sel = jnp.argmax(lg, axis=-1)
    pg_sel = jnp.take_along_axis(pg, g_sel[:, None], axis=-1)
    le = ((t @ we).astype(jnp.float32) + be.astype(jnp.float32)).reshape(-1, N_EXPERT_GROUPS, EXPERTS_PER_GROUP)
    le_sel = jnp.take_along_axis(le, g_sel[:, None, None], axis=1)[:, 0]
    top_v, top_i = lax.top_k(le_sel, TOP_K_INNER)
    pe = jax.nn.softmax(top_v, axis=-1) * pg_sel
    e_idx = g_sel[:, None] * EXPERTS_PER_GROUP + top_i
    gates = jnp.sum(jax.nn.one_hot(e_idx, N_EXPERTS, dtype=jnp.float32) * pe[..., None], axis=1)
    out = jnp.zeros(t.shape, jnp.float32)
    for e in range(N_EXPERTS):
        y = (jax.nn.silu(t @ w1[e]) * (t @ w3[e])) @ w2[e]
        out = out + gates[:, e:e + 1] * y.astype(jnp.float32)
    return out.reshape(bsz, t_len, d).astype(h.dtype)


def setup_inputs(seed: int = 0) -> dict:
    key = jax.random.key(seed)
    ks = jax.random.split(key, 32)
    nrm = lambda k, shape, s: jax.random.normal(k, shape, jnp.float32) * s
    L, D = DEPTH, D_MODEL
    n_idx = jnp.arange(SSM_STATE, dtype=jnp.float32)
    lam_im = jnp.broadcast_to(math.pi * n_idx, (L, SSM_GROUPS, SSM_STATE)) + nrm(ks[9], (L, SSM_GROUPS, SSM_STATE), 0.01)
    lam_re = -0.5 + nrm(ks[10], (L, SSM_GROUPS, SSM_STATE), 0.01)
    log_dt = jax.random.uniform(ks[11], (L, SSM_GROUPS), jnp.float32, math.log(1e-3), math.log(1e-1))
    return {
        "x": nrm(ks[0], (BATCH, SEQ, D), 1.0),
        "meta_tokens": nrm(ks[1], (N_META, D), 1.0),
        "norm_mix_g": 1.0 + nrm(ks[2], (L, D), 0.02),
        "w_in": nrm(ks[3], (L, D, D_IN), D ** -0.5),
        "fgate_b": 3.0 + nrm(ks[4], (L, ATT_HEADS), 1.0),
        "conv_w": nrm(ks[5], (L, CONV_WIDTH, CONV_DIM), CONV_WIDTH ** -0.5),
        "conv_b": nrm(ks[6], (L, CONV_DIM), 0.02),
        "conv_ln_g": 1.0 + nrm(ks[7], (L, CONV_DIM), 0.02),
        "conv_ln_b": nrm(ks[8], (L, CONV_DIM), 0.02),
        "att_norm_g": 1.0 + nrm(ks[12], (L, ATT_DIM), 0.02),
        "ssm_lam_re": lam_re,
        "ssm_lam_im": lam_im,
        "ssm_log_dt": log_dt,
        "ssm_b_re": nrm(ks[13], (L, SSM_GROUPS, SSM_STATE, SSM_GROUP), (2 * SSM_GROUP) ** -0.5),
        "ssm_b_im": nrm(ks[14], (L, SSM_GROUPS, SSM_STATE, SSM_GROUP), (2 * SSM_GROUP) ** -0.5),
        "ssm_c_re": nrm(ks[15], (L, SSM_GROUPS, SSM_GROUP, SSM_STATE), (2 * SSM_STATE) ** -0.5),
        "ssm_c_im": nrm(ks[16], (L, SSM_GROUPS, SSM_GROUP, SSM_STATE), (2 * SSM_STATE) ** -0.5),
        "ssm_d": nrm(ks[17], (L, SSM_DIM), 1.0),
        "ssm_glu_w": nrm(ks[18], (L, SSM_GROUPS, SSM_GROUP, SSM_GROUP), SSM_GROUP ** -0.5),
        "ssm_glu_b": nrm(ks[19], (L, SSM_GROUPS, SSM_GROUP), 0.02),
        "ssm_norm_g": 1.0 + nrm(ks[20], (L, SSM_DIM), 0.02),
        "w_out": nrm(ks[21], (L, D_MIX, D), D_MIX ** -0.5),
        "norm_ffn_g": 1.0 + nrm(ks[22], (L, D), 0.02),
        "router_g_w": nrm(ks[23], (L, D, N_EXPERT_GROUPS), D ** -0.5),
        "router_g_b": nrm(ks[24], (L, N_EXPERT_GROUPS), 0.01),
        "router_e_w": nrm(ks[25], (L, D, N_EXPERTS), D ** -0.5),
        "router_e_b": nrm(ks[26], (L, N_EXPERTS), 0.01),
        "exp_w1": nrm(ks[27], (L, N_EXPERTS, D, D_FF_EXPERT), D ** -0.5),
        "exp_w3": nrm(ks[28], (L, N_EXPERTS, D, D_FF_EXPERT), D ** -0.5),
        "exp_w2": nrm(ks[29], (L, N_EXPERTS, D_FF_EXPERT, D), D_FF_EXPERT ** -0.5),
        "final_norm_g": 1.0 + nrm(ks[30], (D,), 0.02),
    }


def reference(x, meta_tokens, norm_mix_g, w_in, fgate_b, conv_w, conv_b, conv_ln_g, conv_ln_b,
              att_norm_g, ssm_lam_re, ssm_lam_im, ssm_log_dt, ssm_b_re, ssm_b_im, ssm_c_re,
              ssm_c_im, ssm_d, ssm_glu_w, ssm_glu_b, ssm_norm_g, w_out, norm_ffn_g,
              router_g_w, router_g_b, router_e_w, router_e_b, exp_w1, exp_w3, exp_w2,
              final_norm_g):
    bsz = x.shape[0]
    meta = jnp.broadcast_to(meta_tokens[None].astype(x.dtype), (bsz, N_META, D_MODEL))
    h = jnp.concatenate([meta, x], axis=1)
    t_len = h.shape[1]
    for l in range(DEPTH):
        z = rms_norm(h, norm_mix_g[l])
        proj = z @ w_in[l]
        cv_a, cv_g, q, k, v, f_lg, s_u = jnp.split(proj, IN_SPLITS, axis=-1)
        y_conv = conformer_conv(cv_a, cv_g, conv_w[l], conv_b[l], conv_ln_g[l], conv_ln_b[l])
        hs = (bsz, t_len, ATT_HEADS, ATT_HEAD_DIM)
        y_att = forgetting_attention(q.reshape(hs), k.reshape(hs), v.reshape(hs),
                                     f_lg + fgate_b[l].astype(f_lg.dtype))
        y_ssm = s5_mixer(s_u, ssm_lam_re[l], ssm_lam_im[l], ssm_log_dt[l], ssm_b_re[l], ssm_b_im[l],
                         ssm_c_re[l], ssm_c_im[l], ssm_d[l], ssm_glu_w[l], ssm_glu_b[l])
        mixed = jnp.concatenate([y_conv, rms_norm(y_att, att_norm_g[l]),
                                 rms_norm(y_ssm, ssm_norm_g[l])], axis=-1)
        h = h + mixed @ w_out[l]
        h = h + hier_moe(rms_norm(h, norm_ffn_g[l]), router_g_w[l], router_g_b[l],
                         router_e_w[l], router_e_b[l], exp_w1[l], exp_w3[l], exp_w2[l])
    return rms_norm(h, final_norm_g)[:, N_META:]
```

```cpp
#include <hip/hip_runtime.h>
#include <cstdio>
#include <cstdint>

#ifndef DUP_ATT
#define DUP_ATT 1
#endif
#ifndef DUP_CS
#define DUP_CS 1
#endif
#ifndef DUP_G1
#define DUP_G1 1
#endif
#ifndef DUP_MIX
#define DUP_MIX 1
#endif
#ifndef DUP_E1
#define DUP_E1 1
#endif
#ifndef DUP_P0
#define DUP_P0 1
#endif
#ifndef MK_PER_PHASE
#define MK_PER_PHASE 0
#endif

#define LAS __attribute__((address_space(3)))
#define GAS __attribute__((address_space(1)))
typedef unsigned short bf16_t;
typedef short bf16x8 __attribute__((ext_vector_type(8)));
typedef short s16x4 __attribute__((ext_vector_type(4)));
typedef float f32x4 __attribute__((ext_vector_type(4)));
typedef float f32x2 __attribute__((ext_vector_type(2)));
typedef float f32x16 __attribute__((ext_vector_type(16)));
typedef unsigned u32x4 __attribute__((ext_vector_type(4)));
typedef unsigned u32x2 __attribute__((ext_vector_type(2)));

constexpr int NB = 8, SEQ = 4096, NMETA = 16, DM = 1024, DEPTH = 2;
constexpr int NREAL = NB * SEQ;
constexpr int NTOK = NREAL + NMETA;
constexpr int MROWS = 33024;
constexpr int DUMMY_ROW = NTOK;
constexpr int PJ = 2304;
constexpr int NIN = 2560;
constexpr int DINSRC = 2312;
constexpr int PQ = 512, PK = 1024, PV = 1536, PU = 2048;
constexpr int MX_ATT = 0, MX_SSM = 512, MX_CONV = 768;
constexpr int NCLS = 24;
constexpr float EPS = 1e-6f;
constexpr float LOG2E = 1.4426950408889634f;
constexpr int H1CAP = 40960;

constexpr size_t MiB = 1u << 20;
constexpr size_t WS_CTL = 0, CTL_BYTES = 1 * MiB;
constexpr size_t WS_WIN = 2 * MiB, WS_WOUT = 12 * MiB, WS_W13 = 16 * MiB, WS_W2C = 48 * MiB, WS_WR = 96 * MiB;
constexpr size_t WS_H = 100 * MiB, WS_PROJ = 165 * MiB, WS_MIX = 311 * MiB, WS_H1 = 376 * MiB;
constexpr size_t WS_FLOG = 416 * MiB, WS_SSQ1 = 418 * MiB, WS_SSQ2 = 421 * MiB, WS_SSQA = 424 * MiB, WS_SSQS = 426 * MiB, WS_TINFO = 429 * MiB, WS_LIST = 430 * MiB, WS_S5T = 434 * MiB, WS_END = 440 * MiB;
constexpr int CW_TMO = 0, CW_BAR = 4096, CW_CNT = 16384;

constexpr int RING_BYTES = 131072;
constexpr int LDSCTL_OFF = RING_BYTES;
constexpr int LDS_BYTES = 147456;
constexpr int NWAVES = 8;

#define LDS_WAIT() asm volatile("s_waitcnt lgkmcnt(0)" ::: "memory")
#define VM_WAIT() asm volatile("s_waitcnt vmcnt(0)" ::: "memory")

__device__ __forceinline__ unsigned f2bf(float f) { unsigned u = __float_as_uint(f); return (u + 0x7fffu + ((u >> 16) & 1u)) >> 16; }
__device__ __forceinline__ unsigned pk2(float lo, float hi) { return f2bf(lo) | (f2bf(hi) << 16); }
__device__ __forceinline__ float bflo(unsigned w) { return __uint_as_float(w << 16); }
__device__ __forceinline__ float bfhi(unsigned w) { return __uint_as_float(w & 0xffff0000u); }
__device__ __forceinline__ float bf2f(bf16_t b) { return __uint_as_float(((unsigned)b) << 16); }
__device__ __forceinline__ unsigned cvt_pk_bf16(float lo, float hi) { unsigned r; asm volatile("v_cvt_pk_bf16_f32 %0, %1, %2" : "=v"(r) : "v"(lo), "v"(hi)); return r; }
__device__ __forceinline__ float wave_sum(float v) {
#pragma unroll
    for (int o = 1; o < 64; o <<= 1) v += __shfl_xor(v, o);
    return v;
}
__device__ __forceinline__ float fast_exp2(float x) { return __builtin_amdgcn_exp2f(x); }
__device__ __forceinline__ float fast_rcp(float x) { return __builtin_amdgcn_rcpf(x); }
__device__ __forceinline__ float sigmoidf_(float x) { return fast_rcp(1.f + fast_exp2(-x * LOG2E)); }
__device__ __forceinline__ float siluf_(float x) { return x * sigmoidf_(x); }
__device__ __forceinline__ int rowof(int b, int t) { return t < NMETA ? NREAL + t : b * SEQ + (t - NMETA); }

namespace pg8 {
constexpr int BM = 256, BK = 64, HALF = 128, HTB = HALF * BK * 2, STAGE_BYTES = 8 * HTB;
__host__ __device__ __forceinline__ int lds_byte(int r, int c) { const int st = (r >> 4) * 2 + (c >> 5), rr = r & 15, cc = c & 31, ob = rr * 64 + cc * 2; return st * 1024 + (ob ^ (((ob >> 9) & 1) << 5)); }
__host__ __device__ __forceinline__ void stage_rc(int b, int& R, int& C) { const int st = b / 1024, sb = b % 1024, swz = sb ^ (((sb >> 9) & 1) << 5); R = (st >> 1) * 16 + swz / 64; C = (st & 1) * 32 + (swz % 64) / 2; }
__host__ __device__ __forceinline__ int perm32(int rho) { const int n = rho >> 4, i = rho & 15; return 8 * (i >> 2) + 4 * n + (i & 3); }

struct Unit { int pm, pn, cls, p0; };

template <class Epi, class Sched, bool ALIGN_EPI, bool GATHER, bool BSPLIT = false>
__device__ __forceinline__ void gemm_phase(LAS unsigned char* lds, const int tid, const int K, const int ldb, const Sched& S, const Epi& E) {
    const int wid = __builtin_amdgcn_readfirstlane(tid >> 6), lane = tid & 63, wr = wid >> 2, wc = wid & 3, fr = lane & 15, fq = lane >> 4;
    const int nt = K / BK;
    unsigned voffA[2], voffB[2]; int RA[2], CA[2];
#pragma unroll
    for (int i = 0; i < 2; ++i) { int R, C; stage_rc(tid * 16 + i * 8192, R, C); const int Rb = (R & ~31) + perm32(R & 31);
        voffA[i] = (unsigned)(R * K + C) * 2u; voffB[i] = (unsigned)(Rb * ldb + C) * 2u; RA[i] = R; CA[i] = C; }
    const size_t kstep = (size_t)(BK * 2);
    const size_t hstepA = (size_t)HALF * K * 2, hstepB = (size_t)HALF * ldb * 2;
    const size_t pstepA = (size_t)64 * K * 2, pstepB = (size_t)64 * ldb * 2;
    const unsigned ldsw = (unsigned)wid * 1024u;
    const int aoff = lds_byte(wr * 64 + fr, fq * 8), boff = lds_byte(wc * 32 + fr, fq * 8);
#define PG8_SA(b, h) (((b) * 2 + (h)) * HTB)
#define PG8_SB(b, h) ((4 + (b) * 2 + (h)) * HTB)
#define PG8_STAGE(bufoff, gbase, voff) do { _Pragma("unroll") for (int _i = 0; _i < 2; ++_i) \
        __builtin_amdgcn_global_load_lds((const unsigned*)((const char*)(gbase) + (voff)[_i]), (LAS unsigned*)(lds + (bufoff) + ldsw + _i * 8192), 16, 0, 0); } while (0)
#define PG8_STAGE1(bufoff, gbase, voff1, step) do { _Pragma("unroll") for (int _i = 0; _i < 2; ++_i) \
        __builtin_amdgcn_global_load_lds((const unsigned*)((const char*)(gbase) + (size_t)_i * (step) + (voff1)), (LAS unsigned*)(lds + (bufoff) + ldsw + _i * 8192), 16, 0, 0); } while (0)
#define PG8_LDA(dst, b, h) do { _Pragma("unroll") for (int m = 0; m < 4; ++m) _Pragma("unroll") for (int k = 0; k < 2; ++k) dst[m][k] = *(const LAS bf16x8*)(lds + PG8_SA(b, h) + aoff + m * 2048 + k * 1024); } while (0)
#define PG8_LDB(dst, b, h) do { _Pragma("unroll") for (int n = 0; n < 2; ++n) _Pragma("unroll") for (int k = 0; k < 2; ++k) dst[n][k] = *(const LAS bf16x8*)(lds + PG8_SB(b, h) + boff + n * 2048 + k * 1024); } while (0)
#define PG8_MMA(ai, bj, At, Bt) do { __builtin_amdgcn_s_setprio(1); _Pragma("unroll") for (int m = 0; m < 4; ++m) _Pragma("unroll") for (int n = 0; n < 2; ++n) _Pragma("unroll") for (int k = 0; k < 2; ++k) \
        acc[ai][bj][m][n] = __builtin_amdgcn_mfma_f32_16x16x32_bf16(Bt[n][k], At[m][k], acc[ai][bj][m][n], 0, 0, 0); __builtin_amdgcn_s_setprio(0); } while (0)
#define PG8_WAIT_V(n) asm volatile("s_waitcnt vmcnt(" #n ")" ::: "memory")
#define PG8_WAIT_L(n) asm volatile("s_waitcnt lgkmcnt(" #n ")" ::: "memory")
#define PG8_BAR __builtin_amdgcn_s_barrier()
#define PG8_SCHED __builtin_amdgcn_sched_barrier(0)
    Unit cur, nxt; int ui = 0;
    if (!S.next(0, cur)) return;
    f32x4 acc[2][2][4][2];
#pragma unroll
    for (int a = 0; a < 2; ++a)
#pragma unroll
        for (int b = 0; b < 2; ++b)
#pragma unroll
            for (int m = 0; m < 4; ++m)
#pragma unroll
                for (int n = 0; n < 2; ++n) acc[a][b][m][n] = (f32x4){0.f, 0.f, 0.f, 0.f};
    bf16x8 At[4][2], B0[2][2], B1[2][2];
    const char* cA = S.abase(cur); const char* cB = S.bbase(cur);
    const char* cB2 = cB; const int ksp = BSPLIT ? nt / 2 : (1 << 30);
    if constexpr (BSPLIT) cB2 = S.bbase2(cur) - (size_t)ksp * kstep;
    unsigned oC[2][2], oN[2][2];
    if constexpr (GATHER) {
#pragma unroll
        for (int h = 0; h < 2; ++h)
#pragma unroll
            for (int i = 0; i < 2; ++i) oC[h][i] = (unsigned)S.rowtok(cur, h * HALF + RA[i]) * (unsigned)(K * 2) + (unsigned)(CA[i] * 2);
    }
    PG8_STAGE1(PG8_SB(0, 0), cB, voffB[0], pstepB); PG8_STAGE1(PG8_SB(0, 1), cB + hstepB, voffB[0], pstepB);
    if constexpr (GATHER) { PG8_STAGE(PG8_SA(0, 0), cA, oC[0]); PG8_STAGE(PG8_SA(0, 1), cA, oC[1]); }
    else { PG8_STAGE1(PG8_SA(0, 0), cA, voffA[0], pstepA); PG8_STAGE1(PG8_SA(0, 1), cA + hstepA, voffA[0], pstepA); }
    if (wr == 1) PG8_BAR;
    PG8_WAIT_V(2); PG8_BAR;
    PG8_STAGE1(PG8_SB(1, 0), cB + kstep, voffB[0], pstepB);
    if constexpr (GATHER) { PG8_STAGE(PG8_SA(1, 0), cA + kstep, oC[0]); } else { PG8_STAGE1(PG8_SA(1, 0), cA + kstep, voffA[0], pstepA); }
    PG8_STAGE1(PG8_SB(1, 1), cB + hstepB + kstep, voffB[0], pstepB);
    PG8_WAIT_V(6); PG8_BAR;
    for (;;) {
        const bool has_next = S.next(ui + 1, nxt);
        const char* nA = has_next ? S.abase(nxt) : cA; const char* nB = has_next ? S.bbase(nxt) : cB;
        const char* nB2 = nB; if constexpr (BSPLIT) nB2 = has_next ? S.bbase2(nxt) - (size_t)ksp * kstep : cB2;
        if constexpr (GATHER) {
#pragma unroll
            for (int h = 0; h < 2; ++h)
#pragma unroll
                for (int i = 0; i < 2; ++i) oN[h][i] = has_next ? (unsigned)S.rowtok(nxt, h * HALF + RA[i]) * (unsigned)(K * 2) + (unsigned)(CA[i] * 2) : oC[h][i];
        }
        for (int t = 0; t < nt; t += 2) {
            const bool last = (t == nt - 2);
            const char* a1 = cA + (size_t)(t + 1) * kstep;
            const char* a2 = last ? nA : cA + (size_t)(t + 2) * kstep; const char* b2 = last ? nB : ((t + 2 < ksp) ? cB : cB2) + (size_t)(t + 2) * kstep;
            const char* a3 = a2 + kstep; const char* b3 = b2 + kstep;
            unsigned s0[2], s1[2];
            if constexpr (GATHER) { s0[0] = last ? oN[0][0] : oC[0][0]; s0[1] = last ? oN[0][1] : oC[0][1]; s1[0] = last ? oN[1][0] : oC[1][0]; s1[1] = last ? oN[1][1] : oC[1][1]; }
            PG8_LDB(B0, 0, 0); PG8_LDB(B1, 0, 1); PG8_SCHED; PG8_LDA(At, 0, 0);
            if constexpr (GATHER) { PG8_STAGE(PG8_SA(1, 1), a1, oC[1]); } else { PG8_STAGE1(PG8_SA(1, 1), a1 + hstepA, voffA[0], pstepA); }
            PG8_WAIT_V(8); PG8_WAIT_L(0); PG8_BAR; PG8_MMA(0, 0, At, B0); PG8_MMA(0, 1, At, B1); PG8_BAR; PG8_SCHED;
            PG8_LDA(At, 0, 1); PG8_STAGE1(PG8_SB(0, 0), b2, voffB[0], pstepB); PG8_STAGE1(PG8_SB(0, 1), b2 + hstepB, voffB[0], pstepB);
            if constexpr (GATHER) { PG8_STAGE(PG8_SA(0, 0), a2, s0); } else { PG8_STAGE1(PG8_SA(0, 0), a2, voffA[0], pstepA); }
            PG8_WAIT_V(8); PG8_WAIT_L(0); PG8_BAR; PG8_MMA(1, 0, At, B0); PG8_MMA(1, 1, At, B1); PG8_BAR; PG8_SCHED;
            PG8_LDB(B0, 1, 0); PG8_LDB(B1, 1, 1); PG8_SCHED; PG8_LDA(At, 1, 0);
            if constexpr (GATHER) { PG8_STAGE(PG8_SA(0, 1), a2, s1); } else { PG8_STAGE1(PG8_SA(0, 1), a2 + hstepA, voffA[0], pstepA); }
            PG8_WAIT_V(8); PG8_WAIT_L(0); PG8_BAR; PG8_MMA(0, 0, At, B0); PG8_MMA(0, 1, At, B1); PG8_BAR; PG8_SCHED;
            PG8_LDA(At, 1, 1); PG8_STAGE1(PG8_SB(1, 0), b3, voffB[0], pstepB); PG8_STAGE1(PG8_SB(1, 1), b3 + hstepB, voffB[0], pstepB);
            if constexpr (GATHER) { PG8_STAGE(PG8_SA(1, 0), a3, s0); } else { PG8_STAGE1(PG8_SA(1, 0), a3, voffA[0], pstepA); }
            PG8_WAIT_V(8); PG8_WAIT_L(0); PG8_BAR; PG8_MMA(1, 0, At, B0); PG8_MMA(1, 1, At, B1); PG8_BAR; PG8_SCHED;
        }
        if constexpr (ALIGN_EPI) { if (wr == 0) PG8_BAR; }
        { int ln_; asm volatile("v_mbcnt_lo_u32_b32 %0, -1, 0\n\tv_mbcnt_hi_u32_b32 %0, -1, %0" : "=v"(ln_)); E(acc, cur, wr, wc, ln_ & 15, ln_ >> 4); }
        if (!has_next) break;
#pragma unroll
        for (int a = 0; a < 2; ++a)
#pragma unroll
            for (int b = 0; b < 2; ++b)
#pragma unroll
                for (int m = 0; m < 4; ++m)
#pragma unroll
                    for (int n = 0; n < 2; ++n) acc[a][b][m][n] = (f32x4){0.f, 0.f, 0.f, 0.f};
        cur = nxt; cA = nA; cB = nB; cB2 = nB2; ++ui;
        if constexpr (GATHER) {
#pragma unroll
            for (int h = 0; h < 2; ++h)
#pragma unroll
                for (int i = 0; i < 2; ++i) oC[h][i] = oN[h][i];
        }
        if constexpr (ALIGN_EPI) { if (wr == 1) PG8_BAR; }
    }
    PG8_WAIT_V(0);
    if constexpr (!ALIGN_EPI) { if (wr == 0) PG8_BAR; }
    PG8_BAR;
#undef PG8_SA
#undef PG8_SB
#undef PG8_STAGE
#undef PG8_STAGE1
#undef PG8_LDA
#undef PG8_LDB
#undef PG8_MMA
#undef PG8_WAIT_V
#undef PG8_WAIT_L
#undef PG8_BAR
#undef PG8_SCHED
}
}
using pg8::Unit;

struct DenseOrder {
    const char* A; const char* Bt; size_t tstepA, tstepB; int nM, nN, nwg, G, c;
    __device__ __forceinline__ void init(const void* A_, const void* Bt_, int M, int N, int K, int ldb, int G_, int c_) {
        A = (const char*)A_; Bt = (const char*)Bt_; tstepA = (size_t)256 * K * 2; tstepB = (size_t)256 * ldb * 2; nM = M / 256; nN = N / 256; nwg = nM * nN; G = G_; c = c_; }
    __device__ __forceinline__ bool next(int i, Unit& u) const {
        const long L = (long)i * G + c; if (L >= nwg) return false;
        int wgid = (int)L; { const int q = nwg / 8, r = nwg % 8, xcd = wgid % 8, off = wgid / 8; wgid = (xcd < r ? xcd * (q + 1) : r * (q + 1) + (xcd - r) * q) + off; }
        const int nig = 8 * nN, gid = wgid / nig, fm = gid * 8, gsz = (nM - fm) < 8 ? (nM - fm) : 8;
        u.pm = fm + ((wgid % nig) % gsz); u.pn = (wgid % nig) / gsz; u.cls = 0; u.p0 = 0; return true;
    }
    __device__ __forceinline__ const char* abase(const Unit& u) const { return A + (size_t)u.pm * tstepA; }
    __device__ __forceinline__ const char* bbase(const Unit& u) const { return Bt + (size_t)u.pn * tstepB; }
    __device__ __forceinline__ const char* bbase2(const Unit& u) const { return bbase(u); }
    __device__ __forceinline__ int rowtok(const Unit&, int) const { return 0; }
};

__device__ __forceinline__ void cls_experts(int cls, int& eA, int& eB) { const int g = cls / 6, p = cls % 6; const int a = (p >= 3) + (p >= 5), b = p < 3 ? p + 1 : (p < 5 ? p - 1 : 3); eA = 4 * g + a; eB = 4 * g + b; }
struct ExpertOrder {
    const LAS int* tb; const LAS int* cn; const int* list; const char* A; const char* W; int G, c, mode, layer;
    __device__ __forceinline__ bool next(int i, Unit& u) const {
        const int nwg = __builtin_amdgcn_readfirstlane(tb[NCLS]) * 4; const long L = (long)i * G + c; if (L >= nwg) return false;
        int wgid = (int)L; { const int q = nwg / 8, r = nwg % 8, xcd = wgid % 8, off = wgid / 8; wgid = (xcd < r ? xcd * (q + 1) : r * (q + 1) + (xcd - r) * q) + off; }
        const int rt = wgid >> 2; int cls = 0;
        for (int k = 1; k < NCLS; ++k) cls += (rt >= tb[k]) ? 1 : 0;
        cls = __builtin_amdgcn_readfirstlane(cls);
        u.pm = rt; u.pn = wgid & 3; u.cls = cls; u.p0 = __builtin_amdgcn_readfirstlane((rt - tb[cls]) * 256); return true;
    }
    __device__ __forceinline__ const char* abase(const Unit& u) const { return mode == 1 ? A : A + (size_t)u.pm * (256 * 512 * 2); }
    __device__ __forceinline__ const char* bbase(const Unit& u) const {
        if (mode == 1) { int eA, eB; cls_experts(u.cls, eA, eB); const int e = (u.pn >> 1) ? eB : eA; return W + ((size_t)(layer * 16 + e) * 512 + (size_t)(u.pn & 1) * 256) * (1024 * 2); }
        int eA, eB; cls_experts(u.cls, eA, eB); return W + ((size_t)(layer * 16 + eA) * 1024 + (size_t)u.pn * 256) * (256 * 2);
    }
    __device__ __forceinline__ const char* bbase2(const Unit& u) const { int eA, eB; cls_experts(u.cls, eA, eB); return W + ((size_t)(layer * 16 + eB) * 1024 + (size_t)u.pn * 256) * (256 * 2); }
    __device__ __forceinline__ int rowtok(const Unit& u, int rr) const { const int pos = u.p0 + rr; return pos < cn[u.cls] ? list[(size_t)u.cls * NTOK + pos] : DUMMY_ROW; }
};

__device__ __forceinline__ float row_rstd16(const float* ssq, int row, int fq, float inv_n) {
    const f32x4 v = *(const f32x4*)(ssq + (size_t)row * 16 + 4 * fq);
    float s = (v.x + v.y) + (v.z + v.w);
    s += __shfl_xor(s, 16); s += __shfl_xor(s, 32);
    return rsqrtf(s * inv_n + EPS);
}

struct EpiProj {
    bf16_t* proj; float* flog; const float* ssq1; const float* fb;
    __device__ __forceinline__ void operator()(const f32x4 (&acc)[2][2][4][2], const Unit& u, int wr, int wc, int fr, int fq) const {
#pragma unroll
        for (int ai = 0; ai < 2; ++ai)
#pragma unroll
            for (int m = 0; m < 4; ++m) {
                const int row = u.pm * 256 + ai * 128 + wr * 64 + m * 16 + fr;
                const float rs = row_rstd16(ssq1, row, fq, 1.f / DM);
                if (u.pn < 9) {
#pragma unroll
                    for (int bj = 0; bj < 2; ++bj) { const f32x4 v0 = acc[ai][bj][m][0] * rs, v1 = acc[ai][bj][m][1] * rs; u32x4 w;
                        w.x = cvt_pk_bf16(v0[0], v0[1]); w.y = cvt_pk_bf16(v0[2], v0[3]); w.z = cvt_pk_bf16(v1[0], v1[1]); w.w = cvt_pk_bf16(v1[2], v1[3]);
                        *(u32x4*)(proj + (size_t)row * PJ + u.pn * 256 + bj * 128 + wc * 32 + 8 * fq) = w; }
                } else if (wc == 0 && fq == 0) {
                    f32x4 o0, o1;
#pragma unroll
                    for (int e = 0; e < 4; ++e) { const float f0 = acc[ai][0][m][0][e] * rs + fb[e], f1 = acc[ai][0][m][1][e] * rs + fb[4 + e];
                        o0[e] = -log2f(1.f + exp2f(-f0 * LOG2E)); o1[e] = -log2f(1.f + exp2f(-f1 * LOG2E)); }
                    *(f32x4*)(flog + (size_t)row * 8) = o0; *(f32x4*)(flog + (size_t)row * 8 + 4) = o1;
                }
            }
    }
};
template <bool TOKMAP> struct EpiRes {
    bf16_t* h; float* ssq; const LAS int* cn; const int* list;
    __device__ __forceinline__ void operator()(const f32x4 (&acc)[2][2][4][2], const Unit& u, int wr, int wc, int fr, int fq) const {
#pragma unroll
        for (int ai = 0; ai < 2; ++ai)
#pragma unroll
            for (int m = 0; m < 4; ++m) {
                const int rr = ai * 128 + wr * 64 + m * 16 + fr; int row;
                if constexpr (TOKMAP) { const int pos = u.p0 + rr; row = pos < cn[u.cls] ? list[(size_t)u.cls * NTOK + pos] : DUMMY_ROW; } else row = u.pm * 256 + rr;
                float sq = 0.f;
#pragma unroll
                for (int bj = 0; bj < 2; ++bj) { bf16_t* p = h + (size_t)row * DM + u.pn * 256 + bj * 128 + wc * 32 + 8 * fq; const u32x4 o = *(const u32x4*)p;
                    const f32x4 a0 = acc[ai][bj][m][0], a1 = acc[ai][bj][m][1]; u32x4 w;
                    w.x = cvt_pk_bf16(bflo(o.x) + a0[0], bfhi(o.x) + a0[1]); w.y = cvt_pk_bf16(bflo(o.y) + a0[2], bfhi(o.y) + a0[3]);
                    w.z = cvt_pk_bf16(bflo(o.z) + a1[0], bfhi(o.z) + a1[1]); w.w = cvt_pk_bf16(bflo(o.w) + a1[2], bfhi(o.w) + a1[3]);
                    *(u32x4*)p = w;
                    sq += bflo(w.x) * bflo(w.x) + bfhi(w.x) * bfhi(w.x) + bflo(w.y) * bflo(w.y) + bfhi(w.y) * bfhi(w.y) + bflo(w.z) * bflo(w.z) + bfhi(w.z) * bfhi(w.z) + bflo(w.w) * bflo(w.w) + bfhi(w.w) * bfhi(w.w); }
                sq += __shfl_xor(sq, 16); sq += __shfl_xor(sq, 32);
                if (fq == 0) ssq[(size_t)row * 16 + u.pn * 4 + wc] = sq;
                if (m & 1) asm volatile("" ::: "memory");
            }
    }
};
struct EpiE1 {
    bf16_t* H1; const float* tinfo; const LAS int* cn; const int* list;
    __device__ __forceinline__ void operator()(const f32x4 (&acc)[2][2][4][2], const Unit& u, int wr, int wc, int fr, int fq) const {
#pragma unroll
        for (int ai = 0; ai < 2; ++ai)
#pragma unroll
            for (int m = 0; m < 4; ++m) {
                const int rr = ai * 128 + wr * 64 + m * 16 + fr; const int pos = u.p0 + rr;
                const int tok = pos < cn[u.cls] ? list[(size_t)u.cls * NTOK + pos] : DUMMY_ROW;
                const f32x4 ti = *(const f32x4*)(tinfo + (size_t)tok * 4);
                const float rs = ti.x, gate = (u.pn >> 1) ? ti.z : ti.y;
                float o[8];
#pragma unroll
                for (int n = 0; n < 2; ++n)
#pragma unroll
                    for (int e = 0; e < 4; ++e) { const float a = acc[ai][0][m][n][e] * rs, b = acc[ai][1][m][n][e] * rs; o[n * 4 + e] = gate * siluf_(a) * b; }
                u32x4 w; w.x = cvt_pk_bf16(o[0], o[1]); w.y = cvt_pk_bf16(o[2], o[3]); w.z = cvt_pk_bf16(o[4], o[5]); w.w = cvt_pk_bf16(o[6], o[7]);
                *(u32x4*)(H1 + (size_t)(u.pm * 256 + rr) * 512 + (u.pn >> 1) * 256 + (u.pn & 1) * 128 + wc * 32 + 8 * fq) = w;
            }
    }
};

__device__ __forceinline__ void meta_gemm16(const bf16_t* A, const bf16_t* Bt, int K, int n0, int wave, int lane, f32x4 (&acc)[2]) {
    const int m = lane & 15, q4 = lane >> 4;
    acc[0] = (f32x4){0.f, 0.f, 0.f, 0.f}; acc[1] = acc[0];
    const bf16_t* ap = A + (size_t)m * K + 8 * q4;
    const bf16_t* bp0 = Bt + (size_t)(n0 + 32 * wave + m) * K + 8 * q4; const bf16_t* bp1 = bp0 + (size_t)16 * K;
#pragma unroll 4
    for (int k0 = 0; k0 < K; k0 += 32) {
        const bf16x8 a = *(const bf16x8*)(ap + k0), b0 = *(const bf16x8*)(bp0 + k0), b1 = *(const bf16x8*)(bp1 + k0);
        acc[0] = __builtin_amdgcn_mfma_f32_16x16x32_bf16(b0, a, acc[0], 0, 0, 0);
        acc[1] = __builtin_amdgcn_mfma_f32_16x16x32_bf16(b1, a, acc[1], 0, 0, 0);
    }
}

#define XB_TMO      128
#define XB_XCNT(j)  (256  + 64 * (j))
#define XB_XSUB(j)  (1280 + 64 * (j))
#define XB_XGEN(j)  (2304 + 64 * (j))
#define XB_TOP      3328
#define XB_TOPGEN   3392
#define XCD_BAR_WORDS 3456
#define XB_SPIN_CAP (1u << 18)
__device__ __forceinline__ unsigned xb_ld(unsigned* p)              { return __hip_atomic_load(p, __ATOMIC_RELAXED, __HIP_MEMORY_SCOPE_AGENT); }
__device__ __forceinline__ unsigned xb_add(unsigned* p, unsigned v) { return __hip_atomic_fetch_add(p, v, __ATOMIC_RELAXED, __HIP_MEMORY_SCOPE_AGENT); }
__device__ __forceinline__ unsigned xb_xcc_id() { return (unsigned)__builtin_amdgcn_s_getreg((3 << 11) | 20) & 0xFu; }
#define XB_SPIN(cond, bar) do { unsigned _sp = 0; while (cond) { __builtin_amdgcn_s_sleep(1); \
    if ((++_sp & 255u) == 0u) { if (xb_ld(&(bar)[XB_TMO])) break; if (_sp > XB_SPIN_CAP) { atomicAdd(&(bar)[XB_TMO], 1u); break; } } } } while (0)
struct XcdBarrier { unsigned* bar; unsigned x; volatile LAS unsigned* st; };
__device__ __forceinline__ XcdBarrier xcd_barrier_post(unsigned* bar, volatile LAS unsigned* st) {
    XcdBarrier b; b.bar = bar; b.x = xb_xcc_id(); b.st = st;
    if (threadIdx.x == 0) (void)xb_add(&bar[XB_XCNT(b.x)], 1u);
    return b;
}
__device__ __forceinline__ void xcd_barrier_complete(unsigned* bar, unsigned x, unsigned& nloc, unsigned& nx) {
    const unsigned G = gridDim.x * gridDim.y * gridDim.z;
    unsigned sum, cnt, mine, sp = 0u;
    for (;;) {
        sum = 0u; cnt = 0u; mine = 0u;
#pragma unroll
        for (unsigned j = 0; j < 16; ++j) { const unsigned c = xb_ld(&bar[XB_XCNT(j)]); sum += c; cnt += (c > 0u) ? 1u : 0u; mine = (j == x) ? c : mine; }
        if (sum == G) break;
        __builtin_amdgcn_s_sleep(1);
        if ((++sp & 255u) == 0u) { if (xb_ld(&bar[XB_TMO])) break; if (sp > XB_SPIN_CAP) { atomicAdd(&bar[XB_TMO], 1u); break; } }
    }
    nloc = mine > 0u ? mine : 1u; nx = cnt > 0u ? cnt : 1u;
}
__device__ __forceinline__ void xcd_barrier(const XcdBarrier& b, const bool leader_thread) {
    asm volatile("s_waitcnt vmcnt(0)" ::: "memory");
    __syncthreads();
    if (leader_thread) {
        unsigned* bar = b.bar; asm volatile("" : "+s"(bar));
        __builtin_amdgcn_s_waitcnt(0);
        unsigned nloc = b.st[0], nx = b.st[1];
        if (nloc == 0u) { xcd_barrier_complete(bar, b.x, nloc, nx); b.st[0] = nloc; b.st[1] = nx; }
        const unsigned old = xb_add(&bar[XB_XSUB(b.x)], 1u);
        const unsigned gen = old / nloc;
        if (old + 1u == (gen + 1u) * nloc) {
            __builtin_amdgcn_fence(__ATOMIC_RELEASE, "agent");
            asm volatile("s_waitcnt vmcnt(0)" ::: "memory");
            const unsigned og = xb_add(&bar[XB_TOP], 1u);
            const unsigned tg = og / nx;
            if (og + 1u == (tg + 1u) * nx) xb_add(&bar[XB_TOPGEN], 1u);
            else XB_SPIN(xb_ld(&bar[XB_TOPGEN]) == tg, bar);
            __builtin_amdgcn_fence(__ATOMIC_ACQUIRE, "agent");
            xb_add(&bar[XB_XGEN(b.x)], 1u);
            asm volatile("s_waitcnt vmcnt(0)" ::: "memory");
        } else {
            XB_SPIN(xb_ld(&bar[XB_XGEN(b.x)]) == gen, bar);
            __builtin_amdgcn_fence(__ATOMIC_ACQUIRE, "agent");
            asm volatile("s_waitcnt vmcnt(0)" ::: "memory");
        }
    }
    __syncthreads();
}

template <class Get>
__device__ __forceinline__ void tr_item(const Get& get, bf16_t* dst, int dpitch, int k0, int n0, LAS float* scr, int lane) {
    float tv[32];
#pragma unroll
    for (int i = 0; i < 32; ++i) tv[i] = get(k0 + 2 * i + (lane >> 5), n0 + (lane & 31));
#pragma unroll
    for (int i = 0; i < 32; ++i) scr[(2 * i + (lane >> 5)) * 33 + (lane & 31)] = tv[i];
    LDS_WAIT(); asm volatile("" ::: "memory");
    const int c = lane & 7;
#pragma unroll
    for (int j = 0; j < 4; ++j) { const int n = (lane >> 3) + 8 * j; const LAS float* s = scr + (8 * c) * 33 + n;
        u32x4 o; o.x = pk2(s[0 * 33], s[1 * 33]); o.y = pk2(s[2 * 33], s[3 * 33]); o.z = pk2(s[4 * 33], s[5 * 33]); o.w = pk2(s[6 * 33], s[7 * 33]);
        *(u32x4*)(dst + (size_t)(n0 + n) * dpitch + k0 + 8 * c) = o; }
    LDS_WAIT(); asm volatile("" ::: "memory");
}
struct GetWin { const float* w; const float* g;
    __device__ __forceinline__ float operator()(int k, int n) const { int src; if (n < 2048) src = n; else if (n < 2304) src = n + 8; else if (n < 2312) src = n - 256; else return 0.f;
        float v = w[(size_t)k * DINSRC + src] * g[k]; if (n >= PQ && n < PK) v *= 0.125f * LOG2E; return v; } };
struct GetWout { const float* w; const float* ga; const float* gs;
    __device__ __forceinline__ float operator()(int k, int n) const { const int src = k < 768 ? k + 256 : k - 768; const float gn = k < 512 ? ga[k] : (k < 768 ? gs[k - 512] : 1.f);
        return w[(size_t)src * DM + n] * gn; } };
struct GetW13 { const float* w1; const float* w3; const float* g;
    __device__ __forceinline__ float operator()(int k, int n) const { const int u = n >> 8, hf = (n >> 7) & 1, j = n & 127; const uintptr_t wp = (uintptr_t)w1 + (uintptr_t)hf * ((uintptr_t)w3 - (uintptr_t)w1); return ((const float*)wp)[(size_t)k * 256 + u * 128 + j] * g[k]; } };
struct GetW2 { const float* w;
    __device__ __forceinline__ float operator()(int k, int n) const { return w[(size_t)k * DM + n]; } };
struct GetWr { const float* rg; const float* re; const float* g; int lo;
    __device__ __forceinline__ float operator()(int k, int n) const { float v = 0.f; if (n < 4) v = rg[(size_t)k * 4 + n]; else if (n < 20) v = re[(size_t)k * 16 + (n - 4)]; v *= g[k];
        if (lo) v = v - __uint_as_float(f2bf(v) << 16); return v; } };

constexpr int AT_SLOT = 16384, AT_CS = 65536, AT_WT = AT_CS + 4608 * 4;
__device__ __forceinline__ int crow(int r, int hi) { return (r & 3) + 8 * (r >> 2) + 4 * hi; }
__device__ __forceinline__ void attn_prefix(LAS unsigned char* lds, const int tid, const float* flog, int b, int h) {
    const int lane = tid & 63; const int w = __builtin_amdgcn_readfirstlane(tid >> 6);
    LAS float* cs = (LAS float*)(lds + AT_CS); LAS float* wt = (LAS float*)(lds + AT_WT);
    float v[9]; float run = 0.f;
#pragma unroll
    for (int i = 0; i < 9; ++i) { const int j = tid * 9 + i; float x = 0.f; if (j < NMETA + SEQ) x = flog[(size_t)rowof(b, j) * 8 + h]; run += x; v[i] = run; }
    float inc = run;
#pragma unroll
    for (int o = 1; o < 64; o <<= 1) { const float t = __shfl_up(inc, o); if (lane >= o) inc += t; }
    if (lane == 63) wt[w] = inc;
    __syncthreads();
    float base = inc - run;
    for (int k = 0; k < w; ++k) base += wt[k];
#pragma unroll
    for (int i = 0; i < 9; ++i) cs[tid * 9 + i] = base + v[i];
    __syncthreads();
}
__device__ __forceinline__ void at_glds16(const void* gsrc, unsigned lds_dst) { unsigned keep;
    asm volatile("s_mov_b32 %0, m0\n\ts_mov_b32 m0, %2\n\ts_nop 0\n\tglobal_load_lds_dwordx4 %1, off\n\ts_mov_b32 m0, %0" : "=&s"(keep) : "v"(gsrc), "s"(lds_dst) : "memory"); }
constexpr float AT_THR = 8.f;
__device__ __forceinline__ void attn_unit(LAS unsigned char* lds, const int tid, const bf16_t* proj, bf16_t* mixed, float* ssqa, int b, int h, int qt) {
    const int lane = tid & 63, r32 = lane & 31, hi = lane >> 5; const int w = __builtin_amdgcn_readfirstlane(tid >> 6);
    const LAS float* cs = (const LAS float*)(lds + AT_CS);
    const int qrel = 32 * w + r32;
    const int qrow = qt >= 0 ? b * SEQ + 256 * qt + qrel : NREAL + (qrel & 15);
    const int qkey = qt >= 0 ? NMETA + 256 * qt + qrel : (qrel & 15);
    const int qkey_w0 = qt >= 0 ? NMETA + 256 * qt + 32 * w : 0;
    const float cq = cs[qkey];
    bf16x8 qr[4];
#pragma unroll
    for (int d0 = 0; d0 < 4; ++d0) qr[d0] = *(const bf16x8*)(proj + (size_t)qrow * PJ + PQ + h * 64 + d0 * 16 + hi * 8);
    const int ntiles = qt >= 0 ? 1 + 4 * (qt + 1) : 1;
    const int wnt = qt >= 0 ? 4 * qt + (w >> 1) + 2 : 1;
    const int vr = 16 * (w & 3) + (lane >> 2);
    const unsigned ldsb = (unsigned)(uintptr_t)lds;
#define AT_DMA(jj) do { int kr_, vr_; if ((jj) == 0) { kr_ = NREAL + (lane < 15 ? lane : 15); vr_ = NREAL + (vr < 15 ? vr : 15); } else { kr_ = b * SEQ + 64 * ((jj) - 1) + lane; vr_ = b * SEQ + 64 * ((jj) - 1) + vr; } \
        const int so_ = ((jj) & 3) * AT_SLOT + w * 1024; \
        at_glds16(proj + (size_t)kr_ * PJ + PK + h * 64 + w * 8, (unsigned)__builtin_amdgcn_readfirstlane(ldsb + so_)); \
        at_glds16(proj + (size_t)vr_ * PJ + PV + h * 64 + (w >> 2) * 32 + (lane & 3) * 8, (unsigned)__builtin_amdgcn_readfirstlane(ldsb + so_ + 8192)); } while (0)
#define AT_WAITBAR(n) asm volatile("s_waitcnt vmcnt(" #n ") lgkmcnt(0)\n\ts_barrier" ::: "memory")
    float mref = 0.f, lrun = 0.f; f32x16 o0 = {}, o1 = {};
    const int kfo = hi * 1024 + r32 * 16;
    const int vb = 8192 + ((lane >> 4) & 1) * 32 + (lane & 3) * 8 + (4 * hi + ((lane & 15) >> 2)) * 64;
    const LAS float* csl = cs + 4 * hi;
#define AT_QK(P0, P1, jjn, so) do { const int kb_ = (jjn) == 0 ? 0 : NMETA + 64 * ((jjn) - 1); const float cqm = cq - mref; \
        _Pragma("unroll") for (int g_ = 0; g_ < 4; ++g_) { const f32x4 c0_ = *(const LAS f32x4*)(csl + kb_ + 8 * g_), c1_ = *(const LAS f32x4*)(csl + kb_ + 32 + 8 * g_); \
            _Pragma("unroll") for (int e_ = 0; e_ < 4; ++e_) { P0[4 * g_ + e_] = cqm - c0_[e_]; P1[4 * g_ + e_] = cqm - c1_[e_]; } } \
        _Pragma("unroll") for (int d0 = 0; d0 < 4; ++d0) { const bf16x8 k0_ = *(const LAS bf16x8*)(lds + (so) + kfo + d0 * 2048), k1_ = *(const LAS bf16x8*)(lds + (so) + kfo + d0 * 2048 + 512); \
            P0 = __builtin_amdgcn_mfma_f32_32x32x16_bf16(k0_, qr[d0], P0, 0, 0, 0); P1 = __builtin_amdgcn_mfma_f32_32x32x16_bf16(k1_, qr[d0], P1, 0, 0, 0); } } while (0)
#define AT_SMPV(P0, P1, N0, N1, jj, pend, so) do { const int kb_ = (jj) == 0 ? 0 : NMETA + 64 * ((jj) - 1); \
        if ((jj) == 0 || kb_ + 63 > qkey_w0) { const int lim_ = (jj) == 0 ? (qkey < 15 ? qkey : 15) : qkey; \
            _Pragma("unroll") for (int r = 0; r < 16; ++r) { const int j_ = kb_ + crow(r, hi); if (j_ > lim_) P0[r] = -INFINITY; if (j_ + 32 > lim_) P1[r] = -INFINITY; } } \
        float rm_ = fmaxf(P0[0], P1[0]); \
        _Pragma("unroll") for (int r = 1; r < 16; ++r) rm_ = fmaxf(rm_, fmaxf(P0[r], P1[r])); \
        rm_ = fmaxf(rm_, __shfl_xor(rm_, 32)); \
        if ((jj) == 0 || __any(rm_ > AT_THR)) { const float dl_ = (jj) == 0 ? rm_ : fmaxf(rm_, 0.f); mref += dl_; const float f_ = (jj) == 0 ? 1.f : fast_exp2(-dl_); lrun *= f_; \
            _Pragma("unroll") for (int r = 0; r < 16; ++r) { P0[r] -= dl_; P1[r] -= dl_; o0[r] *= f_; o1[r] *= f_; } \
            if (pend) { _Pragma("unroll") for (int r = 0; r < 16; ++r) { N0[r] -= dl_; N1[r] -= dl_; } } } \
        float rs_ = 0.f; \
        _Pragma("unroll") for (int r = 0; r < 16; ++r) { P0[r] = fast_exp2(P0[r]); P1[r] = fast_exp2(P1[r]); rs_ += P0[r] + P1[r]; } \
        lrun += rs_; \
        u32x4 pw_[4]; \
        _Pragma("unroll") for (int i = 0; i < 4; ++i) { pw_[0][i] = cvt_pk_bf16(P0[2 * i], P0[2 * i + 1]); pw_[1][i] = cvt_pk_bf16(P0[8 + 2 * i], P0[8 + 2 * i + 1]); \
            pw_[2][i] = cvt_pk_bf16(P1[2 * i], P1[2 * i + 1]); pw_[3][i] = cvt_pk_bf16(P1[8 + 2 * i], P1[8 + 2 * i + 1]); } \
        const LAS unsigned char* Vb_ = lds + (so) + vb; \
        _Pragma("unroll") for (int ks = 0; ks < 4; ++ks) { \
            const s16x4 a0 = __builtin_bit_cast(s16x4, __builtin_amdgcn_ds_read_tr16_b64_v4i16((LAS s16x4*)(Vb_ + ks * 1024))); \
            const s16x4 a1 = __builtin_bit_cast(s16x4, __builtin_amdgcn_ds_read_tr16_b64_v4i16((LAS s16x4*)(Vb_ + ks * 1024 + 512))); \
            const s16x4 b0 = __builtin_bit_cast(s16x4, __builtin_amdgcn_ds_read_tr16_b64_v4i16((LAS s16x4*)(Vb_ + 4096 + ks * 1024))); \
            const s16x4 b1 = __builtin_bit_cast(s16x4, __builtin_amdgcn_ds_read_tr16_b64_v4i16((LAS s16x4*)(Vb_ + 4096 + ks * 1024 + 512))); \
            const bf16x8 va = {a0[0], a0[1], a0[2], a0[3], a1[0], a1[1], a1[2], a1[3]}, vbb = {b0[0], b0[1], b0[2], b0[3], b1[0], b1[1], b1[2], b1[3]}; \
            const bf16x8 pf = __builtin_bit_cast(bf16x8, pw_[ks]); \
            o0 = __builtin_amdgcn_mfma_f32_32x32x16_bf16(va, pf, o0, 0, 0, 0); o1 = __builtin_amdgcn_mfma_f32_32x32x16_bf16(vbb, pf, o1, 0, 0, 0); } } while (0)
#define AT_STEP(C0, C1, N0, N1, jj) do { \
        const bool dma_ = (jj) + 3 < ntiles; \
        if (dma_) AT_DMA((jj) + 3); \
        const bool pend_ = (jj) + 1 < wnt; \
        if (pend_) AT_QK(N0, N1, (jj) + 1, (((jj) + 1) & 3) * AT_SLOT); \
        if ((jj) < wnt) AT_SMPV(C0, C1, N0, N1, jj, pend_, ((jj) & 3) * AT_SLOT); \
        if (dma_) AT_WAITBAR(2); else AT_WAITBAR(0); } while (0)
    AT_DMA(0);
    if (ntiles > 1) AT_DMA(1);
    if (ntiles > 2) { AT_DMA(2); AT_WAITBAR(2); } else AT_WAITBAR(0);
    f32x16 pa0, pa1, pb0, pb1;
    AT_QK(pa0, pa1, 0, 0);
#pragma unroll 1
    for (int jj = 0; jj < ntiles; jj += 2) {
        AT_STEP(pa0, pa1, pb0, pb1, jj);
        if (jj + 1 < ntiles) AT_STEP(pb0, pb1, pa0, pa1, jj + 1);
    }
#undef AT_DMA
#undef AT_WAITBAR
#undef AT_QK
#undef AT_SMPV
#undef AT_STEP
    const float ltot = lrun + __shfl_xor(lrun, 32);
    const float inv = 1.f / ltot;
    float sq = 0.f;
#pragma unroll
    for (int r = 0; r < 16; ++r) { o0[r] *= inv; o1[r] *= inv; sq += o0[r] * o0[r] + o1[r] * o1[r]; }
    sq += __shfl_xor(sq, 32);
    const bool st = qt >= 0 || qrel < 16;
    if (st) {
        bf16_t* op = mixed + (size_t)qrow * DM + MX_ATT + h * 64;
#pragma unroll
        for (int g = 0; g < 4; ++g) { u32x2 w0, w1; w0.x = cvt_pk_bf16(o0[4 * g], o0[4 * g + 1]); w0.y = cvt_pk_bf16(o0[4 * g + 2], o0[4 * g + 3]); w1.x = cvt_pk_bf16(o1[4 * g], o1[4 * g + 1]); w1.y = cvt_pk_bf16(o1[4 * g + 2], o1[4 * g + 3]);
            *(u32x2*)(op + 8 * g + 4 * hi) = w0; *(u32x2*)(op + 32 + 8 * g + 4 * hi) = w1; }
        if (hi == 0) ssqa[(size_t)qrow * 8 + h] = sq;
    }
    __syncthreads();
}

constexpr int CV_U = 0, CV_Y = 65536;
__device__ __forceinline__ void conv_subtile(LAS unsigned char* lds, const int tid, const bf16_t* proj, bf16_t* mixed, const float* cw, const float* cb, const float* lg, const float* lb, int b, int t0, int nvalid) {
    const int lane = tid & 63; const int w = __builtin_amdgcn_readfirstlane(tid >> 6);
    LAS float* ub = (LAS float*)(lds + CV_U); LAS float* yb = (LAS float*)(lds + CV_Y);
    for (int idx = tid; idx < 62 * 64; idx += 512) {
        const int rr = idx >> 6, cq4 = (idx & 63) * 4; const int t = t0 - 30 + rr; f32x4 u = {0.f, 0.f, 0.f, 0.f};
        if (t >= 0 && t < NMETA + SEQ) { const bf16_t* p = proj + (size_t)rowof(b, t) * PJ + cq4; const u32x2 a = *(const u32x2*)p, g = *(const u32x2*)(p + 256);
            u[0] = bflo(a.x) * sigmoidf_(bflo(g.x)); u[1] = bfhi(a.x) * sigmoidf_(bfhi(g.x)); u[2] = bflo(a.y) * sigmoidf_(bflo(g.y)); u[3] = bfhi(a.y) * sigmoidf_(bfhi(g.y)); }
        *(LAS f32x4*)(ub + rr * 256 + cq4) = u;
    }
    __syncthreads();
    {
        const int c = tid & 255, rh = tid >> 8;
        float wv[31];
#pragma unroll
        for (int j = 0; j < 31; ++j) wv[j] = cw[j * 256 + c];
        float acc[16];
#pragma unroll
        for (int i = 0; i < 16; ++i) acc[i] = 0.f;
#pragma unroll
        for (int rr = 0; rr < 46; ++rr) { const float uv = ub[(16 * rh + rr) * 256 + c];
#pragma unroll
            for (int i = 0; i < 16; ++i) if (rr - i >= 0 && rr - i <= 30) acc[i] += wv[rr - i] * uv; }
        const float bb = cb[c];
#pragma unroll
        for (int i = 0; i < 16; ++i) yb[(16 * rh + i) * 256 + c] = acc[i] + bb;
    }
    __syncthreads();
    {
        const f32x4 g4 = *(const f32x4*)(lg + 4 * lane), b4 = *(const f32x4*)(lb + 4 * lane);
#pragma unroll
        for (int i = 0; i < 4; ++i) { const int rr = 4 * w + i; const f32x4 y = *(const LAS f32x4*)(yb + rr * 256 + 4 * lane);
            const float mu = wave_sum((y[0] + y[1]) + (y[2] + y[3])) * (1.f / 256.f);
            const f32x4 d = y - mu; const float var = wave_sum((d[0] * d[0] + d[1] * d[1]) + (d[2] * d[2] + d[3] * d[3])) * (1.f / 256.f);
            const float rs = rsqrtf(var + EPS); f32x4 o;
#pragma unroll
            for (int e = 0; e < 4; ++e) o[e] = siluf_(d[e] * rs * g4[e] + b4[e]);
            if (rr < nvalid) { u32x2 wv2; wv2.x = cvt_pk_bf16(o[0], o[1]); wv2.y = cvt_pk_bf16(o[2], o[3]); *(u32x2*)(mixed + (size_t)rowof(b, t0 + rr) * DM + MX_CONV + 4 * lane) = wv2; } }
    }
    __syncthreads();
}

struct S5P { const float *lre, *lim, *ldt, *bre, *bim, *cre, *cim, *dsk, *gw, *gb; };
__device__ __forceinline__ float gelu_tanh(float x) { const float u = 0.7978845608028654f * (x + 0.044715f * x * x * x); const float e = fast_exp2(2.f * LOG2E * u); const float th = 1.f - 2.f * fast_rcp(e + 1.f); return 0.5f * x * (1.f + th); }
__device__ __forceinline__ void s5_seq_unit(const S5P& P, const bf16_t* proj, bf16_t* mixed, float* ssqs, int b, int g, int lane) {
    const int p = lane;
    const float dt = expf(P.ldt[g]);
    const float lr = P.lre[g * 64 + p], li = P.lim[g * 64 + p];
    const float mag = expf(lr * dt);
    const double turns = (double)li * (double)dt * 0.15915494309189535; const float fr = (float)(turns - floor(turns));
    const float ar = mag * __builtin_amdgcn_cosf(fr), ai = mag * __builtin_amdgcn_sinf(fr);
    const float nr = ar - 1.f, ni = ai, den = lr * lr + li * li;
    const float fre = (nr * lr + ni * li) / den, fim = (ni * lr - nr * li) / den;
    float bbr[16], bbi[16], cr[16], ci[16];
#pragma unroll
    for (int h = 0; h < 16; ++h) { const float br = P.bre[(g * 64 + p) * 16 + h], bi = P.bim[(g * 64 + p) * 16 + h]; bbr[h] = fre * br - fim * bi; bbi[h] = fre * bi + fim * br;
        cr[h] = P.cre[(g * 16 + h) * 64 + p]; ci[h] = P.cim[(g * 16 + h) * 64 + p]; }
    const int hl = ((lane >> 5) & 1) * 8 + ((lane >> 4) & 1) * 4 + ((lane >> 3) & 1) * 2 + ((lane >> 2) & 1);
    const float dsk = P.dsk[g * 16 + hl], gbk = P.gb[g * 16 + hl];
    float gwk[16];
#pragma unroll
    for (int h = 0; h < 16; ++h) gwk[h] = P.gw[(g * 16 + h) * 16 + hl];
    float xr = 0.f, xi = 0.f;
    u32x4 nua = *(const u32x4*)(proj + (size_t)rowof(b, 0) * PJ + PU + 16 * g), nub = *(const u32x4*)(proj + (size_t)rowof(b, 0) * PJ + PU + 16 * g + 8);
#pragma unroll 1
    for (int t = 0; t < NMETA + SEQ; ++t) {
        const int row = rowof(b, t);
        const u32x4 ua = nua, ub = nub;
        { const int tn = t + 1 < NMETA + SEQ ? t + 1 : t; const bf16_t* np = proj + (size_t)rowof(b, tn) * PJ + PU + 16 * g; nua = *(const u32x4*)np; nub = *(const u32x4*)(np + 8); }
        float u[16]; u[0] = bflo(ua.x); u[1] = bfhi(ua.x); u[2] = bflo(ua.y); u[3] = bfhi(ua.y); u[4] = bflo(ua.z); u[5] = bfhi(ua.z); u[6] = bflo(ua.w); u[7] = bfhi(ua.w);
        u[8] = bflo(ub.x); u[9] = bfhi(ub.x); u[10] = bflo(ub.y); u[11] = bfhi(ub.y); u[12] = bflo(ub.z); u[13] = bfhi(ub.z); u[14] = bflo(ub.w); u[15] = bfhi(ub.w);
        float bur = 0.f, bui = 0.f;
#pragma unroll
        for (int h = 0; h < 16; ++h) { bur += bbr[h] * u[h]; bui += bbi[h] * u[h]; }
        const float nxr = ar * xr - ai * xi + bur, nxi = ar * xi + ai * xr + bui; xr = nxr; xi = nxi;
        float v[16];
#pragma unroll
        for (int h = 0; h < 16; ++h) v[h] = cr[h] * xr - ci[h] * xi;
        float v8[8], v4[4], v2[2], v1;
        { const bool up = (lane >> 5) & 1;
#pragma unroll
          for (int i = 0; i < 8; ++i) { const float send = up ? v[i] : v[i + 8], keep = up ? v[i + 8] : v[i]; v8[i] = keep + __shfl_xor(send, 32); } }
        { const bool up = (lane >> 4) & 1;
#pragma unroll
          for (int i = 0; i < 4; ++i) { const float send = up ? v8[i] : v8[i + 4], keep = up ? v8[i + 4] : v8[i]; v4[i] = keep + __shfl_xor(send, 16); } }
        { const bool up = (lane >> 3) & 1;
#pragma unroll
          for (int i = 0; i < 2; ++i) { const float send = up ? v4[i] : v4[i + 2], keep = up ? v4[i + 2] : v4[i]; v2[i] = keep + __shfl_xor(send, 8); } }
        { const bool up = (lane >> 2) & 1; const float send = up ? v2[0] : v2[1], keep = up ? v2[1] : v2[0]; v1 = keep + __shfl_xor(send, 4); }
        v1 += __shfl_xor(v1, 2); v1 += __shfl_xor(v1, 1);
        float uh = u[0];
#pragma unroll
        for (int h = 1; h < 16; ++h) uh = (hl == h) ? u[h] : uh;
        const float y = v1 + dsk * uh;
        const float zg = gelu_tanh(y);
        float gate = gbk;
#pragma unroll
        for (int h = 0; h < 16; ++h) { const int src = ((h >> 3) & 1) * 32 + ((h >> 2) & 1) * 16 + ((h >> 1) & 1) * 8 + (h & 1) * 4; gate += __shfl(zg, src) * gwk[h]; }
        const float outv = zg * sigmoidf_(gate);
        float sq = outv * outv;
        sq += __shfl_xor(sq, 32); sq += __shfl_xor(sq, 16); sq += __shfl_xor(sq, 8); sq += __shfl_xor(sq, 4);
        if (t >= NMETA || b == 0) {
            if ((lane & 3) == 0) mixed[(size_t)row * DM + MX_SSM + 16 * g + hl] = (bf16_t)f2bf(outv);
            if (lane == 0) ssqs[(size_t)row * 16 + g] = sq;
        }
    }
}

constexpr size_t S5T_BYTES = 163840;
constexpr int S5_KT = 0, S5_WS = 8704, S5_WC = 74240, S5_MD = 139776, S5_MC = 142848;
constexpr int S5L_KT = 0, S5L_W = 8704, S5L_EX = 78336, S5L_MD = 82944, S5L_MC = 86016;
__device__ __forceinline__ void s5_tables_block(LAS unsigned char* lds, const int tid, const S5P& P, int g, unsigned char* tbl) {
    typedef float f2 __attribute__((ext_vector_type(2)));
    LAS f2* pw = (LAS f2*)lds;
    LAS f2* Bb = (LAS f2*)(lds + 8704);
    LAS f2* Cc = (LAS f2*)(lds + 16896);
    if (tid < 64) {
        const int p = tid;
        const float dt = expf(P.ldt[g]);
        const float lr = P.lre[g * 64 + p], li = P.lim[g * 64 + p];
        const float mag = expf(lr * dt);
        const double turns = (double)li * (double)dt * 0.15915494309189535; const float fr = (float)(turns - floor(turns));
        const float ar = mag * __builtin_amdgcn_cosf(fr), ai = mag * __builtin_amdgcn_sinf(fr);
        const float nr = ar - 1.f, ni = ai, den = lr * lr + li * li;
        const float fre = (nr * lr + ni * li) / den, fim = (ni * lr - nr * li) / den;
        float xr = 1.f, xi = 0.f;
        for (int t = 0; t <= 16; ++t) { pw[t * 64 + p] = (f2){xr, xi}; const float nxr = xr * ar - xi * ai, nxi = xr * ai + xi * ar; xr = nxr; xi = nxi; }
        const f2 M = pw[16 * 64 + p];
        float* MD = (float*)(tbl + S5_MD); float* MC = (float*)(tbl + S5_MC);
        float mr = M.x, mi = M.y;
        for (int k = 0; k < 6; ++k) { MD[(k * 64 + p) * 2] = mr; MD[(k * 64 + p) * 2 + 1] = mi; const float n1 = mr * mr - mi * mi, n2 = 2.f * mr * mi; mr = n1; mi = n2; }
        xr = 1.f; xi = 0.f;
        for (int c = 0; c < 32; ++c) { MC[(c * 64 + p) * 2] = xr; MC[(c * 64 + p) * 2 + 1] = xi; const float nxr = xr * M.x - xi * M.y, nxi = xr * M.y + xi * M.x; xr = nxr; xi = nxi; }
        for (int h = 0; h < 16; ++h) { const float br = P.bre[(g * 64 + p) * 16 + h], bi = P.bim[(g * 64 + p) * 16 + h]; Bb[p * 16 + h] = (f2){fre * br - fim * bi, fre * bi + fim * br}; }
    }
    for (int e = tid; e < 1024; e += 512) Cc[e] = (f2){P.cre[g * 1024 + e], P.cim[g * 1024 + e]};
    __syncthreads();
    bf16_t* KT = (bf16_t*)(tbl + S5_KT); bf16_t* WSg = (bf16_t*)(tbl + S5_WS); bf16_t* WCg = (bf16_t*)(tbl + S5_WC);
    for (int e = tid; e < 17 * 256; e += 512) {
        const int t1 = e >> 8, h = (e >> 4) & 15, h2 = e & 15; float acc = 0.f;
        if (t1 > 0) { const int tau = t1 - 1;
            for (int p = 0; p < 64; ++p) { const f2 a = pw[tau * 64 + p], bb = Bb[p * 16 + h2], c = Cc[h * 64 + p]; const float zr = a.x * bb.x - a.y * bb.y, zi = a.x * bb.y + a.y * bb.x; acc += c.x * zr - c.y * zi; }
            if (tau == 0 && h == h2) acc += P.dsk[g * 16 + h]; }
        KT[e] = (bf16_t)f2bf(acc);
    }
    for (int e = tid; e < 128 * 256; e += 512) {
        const int r = e >> 8, ri = r >> 6, p = r & 63, q = e & 255, j = q >> 4, h2 = q & 15;
        const f2 a = pw[(15 - j) * 64 + p], bb = Bb[p * 16 + h2]; const float zr = a.x * bb.x - a.y * bb.y, zi = a.x * bb.y + a.y * bb.x;
        WSg[e] = (bf16_t)f2bf(ri ? zi : zr);
    }
    for (int e = tid; e < 256 * 128; e += 512) {
        const int row = e >> 7, i = row >> 4, h = row & 15, q = e & 127; const int blk = q >> 5, sq_ = (q >> 4) & 1, hh = (q >> 3) & 1, j = q & 7;
        const int n = 32 * blk + 16 * sq_ + 8 * (j >> 2) + 4 * hh + (j & 3); const int ri = n >> 6, p = n & 63;
        const f2 a = pw[(i + 1) * 64 + p], c = Cc[h * 64 + p]; const float zr = c.x * a.x - c.y * a.y, zi = c.x * a.y + c.y * a.x;
        WCg[e] = (bf16_t)f2bf(ri ? -zi : zr);
    }
    __syncthreads();
}

__device__ __forceinline__ void s5_unit(LAS unsigned char* lds, const int tid, const unsigned char* tbl, const float* gw, const float* gb, const bf16_t* proj, bf16_t* mixed, float* ssqs, int b, int g) {
    typedef float f2 __attribute__((ext_vector_type(2)));
    const int lane = tid & 63, c = lane & 31, hi = lane >> 5; const int w = __builtin_amdgcn_readfirstlane(tid >> 6);
    for (int q = tid; q < 544; q += 512) *(LAS u32x4*)(lds + S5L_KT + q * 16) = *(const u32x4*)(tbl + S5_KT + q * 16);
#pragma unroll
    for (int it = 0; it < 8; ++it) { const int q = tid + 512 * it; *(LAS u32x4*)(lds + S5L_W + (q >> 5) * 528 + (q & 31) * 16) = *(const u32x4*)(tbl + S5_WS + q * 16); }
    if (tid < 192) *(LAS u32x4*)(lds + S5L_MD + tid * 16) = *(const u32x4*)(tbl + S5_MD + tid * 16);
#pragma unroll
    for (int it = 0; it < 4; ++it) { const int q = tid + 512 * it; *(LAS u32x2*)(lds + S5L_MC + (q >> 6) * 520 + (q & 63) * 8) = *(const u32x2*)(tbl + S5_MC + q * 8); }
    __syncthreads();
    const bf16_t* ubase = proj + PU + 16 * g + 8 * hi;
    const LAS unsigned char* mdb = lds + S5L_MD + hi * 32;
    const LAS unsigned char* mcb = lds + S5L_MC + c * 520 + hi * 32;
    LAS float* EX = (LAS float*)(lds + S5L_EX) + 4 * hi;
    const LAS unsigned char* wsb = lds + S5L_W + c * 528 + hi * 16;
    const LAS unsigned char* wcb = lds + S5L_W + c * 272 + hi * 16;
    f32x16 sa[4];
#pragma unroll
    for (int k = 0; k < 4; ++k) sa[k] = (f32x16){};
    {
        const int cc = 32 * w + c;
        const bf16_t* up = ubase + (size_t)rowof(b, 16 * cc) * PJ;
#pragma unroll
        for (int s0 = 0; s0 < 16; s0 += 4) {
            bf16x8 uf[4];
#pragma unroll
            for (int s = 0; s < 4; ++s) { uf[s] = *(const bf16x8*)up; up += PJ; asm volatile("" : "+v"(up)); }
#pragma unroll
            for (int s = 0; s < 4; ++s) {
#pragma unroll
                for (int blk = 0; blk < 4; ++blk) { const bf16x8 A = *(const LAS bf16x8*)(wsb + blk * (32 * 528) + (s0 + s) * 32); sa[blk] = __builtin_amdgcn_mfma_f32_32x32x16_bf16(A, uf[s], sa[blk], 0, 0, 0); }
                __builtin_amdgcn_sched_barrier(0); }
        }
    }
#pragma unroll
    for (int k = 0; k < 5; ++k) { const int d = 1 << k;
#pragma unroll
        for (int pb = 0; pb < 2; ++pb)
#pragma unroll
            for (int r = 0; r < 16; ++r) { const f2 m = *(const LAS f2*)(mdb + (k * 64 + 32 * pb + (r & 3) + 8 * (r >> 2)) * 8);
                const float yr = __shfl_up(sa[pb][r], d, 32), yi = __shfl_up(sa[2 + pb][r], d, 32);
                if (c >= d) { sa[pb][r] += m.x * yr - m.y * yi; sa[2 + pb][r] += m.x * yi + m.y * yr; }
                if ((r & 3) == 3) __builtin_amdgcn_sched_barrier(0); }
    }
    if (c == 31) {
#pragma unroll
        for (int pb = 0; pb < 2; ++pb)
#pragma unroll
            for (int r = 0; r < 16; ++r) { const int p0 = 32 * pb + (r & 3) + 8 * (r >> 2); EX[w * 128 + p0] = sa[pb][r]; EX[w * 128 + 64 + p0] = sa[2 + pb][r]; }
    }
    __syncthreads();
#pragma unroll
    for (int it = 0; it < 8; ++it) { const int q = tid + 512 * it; *(LAS u32x4*)(lds + S5L_W + (q >> 4) * 272 + (q & 15) * 16) = *(const u32x4*)(tbl + S5_WC + q * 16); }
    __syncthreads();
    const int npass = w == 0 ? 2 : 1;
#pragma unroll 1
    for (int pass = 0; pass < npass; ++pass) {
        const int nprev = pass == 0 ? w : 8;
        const int cc = pass == 0 ? 32 * w + c : 256;
        if (pass == 1) {
#pragma unroll
            for (int k = 0; k < 4; ++k) sa[k] = (f32x16){};
        }
        {
            float cr[2][16], ci[2][16];
#pragma unroll
            for (int pb = 0; pb < 2; ++pb)
#pragma unroll
                for (int r = 0; r < 16; ++r) { cr[pb][r] = 0.f; ci[pb][r] = 0.f; }
#pragma unroll 1
            for (int wp = 0; wp < nprev; ++wp) {
                const LAS float* exw = EX + wp * 128;
#pragma unroll
                for (int pb = 0; pb < 2; ++pb)
#pragma unroll
                    for (int r = 0; r < 16; ++r) { const int p0 = 32 * pb + (r & 3) + 8 * (r >> 2); const f2 m = *(const LAS f2*)(mdb + (5 * 64 + p0) * 8); const float er = exw[p0], ei = exw[64 + p0];
                        const float nr = m.x * cr[pb][r] - m.y * ci[pb][r] + er, ni = m.x * ci[pb][r] + m.y * cr[pb][r] + ei; cr[pb][r] = nr; ci[pb][r] = ni;
                        if ((r & 7) == 7) __builtin_amdgcn_sched_barrier(0); }
            }
#pragma unroll
            for (int pb = 0; pb < 2; ++pb)
#pragma unroll
                for (int r = 0; r < 16; ++r) { const f2 m = *(const LAS f2*)(mcb + (32 * pb + (r & 3) + 8 * (r >> 2)) * 8);
                    float xr = __shfl_up(sa[pb][r], 1, 32), xi = __shfl_up(sa[2 + pb][r], 1, 32); if (c == 0) { xr = 0.f; xi = 0.f; }
                    sa[pb][r] = xr + m.x * cr[pb][r] - m.y * ci[pb][r]; sa[2 + pb][r] = xi + m.x * ci[pb][r] + m.y * cr[pb][r];
                    if ((r & 7) == 7) __builtin_amdgcn_sched_barrier(0); }
        }
        bf16x8 xf[4][2];
#pragma unroll
        for (int blk = 0; blk < 4; ++blk)
#pragma unroll
            for (int s = 0; s < 2; ++s) { u32x4 t; t.x = cvt_pk_bf16(sa[blk][8 * s], sa[blk][8 * s + 1]); t.y = cvt_pk_bf16(sa[blk][8 * s + 2], sa[blk][8 * s + 3]); t.z = cvt_pk_bf16(sa[blk][8 * s + 4], sa[blk][8 * s + 5]); t.w = cvt_pk_bf16(sa[blk][8 * s + 6], sa[blk][8 * s + 7]); xf[blk][s] = __builtin_bit_cast(bf16x8, t); }
        const int io = (lane >> 4) & 1, kk = lane & 15;
        bf16x8 Gf0, Gf1;
        { unsigned pkd[4];
    #pragma unroll
          for (int jj = 0; jj < 4; ++jj) { const int j0 = 2 * jj, j1 = 2 * jj + 1; const int h0 = 8 * (j0 >> 2) + 4 * hi + (j0 & 3), h1 = 8 * (j1 >> 2) + 4 * hi + (j1 & 3); pkd[jj] = pk2(gw[h0 * 16 + kk], gw[h1 * 16 + kk]); }
          const u32x4 wv = {pkd[0], pkd[1], pkd[2], pkd[3]}, zz = {0u, 0u, 0u, 0u};
          Gf0 = __builtin_bit_cast(bf16x8, io == 0 ? wv : zz); Gf1 = __builtin_bit_cast(bf16x8, io == 1 ? wv : zz); }
        float gbv[8];
    #pragma unroll
        for (int q = 0; q < 8; ++q) gbv[q] = gb[(q & 3) + 8 * (q >> 2) + 4 * hi];
        const int ktb = S5L_KT + ((lane >> 4) & 1) * 512 + (lane & 15) * 32 + hi * 16;
        const bool stok = pass == 0 ? (cc > 0 || b == 0) : (c == 0);
#pragma unroll
        for (int half = 0; half < 2; ++half) {
            __builtin_amdgcn_sched_barrier(0);
            f32x16 ya[4];
#pragma unroll
            for (int rl = 0; rl < 4; ++rl) ya[rl] = (f32x16){};
            const bf16_t* up = ubase + (size_t)rowof(b, 16 * cc) * PJ;
#pragma unroll
            for (int s0 = 0; s0 < 8 * half + 8; s0 += 4) {
                bf16x8 uf[4];
#pragma unroll
                for (int s = 0; s < 4; ++s) { uf[s] = *(const bf16x8*)up; up += PJ; asm volatile("" : "+v"(up)); }
#pragma unroll
                for (int s = 0; s < 4; ++s) {
#pragma unroll
                    for (int rl = 0; rl < 4; ++rl) { const int rb = 4 * half + rl; if (s0 + s <= 2 * rb + 1) { const bf16x8 A = *(const LAS bf16x8*)(lds + ktb + (2 * rb - (s0 + s) + 1) * 512); ya[rl] = __builtin_amdgcn_mfma_f32_32x32x16_bf16(A, uf[s], ya[rl], 0, 0, 0); } }
                    __builtin_amdgcn_sched_barrier(0); }
            }
#pragma unroll
            for (int rl = 0; rl < 4; ++rl) {
#pragma unroll
                for (int blk = 0; blk < 4; ++blk)
#pragma unroll
                    for (int s = 0; s < 2; ++s) { const bf16x8 A = *(const LAS bf16x8*)(wcb + (4 * half + rl) * (32 * 272) + (blk * 2 + s) * 32); ya[rl] = __builtin_amdgcn_mfma_f32_32x32x16_bf16(A, xf[blk][s], ya[rl], 0, 0, 0); }
                __builtin_amdgcn_sched_barrier(0);
            }
#pragma unroll
            for (int rl = 0; rl < 4; ++rl) {
                const int rb = 4 * half + rl;
                float zg[16];
#pragma unroll
                for (int r = 0; r < 16; ++r) zg[r] = gelu_tanh(ya[rl][r]);
                u32x4 z0, z1; z0.x = cvt_pk_bf16(zg[0], zg[1]); z0.y = cvt_pk_bf16(zg[2], zg[3]); z0.z = cvt_pk_bf16(zg[4], zg[5]); z0.w = cvt_pk_bf16(zg[6], zg[7]);
                z1.x = cvt_pk_bf16(zg[8], zg[9]); z1.y = cvt_pk_bf16(zg[10], zg[11]); z1.z = cvt_pk_bf16(zg[12], zg[13]); z1.w = cvt_pk_bf16(zg[14], zg[15]);
                f32x16 gt = (f32x16){};
                gt = __builtin_amdgcn_mfma_f32_32x32x16_bf16(Gf0, __builtin_bit_cast(bf16x8, z0), gt, 0, 0, 0);
                gt = __builtin_amdgcn_mfma_f32_32x32x16_bf16(Gf1, __builtin_bit_cast(bf16x8, z1), gt, 0, 0, 0);
#pragma unroll
                for (int il = 0; il < 2; ++il) {
                    float o[8]; float sq = 0.f;
#pragma unroll
                    for (int q = 0; q < 8; ++q) { o[q] = zg[8 * il + q] * sigmoidf_(gt[8 * il + q] + gbv[q]); sq += o[q] * o[q]; }
                    sq += __shfl_xor(sq, 32);
                    if (stok) { const int row = rowof(b, 16 * cc + 2 * rb + il); bf16_t* op = mixed + (size_t)row * DM + MX_SSM + 16 * g + 4 * hi;
                        u32x2 w0, w1; w0.x = cvt_pk_bf16(o[0], o[1]); w0.y = cvt_pk_bf16(o[2], o[3]); w1.x = cvt_pk_bf16(o[4], o[5]); w1.y = cvt_pk_bf16(o[6], o[7]);
                        *(u32x2*)op = w0; *(u32x2*)(op + 8) = w1;
                        if (hi == 0) ssqs[(size_t)row * 16 + g] = sq; }
                }
                __builtin_amdgcn_sched_barrier(0);
            }
        }
    }
    __syncthreads();
}

struct Args { const float* in[31]; float* out; unsigned char* ws; int ph_lo, ph_hi; };
constexpr int N_PHASES = 16;
#define PHASE_IDS() int tid; { int ln_; asm volatile("v_mbcnt_lo_u32_b32 %0, -1, 0\n\tv_mbcnt_hi_u32_b32 %0, -1, %0" : "=v"(ln_)); tid = wave0 * 64 + ln_; } unsigned char* ws = ws0; asm volatile("" : "+s"(ws)); const int lane = tid & 63; const int wave = __builtin_amdgcn_readfirstlane(tid >> 6); (void)lane; (void)wave

__global__ void __launch_bounds__(NWAVES * 64, 2) hymba_fwd(Args args) {
    extern __shared__ __attribute__((aligned(16))) unsigned char lds_raw[];
    LAS unsigned char* lds = (LAS unsigned char*)lds_raw;
    volatile LAS unsigned* MISC = (volatile LAS unsigned*)(lds + LDSCTL_OFF);
    LAS int* TB = (LAS int*)(lds + LDSCTL_OFF + 256);
    LAS int* CN = (LAS int*)(lds + LDSCTL_OFF + 512);
    LAS int* HIST = (LAS int*)(lds + LDSCTL_OFF + 768);
    const int wave0 = __builtin_amdgcn_readfirstlane(threadIdx.x >> 6);
    const int G = gridDim.x; const int bx = blockIdx.x; const int vcu = (G % 8 == 0) ? (bx % 8) * (G / 8) + bx / 8 : bx;
    unsigned char* const ws0 = args.ws;
    unsigned* const ctl = (unsigned*)(ws0 + WS_CTL);
    for (int u = threadIdx.x; u < (LDS_BYTES - LDSCTL_OFF) / 4; u += NWAVES * 64) ((LAS unsigned*)(lds + LDSCTL_OFF))[u] = 0u;
    __syncthreads();
    const int lo = args.ph_lo, hi = args.ph_hi;
    XcdBarrier bar; bar.bar = ctl + CW_BAR; bar.x = 0; bar.st = nullptr;
    if (hi - lo > 1) bar = xcd_barrier_post(ctl + CW_BAR, MISC + 8);
#define IN(k) (lo <= (k) && (k) < hi)
#define SEAM(k) do { if (IN(k) && IN((k) + 1)) { PHASE_IDS(); xcd_barrier(bar, tid == 0); } } while (0)
#define WSP(T, off) ((T*)(ws + (off)))

    for (int rep_ = 0; rep_ < DUP_P0; ++rep_) if (IN(0)) {
        PHASE_IDS();
        bf16_t* WinT = WSP(bf16_t, WS_WIN); bf16_t* WoutT = WSP(bf16_t, WS_WOUT); bf16_t* W13T = WSP(bf16_t, WS_W13); bf16_t* W2C = WSP(bf16_t, WS_W2C); bf16_t* WrT = WSP(bf16_t, WS_WR);
        bf16_t* hbuf = WSP(bf16_t, WS_H); float* ssq1 = WSP(float, WS_SSQ1); float* tinfo = WSP(float, WS_TINFO);
#pragma unroll 1
        for (int lg = vcu; lg < 32; lg += G) { const int l = lg >> 4, g = lg & 15;
            const S5P SP{args.in[10] + l * 1024, args.in[11] + l * 1024, args.in[12] + l * 16, args.in[13] + (size_t)l * 16384, args.in[14] + (size_t)l * 16384, args.in[15] + (size_t)l * 16384, args.in[16] + (size_t)l * 16384,
                         args.in[17] + l * 256, args.in[18] + (size_t)l * 4096, args.in[19] + l * 256};
            int tidp = tid; asm volatile("" : "+v"(tidp));
            s5_tables_block(lds, tidp, SP, g, ws + WS_S5T + (size_t)lg * S5T_BYTES); }
        LAS float* scr = (LAS float*)(lds + wave * 16384);
        const int gw = vcu * NWAVES + wave, NGW = G * NWAVES;
        constexpr int I_WIN = 16 * 80, I_WOUT = 16 * 32, I_W13 = 16 * 16, I_W2 = 4 * 32, I_WR = 16;
        constexpr int T_WIN = 2 * I_WIN, T_WOUT = 2 * I_WOUT, T_W13 = 32 * I_W13, T_W2 = 32 * I_W2, T_WR = 4 * I_WR;
        constexpr int NITEMS = T_WIN + T_WOUT + T_W13 + T_W2 + T_WR;
        const int nskip = G >= 64 ? 32 : 0; const int igw = (vcu - nskip) * NWAVES + wave, INGW = (G - nskip) * NWAVES;
#pragma unroll 1
        for (int it = igw; it < NITEMS && vcu >= nskip; it += INGW) {
            int r = it;
            if (r < T_WIN) { const int l = r / I_WIN, q = r % I_WIN, kb = q / 80, nb = q % 80; GetWin gt{args.in[3] + (size_t)l * DM * DINSRC, args.in[2] + l * DM};
                tr_item(gt, WinT + (size_t)l * NIN * DM, DM, 64 * kb, 32 * nb, scr, lane); continue; } r -= T_WIN;
            if (r < T_WOUT) { const int l = r / I_WOUT, q = r % I_WOUT, kb = q / 32, nb = q % 32; GetWout gt{args.in[21] + (size_t)l * DM * DM, args.in[9] + l * 512, args.in[20] + l * 256};
                tr_item(gt, WoutT + (size_t)l * DM * DM, DM, 64 * kb, 32 * nb, scr, lane); continue; } r -= T_WOUT;
            if (r < T_W13) { const int le = r / I_W13, q = r % I_W13, kb = q / 16, nb = q % 16; const int l = le / 16; GetW13 gt{args.in[27] + (size_t)le * DM * 256, args.in[28] + (size_t)le * DM * 256, args.in[22] + l * DM};
                tr_item(gt, W13T + (size_t)le * 512 * DM, DM, 64 * kb, 32 * nb, scr, lane); continue; } r -= T_W13;
            if (r < T_W2) { const int le = r / I_W2, q = r % I_W2, kb = q / 32, nb = q % 32; GetW2 gt{args.in[29] + (size_t)le * 256 * DM};
                tr_item(gt, W2C + (size_t)le * DM * 256, 256, 64 * kb, 32 * nb, scr, lane); continue; } r -= T_W2;
            { const int lh = r / I_WR, kb = r % I_WR; const int l = lh >> 1, lo_ = lh & 1; GetWr gt{args.in[23] + (size_t)l * DM * 4, args.in[25] + (size_t)l * DM * 16, args.in[22] + l * DM, lo_};
                tr_item(gt, WrT + (size_t)lh * 32 * DM, DM, 64 * kb, 0, scr, lane); }
        }
#pragma unroll 1
        for (int r0 = 2 * gw; r0 < MROWS; r0 += 2 * NGW) {
            f32x4 v[2][4];
#pragma unroll
            for (int q = 0; q < 2; ++q) { const int r = r0 + q;
#pragma unroll
                for (int j = 0; j < 4; ++j) { if (r < NREAL) v[q][j] = *(const f32x4*)(args.in[0] + (size_t)r * DM + 4 * lane + 256 * j); else if (r < NTOK) v[q][j] = *(const f32x4*)(args.in[1] + (size_t)(r - NREAL) * DM + 4 * lane + 256 * j); else v[q][j] = (f32x4){0.f, 0.f, 0.f, 0.f}; } }
#pragma unroll
            for (int q = 0; q < 2; ++q) { const int r = r0 + q; float s = 0.f;
#pragma unroll
                for (int j = 0; j < 4; ++j) { u32x2 w; w.x = pk2(v[q][j][0], v[q][j][1]); w.y = pk2(v[q][j][2], v[q][j][3]); *(u32x2*)(hbuf + (size_t)r * DM + 4 * lane + 256 * j) = w;
                    s += bflo(w.x) * bflo(w.x) + bfhi(w.x) * bfhi(w.x) + bflo(w.y) * bflo(w.y) + bfhi(w.y) * bfhi(w.y); }
                s = wave_sum(s);
                if (lane < 16) ssq1[(size_t)r * 16 + lane] = lane == 0 ? s : 0.f;
                if (r >= NTOK && lane < 4) tinfo[(size_t)r * 4 + lane] = 0.f; }
        }
    }
    SEAM(0);

#pragma unroll 1
    for (int l = 0; l < DEPTH; ++l) {
        const int P = 1 + 7 * l;
        for (int rep_ = 0; rep_ < DUP_G1; ++rep_) if (IN(P)) {
            PHASE_IDS();
            bf16_t* hbuf = WSP(bf16_t, WS_H); bf16_t* proj = WSP(bf16_t, WS_PROJ); float* flog = WSP(float, WS_FLOG); const float* ssq1 = WSP(float, WS_SSQ1);
            const bf16_t* Win = WSP(bf16_t, WS_WIN) + (size_t)l * NIN * DM; const float* fb = args.in[4] + l * 8;
            DenseOrder S; S.init(hbuf, Win, NREAL, NIN, DM, DM, G, bx);
            EpiProj E{proj, flog, ssq1, fb};
            pg8::gemm_phase<EpiProj, DenseOrder, true, false>(lds, tid, DM, DM, S, E);
#pragma unroll 1
            for (int cb = bx; cb < 10; cb += G) {
                f32x4 acc[2]; meta_gemm16(hbuf + (size_t)NREAL * DM, Win, DM, cb * 256, wave, lane, acc);
                const int m = lane & 15, q4 = lane >> 4, row = NREAL + m;
                const float rs = row_rstd16(ssq1, row, q4, 1.f / DM);
#pragma unroll
                for (int j = 0; j < 2; ++j) { const f32x4 v = acc[j] * rs; const int col = cb * 256 + 32 * wave + 16 * j + 4 * q4;
                    if (cb < 9) { u32x2 w; w.x = cvt_pk_bf16(v[0], v[1]); w.y = cvt_pk_bf16(v[2], v[3]); *(u32x2*)(proj + (size_t)row * PJ + col) = w; }
                    else if (wave == 0 && j == 0 && q4 < 2) { f32x4 o;
#pragma unroll
                        for (int e = 0; e < 4; ++e) { const float f = v[e] + fb[4 * q4 + e]; o[e] = -log2f(1.f + exp2f(-f * LOG2E)); }
                        *(f32x4*)(flog + (size_t)row * 8 + 4 * q4) = o; } }
            }
        }
        SEAM(P);
        for (int rep_ = 0; rep_ < DUP_MIX; ++rep_) if (IN(P + 1)) {
            PHASE_IDS();
            const bf16_t* proj = WSP(bf16_t, WS_PROJ); bf16_t* mixed = WSP(bf16_t, WS_MIX); const float* flog = WSP(float, WS_FLOG); float* ssqa = WSP(float, WS_SSQA); float* ssqs = WSP(float, WS_SSQS);
            for (int repa_ = 0; repa_ < DUP_ATT; ++repa_)
#pragma unroll 1
            for (int vc = vcu; vc < 256; vc += G) {
                int bh = vc >> 2; asm volatile("" : "+s"(bh));
                const int b = bh >> 3, h = bh & 7;
                attn_prefix(lds, tid, flog, b, h);
#pragma unroll 1
                for (int i = 0; i < 4; ++i) { const int s = (vc & 3) * 2 + (i >> 1); int qt = (i & 1) ? 15 - s : s; asm volatile("" : "+s"(qt)); attn_unit(lds, tid, proj, mixed, ssqa, b, h, qt); }
            }
#pragma unroll 1
            for (int vc = vcu; vc < 8; vc += G) { int hh = vc; asm volatile("" : "+s"(hh)); attn_prefix(lds, tid, flog, 0, hh); attn_unit(lds, tid, proj, mixed, ssqa, 0, hh, -1); }
            const float* cw = args.in[5] + (size_t)l * 31 * 256; const float* cbp = args.in[6] + l * 256; const float* clg = args.in[7] + l * 256; const float* clb = args.in[8] + l * 256;
            for (int repc_ = 0; repc_ < DUP_CS; ++repc_)
#pragma unroll 1
            for (int vc = vcu; vc < 256; vc += G) {
                int tid2 = tid; asm volatile("" : "+v"(tid2));
                if ((vc & 1) == 0) { const int ci = vc >> 1;
#pragma unroll 1
                    for (int s = 0; s < 8; ++s) conv_subtile(lds, tid2, proj, mixed, cw, cbp, clg, clb, ci >> 4, NMETA + 256 * (ci & 15) + 32 * s, 32);
                } else {
                    if (vc == 1) conv_subtile(lds, tid2, proj, mixed, cw, cbp, clg, clb, 0, 0, 16);
                    int ug = vc >> 1; asm volatile("" : "+s"(ug));
                    s5_unit(lds, tid2, ws + WS_S5T + (size_t)(l * 16 + (ug & 15)) * S5T_BYTES, args.in[18] + (size_t)l * 4096 + (ug & 15) * 256, args.in[19] + l * 256 + (ug & 15) * 16, proj, mixed, ssqs, ug >> 4, ug & 15);
                }
            }
        }
        SEAM(P + 1);
        if (IN(P + 2)) {
            PHASE_IDS();
            bf16_t* mixed = WSP(bf16_t, WS_MIX); const float* ssqa = WSP(float, WS_SSQA); const float* ssqs = WSP(float, WS_SSQS);
            const int gw = vcu * NWAVES + wave, NGW = G * NWAVES;
#pragma unroll 1
            for (int r = gw; r < NTOK; r += NGW) {
                float sa = lane < 8 ? ssqa[(size_t)r * 8 + lane] : 0.f, ss = lane < 16 ? ssqs[(size_t)r * 16 + lane] : 0.f;
                sa = wave_sum(sa); ss = wave_sum(ss);
                const float ra = rsqrtf(sa * (1.f / 512.f) + EPS), rsm = rsqrtf(ss * (1.f / 256.f) + EPS);
                bf16_t* p = mixed + (size_t)r * DM;
                u32x4 a = *(u32x4*)(p + 8 * lane);
                a.x = cvt_pk_bf16(bflo(a.x) * ra, bfhi(a.x) * ra); a.y = cvt_pk_bf16(bflo(a.y) * ra, bfhi(a.y) * ra); a.z = cvt_pk_bf16(bflo(a.z) * ra, bfhi(a.z) * ra); a.w = cvt_pk_bf16(bflo(a.w) * ra, bfhi(a.w) * ra);
                *(u32x4*)(p + 8 * lane) = a;
                u32x2 s2 = *(u32x2*)(p + MX_SSM + 4 * lane);
                s2.x = cvt_pk_bf16(bflo(s2.x) * rsm, bfhi(s2.x) * rsm); s2.y = cvt_pk_bf16(bflo(s2.y) * rsm, bfhi(s2.y) * rsm);
                *(u32x2*)(p + MX_SSM + 4 * lane) = s2;
            }
        }
        SEAM(P + 2);
        if (IN(P + 3)) {
            PHASE_IDS();
            bf16_t* hbuf = WSP(bf16_t, WS_H); const bf16_t* mixed = WSP(bf16_t, WS_MIX); float* ssq2 = WSP(float, WS_SSQ2); const bf16_t* Wo = WSP(bf16_t, WS_WOUT) + (size_t)l * DM * DM;
            DenseOrder S; S.init(mixed, Wo, NREAL, DM, DM, DM, G, bx);
            EpiRes<false> E{hbuf, ssq2, CN, nullptr};
            pg8::gemm_phase<EpiRes<false>, DenseOrder, true, false>(lds, tid, DM, DM, S, E);
            LAS float* mscr = (LAS float*)lds;
#pragma unroll 1
            for (int cb = bx; cb < 4; cb += G) {
                f32x4 acc[2]; meta_gemm16(mixed + (size_t)NREAL * DM, Wo, DM, cb * 256, wave, lane, acc);
                const int m = lane & 15, q4 = lane >> 4, row = NREAL + m; float sq = 0.f;
#pragma unroll
                for (int j = 0; j < 2; ++j) { bf16_t* p = hbuf + (size_t)row * DM + cb * 256 + 32 * wave + 16 * j + 4 * q4; const u32x2 o = *(const u32x2*)p; u32x2 w;
                    w.x = cvt_pk_bf16(bflo(o.x) + acc[j][0], bfhi(o.x) + acc[j][1]); w.y = cvt_pk_bf16(bflo(o.y) + acc[j][2], bfhi(o.y) + acc[j][3]); *(u32x2*)p = w;
                    sq += bflo(w.x) * bflo(w.x) + bfhi(w.x) * bfhi(w.x) + bflo(w.y) * bflo(w.y) + bfhi(w.y) * bfhi(w.y); }
                sq += __shfl_xor(sq, 16); sq += __shfl_xor(sq, 32);
                if (q4 == 0) mscr[m * 8 + wave] = sq;
                __syncthreads();
                if (wave == 0) ssq2[(size_t)row * 16 + cb * 4 + q4] = mscr[m * 8 + 2 * q4] + mscr[m * 8 + 2 * q4 + 1];
                __syncthreads();
            }
        }
        SEAM(P + 3);
        if (IN(P + 4)) {
            PHASE_IDS();
            const bf16_t* hbuf = WSP(bf16_t, WS_H); const float* ssq2 = WSP(float, WS_SSQ2); float* tinfo = WSP(float, WS_TINFO); int* list = WSP(int, WS_LIST);
            unsigned* gcnt = ctl + CW_CNT + l * 32;
            const bf16_t* Whi = WSP(bf16_t, WS_WR) + (size_t)(2 * l) * 32 * DM; const bf16_t* Wlo = Whi + (size_t)32 * DM;
            LAS float* scr = (LAS float*)(lds + wave * 4352);
#pragma unroll 1
            for (int base = 0; base < 1025; base += G * 4) {
                const int grp = base + bx * 4 + wave;
                const bool active = wave < 4 && grp < 1025;
                int cls = 0, posl = 0, tok = 0; bool valid = false; float rstd = 0.f, gA = 0.f, gB = 0.f;
                if (active) {
                    const int r32 = lane & 31, hh = lane >> 5; const int rowA = grp * 32 + r32 < NTOK ? grp * 32 + r32 : DUMMY_ROW;
                    f32x16 acc = {};
                    const bf16_t* ap = hbuf + (size_t)rowA * DM + 8 * hh; const bf16_t* bh_ = Whi + (size_t)r32 * DM + 8 * hh; const bf16_t* bl_ = Wlo + (size_t)r32 * DM + 8 * hh;
#pragma unroll 4
                    for (int k0 = 0; k0 < DM; k0 += 16) { const bf16x8 a = *(const bf16x8*)(ap + k0), b0 = *(const bf16x8*)(bh_ + k0), b1 = *(const bf16x8*)(bl_ + k0);
                        acc = __builtin_amdgcn_mfma_f32_32x32x16_bf16(a, b0, acc, 0, 0, 0); acc = __builtin_amdgcn_mfma_f32_32x32x16_bf16(a, b1, acc, 0, 0, 0); }
#pragma unroll
                    for (int r = 0; r < 16; ++r) scr[crow(r, hh) * 33 + r32] = acc[r];
                    LDS_WAIT(); asm volatile("" ::: "memory");
                    tok = grp * 32 + r32; valid = hh == 0 && tok < NTOK;
                    if (valid) {
                        float s = 0.f;
#pragma unroll
                        for (int q = 0; q < 4; ++q) { const f32x4 v = *(const f32x4*)(ssq2 + (size_t)tok * 16 + 4 * q); s += (v.x + v.y) + (v.z + v.w); }
                        rstd = rsqrtf(s * (1.f / DM) + EPS);
                        float lg[4]; const float* bg = args.in[24] + l * 4; const float* be = args.in[26] + l * 16;
#pragma unroll
                        for (int i = 0; i < 4; ++i) lg[i] = scr[r32 * 33 + i] * rstd + bg[i];
                        int gs = 0; float mx = lg[0];
#pragma unroll
                        for (int i = 1; i < 4; ++i) if (lg[i] > mx) { mx = lg[i]; gs = i; }
                        float se = 0.f;
#pragma unroll
                        for (int i = 0; i < 4; ++i) se += expf(lg[i] - mx);
                        const float pg = 1.f / se;
                        float le[4];
#pragma unroll
                        for (int i = 0; i < 4; ++i) le[i] = scr[r32 * 33 + 4 + 4 * gs + i] * rstd + be[4 * gs + i];
                        int i1 = 0; float v1 = le[0];
#pragma unroll
                        for (int i = 1; i < 4; ++i) if (le[i] > v1) { v1 = le[i]; i1 = i; }
                        int i2 = -1; float v2 = -INFINITY;
#pragma unroll
                        for (int i = 0; i < 4; ++i) if (i != i1 && le[i] > v2) { v2 = le[i]; i2 = i; }
                        const float w1 = pg / (1.f + expf(v2 - v1)), w2 = pg - w1;
                        const int a = i1 < i2 ? i1 : i2, bb = i1 < i2 ? i2 : i1;
                        gA = i1 < i2 ? w1 : w2; gB = i1 < i2 ? w2 : w1;
                        cls = gs * 6 + (a == 0 ? bb - 1 : (a == 1 ? bb + 1 : 5));
                        posl = __hip_atomic_fetch_add(&HIST[cls], 1, __ATOMIC_RELAXED, __HIP_MEMORY_SCOPE_WORKGROUP);
                    }
                }
                __syncthreads();
                if (tid < NCLS) { const int n = HIST[tid]; HIST[32 + tid] = n ? (int)__hip_atomic_fetch_add(gcnt + tid, (unsigned)n, __ATOMIC_RELAXED, __HIP_MEMORY_SCOPE_AGENT) : 0; }
                __syncthreads();
                if (valid) { const int pos = HIST[32 + cls] + posl; list[(size_t)cls * NTOK + pos] = tok; *(f32x4*)(tinfo + (size_t)tok * 4) = (f32x4){rstd, gA, gB, 0.f}; }
                __syncthreads();
                if (tid < NCLS) HIST[tid] = 0;
                __syncthreads();
            }
        }
        SEAM(P + 4);
        if (IN(P + 5) || IN(P + 6)) {
            unsigned* gcnt = ctl + CW_CNT + l * 32;
            PHASE_IDS();
            if (tid == 0) { int run = 0; for (int c = 0; c < NCLS; ++c) { const int n = (int)__hip_atomic_load(gcnt + c, __ATOMIC_RELAXED, __HIP_MEMORY_SCOPE_AGENT); CN[c] = n; TB[c] = run; run += (n + 255) >> 8; } TB[NCLS] = run; }
            __syncthreads();
        }
        for (int rep_ = 0; rep_ < DUP_E1; ++rep_) if (IN(P + 5)) {
            PHASE_IDS();
            const int* list = WSP(int, WS_LIST);
            ExpertOrder S{TB, CN, list, (const char*)WSP(bf16_t, WS_H), (const char*)WSP(bf16_t, WS_W13), G, bx, 1, l};
            EpiE1 E{WSP(bf16_t, WS_H1), WSP(float, WS_TINFO), CN, list};
            pg8::gemm_phase<EpiE1, ExpertOrder, true, true>(lds, tid, DM, DM, S, E);
        }
        SEAM(P + 5);
        if (IN(P + 6)) {
            PHASE_IDS();
            const int* list = WSP(int, WS_LIST);
            ExpertOrder S{TB, CN, list, (const char*)WSP(bf16_t, WS_H1), (const char*)WSP(bf16_t, WS_W2C), G, bx, 2, l};
            EpiRes<true> E{WSP(bf16_t, WS_H), WSP(float, WS_SSQ1), CN, list};
            pg8::gemm_phase<EpiRes<true>, ExpertOrder, true, false, true>(lds, tid, 512, 256, S, E);
        }
        SEAM(P + 6);
    }
    if (IN(15)) {
        PHASE_IDS();
        const bf16_t* hbuf = WSP(bf16_t, WS_H); const float* ssq1 = WSP(float, WS_SSQ1);
        const int gw = vcu * NWAVES + wave, NGW = G * NWAVES; const float* gF = args.in[30];
        f32x4 gv[4];
#pragma unroll
        for (int j = 0; j < 4; ++j) gv[j] = *(const f32x4*)(gF + 4 * lane + 256 * j);
#pragma unroll 1
        for (int r = gw; r < NREAL; r += NGW) {
            float s = lane < 16 ? ssq1[(size_t)r * 16 + lane] : 0.f; s = wave_sum(s);
            const float rs = rsqrtf(s * (1.f / DM) + EPS);
#pragma unroll
            for (int j = 0; j < 4; ++j) { const u32x2 w = *(const u32x2*)(hbuf + (size_t)r * DM + 4 * lane + 256 * j);
                f32x4 o; o[0] = bflo(w.x) * rs * gv[j][0]; o[1] = bfhi(w.x) * rs * gv[j][1]; o[2] = bflo(w.y) * rs * gv[j][2]; o[3] = bfhi(w.y) * rs * gv[j][3];
                *(f32x4*)(args.out + (size_t)r * DM + 4 * lane + 256 * j) = o; }
        }
    }
#undef IN
#undef SEAM
#undef WSP
}

extern "C" void kernel_launch(void* const* d_in, const int* in_sizes, int n_in, void* d_out, int out_size, void* d_ws, size_t ws_size, hipStream_t stream) {
    static int grid = 0;
    if (grid == 0) {
        if (n_in != 31 || out_size != NREAL * DM || ws_size < WS_END) { fprintf(stderr, "kernel_launch: unexpected shapes (n_in %d, out %d, ws %zu)\n", n_in, out_size, ws_size); grid = -1; return; }
        int dev = 0, cus = 0, per_cu = 0;
        if (hipGetDevice(&dev) != hipSuccess || hipDeviceGetAttribute(&cus, hipDeviceAttributeMultiprocessorCount, dev) != hipSuccess) { grid = -1; return; }
        if (hipFuncSetAttribute((const void*)hymba_fwd, hipFuncAttributeMaxDynamicSharedMemorySize, LDS_BYTES) != hipSuccess) { fprintf(stderr, "kernel_launch: hipFuncSetAttribute failed\n"); grid = -1; return; }
        if (hipOccupancyMaxActiveBlocksPerMultiprocessor(&per_cu, (const void*)hymba_fwd, NWAVES * 64, LDS_BYTES) != hipSuccess || per_cu < 1) { fprintf(stderr, "kernel_launch: occupancy query says %d\n", per_cu); }
        (void)hipGetLastError();
        grid = cus;
    }
    if (grid < 0) return;
    (void)in_sizes;
    if (hipMemsetAsync((char*)d_ws + WS_CTL, 0, CTL_BYTES, stream) != hipSuccess) return;
    Args a{};
    for (int i = 0; i < 31; ++i) a.in[i] = (const float*)d_in[i];
    a.out = (float*)d_out; a.ws = (unsigned char*)d_ws;
#if MK_PER_PHASE
    for (int p = 0; p < N_PHASES; ++p) { a.ph_lo = p; a.ph_hi = p + 1; hipLaunchKernelGGL(hymba_fwd, dim3(grid), dim3(NWAVES * 64), LDS_BYTES, stream, a); }
#else
    a.ph_lo = 0; a.ph_hi = N_PHASES;
    hipLaunchKernelGGL(hymba_fwd, dim3(grid), dim3(NWAVES * 64), LDS_BYTES, stream, a);
#endif
}
```

```cpp
#include <hip/hip_runtime.h>
#include <cstdio>
#include <cstdint>

#ifndef DUP_ATT
#define DUP_ATT 1
#endif
#ifndef DUP_CS
#define DUP_CS 1
#endif
#ifndef DUP_G1
#define DUP_G1 1
#endif
#ifndef DUP_MIX
#define DUP_MIX 1
#endif
#ifndef DUP_E1
#define DUP_E1 1
#endif
#ifndef DUP_P0
#define DUP_P0 1
#endif
#ifndef MK_PER_PHASE
#define MK_PER_PHASE 0
#endif

#define LAS __attribute__((address_space(3)))
#define GAS __attribute__((address_space(1)))
typedef unsigned short bf16_t;
typedef short bf16x8 __attribute__((ext_vector_type(8)));
typedef short s16x4 __attribute__((ext_vector_type(4)));
typedef float f32x4 __attribute__((ext_vector_type(4)));
typedef float f32x2 __attribute__((ext_vector_type(2)));
typedef float f32x16 __attribute__((ext_vector_type(16)));
typedef unsigned u32x4 __attribute__((ext_vector_type(4)));
typedef unsigned u32x2 __attribute__((ext_vector_type(2)));

constexpr int NB = 8, SEQ = 4096, NMETA = 16, DM = 1024, DEPTH = 2;
constexpr int NREAL = NB * SEQ;
constexpr int NTOK = NREAL + NMETA;
constexpr int MROWS = 33024;
constexpr int DUMMY_ROW = NTOK;
constexpr int PJ = 2304;
constexpr int NIN = 2560;
constexpr int DINSRC = 2312;
constexpr int PQ = 512, PK = 1024, PV = 1536, PU = 2048;
constexpr int MX_ATT = 0, MX_SSM = 512, MX_CONV = 768;
constexpr int NCLS = 24;
constexpr float EPS = 1e-6f;
constexpr float LOG2E = 1.4426950408889634f;
constexpr int H1CAP = 40960;

constexpr size_t MiB = 1u << 20;
constexpr size_t WS_CTL = 0, CTL_BYTES = 1 * MiB;
constexpr size_t WS_WIN = 2 * MiB, WS_WOUT = 12 * MiB, WS_W13 = 16 * MiB, WS_W2C = 48 * MiB, WS_WR = 96 * MiB;
constexpr size_t WS_H = 100 * MiB, WS_PROJ = 165 * MiB, WS_MIX = 311 * MiB, WS_H1 = 376 * MiB;
constexpr size_t WS_FLOG = 416 * MiB, WS_SSQ1 = 418 * MiB, WS_SSQ2 = 421 * MiB, WS_SSQA = 424 * MiB, WS_SSQS = 426 * MiB, WS_TINFO = 429 * MiB, WS_LIST = 430 * MiB, WS_S5T = 434 * MiB, WS_END = 440 * MiB;
constexpr int CW_TMO = 0, CW_BAR = 4096, CW_CNT = 16384;

constexpr int RING_BYTES = 131072;
constexpr int LDSCTL_OFF = RING_BYTES;
constexpr int LDS_BYTES = 147456;
constexpr int NWAVES = 8;

#define LDS_WAIT() asm volatile("s_waitcnt lgkmcnt(0)" ::: "memory")
#define VM_WAIT() asm volatile("s_waitcnt vmcnt(0)" ::: "memory")

__device__ __forceinline__ unsigned f2bf(float f) { unsigned u = __float_as_uint(f); return (u + 0x7fffu + ((u >> 16) & 1u)) >> 16; }
__device__ __forceinline__ unsigned pk2(float lo, float hi) { return f2bf(lo) | (f2bf(hi) << 16); }
__device__ __forceinline__ float bflo(unsigned w) { return __uint_as_float(w << 16); }
__device__ __forceinline__ float bfhi(unsigned w) { return __uint_as_float(w & 0xffff0000u); }
__device__ __forceinline__ float bf2f(bf16_t b) { return __uint_as_float(((unsigned)b) << 16); }
__device__ __forceinline__ unsigned cvt_pk_bf16(float lo, float hi) { unsigned r; asm volatile("v_cvt_pk_bf16_f32 %0, %1, %2" : "=v"(r) : "v"(lo), "v"(hi)); return r; }
__device__ __forceinline__ float wave_sum(float v) {
#pragma unroll
    for (int o = 1; o < 64; o <<= 1) v += __shfl_xor(v, o);
    return v;
}
__device__ __forceinline__ float fast_exp2(float x) { return __builtin_amdgcn_exp2f(x); }
__device__ __forceinline__ float fast_rcp(float x) { return __builtin_amdgcn_rcpf(x); }
__device__ __forceinline__ float sigmoidf_(float x) { return fast_rcp(1.f + fast_exp2(-x * LOG2E)); }
__device__ __forceinline__ float siluf_(float x) { return x * sigmoidf_(x); }
__device__ __forceinline__ int rowof(int b, int t) { return t < NMETA ? NREAL + t : b * SEQ + (t - NMETA); }

namespace pg8 {
constexpr int BM = 256, BK = 64, HALF = 128, HTB = HALF * BK * 2, STAGE_BYTES = 8 * HTB;
__host__ __device__ __forceinline__ int lds_byte(int r, int c) { const int st = (r >> 4) * 2 + (c >> 5), rr = r & 15, cc = c & 31, ob = rr * 64 + cc * 2; return st * 1024 + (ob ^ (((ob >> 9) & 1) << 5)); }
__host__ __device__ __forceinline__ void stage_rc(int b, int& R, int& C) { const int st = b / 1024, sb = b % 1024, swz = sb ^ (((sb >> 9) & 1) << 5); R = (st >> 1) * 16 + swz / 64; C = (st & 1) * 32 + (swz % 64) / 2; }
__host__ __device__ __forceinline__ int perm32(int rho) { const int n = rho >> 4, i = rho & 15; return 8 * (i >> 2) + 4 * n + (i & 3); }

struct Unit { int pm, pn, cls, p0; };

template <class Epi, class Sched, bool ALIGN_EPI, bool GATHER, bool BSPLIT = false>
__device__ __forceinline__ void gemm_phase(LAS unsigned char* lds, const int tid, const int K, const int ldb, const Sched& S, const Epi& E) {
    const int wid = __builtin_amdgcn_readfirstlane(tid >> 6), lane = tid & 63, wr = wid >> 2, wc = wid & 3, fr = lane & 15, fq = lane >> 4;
    const int nt = K / BK;
    unsigned voffA[2], voffB[2]; int RA[2], CA[2];
#pragma unroll
    for (int i = 0; i < 2; ++i) { int R, C; stage_rc(tid * 16 + i * 8192, R, C); const int Rb = (R & ~31) + perm32(R & 31);
        voffA[i] = (unsigned)(R * K + C) * 2u; voffB[i] = (unsigned)(Rb * ldb + C) * 2u; RA[i] = R; CA[i] = C; }
    const size_t kstep = (size_t)(BK * 2);
    const size_t hstepA = (size_t)HALF * K * 2, hstepB = (size_t)HALF * ldb * 2;
    const size_t pstepA = (size_t)64 * K * 2, pstepB = (size_t)64 * ldb * 2;
    const unsigned ldsw = (unsigned)wid * 1024u;
    const int aoff = lds_byte(wr * 64 + fr, fq * 8), boff = lds_byte(wc * 32 + fr, fq * 8);
#define PG8_SA(b, h) (((b) * 2 + (h)) * HTB)
#define PG8_SB(b, h) ((4 + (b) * 2 + (h)) * HTB)
#define PG8_STAGE(bufoff, gbase, voff) do { _Pragma("unroll") for (int _i = 0; _i < 2; ++_i) \
        __builtin_amdgcn_global_load_lds((const unsigned*)((const char*)(gbase) + (voff)[_i]), (LAS unsigned*)(lds + (bufoff) + ldsw + _i * 8192), 16, 0, 0); } while (0)
#define PG8_STAGE1(bufoff, gbase, voff1, step) do { _Pragma("unroll") for (int _i = 0; _i < 2; ++_i) \
        __builtin_amdgcn_global_load_lds((const unsigned*)((const char*)(gbase) + (size_t)_i * (step) + (voff1)), (LAS unsigned*)(lds + (bufoff) + ldsw + _i * 8192), 16, 0, 0); } while (0)
#define PG8_LDA(dst, b, h) do { _Pragma("unroll") for (int m = 0; m < 4; ++m) _Pragma("unroll") for (int k = 0; k < 2; ++k) dst[m][k] = *(const LAS bf16x8*)(lds + PG8_SA(b, h) + aoff + m * 2048 + k * 1024); } while (0)
#define PG8_LDB(dst, b, h) do { _Pragma("unroll") for (int n = 0; n < 2; ++n) _Pragma("unroll") for (int k = 0; k < 2; ++k) dst[n][k] = *(const LAS bf16x8*)(lds + PG8_SB(b, h) + boff + n * 2048 + k * 1024); } while (0)
#define PG8_MMA(ai, bj, At, Bt) do { __builtin_amdgcn_s_setprio(1); _Pragma("unroll") for (int m = 0; m < 4; ++m) _Pragma("unroll") for (int n = 0; n < 2; ++n) _Pragma("unroll") for (int k = 0; k < 2; ++k) \
        acc[ai][bj][m][n] = __builtin_amdgcn_mfma_f32_16x16x32_bf16(Bt[n][k], At[m][k], acc[ai][bj][m][n], 0, 0, 0); __builtin_amdgcn_s_setprio(0); } while (0)
#define PG8_WAIT_V(n) asm volatile("s_waitcnt vmcnt(" #n ")" ::: "memory")
#define PG8_WAIT_L(n) asm volatile("s_waitcnt lgkmcnt(" #n ")" ::: "memory")
#define PG8_BAR __builtin_amdgcn_s_barrier()
#define PG8_SCHED __builtin_amdgcn_sched_barrier(0)
    Unit cur, nxt; int ui = 0;
    if (!S.next(0, cur)) return;
    f32x4 acc[2][2][4][2];
#pragma unroll
    for (int a = 0; a < 2; ++a)
#pragma unroll
        for (int b = 0; b < 2; ++b)
#pragma unroll
            for (int m = 0; m < 4; ++m)
#pragma unroll
                for (int n = 0; n < 2; ++n) acc[a][b][m][n] = (f32x4){0.f, 0.f, 0.f, 0.f};
    bf16x8 At[4][2], B0[2][2], B1[2][2];
    const char* cA = S.abase(cur); const char* cB = S.bbase(cur);
    const char* cB2 = cB; const int ksp = BSPLIT ? nt / 2 : (1 << 30);
    if constexpr (BSPLIT) cB2 = S.bbase2(cur) - (size_t)ksp * kstep;
    unsigned oC[2][2], oN[2][2];
    if constexpr (GATHER) {
#pragma unroll
        for (int h = 0; h < 2; ++h)
#pragma unroll
            for (int i = 0; i < 2; ++i) oC[h][i] = (unsigned)S.rowtok(cur, h * HALF + RA[i]) * (unsigned)(K * 2) + (unsigned)(CA[i] * 2);
    }
    PG8_STAGE1(PG8_SB(0, 0), cB, voffB[0], pstepB); PG8_STAGE1(PG8_SB(0, 1), cB + hstepB, voffB[0], pstepB);
    if constexpr (GATHER) { PG8_STAGE(PG8_SA(0, 0), cA, oC[0]); PG8_STAGE(PG8_SA(0, 1), cA, oC[1]); }
    else { PG8_STAGE1(PG8_SA(0, 0), cA, voffA[0], pstepA); PG8_STAGE1(PG8_SA(0, 1), cA + hstepA, voffA[0], pstepA); }
    if (wr == 1) PG8_BAR;
    PG8_WAIT_V(2); PG8_BAR;
    PG8_STAGE1(PG8_SB(1, 0), cB + kstep, voffB[0], pstepB);
    if constexpr (GATHER) { PG8_STAGE(PG8_SA(1, 0), cA + kstep, oC[0]); } else { PG8_STAGE1(PG8_SA(1, 0), cA + kstep, voffA[0], pstepA); }
    PG8_STAGE1(PG8_SB(1, 1), cB + hstepB + kstep, voffB[0], pstepB);
    PG8_WAIT_V(6); PG8_BAR;
    for (;;) {
        const bool has_next = S.next(ui + 1, nxt);
        const char* nA = has_next ? S.abase(nxt) : cA; const char* nB = has_next ? S.bbase(nxt) : cB;
        const char* nB2 = nB; if constexpr (BSPLIT) nB2 = has_next ? S.bbase2(nxt) - (size_t)ksp * kstep : cB2;
        if constexpr (GATHER) {
#pragma unroll
            for (int h = 0; h < 2; ++h)
#pragma unroll
                for (int i = 0; i < 2; ++i) oN[h][i] = has_next ? (unsigned)S.rowtok(nxt, h * HALF + RA[i]) * (unsigned)(K * 2) + (unsigned)(CA[i] * 2) : oC[h][i];
        }
        for (int t = 0; t < nt; t += 2) {
            const bool last = (t == nt - 2);
            const char* a1 = cA + (size_t)(t + 1) * kstep;
            const char* a2 = last ? nA : cA + (size_t)(t + 2) * kstep; const char* b2 = last ? nB : ((t + 2 < ksp) ? cB : cB2) + (size_t)(t + 2) * kstep;
            const char* a3 = a2 + kstep; const char* b3 = b2 + kstep;
            unsigned s0[2], s1[2];
            if constexpr (GATHER) { s0[0] = last ? oN[0][0] : oC[0][0]; s0[1] = last ? oN[0][1] : oC[0][1]; s1[0] = last ? oN[1][0] : oC[1][0]; s1[1] = last ? oN[1][1] : oC[1][1]; }
            PG8_LDB(B0, 0, 0); PG8_LDB(B1, 0, 1); PG8_SCHED; PG8_LDA(At, 0, 0);
            if constexpr (GATHER) { PG8_STAGE(PG8_SA(1, 1), a1, oC[1]); } else { PG8_STAGE1(PG8_SA(1, 1), a1 + hstepA, voffA[0], pstepA); }
            PG8_WAIT_V(8); PG8_WAIT_L(0); PG8_BAR; PG8_MMA(0, 0, At, B0); PG8_MMA(0, 1, At, B1); PG8_BAR; PG8_SCHED;
            PG8_LDA(At, 0, 1); PG8_STAGE1(PG8_SB(0, 0), b2, voffB[0], pstepB); PG8_STAGE1(PG8_SB(0, 1), b2 + hstepB, voffB[0], pstepB);
            if constexpr (GATHER) { PG8_STAGE(PG8_SA(0, 0), a2, s0); } else { PG8_STAGE1(PG8_SA(0, 0), a2, voffA[0], pstepA); }
            PG8_WAIT_V(8); PG8_WAIT_L(0); PG8_BAR; PG8_MMA(1, 0, At, B0); PG8_MMA(1, 1, At, B1); PG8_BAR; PG8_SCHED;
            PG8_LDB(B0, 1, 0); PG8_LDB(B1, 1, 1); PG8_SCHED; PG8_LDA(At, 1, 0);
            if constexpr (GATHER) { PG8_STAGE(PG8_SA(0, 1), a2, s1); } else { PG8_STAGE1(PG8_SA(0, 1), a2 + hstepA, voffA[0], pstepA); }
            PG8_WAIT_V(8); PG8_WAIT_L(0); PG8_BAR; PG8_MMA(0, 0, At, B0); PG8_MMA(0, 1, At, B1); PG8_BAR; PG8_SCHED;
            PG8_LDA(At, 1, 1); PG8_STAGE1(PG8_SB(1, 0), b3, voffB[0], pstepB); PG8_STAGE1(PG8_SB(1, 1), b3 + hstepB, voffB[0], pstepB);
            if constexpr (GATHER) { PG8_STAGE(PG8_SA(1, 0), a3, s0); } else { PG8_STAGE1(PG8_SA(1, 0), a3, voffA[0], pstepA); }
            PG8_WAIT_V(8); PG8_WAIT_L(0); PG8_BAR; PG8_MMA(1, 0, At, B0); PG8_MMA(1, 1, At, B1); PG8_BAR; PG8_SCHED;
        }
        if constexpr (ALIGN_EPI) { if (wr == 0) PG8_BAR; }
        { int ln_; asm volatile("v_mbcnt_lo_u32_b32 %0, -1, 0\n\tv_mbcnt_hi_u32_b32 %0, -1, %0" : "=v"(ln_)); E(acc, cur, wr, wc, ln_ & 15, ln_ >> 4); }
        if (!has_next) break;
#pragma unroll
        for (int a = 0; a < 2; ++a)
#pragma unroll
            for (int b = 0; b < 2; ++b)
#pragma unroll
                for (int m = 0; m < 4; ++m)
#pragma unroll
                    for (int n = 0; n < 2; ++n) acc[a][b][m][n] = (f32x4){0.f, 0.f, 0.f, 0.f};
        cur = nxt; cA = nA; cB = nB; cB2 = nB2; ++ui;
        if constexpr (GATHER) {
#pragma unroll
            for (int h = 0; h < 2; ++h)
#pragma unroll
                for (int i = 0; i < 2; ++i) oC[h][i] = oN[h][i];
        }
        if constexpr (ALIGN_EPI) { if (wr == 1) PG8_BAR; }
    }
    PG8_WAIT_V(0);
    if constexpr (!ALIGN_EPI) { if (wr == 0) PG8_BAR; }
    PG8_BAR;
#undef PG8_SA
#undef PG8_SB
#undef PG8_STAGE
#undef PG8_STAGE1
#undef PG8_LDA
#undef PG8_LDB
#undef PG8_MMA
#undef PG8_WAIT_V
#undef PG8_WAIT_L
#undef PG8_BAR
#undef PG8_SCHED
}
}
using pg8::Unit;

struct DenseOrder {
    const char* A; const char* Bt; size_t tstepA, tstepB; int nM, nN, nwg, G, c;
    __device__ __forceinline__ void init(const void* A_, const void* Bt_, int M, int N, int K, int ldb, int G_, int c_) {
        A = (const char*)A_; Bt = (const char*)Bt_; tstepA = (size_t)256 * K * 2; tstepB = (size_t)256 * ldb * 2; nM = M / 256; nN = N / 256; nwg = nM * nN; G = G_; c = c_; }
    __device__ __forceinline__ bool next(int i, Unit& u) const {
        const long L = (long)i * G + c; if (L >= nwg) return false;
        int wgid = (int)L; { const int q = nwg / 8, r = nwg % 8, xcd = wgid % 8, off = wgid / 8; wgid = (xcd < r ? xcd * (q + 1) : r * (q + 1) + (xcd - r) * q) + off; }
        const int nig = 8 * nN, gid = wgid / nig, fm = gid * 8, gsz = (nM - fm) < 8 ? (nM - fm) : 8;
        u.pm = fm + ((wgid % nig) % gsz); u.pn = (wgid % nig) / gsz; u.cls = 0; u.p0 = 0; return true;
    }
    __device__ __forceinline__ const char* abase(const Unit& u) const { return A + (size_t)u.pm * tstepA; }
    __device__ __forceinline__ const char* bbase(const Unit& u) const { return Bt + (size_t)u.pn * tstepB; }
    __device__ __forceinline__ const char* bbase2(const Unit& u) const { return bbase(u); }
    __device__ __forceinline__ int rowtok(const Unit&, int) const { return 0; }
};

__device__ __forceinline__ void cls_experts(int cls, int& eA, int& eB) { const int g = cls / 6, p = cls % 6; const int a = (p >= 3) + (p >= 5), b = p < 3 ? p + 1 : (p < 5 ? p - 1 : 3); eA = 4 * g + a; eB = 4 * g + b; }
struct ExpertOrder {
    const LAS int* tb; const LAS int* cn; const int* list; const char* A; const char* W; int G, c, mode, layer;
    __device__ __forceinline__ bool next(int i, Unit& u) const {
        const int nwg = __builtin_amdgcn_readfirstlane(tb[NCLS]) * 4; const long L = (long)i * G + c; if (L >= nwg) return false;
        int wgid = (int)L; { const int q = nwg / 8, r = nwg % 8, xcd = wgid % 8, off = wgid / 8; wgid = (xcd < r ? xcd * (q + 1) : r * (q + 1) + (xcd - r) * q) + off; }
        const int rt = wgid >> 2; int cls = 0;
        for (int k = 1; k < NCLS; ++k) cls += (rt >= tb[k]) ? 1 : 0;
        cls = __builtin_amdgcn_readfirstlane(cls);
        u.pm = rt; u.pn = wgid & 3; u.cls = cls; u.p0 = __builtin_amdgcn_readfirstlane((rt - tb[cls]) * 256); return true;
    }
    __device__ __forceinline__ const char* abase(const Unit& u) const { return mode == 1 ? A : A + (size_t)u.pm * (256 * 512 * 2); }
    __device__ __forceinline__ const char* bbase(const Unit& u) const {
        if (mode == 1) { int eA, eB; cls_experts(u.cls, eA, eB); const int e = (u.pn >> 1) ? eB : eA; return W + ((size_t)(layer * 16 + e) * 512 + (size_t)(u.pn & 1) * 256) * (1024 * 2); }
        int eA, eB; cls_experts(u.cls, eA, eB); return W + ((size_t)(layer * 16 + eA) * 1024 + (size_t)u.pn * 256) * (256 * 2);
    }
    __device__ __forceinline__ const char* bbase2(const Unit& u) const { int eA, eB; cls_experts(u.cls, eA, eB); return W + ((size_t)(layer * 16 + eB) * 1024 + (size_t)u.pn * 256) * (256 * 2); }
    __device__ __forceinline__ int rowtok(const Unit& u, int rr) const { const int pos = u.p0 + rr; return pos < cn[u.cls] ? list[(size_t)u.cls * NTOK + pos] : DUMMY_ROW; }
};

__device__ __forceinline__ float row_rstd16(const float* ssq, int row, int fq, float inv_n) {
    const f32x4 v = *(const f32x4*)(ssq + (size_t)row * 16 + 4 * fq);
    float s = (v.x + v.y) + (v.z + v.w);
    s += __shfl_xor(s, 16); s += __shfl_xor(s, 32);
    return rsqrtf(s * inv_n + EPS);
}

struct EpiProj {
    bf16_t* proj; float* flog; const float* ssq1; const float* fb;
    __device__ __forceinline__ void operator()(const f32x4 (&acc)[2][2][4][2], const Unit& u, int wr, int wc, int fr, int fq) const {
#pragma unroll
        for (int ai = 0; ai < 2; ++ai)
#pragma unroll
            for (int m = 0; m < 4; ++m) {
                const int row = u.pm * 256 + ai * 128 + wr * 64 + m * 16 + fr;
                const float rs = row_rstd16(ssq1, row, fq, 1.f / DM);
                if (u.pn < 9) {
#pragma unroll
                    for (int bj = 0; bj < 2; ++bj) { const f32x4 v0 = acc[ai][bj][m][0] * rs, v1 = acc[ai][bj][m][1] * rs; u32x4 w;
                        w.x = cvt_pk_bf16(v0[0], v0[1]); w.y = cvt_pk_bf16(v0[2], v0[3]); w.z = cvt_pk_bf16(v1[0], v1[1]); w.w = cvt_pk_bf16(v1[2], v1[3]);
                        *(u32x4*)(proj + (size_t)row * PJ + u.pn * 256 + bj * 128 + wc * 32 + 8 * fq) = w; }
                } else if (wc == 0 && fq == 0) {
                    f32x4 o0, o1;
#pragma unroll
                    for (int e = 0; e < 4; ++e) { const float f0 = acc[ai][0][m][0][e] * rs + fb[e], f1 = acc[ai][0][m][1][e] * rs + fb[4 + e];
                        o0[e] = -log2f(1.f + exp2f(-f0 * LOG2E)); o1[e] = -log2f(1.f + exp2f(-f1 * LOG2E)); }
                    *(f32x4*)(flog + (size_t)row * 8) = o0; *(f32x4*)(flog + (size_t)row * 8 + 4) = o1;
                }
            }
    }
};
template <bool TOKMAP> struct EpiRes {
    bf16_t* h; float* ssq; const LAS int* cn; const int* list;
    __device__ __forceinline__ void operator()(const f32x4 (&acc)[2][2][4][2], const Unit& u, int wr, int wc, int fr, int fq) const {
#pragma unroll
        for (int ai = 0; ai < 2; ++ai)
#pragma unroll
            for (int m = 0; m < 4; ++m) {
                const int rr = ai * 128 + wr * 64 + m * 16 + fr; int row;
                if constexpr (TOKMAP) { const int pos = u.p0 + rr; row = pos < cn[u.cls] ? list[(size_t)u.cls * NTOK + pos] : DUMMY_ROW; } else row = u.pm * 256 + rr;
                float sq = 0.f;
#pragma unroll
                for (int bj = 0; bj < 2; ++bj) { bf16_t* p = h + (size_t)row * DM + u.pn * 256 + bj * 128 + wc * 32 + 8 * fq; const u32x4 o = *(const u32x4*)p;
                    const f32x4 a0 = acc[ai][bj][m][0], a1 = acc[ai][bj][m][1]; u32x4 w;
                    w.x = cvt_pk_bf16(bflo(o.x) + a0[0], bfhi(o.x) + a0[1]); w.y = cvt_pk_bf16(bflo(o.y) + a0[2], bfhi(o.y) + a0[3]);
                    w.z = cvt_pk_bf16(bflo(o.z) + a1[0], bfhi(o.z) + a1[1]); w.w = cvt_pk_bf16(bflo(o.w) + a1[2], bfhi(o.w) + a1[3]);
                    *(u32x4*)p = w;
                    sq += bflo(w.x) * bflo(w.x) + bfhi(w.x) * bfhi(w.x) + bflo(w.y) * bflo(w.y) + bfhi(w.y) * bfhi(w.y) + bflo(w.z) * bflo(w.z) + bfhi(w.z) * bfhi(w.z) + bflo(w.w) * bflo(w.w) + bfhi(w.w) * bfhi(w.w); }
                sq += __shfl_xor(sq, 16); sq += __shfl_xor(sq, 32);
                if (fq == 0) ssq[(size_t)row * 16 + u.pn * 4 + wc] = sq;
                if (m & 1) asm volatile("" ::: "memory");
            }
    }
};
struct EpiE1 {
    bf16_t* H1; const float* tinfo; const LAS int* cn; const int* list;
    __device__ __forceinline__ void operator()(const f32x4 (&acc)[2][2][4][2], const Unit& u, int wr, int wc, int fr, int fq) const {
#pragma unroll
        for (int ai = 0; ai < 2; ++ai)
#pragma unroll
            for (int m = 0; m < 4; ++m) {
                const int rr = ai * 128 + wr * 64 + m * 16 + fr; const int pos = u.p0 + rr;
                const int tok = pos < cn[u.cls] ? list[(size_t)u.cls * NTOK + pos] : DUMMY_ROW;
                const f32x4 ti = *(const f32x4*)(tinfo + (size_t)tok * 4);
                const float rs = ti.x, gate = (u.pn >> 1) ? ti.z : ti.y;
                float o[8];
#pragma unroll
                for (int n = 0; n < 2; ++n)
#pragma unroll
                    for (int e = 0; e < 4; ++e) { const float a = acc[ai][0][m][n][e] * rs, b = acc[ai][1][m][n][e] * rs; o[n * 4 + e] = gate * siluf_(a) * b; }
                u32x4 w; w.x = cvt_pk_bf16(o[0], o[1]); w.y = cvt_pk_bf16(o[2], o[3]); w.z = cvt_pk_bf16(o[4], o[5]); w.w = cvt_pk_bf16(o[6], o[7]);
                *(u32x4*)(H1 + (size_t)(u.pm * 256 + rr) * 512 + (u.pn >> 1) * 256 + (u.pn & 1) * 128 + wc * 32 + 8 * fq) = w;
            }
    }
};

__device__ __forceinline__ void meta_gemm16(const bf16_t* A, const bf16_t* Bt, int K, int n0, int wave, int lane, f32x4 (&acc)[2]) {
    const int m = lane & 15, q4 = lane >> 4;
    acc[0] = (f32x4){0.f, 0.f, 0.f, 0.f}; acc[1] = acc[0];
    const bf16_t* ap = A + (size_t)m * K + 8 * q4;
    const bf16_t* bp0 = Bt + (size_t)(n0 + 32 * wave + m) * K + 8 * q4; const bf16_t* bp1 = bp0 + (size_t)16 * K;
#pragma unroll 4
    for (int k0 = 0; k0 < K; k0 += 32) {
        const bf16x8 a = *(const bf16x8*)(ap + k0), b0 = *(const bf16x8*)(bp0 + k0), b1 = *(const bf16x8*)(bp1 + k0);
        acc[0] = __builtin_amdgcn_mfma_f32_16x16x32_bf16(b0, a, acc[0], 0, 0, 0);
        acc[1] = __builtin_amdgcn_mfma_f32_16x16x32_bf16(b1, a, acc[1], 0, 0, 0);
    }
}

#define XB_TMO      128
#define XB_XCNT(j)  (256  + 64 * (j))
#define XB_XSUB(j)  (1280 + 64 * (j))
#define XB_XGEN(j)  (2304 + 64 * (j))
#define XB_TOP      3328
#define XB_TOPGEN   3392
#define XCD_BAR_WORDS 3456
#define XB_SPIN_CAP (1u << 18)
__device__ __forceinline__ unsigned xb_ld(unsigned* p)              { return __hip_atomic_load(p, __ATOMIC_RELAXED, __HIP_MEMORY_SCOPE_AGENT); }
__device__ __forceinline__ unsigned xb_add(unsigned* p, unsigned v) { return __hip_atomic_fetch_add(p, v, __ATOMIC_RELAXED, __HIP_MEMORY_SCOPE_AGENT); }
__device__ __forceinline__ unsigned xb_xcc_id() { return (unsigned)__builtin_amdgcn_s_getreg((3 << 11) | 20) & 0xFu; }
#define XB_SPIN(cond, bar) do { unsigned _sp = 0; while (cond) { __builtin_amdgcn_s_sleep(1); \
    if ((++_sp & 255u) == 0u) { if (xb_ld(&(bar)[XB_TMO])) break; if (_sp > XB_SPIN_CAP) { atomicAdd(&(bar)[XB_TMO], 1u); break; } } } } while (0)
struct XcdBarrier { unsigned* bar; unsigned x; volatile LAS unsigned* st; };
__device__ __forceinline__ XcdBarrier xcd_barrier_post(unsigned* bar, volatile LAS unsigned* st) {
    XcdBarrier b; b.bar = bar; b.x = xb_xcc_id(); b.st = st;
    if (threadIdx.x == 0) (void)xb_add(&bar[XB_XCNT(b.x)], 1u);
    return b;
}
__device__ __forceinline__ void xcd_barrier_complete(unsigned* bar, unsigned x, unsigned& nloc, unsigned& nx) {
    const unsigned G = gridDim.x * gridDim.y * gridDim.z;
    unsigned sum, cnt, mine, sp = 0u;
    for (;;) {
        sum = 0u; cnt = 0u; mine = 0u;
#pragma unroll
        for (unsigned j = 0; j < 16; ++j) { const unsigned c = xb_ld(&bar[XB_XCNT(j)]); sum += c; cnt += (c > 0u) ? 1u : 0u; mine = (j == x) ? c : mine; }
        if (sum == G) break;
        __builtin_amdgcn_s_sleep(1);
        if ((++sp & 255u) == 0u) { if (xb_ld(&bar[XB_TMO])) break; if (sp > XB_SPIN_CAP) { atomicAdd(&bar[XB_TMO], 1u); break; } }
    }
    nloc = mine > 0u ? mine : 1u; nx = cnt > 0u ? cnt : 1u;
}
__device__ __forceinline__ void xcd_barrier(const XcdBarrier& b, const bool leader_thread) {
    asm volatile("s_waitcnt vmcnt(0)" ::: "memory");
    __syncthreads();
    if (leader_thread) {
        unsigned* bar = b.bar; asm volatile("" : "+s"(bar));
        __builtin_amdgcn_s_waitcnt(0);
        unsigned nloc = b.st[0], nx = b.st[1];
        if (nloc == 0u) { xcd_barrier_complete(bar, b.x, nloc, nx); b.st[0] = nloc; b.st[1] = nx; }
        const unsigned old = xb_add(&bar[XB_XSUB(b.x)], 1u);
        const unsigned gen = old / nloc;
        if (old + 1u == (gen + 1u) * nloc) {
            __builtin_amdgcn_fence(__ATOMIC_RELEASE, "agent");
            asm volatile("s_waitcnt vmcnt(0)" ::: "memory");
            const unsigned og = xb_add(&bar[XB_TOP], 1u);
            const unsigned tg = og / nx;
            if (og + 1u == (tg + 1u) * nx) xb_add(&bar[XB_TOPGEN], 1u);
            else XB_SPIN(xb_ld(&bar[XB_TOPGEN]) == tg, bar);
            __builtin_amdgcn_fence(__ATOMIC_ACQUIRE, "agent");
            xb_add(&bar[XB_XGEN(b.x)], 1u);
            asm volatile("s_waitcnt vmcnt(0)" ::: "memory");
        } else {
            XB_SPIN(xb_ld(&bar[XB_XGEN(b.x)]) == gen, bar);
            __builtin_amdgcn_fence(__ATOMIC_ACQUIRE, "agent");
            asm volatile("s_waitcnt vmcnt(0)" ::: "memory");
        }
    }
    __syncthreads();
}

template <class Get>
__device__ __forceinline__ void tr_item(const Get& get, bf16_t* dst, int dpitch, int k0, int n0, LAS float* scr, int lane) {
    float tv[32];
#pragma unroll
    for (int i = 0; i < 32; ++i) tv[i] = get(k0 + 2 * i + (lane >> 5), n0 + (lane & 31));
#pragma unroll
    for (int i = 0; i < 32; ++i) scr[(2 * i + (lane >> 5)) * 33 + (lane & 31)] = tv[i];
    LDS_WAIT(); asm volatile("" ::: "memory");
    const int c = lane & 7;
#pragma unroll
    for (int j = 0; j < 4; ++j) { const int n = (lane >> 3) + 8 * j; const LAS float* s = scr + (8 * c) * 33 + n;
        u32x4 o; o.x = pk2(s[0 * 33], s[1 * 33]); o.y = pk2(s[2 * 33], s[3 * 33]); o.z = pk2(s[4 * 33], s[5 * 33]); o.w = pk2(s[6 * 33], s[7 * 33]);
        *(u32x4*)(dst + (size_t)(n0 + n) * dpitch + k0 + 8 * c) = o; }
    LDS_WAIT(); asm volatile("" ::: "memory");
}
struct GetWin { const float* w; const float* g;
    __device__ __forceinline__ float operator()(int k, int n) const { int src; if (n < 2048) src = n; else if (n < 2304) src = n + 8; else if (n < 2312) src = n - 256; else return 0.f;
        float v = w[(size_t)k * DINSRC + src] * g[k]; if (n >= PQ && n < PK) v *= 0.125f * LOG2E; return v; } };
struct GetWout { const float* w; const float* ga; const float* gs;
    __device__ __forceinline__ float operator()(int k, int n) const { const int src = k < 768 ? k + 256 : k - 768; const float gn = k < 512 ? ga[k] : (k < 768 ? gs[k - 512] : 1.f);
        return w[(size_t)src * DM + n] * gn; } };
struct GetW13 { const float* w1; const float* w3; const float* g;
    __device__ __forceinline__ float operator()(int k, int n) const { const int u = n >> 8, hf = (n >> 7) & 1, j = n & 127; const uintptr_t wp = (uintptr_t)w1 + (uintptr_t)hf * ((uintptr_t)w3 - (uintptr_t)w1); return ((const float*)wp)[(size_t)k * 256 + u * 128 + j] * g[k]; } };
struct GetW2 { const float* w;
    __device__ __forceinline__ float operator()(int k, int n) const { return w[(size_t)k * DM + n]; } };
struct GetWr { const float* rg; const float* re; const float* g; int lo;
    __device__ __forceinline__ float operator()(int k, int n) const { float v = 0.f; if (n < 4) v = rg[(size_t)k * 4 + n]; else if (n < 20) v = re[(size_t)k * 16 + (n - 4)]; v *= g[k];
        if (lo) v = v - __uint_as_float(f2bf(v) << 16); return v; } };

constexpr int AT_SLOT = 16384, AT_CS = 65536, AT_WT = AT_CS + 4608 * 4;
__device__ __forceinline__ int crow(int r, int hi) { return (r & 3) + 8 * (r >> 2) + 4 * hi; }
__device__ __forceinline__ void attn_prefix(LAS unsigned char* lds, const int tid, const float* flog, int b, int h) {
    const int lane = tid & 63; const int w = __builtin_amdgcn_readfirstlane(tid >> 6);
    LAS float* cs = (LAS float*)(lds + AT_CS); LAS float* wt = (LAS float*)(lds + AT_WT);
    float v[9]; float run = 0.f;
#pragma unroll
    for (int i = 0; i < 9; ++i) { const int j = tid * 9 + i; float x = 0.f; if (j < NMETA + SEQ) x = flog[(size_t)rowof(b, j) * 8 + h]; run += x; v[i] = run; }
    float inc = run;
#pragma unroll
    for (int o = 1; o < 64; o <<= 1) { const float t = __shfl_up(inc, o); if (lane >= o) inc += t; }
    if (lane == 63) wt[w] = inc;
    __syncthreads();
    float base = inc - run;
    for (int k = 0; k < w; ++k) base += wt[k];
#pragma unroll
    for (int i = 0; i < 9; ++i) cs[tid * 9 + i] = base + v[i];
    __syncthreads();
}
__device__ __forceinline__ void at_glds16(const void* gsrc, unsigned lds_dst) { unsigned keep;
    asm volatile("s_mov_b32 %0, m0\n\ts_mov_b32 m0, %2\n\ts_nop 0\n\tglobal_load_lds_dwordx4 %1, off\n\ts_mov_b32 m0, %0" : "=&s"(keep) : "v"(gsrc), "s"(lds_dst) : "memory"); }
constexpr float AT_THR = 8.f;
__device__ __forceinline__ void attn_unit(LAS unsigned char* lds, const int tid, const bf16_t* proj, bf16_t* mixed, float* ssqa, int b, int h, int qt) {
    const int lane = tid & 63, r32 = lane & 31, hi = lane >> 5; const int w = __builtin_amdgcn_readfirstlane(tid >> 6);
    const LAS float* cs = (const LAS float*)(lds + AT_CS);
    const int qrel = 32 * w + r32;
    const int qrow = qt >= 0 ? b * SEQ + 256 * qt + qrel : NREAL + (qrel & 15);
    const int qkey = qt >= 0 ? NMETA + 256 * qt + qrel : (qrel & 15);
    const int qkey_w0 = qt >= 0 ? NMETA + 256 * qt + 32 * w : 0;
    const float cq = cs[qkey];
    bf16x8 qr[4];
#pragma unroll
    for (int d0 = 0; d0 < 4; ++d0) qr[d0] = *(const bf16x8*)(proj + (size_t)qrow * PJ + PQ + h * 64 + d0 * 16 + hi * 8);
    const int ntiles = qt >= 0 ? 1 + 4 * (qt + 1) : 1;
    const int wnt = qt >= 0 ? 4 * qt + (w >> 1) + 2 : 1;
    const int vr = 16 * (w & 3) + (lane >> 2);
    const unsigned ldsb = (unsigned)(uintptr_t)lds;
#define AT_DMA(jj) do { int kr_, vr_; if ((jj) == 0) { kr_ = NREAL + (lane < 15 ? lane : 15); vr_ = NREAL + (vr < 15 ? vr : 15); } else { kr_ = b * SEQ + 64 * ((jj) - 1) + lane; vr_ = b * SEQ + 64 * ((jj) - 1) + vr; } \
        const int so_ = ((jj) & 3) * AT_SLOT + w * 1024; \
        at_glds16(proj + (size_t)kr_ * PJ + PK + h * 64 + w * 8, (unsigned)__builtin_amdgcn_readfirstlane(ldsb + so_)); \
        at_glds16(proj + (size_t)vr_ * PJ + PV + h * 64 + (w >> 2) * 32 + (lane & 3) * 8, (unsigned)__builtin_amdgcn_readfirstlane(ldsb + so_ + 8192)); } while (0)
#define AT_WAITBAR(n) asm volatile("s_waitcnt vmcnt(" #n ") lgkmcnt(0)\n\ts_barrier" ::: "memory")
    float mref = 0.f, lrun = 0.f; f32x16 o0 = {}, o1 = {};
    const int kfo = hi * 1024 + r32 * 16;
    const int vb = 8192 + ((lane >> 4) & 1) * 32 + (lane & 3) * 8 + (4 * hi + ((lane & 15) >> 2)) * 64;
    const LAS float* csl = cs + 4 * hi;
#define AT_QK(P0, P1, jjn, so) do { const int kb_ = (jjn) == 0 ? 0 : NMETA + 64 * ((jjn) - 1); const float cqm = cq - mref; \
        bf16x8 kf_[8]; \
        _Pragma("unroll") for (int d0 = 0; d0 < 4; ++d0) { kf_[2 * d0] = *(const LAS bf16x8*)(lds + (so) + kfo + d0 * 2048); kf_[2 * d0 + 1] = *(const LAS bf16x8*)(lds + (so) + kfo + d0 * 2048 + 512); } \
        __builtin_amdgcn_sched_barrier(0); \
        _Pragma("unroll") for (int g_ = 0; g_ < 4; ++g_) { const f32x4 c0_ = *(const LAS f32x4*)(csl + kb_ + 8 * g_), c1_ = *(const LAS f32x4*)(csl + kb_ + 32 + 8 * g_); \
            _Pragma("unroll") for (int e_ = 0; e_ < 4; ++e_) { P0[4 * g_ + e_] = cqm - c0_[e_]; P1[4 * g_ + e_] = cqm - c1_[e_]; } } \
        __builtin_amdgcn_sched_barrier(0); \
        _Pragma("unroll") for (int d0 = 0; d0 < 4; ++d0) { \
            P0 = __builtin_amdgcn_mfma_f32_32x32x16_bf16(kf_[2 * d0], qr[d0], P0, 0, 0, 0); P1 = __builtin_amdgcn_mfma_f32_32x32x16_bf16(kf_[2 * d0 + 1], qr[d0], P1, 0, 0, 0); } \
        __builtin_amdgcn_sched_barrier(0); } while (0)
#define AT_SMPV(P0, P1, N0, N1, jj, pend, so) do { const int kb_ = (jj) == 0 ? 0 : NMETA + 64 * ((jj) - 1); \
        const LAS unsigned char* Vb_ = lds + (so) + vb; s16x4 va_[8], vc_[8]; \
        _Pragma("unroll") for (int ks = 0; ks < 4; ++ks) { \
            va_[2 * ks] = __builtin_bit_cast(s16x4, __builtin_amdgcn_ds_read_tr16_b64_v4i16((LAS s16x4*)(Vb_ + ks * 1024))); \
            va_[2 * ks + 1] = __builtin_bit_cast(s16x4, __builtin_amdgcn_ds_read_tr16_b64_v4i16((LAS s16x4*)(Vb_ + ks * 1024 + 512))); \
            vc_[2 * ks] = __builtin_bit_cast(s16x4, __builtin_amdgcn_ds_read_tr16_b64_v4i16((LAS s16x4*)(Vb_ + 4096 + ks * 1024))); \
            vc_[2 * ks + 1] = __builtin_bit_cast(s16x4, __builtin_amdgcn_ds_read_tr16_b64_v4i16((LAS s16x4*)(Vb_ + 4096 + ks * 1024 + 512))); } \
        __builtin_amdgcn_sched_barrier(0); \
        if ((jj) == 0 || kb_ + 63 > qkey_w0) { const int lim_ = (jj) == 0 ? (qkey < 15 ? qkey : 15) : qkey; \
            _Pragma("unroll") for (int r = 0; r < 16; ++r) { const int j_ = kb_ + crow(r, hi); if (j_ > lim_) P0[r] = -INFINITY; if (j_ + 32 > lim_) P1[r] = -INFINITY; } } \
        float rm_ = fmaxf(P0[0], P1[0]); \
        _Pragma("unroll") for (int r = 1; r < 16; ++r) rm_ = fmaxf(rm_, fmaxf(P0[r], P1[r])); \
        rm_ = fmaxf(rm_, __shfl_xor(rm_, 32)); \
        if ((jj) == 0 || __any(rm_ > AT_THR)) { const float dl_ = (jj) == 0 ? rm_ : fmaxf(rm_, 0.f); mref += dl_; const float f_ = (jj) == 0 ? 1.f : fast_exp2(-dl_); lrun *= f_; \
            _Pragma("unroll") for (int r = 0; r < 16; ++r) { P0[r] -= dl_; P1[r] -= dl_; o0[r] *= f_; o1[r] *= f_; } \
            if (pend) { _Pragma("unroll") for (int r = 0; r < 16; ++r) { N0[r] -= dl_; N1[r] -= dl_; } } } \
        float rs_ = 0.f; \
        _Pragma("unroll") for (int r = 0; r < 16; ++r) { P0[r] = fast_exp2(P0[r]); P1[r] = fast_exp2(P1[r]); rs_ += P0[r] + P1[r]; } \
        lrun += rs_; \
        u32x4 pw_[4]; \
        _Pragma("unroll") for (int i = 0; i < 4; ++i) { pw_[0][i] = cvt_pk_bf16(P0[2 * i], P0[2 * i + 1]); pw_[1][i] = cvt_pk_bf16(P0[8 + 2 * i], P0[8 + 2 * i + 1]); \
            pw_[2][i] = cvt_pk_bf16(P1[2 * i], P1[2 * i + 1]); pw_[3][i] = cvt_pk_bf16(P1[8 + 2 * i], P1[8 + 2 * i + 1]); } \
        __builtin_amdgcn_sched_barrier(0); \
        _Pragma("unroll") for (int ks = 0; ks < 4; ++ks) { \
            const bf16x8 va = {va_[2 * ks][0], va_[2 * ks][1], va_[2 * ks][2], va_[2 * ks][3], va_[2 * ks + 1][0], va_[2 * ks + 1][1], va_[2 * ks + 1][2], va_[2 * ks + 1][3]}; \
            const bf16x8 vbb = {vc_[2 * ks][0], vc_[2 * ks][1], vc_[2 * ks][2], vc_[2 * ks][3], vc_[2 * ks + 1][0], vc_[2 * ks + 1][1], vc_[2 * ks + 1][2], vc_[2 * ks + 1][3]}; \
            const bf16x8 pf = __builtin_bit_cast(bf16x8, pw_[ks]); \
            o0 = __builtin_amdgcn_mfma_f32_32x32x16_bf16(va, pf, o0, 0, 0, 0); o1 = __builtin_amdgcn_mfma_f32_32x32x16_bf16(vbb, pf, o1, 0, 0, 0); } \
        __builtin_amdgcn_sched_barrier(0); } while (0)
#define AT_STEP(C0, C1, N0, N1, jj) do { \
        const bool dma_ = (jj) + 3 < ntiles; \
        if (dma_) AT_DMA((jj) + 3); \
        const bool pend_ = (jj) + 1 < wnt; \
        if (pend_) AT_QK(N0, N1, (jj) + 1, (((jj) + 1) & 3) * AT_SLOT); \
        if ((jj) < wnt) AT_SMPV(C0, C1, N0, N1, jj, pend_, ((jj) & 3) * AT_SLOT); \
        if (dma_) AT_WAITBAR(2); else AT_WAITBAR(0); } while (0)
    AT_DMA(0);
    if (ntiles > 1) AT_DMA(1);
    if (ntiles > 2) { AT_DMA(2); AT_WAITBAR(2); } else AT_WAITBAR(0);
    f32x16 pa0, pa1, pb0, pb1;
    AT_QK(pa0, pa1, 0, 0);
#pragma unroll 1
    for (int jj = 0; jj < ntiles; jj += 2) {
        AT_STEP(pa0, pa1, pb0, pb1, jj);
        if (jj + 1 < ntiles) AT_STEP(pb0, pb1, pa0, pa1, jj + 1);
    }
#undef AT_DMA
#undef AT_WAITBAR
#undef AT_QK
#undef AT_SMPV
#undef AT_STEP
    const float ltot = lrun + __shfl_xor(lrun, 32);
    const float inv = 1.f / ltot;
    float sq = 0.f;
#pragma unroll
    for (int r = 0; r < 16; ++r) { o0[r] *= inv; o1[r] *= inv; sq += o0[r] * o0[r] + o1[r] * o1[r]; }
    sq += __shfl_xor(sq, 32);
    const bool st = qt >= 0 || qrel < 16;
    if (st) {
        bf16_t* op = mixed + (size_t)qrow * DM + MX_ATT + h * 64;
#pragma unroll
        for (int g = 0; g < 4; ++g) { u32x2 w0, w1; w0.x = cvt_pk_bf16(o0[4 * g], o0[4 * g + 1]); w0.y = cvt_pk_bf16(o0[4 * g + 2], o0[4 * g + 3]); w1.x = cvt_pk_bf16(o1[4 * g], o1[4 * g + 1]); w1.y = cvt_pk_bf16(o1[4 * g + 2], o1[4 * g + 3]);
            *(u32x2*)(op + 8 * g + 4 * hi) = w0; *(u32x2*)(op + 32 + 8 * g + 4 * hi) = w1; }
        if (hi == 0) ssqa[(size_t)qrow * 8 + h] = sq;
    }
    __syncthreads();
}

constexpr int CV_U = 0, CV_Y = 65536;
__device__ __forceinline__ void conv_subtile(LAS unsigned char* lds, const int tid, const bf16_t* proj, bf16_t* mixed, const float* cw, const float* cb, const float* lg, const float* lb, int b, int t0, int nvalid) {
    const int lane = tid & 63; const int w = __builtin_amdgcn_readfirstlane(tid >> 6);
    LAS float* ub = (LAS float*)(lds + CV_U); LAS float* yb = (LAS float*)(lds + CV_Y);
    for (int idx = tid; idx < 62 * 64; idx += 512) {
        const int rr = idx >> 6, cq4 = (idx & 63) * 4; const int t = t0 - 30 + rr; f32x4 u = {0.f, 0.f, 0.f, 0.f};
        if (t >= 0 && t < NMETA + SEQ) { const bf16_t* p = proj + (size_t)rowof(b, t) * PJ + cq4; const u32x2 a = *(const u32x2*)p, g = *(const u32x2*)(p + 256);
            u[0] = bflo(a.x) * sigmoidf_(bflo(g.x)); u[1] = bfhi(a.x) * sigmoidf_(bfhi(g.x)); u[2] = bflo(a.y) * sigmoidf_(bflo(g.y)); u[3] = bfhi(a.y) * sigmoidf_(bfhi(g.y)); }
        *(LAS f32x4*)(ub + rr * 256 + cq4) = u;
    }
    __syncthreads();
    {
        const int c = tid & 255, rh = tid >> 8;
        float wv[31];
#pragma unroll
        for (int j = 0; j < 31; ++j) wv[j] = cw[j * 256 + c];
        float acc[16];
#pragma unroll
        for (int i = 0; i < 16; ++i) acc[i] = 0.f;
#pragma unroll
        for (int rr = 0; rr < 46; ++rr) { const float uv = ub[(16 * rh + rr) * 256 + c];
#pragma unroll
            for (int i = 0; i < 16; ++i) if (rr - i >= 0 && rr - i <= 30) acc[i] += wv[rr - i] * uv; }
        const float bb = cb[c];
#pragma unroll
        for (int i = 0; i < 16; ++i) yb[(16 * rh + i) * 256 + c] = acc[i] + bb;
    }
    __syncthreads();
    {
        const f32x4 g4 = *(const f32x4*)(lg + 4 * lane), b4 = *(const f32x4*)(lb + 4 * lane);
#pragma unroll
        for (int i = 0; i < 4; ++i) { const int rr = 4 * w + i; const f32x4 y = *(const LAS f32x4*)(yb + rr * 256 + 4 * lane);
            const float mu = wave_sum((y[0] + y[1]) + (y[2] + y[3])) * (1.f / 256.f);
            const f32x4 d = y - mu; const float var = wave_sum((d[0] * d[0] + d[1] * d[1]) + (d[2] * d[2] + d[3] * d[3])) * (1.f / 256.f);
            const float rs = rsqrtf(var + EPS); f32x4 o;
#pragma unroll
            for (int e = 0; e < 4; ++e) o[e] = siluf_(d[e] * rs * g4[e] + b4[e]);
            if (rr < nvalid) { u32x2 wv2; wv2.x = cvt_pk_bf16(o[0], o[1]); wv2.y = cvt_pk_bf16(o[2], o[3]); *(u32x2*)(mixed + (size_t)rowof(b, t0 + rr) * DM + MX_CONV + 4 * lane) = wv2; } }
    }
    __syncthreads();
}

struct S5P { const float *lre, *lim, *ldt, *bre, *bim, *cre, *cim, *dsk, *gw, *gb; };
__device__ __forceinline__ float gelu_tanh(float x) { const float u = 0.7978845608028654f * (x + 0.044715f * x * x * x); const float e = fast_exp2(2.f * LOG2E * u); const float th = 1.f - 2.f * fast_rcp(e + 1.f); return 0.5f * x * (1.f + th); }
__device__ __forceinline__ void s5_seq_unit(const S5P& P, const bf16_t* proj, bf16_t* mixed, float* ssqs, int b, int g, int lane) {
    const int p = lane;
    const float dt = expf(P.ldt[g]);
    const float lr = P.lre[g * 64 + p], li = P.lim[g * 64 + p];
    const float mag = expf(lr * dt);
    const double turns = (double)li * (double)dt * 0.15915494309189535; const float fr = (float)(turns - floor(turns));
    const float ar = mag * __builtin_amdgcn_cosf(fr), ai = mag * __builtin_amdgcn_sinf(fr);
    const float nr = ar - 1.f, ni = ai, den = lr * lr + li * li;
    const float fre = (nr * lr + ni * li) / den, fim = (ni * lr - nr * li) / den;
    float bbr[16], bbi[16], cr[16], ci[16];
#pragma unroll
    for (int h = 0; h < 16; ++h) { const float br = P.bre[(g * 64 + p) * 16 + h], bi = P.bim[(g * 64 + p) * 16 + h]; bbr[h] = fre * br - fim * bi; bbi[h] = fre * bi + fim * br;
        cr[h] = P.cre[(g * 16 + h) * 64 + p]; ci[h] = P.cim[(g * 16 + h) * 64 + p]; }
    const int hl = ((lane >> 5) & 1) * 8 + ((lane >> 4) & 1) * 4 + ((lane >> 3) & 1) * 2 + ((lane >> 2) & 1);
    const float dsk = P.dsk[g * 16 + hl], gbk = P.gb[g * 16 + hl];
    float gwk[16];
#pragma unroll
    for (int h = 0; h < 16; ++h) gwk[h] = P.gw[(g * 16 + h) * 16 + hl];
    float xr = 0.f, xi = 0.f;
    u32x4 nua = *(const u32x4*)(proj + (size_t)rowof(b, 0) * PJ + PU + 16 * g), nub = *(const u32x4*)(proj + (size_t)rowof(b, 0) * PJ + PU + 16 * g + 8);
#pragma unroll 1
    for (int t = 0; t < NMETA + SEQ; ++t) {
        const int row = rowof(b, t);
        const u32x4 ua = nua, ub = nub;
        { const int tn = t + 1 < NMETA + SEQ ? t + 1 : t; const bf16_t* np = proj + (size_t)rowof(b, tn) * PJ + PU + 16 * g; nua = *(const u32x4*)np; nub = *(const u32x4*)(np + 8); }
        float u[16]; u[0] = bflo(ua.x); u[1] = bfhi(ua.x); u[2] = bflo(ua.y); u[3] = bfhi(ua.y); u[4] = bflo(ua.z); u[5] = bfhi(ua.z); u[6] = bflo(ua.w); u[7] = bfhi(ua.w);
        u[8] = bflo(ub.x); u[9] = bfhi(ub.x); u[10] = bflo(ub.y); u[11] = bfhi(ub.y); u[12] = bflo(ub.z); u[13] = bfhi(ub.z); u[14] = bflo(ub.w); u[15] = bfhi(ub.w);
        float bur = 0.f, bui = 0.f;
#pragma unroll
        for (int h = 0; h < 16; ++h) { bur += bbr[h] * u[h]; bui += bbi[h] * u[h]; }
        const float nxr = ar * xr - ai * xi + bur, nxi = ar * xi + ai * xr + bui; xr = nxr; xi = nxi;
        float v[16];
#pragma unroll
        for (int h = 0; h < 16; ++h) v[h] = cr[h] * xr - ci[h] * xi;
        float v8[8], v4[4], v2[2], v1;
        { const bool up = (lane >> 5) & 1;
#pragma unroll
          for (int i = 0; i < 8; ++i) { const float send = up ? v[i] : v[i + 8], keep = up ? v[i + 8] : v[i]; v8[i] = keep + __shfl_xor(send, 32); } }
        { const bool up = (lane >> 4) & 1;
#pragma unroll
          for (int i = 0; i < 4; ++i) { const float send = up ? v8[i] : v8[i + 4], keep = up ? v8[i + 4] : v8[i]; v4[i] = keep + __shfl_xor(send, 16); } }
        { const bool up = (lane >> 3) & 1;
#pragma unroll
          for (int i = 0; i < 2; ++i) { const float send = up ? v4[i] : v4[i + 2], keep = up ? v4[i + 2] : v4[i]; v2[i] = keep + __shfl_xor(send, 8); } }
        { const bool up = (lane >> 2) & 1; const float send = up ? v2[0] : v2[1], keep = up ? v2[1] : v2[0]; v1 = keep + __shfl_xor(send, 4); }
        v1 += __shfl_xor(v1, 2); v1 += __shfl_xor(v1, 1);
        float uh = u[0];
#pragma unroll
        for (int h = 1; h < 16; ++h) uh = (hl == h) ? u[h] : uh;
        const float y = v1 + dsk * uh;
        const float zg = gelu_tanh(y);
        float gate = gbk;
#pragma unroll
        for (int h = 0; h < 16; ++h) { const int src = ((h >> 3) & 1) * 32 + ((h >> 2) & 1) * 16 + ((h >> 1) & 1) * 8 + (h & 1) * 4; gate += __shfl(zg, src) * gwk[h]; }
        const float outv = zg * sigmoidf_(gate);
        float sq = outv * outv;
        sq += __shfl_xor(sq, 32); sq += __shfl_xor(sq, 16); sq += __shfl_xor(sq, 8); sq += __shfl_xor(sq, 4);
        if (t >= NMETA || b == 0) {
            if ((lane & 3) == 0) mixed[(size_t)row * DM + MX_SSM + 16 * g + hl] = (bf16_t)f2bf(outv);
            if (lane == 0) ssqs[(size_t)row * 16 + g] = sq;
        }
    }
}

constexpr size_t S5T_BYTES = 163840;
constexpr int S5_KT = 0, S5_WS = 8704, S5_WC = 74240, S5_MD = 139776, S5_MC = 142848;
constexpr int S5L_KT = 0, S5L_W = 8704, S5L_EX = 78336, S5L_MD = 82944, S5L_MC = 86016;
__device__ __forceinline__ void s5_tables_block(LAS unsigned char* lds, const int tid, const S5P& P, int g, unsigned char* tbl) {
    typedef float f2 __attribute__((ext_vector_type(2)));
    LAS f2* pw = (LAS f2*)lds;
    LAS f2* Bb = (LAS f2*)(lds + 8704);
    LAS f2* Cc = (LAS f2*)(lds + 16896);
    if (tid < 64) {
        const int p = tid;
        const float dt = expf(P.ldt[g]);
        const float lr = P.lre[g * 64 + p], li = P.lim[g * 64 + p];
        const float mag = expf(lr * dt);
        const double turns = (double)li * (double)dt * 0.15915494309189535; const float fr = (float)(turns - floor(turns));
        const float ar = mag * __builtin_amdgcn_cosf(fr), ai = mag * __builtin_amdgcn_sinf(fr);
        const float nr = ar - 1.f, ni = ai, den = lr * lr + li * li;
        const float fre = (nr * lr + ni * li) / den, fim = (ni * lr - nr * li) / den;
        float xr = 1.f, xi = 0.f;
        for (int t = 0; t <= 16; ++t) { pw[t * 64 + p] = (f2){xr, xi}; const float nxr = xr * ar - xi * ai, nxi = xr * ai + xi * ar; xr = nxr; xi = nxi; }
        const f2 M = pw[16 * 64 + p];
        float* MD = (float*)(tbl + S5_MD); float* MC = (float*)(tbl + S5_MC);
        float mr = M.x, mi = M.y;
        for (int k = 0; k < 6; ++k) { MD[(k * 64 + p) * 2] = mr; MD[(k * 64 + p) * 2 + 1] = mi; const float n1 = mr * mr - mi * mi, n2 = 2.f * mr * mi; mr = n1; mi = n2; }
        xr = 1.f; xi = 0.f;
        for (int c = 0; c < 32; ++c) { MC[(c * 64 + p) * 2] = xr; MC[(c * 64 + p) * 2 + 1] = xi; const float nxr = xr * M.x - xi * M.y, nxi = xr * M.y + xi * M.x; xr = nxr; xi = nxi; }
        for (int h = 0; h < 16; ++h) { const float br = P.bre[(g * 64 + p) * 16 + h], bi = P.bim[(g * 64 + p) * 16 + h]; Bb[p * 16 + h] = (f2){fre * br - fim * bi, fre * bi + fim * br}; }
    }
    for (int e = tid; e < 1024; e += 512) Cc[e] = (f2){P.cre[g * 1024 + e], P.cim[g * 1024 + e]};
    __syncthreads();
    bf16_t* KT = (bf16_t*)(tbl + S5_KT); bf16_t* WSg = (bf16_t*)(tbl + S5_WS); bf16_t* WCg = (bf16_t*)(tbl + S5_WC);
    for (int e = tid; e < 17 * 256; e += 512) {
        const int t1 = e >> 8, h = (e >> 4) & 15, h2 = e & 15; float acc = 0.f;
        if (t1 > 0) { const int tau = t1 - 1;
            for (int p = 0; p < 64; ++p) { const f2 a = pw[tau * 64 + p], bb = Bb[p * 16 + h2], c = Cc[h * 64 + p]; const float zr = a.x * bb.x - a.y * bb.y, zi = a.x * bb.y + a.y * bb.x; acc += c.x * zr - c.y * zi; }
            if (tau == 0 && h == h2) acc += P.dsk[g * 16 + h]; }
        KT[e] = (bf16_t)f2bf(acc);
    }
    for (int e = tid; e < 128 * 256; e += 512) {
        const int r = e >> 8, ri = r >> 6, p = r & 63, q = e & 255, j = q >> 4, h2 = q & 15;
        const f2 a = pw[(15 - j) * 64 + p], bb = Bb[p * 16 + h2]; const float zr = a.x * bb.x - a.y * bb.y, zi = a.x * bb.y + a.y * bb.x;
        WSg[e] = (bf16_t)f2bf(ri ? zi : zr);
    }
    for (int e = tid; e < 256 * 128; e += 512) {
        const int row = e >> 7, i = row >> 4, h = row & 15, q = e & 127; const int blk = q >> 5, sq_ = (q >> 4) & 1, hh = (q >> 3) & 1, j = q & 7;
        const int n = 32 * blk + 16 * sq_ + 8 * (j >> 2) + 4 * hh + (j & 3); const int ri = n >> 6, p = n & 63;
        const f2 a = pw[(i + 1) * 64 + p], c = Cc[h * 64 + p]; const float zr = c.x * a.x - c.y * a.y, zi = c.x * a.y + c.y * a.x;
        WCg[e] = (bf16_t)f2bf(ri ? -zi : zr);
    }
    __syncthreads();
}

__device__ __forceinline__ void s5_unit(LAS unsigned char* lds, const int tid, const unsigned char* tbl, const float* gw, const float* gb, const bf16_t* proj, bf16_t* mixed, float* ssqs, int b, int g) {
    typedef float f2 __attribute__((ext_vector_type(2)));
    const int lane = tid & 63, c = lane & 31, hi = lane >> 5; const int w = __builtin_amdgcn_readfirstlane(tid >> 6);
    for (int q = tid; q < 544; q += 512) *(LAS u32x4*)(lds + S5L_KT + q * 16) = *(const u32x4*)(tbl + S5_KT + q * 16);
#pragma unroll
    for (int it = 0; it < 8; ++it) { const int q = tid + 512 * it; *(LAS u32x4*)(lds + S5L_W + (q >> 5) * 528 + (q & 31) * 16) = *(const u32x4*)(tbl + S5_WS + q * 16); }
    if (tid < 192) *(LAS u32x4*)(lds + S5L_MD + tid * 16) = *(const u32x4*)(tbl + S5_MD + tid * 16);
#pragma unroll
    for (int it = 0; it < 4; ++it) { const int q = tid + 512 * it; *(LAS u32x2*)(lds + S5L_MC + (q >> 6) * 520 + (q & 63) * 8) = *(const u32x2*)(tbl + S5_MC + q * 8); }
    __syncthreads();
    const bf16_t* ubase = proj + PU + 16 * g + 8 * hi;
    const LAS unsigned char* mdb = lds + S5L_MD + hi * 32;
    const LAS unsigned char* mcb = lds + S5L_MC + c * 520 + hi * 32;
    LAS float* EX = (LAS float*)(lds + S5L_EX) + 4 * hi;
    const LAS unsigned char* wsb = lds + S5L_W + c * 528 + hi * 16;
    const LAS unsigned char* wcb = lds + S5L_W + c * 272 + hi * 16;
    f32x16 sa[4];
#pragma unroll
    for (int k = 0; k < 4; ++k) sa[k] = (f32x16){};
    {
        const int cc = 32 * w + c;
        const bf16_t* up = ubase + (size_t)rowof(b, 16 * cc) * PJ;
#pragma unroll
        for (int s0 = 0; s0 < 16; s0 += 4) {
            bf16x8 uf[4];
#pragma unroll
            for (int s = 0; s < 4; ++s) { uf[s] = *(const bf16x8*)up; up += PJ; asm volatile("" : "+v"(up)); }
#pragma unroll
            for (int s = 0; s < 4; ++s) {
#pragma unroll
                for (int blk = 0; blk < 4; ++blk) { const bf16x8 A = *(const LAS bf16x8*)(wsb + blk * (32 * 528) + (s0 + s) * 32); sa[blk] = __builtin_amdgcn_mfma_f32_32x32x16_bf16(A, uf[s], sa[blk], 0, 0, 0); }
                __builtin_amdgcn_sched_barrier(0); }
        }
    }
#pragma unroll
    for (int k = 0; k < 5; ++k) { const int d = 1 << k;
#pragma unroll
        for (int pb = 0; pb < 2; ++pb)
#pragma unroll
            for (int r = 0; r < 16; ++r) { const f2 m = *(const LAS f2*)(mdb + (k * 64 + 32 * pb + (r & 3) + 8 * (r >> 2)) * 8);
                const float yr = __shfl_up(sa[pb][r], d, 32), yi = __shfl_up(sa[2 + pb][r], d, 32);
                if (c >= d) { sa[pb][r] += m.x * yr - m.y * yi; sa[2 + pb][r] += m.x * yi + m.y * yr; }
                if ((r & 3) == 3) __builtin_amdgcn_sched_barrier(0); }
    }
    if (c == 31) {
#pragma unroll
        for (int pb = 0; pb < 2; ++pb)
#pragma unroll
            for (int r = 0; r < 16; ++r) { const int p0 = 32 * pb + (r & 3) + 8 * (r >> 2); EX[w * 128 + p0] = sa[pb][r]; EX[w * 128 + 64 + p0] = sa[2 + pb][r]; }
    }
    __syncthreads();
#pragma unroll
    for (int it = 0; it < 8; ++it) { const int q = tid + 512 * it; *(LAS u32x4*)(lds + S5L_W + (q >> 4) * 272 + (q & 15) * 16) = *(const u32x4*)(tbl + S5_WC + q * 16); }
    __syncthreads();
    const int npass = w == 0 ? 2 : 1;
#pragma unroll 1
    for (int pass = 0; pass < npass; ++pass) {
        const int nprev = pass == 0 ? w : 8;
        const int cc = pass == 0 ? 32 * w + c : 256;
        if (pass == 1) {
#pragma unroll
            for (int k = 0; k < 4; ++k) sa[k] = (f32x16){};
        }
        {
            float cr[2][16], ci[2][16];
#pragma unroll
            for (int pb = 0; pb < 2; ++pb)
#pragma unroll
                for (int r = 0; r < 16; ++r) { cr[pb][r] = 0.f; ci[pb][r] = 0.f; }
#pragma unroll 1
            for (int wp = 0; wp < nprev; ++wp) {
                const LAS float* exw = EX + wp * 128;
#pragma unroll
                for (int pb = 0; pb < 2; ++pb)
#pragma unroll
                    for (int r = 0; r < 16; ++r) { const int p0 = 32 * pb + (r & 3) + 8 * (r >> 2); const f2 m = *(const LAS f2*)(mdb + (5 * 64 + p0) * 8); const float er = exw[p0], ei = exw[64 + p0];
                        const float nr = m.x * cr[pb][r] - m.y * ci[pb][r] + er, ni = m.x * ci[pb][r] + m.y * cr[pb][r] + ei; cr[pb][r] = nr; ci[pb][r] = ni;
                        if ((r & 7) == 7) __builtin_amdgcn_sched_barrier(0); }
            }
#pragma unroll
            for (int pb = 0; pb < 2; ++pb)
#pragma unroll
                for (int r = 0; r < 16; ++r) { const f2 m = *(const LAS f2*)(mcb + (32 * pb + (r & 3) + 8 * (r >> 2)) * 8);
                    float xr = __shfl_up(sa[pb][r], 1, 32), xi = __shfl_up(sa[2 + pb][r], 1, 32); if (c == 0) { xr = 0.f; xi = 0.f; }
                    sa[pb][r] = xr + m.x * cr[pb][r] - m.y * ci[pb][r]; sa[2 + pb][r] = xi + m.x * ci[pb][r] + m.y * cr[pb][r];
                    if ((r & 7) == 7) __builtin_amdgcn_sched_barrier(0); }
        }
        bf16x8 xf[4][2];
#pragma unroll
        for (int blk = 0; blk < 4; ++blk)
#pragma unroll
            for (int s = 0; s < 2; ++s) { u32x4 t; t.x = cvt_pk_bf16(sa[blk][8 * s], sa[blk][8 * s + 1]); t.y = cvt_pk_bf16(sa[blk][8 * s + 2], sa[blk][8 * s + 3]); t.z = cvt_pk_bf16(sa[blk][8 * s + 4], sa[blk][8 * s + 5]); t.w = cvt_pk_bf16(sa[blk][8 * s + 6], sa[blk][8 * s + 7]); xf[blk][s] = __builtin_bit_cast(bf16x8, t); }
        const int io = (lane >> 4) & 1, kk = lane & 15;
        bf16x8 Gf0, Gf1;
        { unsigned pkd[4];
    #pragma unroll
          for (int jj = 0; jj < 4; ++jj) { const int j0 = 2 * jj, j1 = 2 * jj + 1; const int h0 = 8 * (j0 >> 2) + 4 * hi + (j0 & 3), h1 = 8 * (j1 >> 2) + 4 * hi + (j1 & 3); pkd[jj] = pk2(gw[h0 * 16 + kk], gw[h1 * 16 + kk]); }
          const u32x4 wv = {pkd[0], pkd[1], pkd[2], pkd[3]}, zz = {0u, 0u, 0u, 0u};
          Gf0 = __builtin_bit_cast(bf16x8, io == 0 ? wv : zz); Gf1 = __builtin_bit_cast(bf16x8, io == 1 ? wv : zz); }
        float gbv[8];
    #pragma unroll
        for (int q = 0; q < 8; ++q) gbv[q] = gb[(q & 3) + 8 * (q >> 2) + 4 * hi];
        const int ktb = S5L_KT + ((lane >> 4) & 1) * 512 + (lane & 15) * 32 + hi * 16;
        const bool stok = pass == 0 ? (cc > 0 || b == 0) : (c == 0);
#pragma unroll
        for (int half = 0; half < 2; ++half) {
            __builtin_amdgcn_sched_barrier(0);
            f32x16 ya[4];
#pragma unroll
            for (int rl = 0; rl < 4; ++rl) ya[rl] = (f32x16){};
            const bf16_t* up = ubase + (size_t)rowof(b, 16 * cc) * PJ;
#pragma unroll
            for (int s0 = 0; s0 < 8 * half + 8; s0 += 4) {
                bf16x8 uf[4];
#pragma unroll
                for (int s = 0; s < 4; ++s) { uf[s] = *(const bf16x8*)up; up += PJ; asm volatile("" : "+v"(up)); }
#pragma unroll
                for (int s = 0; s < 4; ++s) {
#pragma unroll
                    for (int rl = 0; rl < 4; ++rl) { const int rb = 4 * half + rl; if (s0 + s <= 2 * rb + 1) { const bf16x8 A = *(const LAS bf16x8*)(lds + ktb + (2 * rb - (s0 + s) + 1) * 512); ya[rl] = __builtin_amdgcn_mfma_f32_32x32x16_bf16(A, uf[s], ya[rl], 0, 0, 0); } }
                    __builtin_amdgcn_sched_barrier(0); }
            }
#pragma unroll
            for (int rl = 0; rl < 4; ++rl) {
#pragma unroll
                for (int blk = 0; blk < 4; ++blk)
#pragma unroll
                    for (int s = 0; s < 2; ++s) { const bf16x8 A = *(const LAS bf16x8*)(wcb + (4 * half + rl) * (32 * 272) + (blk * 2 + s) * 32); ya[rl] = __builtin_amdgcn_mfma_f32_32x32x16_bf16(A, xf[blk][s], ya[rl], 0, 0, 0); }
                __builtin_amdgcn_sched_barrier(0);
            }
#pragma unroll
            for (int rl = 0; rl < 4; ++rl) {
                const int rb = 4 * half + rl;
                float zg[16];
#pragma unroll
                for (int r = 0; r < 16; ++r) zg[r] = gelu_tanh(ya[rl][r]);
                u32x4 z0, z1; z0.x = cvt_pk_bf16(zg[0], zg[1]); z0.y = cvt_pk_bf16(zg[2], zg[3]); z0.z = cvt_pk_bf16(zg[4], zg[5]); z0.w = cvt_pk_bf16(zg[6], zg[7]);
                z1.x = cvt_pk_bf16(zg[8], zg[9]); z1.y = cvt_pk_bf16(zg[10], zg[11]); z1.z = cvt_pk_bf16(zg[12], zg[13]); z1.w = cvt_pk_bf16(zg[14], zg[15]);
                f32x16 gt = (f32x16){};
                gt = __builtin_amdgcn_mfma_f32_32x32x16_bf16(Gf0, __builtin_bit_cast(bf16x8, z0), gt, 0, 0, 0);
                gt = __builtin_amdgcn_mfma_f32_32x32x16_bf16(Gf1, __builtin_bit_cast(bf16x8, z1), gt, 0, 0, 0);
#pragma unroll
                for (int il = 0; il < 2; ++il) {
                    float o[8]; float sq = 0.f;
#pragma unroll
                    for (int q = 0; q < 8; ++q) { o[q] = zg[8 * il + q] * sigmoidf_(gt[8 * il + q] + gbv[q]); sq += o[q] * o[q]; }
                    sq += __shfl_xor(sq, 32);
                    if (stok) { const int row = rowof(b, 16 * cc + 2 * rb + il); bf16_t* op = mixed + (size_t)row * DM + MX_SSM + 16 * g + 4 * hi;
                        u32x2 w0, w1; w0.x = cvt_pk_bf16(o[0], o[1]); w0.y = cvt_pk_bf16(o[2], o[3]); w1.x = cvt_pk_bf16(o[4], o[5]); w1.y = cvt_pk_bf16(o[6], o[7]);
                        *(u32x2*)op = w0; *(u32x2*)(op + 8) = w1;
                        if (hi == 0) ssqs[(size_t)row * 16 + g] = sq; }
                }
                __builtin_amdgcn_sched_barrier(0);
            }
        }
    }
    __syncthreads();
}

struct Args { const float* in[31]; float* out; unsigned char* ws; int ph_lo, ph_hi; };
constexpr int N_PHASES = 16;
#define PHASE_IDS() int tid; { int ln_; asm volatile("v_mbcnt_lo_u32_b32 %0, -1, 0\n\tv_mbcnt_hi_u32_b32 %0, -1, %0" : "=v"(ln_)); tid = wave0 * 64 + ln_; } unsigned char* ws = ws0; asm volatile("" : "+s"(ws)); const int lane = tid & 63; const int wave = __builtin_amdgcn_readfirstlane(tid >> 6); (void)lane; (void)wave

__global__ void __launch_bounds__(NWAVES * 64, 2) hymba_fwd(Args args) {
    extern __shared__ __attribute__((aligned(16))) unsigned char lds_raw[];
    LAS unsigned char* lds = (LAS unsigned char*)lds_raw;
    volatile LAS unsigned* MISC = (volatile LAS unsigned*)(lds + LDSCTL_OFF);
    LAS int* TB = (LAS int*)(lds + LDSCTL_OFF + 256);
    LAS int* CN = (LAS int*)(lds + LDSCTL_OFF + 512);
    LAS int* HIST = (LAS int*)(lds + LDSCTL_OFF + 768);
    const int wave0 = __builtin_amdgcn_readfirstlane(threadIdx.x >> 6);
    const int G = gridDim.x; const int bx = blockIdx.x; const int vcu = (G % 8 == 0) ? (bx % 8) * (G / 8) + bx / 8 : bx;
    unsigned char* const ws0 = args.ws;
    unsigned* const ctl = (unsigned*)(ws0 + WS_CTL);
    for (int u = threadIdx.x; u < (LDS_BYTES - LDSCTL_OFF) / 4; u += NWAVES * 64) ((LAS unsigned*)(lds + LDSCTL_OFF))[u] = 0u;
    __syncthreads();
    const int lo = args.ph_lo, hi = args.ph_hi;
    XcdBarrier bar; bar.bar = ctl + CW_BAR; bar.x = 0; bar.st = nullptr;
    if (hi - lo > 1) bar = xcd_barrier_post(ctl + CW_BAR, MISC + 8);
#define IN(k) (lo <= (k) && (k) < hi)
#define SEAM(k) do { if (IN(k) && IN((k) + 1)) { PHASE_IDS(); xcd_barrier(bar, tid == 0); } } while (0)
#define WSP(T, off) ((T*)(ws + (off)))

    for (int rep_ = 0; rep_ < DUP_P0; ++rep_) if (IN(0)) {
        PHASE_IDS();
        bf16_t* WinT = WSP(bf16_t, WS_WIN); bf16_t* WoutT = WSP(bf16_t, WS_WOUT); bf16_t* W13T = WSP(bf16_t, WS_W13); bf16_t* W2C = WSP(bf16_t, WS_W2C); bf16_t* WrT = WSP(bf16_t, WS_WR);
        bf16_t* hbuf = WSP(bf16_t, WS_H); float* ssq1 = WSP(float, WS_SSQ1); float* tinfo = WSP(float, WS_TINFO);
#pragma unroll 1
        for (int lg = vcu; lg < 32; lg += G) { const int l = lg >> 4, g = lg & 15;
            const S5P SP{args.in[10] + l * 1024, args.in[11] + l * 1024, args.in[12] + l * 16, args.in[13] + (size_t)l * 16384, args.in[14] + (size_t)l * 16384, args.in[15] + (size_t)l * 16384, args.in[16] + (size_t)l * 16384,
                         args.in[17] + l * 256, args.in[18] + (size_t)l * 4096, args.in[19] + l * 256};
            int tidp = tid; asm volatile("" : "+v"(tidp));
            s5_tables_block(lds, tidp, SP, g, ws + WS_S5T + (size_t)lg * S5T_BYTES); }
        LAS float* scr = (LAS float*)(lds + wave * 16384);
        const int gw = vcu * NWAVES + wave, NGW = G * NWAVES;
        constexpr int I_WIN = 16 * 80, I_WOUT = 16 * 32, I_W13 = 16 * 16, I_W2 = 4 * 32, I_WR = 16;
        constexpr int T_WIN = 2 * I_WIN, T_WOUT = 2 * I_WOUT, T_W13 = 32 * I_W13, T_W2 = 32 * I_W2, T_WR = 4 * I_WR;
        constexpr int NITEMS = T_WIN + T_WOUT + T_W13 + T_W2 + T_WR;
        const int nskip = G >= 64 ? 32 : 0; const int igw = (vcu - nskip) * NWAVES + wave, INGW = (G - nskip) * NWAVES;
#pragma unroll 1
        for (int it = igw; it < NITEMS && vcu >= nskip; it += INGW) {
            int r = it;
            if (r < T_WIN) { const int l = r / I_WIN, q = r % I_WIN, kb = q / 80, nb = q % 80; GetWin gt{args.in[3] + (size_t)l * DM * DINSRC, args.in[2] + l * DM};
                tr_item(gt, WinT + (size_t)l * NIN * DM, DM, 64 * kb, 32 * nb, scr, lane); continue; } r -= T_WIN;
            if (r < T_WOUT) { const int l = r / I_WOUT, q = r % I_WOUT, kb = q / 32, nb = q % 32; GetWout gt{args.in[21] + (size_t)l * DM * DM, args.in[9] + l * 512, args.in[20] + l * 256};
                tr_item(gt, WoutT + (size_t)l * DM * DM, DM, 64 * kb, 32 * nb, scr, lane); continue; } r -= T_WOUT;
            if (r < T_W13) { const int le = r / I_W13, q = r % I_W13, kb = q / 16, nb = q % 16; const int l = le / 16; GetW13 gt{args.in[27] + (size_t)le * DM * 256, args.in[28] + (size_t)le * DM * 256, args.in[22] + l * DM};
                tr_item(gt, W13T + (size_t)le * 512 * DM, DM, 64 * kb, 32 * nb, scr, lane); continue; } r -= T_W13;
            if (r < T_W2) { const int le = r / I_W2, q = r % I_W2, kb = q / 32, nb = q % 32; GetW2 gt{args.in[29] + (size_t)le * 256 * DM};
                tr_item(gt, W2C + (size_t)le * DM * 256, 256, 64 * kb, 32 * nb, scr, lane); continue; } r -= T_W2;
            { const int lh = r / I_WR, kb = r % I_WR; const int l = lh >> 1, lo_ = lh & 1; GetWr gt{args.in[23] + (size_t)l * DM * 4, args.in[25] + (size_t)l * DM * 16, args.in[22] + l * DM, lo_};
                tr_item(gt, WrT + (size_t)lh * 32 * DM, DM, 64 * kb, 0, scr, lane); }
        }
#pragma unroll 1
        for (int r0 = 2 * gw; r0 < MROWS; r0 += 2 * NGW) {
            f32x4 v[2][4];
#pragma unroll
            for (int q = 0; q < 2; ++q) { const int r = r0 + q;
#pragma unroll
                for (int j = 0; j < 4; ++j) { if (r < NREAL) v[q][j] = *(const f32x4*)(args.in[0] + (size_t)r * DM + 4 * lane + 256 * j); else if (r < NTOK) v[q][j] = *(const f32x4*)(args.in[1] + (size_t)(r - NREAL) * DM + 4 * lane + 256 * j); else v[q][j] = (f32x4){0.f, 0.f, 0.f, 0.f}; } }
#pragma unroll
            for (int q = 0; q < 2; ++q) { const int r = r0 + q; float s = 0.f;
#pragma unroll
                for (int j = 0; j < 4; ++j) { u32x2 w; w.x = pk2(v[q][j][0], v[q][j][1]); w.y = pk2(v[q][j][2], v[q][j][3]); *(u32x2*)(hbuf + (size_t)r * DM + 4 * lane + 256 * j) = w;
                    s += bflo(w.x) * bflo(w.x) + bfhi(w.x) * bfhi(w.x) + bflo(w.y) * bflo(w.y) + bfhi(w.y) * bfhi(w.y); }
                s = wave_sum(s);
                if (lane < 16) ssq1[(size_t)r * 16 + lane] = lane == 0 ? s : 0.f;
                if (r >= NTOK && lane < 4) tinfo[(size_t)r * 4 + lane] = 0.f; }
        }
    }
    SEAM(0);

#pragma unroll 1
    for (int l = 0; l < DEPTH; ++l) {
        const int P = 1 + 7 * l;
        for (int rep_ = 0; rep_ < DUP_G1; ++rep_) if (IN(P)) {
            PHASE_IDS();
            bf16_t* hbuf = WSP(bf16_t, WS_H); bf16_t* proj = WSP(bf16_t, WS_PROJ); float* flog = WSP(float, WS_FLOG); const float* ssq1 = WSP(float, WS_SSQ1);
            const bf16_t* Win = WSP(bf16_t, WS_WIN) + (size_t)l * NIN * DM; const float* fb = args.in[4] + l * 8;
            DenseOrder S; S.init(hbuf, Win, NREAL, NIN, DM, DM, G, bx);
            EpiProj E{proj, flog, ssq1, fb};
            pg8::gemm_phase<EpiProj, DenseOrder, true, false>(lds, tid, DM, DM, S, E);
#pragma unroll 1
            for (int cb = bx; cb < 10; cb += G) {
                f32x4 acc[2]; meta_gemm16(hbuf + (size_t)NREAL * DM, Win, DM, cb * 256, wave, lane, acc);
                const int m = lane & 15, q4 = lane >> 4, row = NREAL + m;
                const float rs = row_rstd16(ssq1, row, q4, 1.f / DM);
#pragma unroll
                for (int j = 0; j < 2; ++j) { const f32x4 v = acc[j] * rs; const int col = cb * 256 + 32 * wave + 16 * j + 4 * q4;
                    if (cb < 9) { u32x2 w; w.x = cvt_pk_bf16(v[0], v[1]); w.y = cvt_pk_bf16(v[2], v[3]); *(u32x2*)(proj + (size_t)row * PJ + col) = w; }
                    else if (wave == 0 && j == 0 && q4 < 2) { f32x4 o;
#pragma unroll
                        for (int e = 0; e < 4; ++e) { const float f = v[e] + fb[4 * q4 + e]; o[e] = -log2f(1.f + exp2f(-f * LOG2E)); }
                        *(f32x4*)(flog + (size_t)row * 8 + 4 * q4) = o; } }
            }
        }
        SEAM(P);
        for (int rep_ = 0; rep_ < DUP_MIX; ++rep_) if (IN(P + 1)) {
            PHASE_IDS();
            const bf16_t* proj = WSP(bf16_t, WS_PROJ); bf16_t* mixed = WSP(bf16_t, WS_MIX); const float* flog = WSP(float, WS_FLOG); float* ssqa = WSP(float, WS_SSQA); float* ssqs = WSP(float, WS_SSQS);
            for (int repa_ = 0; repa_ < DUP_ATT; ++repa_)
#pragma unroll 1
            for (int vc = vcu; vc < 256; vc += G) {
                int bh = vc >> 2; asm volatile("" : "+s"(bh));
                const int b = bh >> 3, h = bh & 7;
                attn_prefix(lds, tid, flog, b, h);
#pragma unroll 1
                for (int i = 0; i < 4; ++i) { const int s = (vc & 3) * 2 + (i >> 1); int qt = (i & 1) ? 15 - s : s; asm volatile("" : "+s"(qt)); attn_unit(lds, tid, proj, mixed, ssqa, b, h, qt); }
            }
#pragma unroll 1
            for (int vc = vcu; vc < 8; vc += G) { int hh = vc; asm volatile("" : "+s"(hh)); attn_prefix(lds, tid, flog, 0, hh); attn_unit(lds, tid, proj, mixed, ssqa, 0, hh, -1); }
            const float* cw = args.in[5] + (size_t)l * 31 * 256; const float* cbp = args.in[6] + l * 256; const float* clg = args.in[7] + l * 256; const float* clb = args.in[8] + l * 256;
            for (int repc_ = 0; repc_ < DUP_CS; ++repc_)
#pragma unroll 1
            for (int vc = vcu; vc < 256; vc += G) {
                int tid2 = tid; asm volatile("" : "+v"(tid2));
                if ((vc & 1) == 0) { const int ci = vc >> 1;
#pragma unroll 1
                    for (int s = 0; s < 8; ++s) conv_subtile(lds, tid2, proj, mixed, cw, cbp, clg, clb, ci >> 4, NMETA + 256 * (ci & 15) + 32 * s, 32);
                } else {
                    if (vc == 1) conv_subtile(lds, tid2, proj, mixed, cw, cbp, clg, clb, 0, 0, 16);
                    int ug = vc >> 1; asm volatile("" : "+s"(ug));
                    s5_unit(lds, tid2, ws + WS_S5T + (size_t)(l * 16 + (ug & 15)) * S5T_BYTES, args.in[18] + (size_t)l * 4096 + (ug & 15) * 256, args.in[19] + l * 256 + (ug & 15) * 16, proj, mixed, ssqs, ug >> 4, ug & 15);
                }
            }
        }
        SEAM(P + 1);
        if (IN(P + 2)) {
            PHASE_IDS();
            bf16_t* mixed = WSP(bf16_t, WS_MIX); const float* ssqa = WSP(float, WS_SSQA); const float* ssqs = WSP(float, WS_SSQS);
            const int gw = vcu * NWAVES + wave, NGW = G * NWAVES;
#pragma unroll 1
            for (int r = gw; r < NTOK; r += NGW) {
                float sa = lane < 8 ? ssqa[(size_t)r * 8 + lane] : 0.f, ss = lane < 16 ? ssqs[(size_t)r * 16 + lane] : 0.f;
                sa = wave_sum(sa); ss = wave_sum(ss);
                const float ra = rsqrtf(sa * (1.f / 512.f) + EPS), rsm = rsqrtf(ss * (1.f / 256.f) + EPS);
                bf16_t* p = mixed + (size_t)r * DM;
                u32x4 a = *(u32x4*)(p + 8 * lane);
                a.x = cvt_pk_bf16(bflo(a.x) * ra, bfhi(a.x) * ra); a.y = cvt_pk_bf16(bflo(a.y) * ra, bfhi(a.y) * ra); a.z = cvt_pk_bf16(bflo(a.z) * ra, bfhi(a.z) * ra); a.w = cvt_pk_bf16(bflo(a.w) * ra, bfhi(a.w) * ra);
                *(u32x4*)(p + 8 * lane) = a;
                u32x2 s2 = *(u32x2*)(p + MX_SSM + 4 * lane);
                s2.x = cvt_pk_bf16(bflo(s2.x) * rsm, bfhi(s2.x) * rsm); s2.y = cvt_pk_bf16(bflo(s2.y) * rsm, bfhi(s2.y) * rsm);
                *(u32x2*)(p + MX_SSM + 4 * lane) = s2;
            }
        }
        SEAM(P + 2);
        if (IN(P + 3)) {
            PHASE_IDS();
            bf16_t* hbuf = WSP(bf16_t, WS_H); const bf16_t* mixed = WSP(bf16_t, WS_MIX); float* ssq2 = WSP(float, WS_SSQ2); const bf16_t* Wo = WSP(bf16_t, WS_WOUT) + (size_t)l * DM * DM;
            DenseOrder S; S.init(mixed, Wo, NREAL, DM, DM, DM, G, bx);
            EpiRes<false> E{hbuf, ssq2, CN, nullptr};
            pg8::gemm_phase<EpiRes<false>, DenseOrder, true, false>(lds, tid, DM, DM, S, E);
            LAS float* mscr = (LAS float*)lds;
#pragma unroll 1
            for (int cb = bx; cb < 4; cb += G) {
                f32x4 acc[2]; meta_gemm16(mixed + (size_t)NREAL * DM, Wo, DM, cb * 256, wave, lane, acc);
                const int m = lane & 15, q4 = lane >> 4, row = NREAL + m; float sq = 0.f;
#pragma unroll
                for (int j = 0; j < 2; ++j) { bf16_t* p = hbuf + (size_t)row * DM + cb * 256 + 32 * wave + 16 * j + 4 * q4; const u32x2 o = *(const u32x2*)p; u32x2 w;
                    w.x = cvt_pk_bf16(bflo(o.x) + acc[j][0], bfhi(o.x) + acc[j][1]); w.y = cvt_pk_bf16(bflo(o.y) + acc[j][2], bfhi(o.y) + acc[j][3]); *(u32x2*)p = w;
                    sq += bflo(w.x) * bflo(w.x) + bfhi(w.x) * bfhi(w.x) + bflo(w.y) * bflo(w.y) + bfhi(w.y) * bfhi(w.y); }
                sq += __shfl_xor(sq, 16); sq += __shfl_xor(sq, 32);
                if (q4 == 0) mscr[m * 8 + wave] = sq;
                __syncthreads();
                if (wave == 0) ssq2[(size_t)row * 16 + cb * 4 + q4] = mscr[m * 8 + 2 * q4] + mscr[m * 8 + 2 * q4 + 1];
                __syncthreads();
            }
        }
        SEAM(P + 3);
        if (IN(P + 4)) {
            PHASE_IDS();
            const bf16_t* hbuf = WSP(bf16_t, WS_H); const float* ssq2 = WSP(float, WS_SSQ2); float* tinfo = WSP(float, WS_TINFO); int* list = WSP(int, WS_LIST);
            unsigned* gcnt = ctl + CW_CNT + l * 32;
            const bf16_t* Whi = WSP(bf16_t, WS_WR) + (size_t)(2 * l) * 32 * DM; const bf16_t* Wlo = Whi + (size_t)32 * DM;
            LAS float* scr = (LAS float*)(lds + wave * 4352);
#pragma unroll 1
            for (int base = 0; base < 1025; base += G * 4) {
                const int grp = base + bx * 4 + wave;
                const bool active = wave < 4 && grp < 1025;
                int cls = 0, posl = 0, tok = 0; bool valid = false; float rstd = 0.f, gA = 0.f, gB = 0.f;
                if (active) {
                    const int r32 = lane & 31, hh = lane >> 5; const int rowA = grp * 32 + r32 < NTOK ? grp * 32 + r32 : DUMMY_ROW;
                    f32x16 acc = {};
                    const bf16_t* ap = hbuf + (size_t)rowA * DM + 8 * hh; const bf16_t* bh_ = Whi + (size_t)r32 * DM + 8 * hh; const bf16_t* bl_ = Wlo + (size_t)r32 * DM + 8 * hh;
#pragma unroll 4
                    for (int k0 = 0; k0 < DM; k0 += 16) { const bf16x8 a = *(const bf16x8*)(ap + k0), b0 = *(const bf16x8*)(bh_ + k0), b1 = *(const bf16x8*)(bl_ + k0);
                        acc = __builtin_amdgcn_mfma_f32_32x32x16_bf16(a, b0, acc, 0, 0, 0); acc = __builtin_amdgcn_mfma_f32_32x32x16_bf16(a, b1, acc, 0, 0, 0); }
#pragma unroll
                    for (int r = 0; r < 16; ++r) scr[crow(r, hh) * 33 + r32] = acc[r];
                    LDS_WAIT(); asm volatile("" ::: "memory");
                    tok = grp * 32 + r32; valid = hh == 0 && tok < NTOK;
                    if (valid) {
                        float s = 0.f;
#pragma unroll
                        for (int q = 0; q < 4; ++q) { const f32x4 v = *(const f32x4*)(ssq2 + (size_t)tok * 16 + 4 * q); s += (v.x + v.y) + (v.z + v.w); }
                        rstd = rsqrtf(s * (1.f / DM) + EPS);
                        float lg[4]; const float* bg = args.in[24] + l * 4; const float* be = args.in[26] + l * 16;
#pragma unroll
                        for (int i = 0; i < 4; ++i) lg[i] = scr[r32 * 33 + i] * rstd + bg[i];
                        int gs = 0; float mx = lg[0];
#pragma unroll
                        for (int i = 1; i < 4; ++i) if (lg[i] > mx) { mx = lg[i]; gs = i; }
                        float se = 0.f;
#pragma unroll
                        for (int i = 0; i < 4; ++i) se += expf(lg[i] - mx);
                        const float pg = 1.f / se;
                        float le[4];
#pragma unroll
                        for (int i = 0; i < 4; ++i) le[i] = scr[r32 * 33 + 4 + 4 * gs + i] * rstd + be[4 * gs + i];
                        int i1 = 0; float v1 = le[0];
#pragma unroll
                        for (int i = 1; i < 4; ++i) if (le[i] > v1) { v1 = le[i]; i1 = i; }
                        int i2 = -1; float v2 = -INFINITY;
#pragma unroll
                        for (int i = 0; i < 4; ++i) if (i != i1 && le[i] > v2) { v2 = le[i]; i2 = i; }
                        const float w1 = pg / (1.f + expf(v2 - v1)), w2 = pg - w1;
                        const int a = i1 < i2 ? i1 : i2, bb = i1 < i2 ? i2 : i1;
                        gA = i1 < i2 ? w1 : w2; gB = i1 < i2 ? w2 : w1;
                        cls = gs * 6 + (a == 0 ? bb - 1 : (a == 1 ? bb + 1 : 5));
                        posl = __hip_atomic_fetch_add(&HIST[cls], 1, __ATOMIC_RELAXED, __HIP_MEMORY_SCOPE_WORKGROUP);
                    }
                }
                __syncthreads();
                if (tid < NCLS) { const int n = HIST[tid]; HIST[32 + tid] = n ? (int)__hip_atomic_fetch_add(gcnt + tid, (unsigned)n, __ATOMIC_RELAXED, __HIP_MEMORY_SCOPE_AGENT) : 0; }
                __syncthreads();
                if (valid) { const int pos = HIST[32 + cls] + posl; list[(size_t)cls * NTOK + pos] = tok; *(f32x4*)(tinfo + (size_t)tok * 4) = (f32x4){rstd, gA, gB, 0.f}; }
                __syncthreads();
                if (tid < NCLS) HIST[tid] = 0;
                __syncthreads();
            }
        }
        SEAM(P + 4);
        if (IN(P + 5) || IN(P + 6)) {
            unsigned* gcnt = ctl + CW_CNT + l * 32;
            PHASE_IDS();
            if (tid == 0) { int run = 0; for (int c = 0; c < NCLS; ++c) { const int n = (int)__hip_atomic_load(gcnt + c, __ATOMIC_RELAXED, __HIP_MEMORY_SCOPE_AGENT); CN[c] = n; TB[c] = run; run += (n + 255) >> 8; } TB[NCLS] = run; }
            __syncthreads();
        }
        for (int rep_ = 0; rep_ < DUP_E1; ++rep_) if (IN(P + 5)) {
            PHASE_IDS();
            const int* list = WSP(int, WS_LIST);
            ExpertOrder S{TB, CN, list, (const char*)WSP(bf16_t, WS_H), (const char*)WSP(bf16_t, WS_W13), G, bx, 1, l};
            EpiE1 E{WSP(bf16_t, WS_H1), WSP(float, WS_TINFO), CN, list};
            pg8::gemm_phase<EpiE1, ExpertOrder, true, true>(lds, tid, DM, DM, S, E);
        }
        SEAM(P + 5);
        if (IN(P + 6)) {
            PHASE_IDS();
            const int* list = WSP(int, WS_LIST);
            ExpertOrder S{TB, CN, list, (const char*)WSP(bf16_t, WS_H1), (const char*)WSP(bf16_t, WS_W2C), G, bx, 2, l};
            EpiRes<true> E{WSP(bf16_t, WS_H), WSP(float, WS_SSQ1), CN, list};
            pg8::gemm_phase<EpiRes<true>, ExpertOrder, true, false, true>(lds, tid, 512, 256, S, E);
        }
        SEAM(P + 6);
    }
    if (IN(15)) {
        PHASE_IDS();
        const bf16_t* hbuf = WSP(bf16_t, WS_H); const float* ssq1 = WSP(float, WS_SSQ1);
        const int gw = vcu * NWAVES + wave, NGW = G * NWAVES; const float* gF = args.in[30];
        f32x4 gv[4];
#pragma unroll
        for (int j = 0; j < 4; ++j) gv[j] = *(const f32x4*)(gF + 4 * lane + 256 * j);
#pragma unroll 1
        for (int r = gw; r < NREAL; r += NGW) {
            float s = lane < 16 ? ssq1[(size_t)r * 16 + lane] : 0.f; s = wave_sum(s);
            const float rs = rsqrtf(s * (1.f / DM) + EPS);
#pragma unroll
            for (int j = 0; j < 4; ++j) { const u32x2 w = *(const u32x2*)(hbuf + (size_t)r * DM + 4 * lane + 256 * j);
                f32x4 o; o[0] = bflo(w.x) * rs * gv[j][0]; o[1] = bfhi(w.x) * rs * gv[j][1]; o[2] = bflo(w.y) * rs * gv[j][2]; o[3] = bfhi(w.y) * rs * gv[j][3];
                *(f32x4*)(args.out + (size_t)r * DM + 4 * lane + 256 * j) = o; }
        }
    }
#undef IN
#undef SEAM
#undef WSP
}

extern "C" void kernel_launch(void* const* d_in, const int* in_sizes, int n_in, void* d_out, int out_size, void* d_ws, size_t ws_size, hipStream_t stream) {
    static int grid = 0;
    if (grid == 0) {
        if (n_in != 31 || out_size != NREAL * DM || ws_size < WS_END) { fprintf(stderr, "kernel_launch: unexpected shapes (n_in %d, out %d, ws %zu)\n", n_in, out_size, ws_size); grid = -1; return; }
        int dev = 0, cus = 0, per_cu = 0;
        if (hipGetDevice(&dev) != hipSuccess || hipDeviceGetAttribute(&cus, hipDeviceAttributeMultiprocessorCount, dev) != hipSuccess) { grid = -1; return; }
        if (hipFuncSetAttribute((const void*)hymba_fwd, hipFuncAttributeMaxDynamicSharedMemorySize, LDS_BYTES) != hipSuccess) { fprintf(stderr, "kernel_launch: hipFuncSetAttribute failed\n"); grid = -1; return; }
        if (hipOccupancyMaxActiveBlocksPerMultiprocessor(&per_cu, (const void*)hymba_fwd, NWAVES * 64, LDS_BYTES) != hipSuccess || per_cu < 1) { fprintf(stderr, "kernel_launch: occupancy query says %d\n", per_cu); }
        (void)hipGetLastError();
        grid = cus;
    }
    if (grid < 0) return;
    (void)in_sizes;
    if (hipMemsetAsync((char*)d_ws + WS_CTL, 0, CTL_BYTES, stream) != hipSuccess) return;
    Args a{};
    for (int i = 0; i < 31; ++i) a.in[i] = (const float*)d_in[i];
    a.out = (float*)d_out; a.ws = (unsigned char*)d_ws;
#if MK_PER_PHASE
    for (int p = 0; p < N_PHASES; ++p) { a.ph_lo = p; a.ph_hi = p + 1; hipLaunchKernelGGL(hymba_fwd, dim3(grid), dim3(NWAVES * 64), LDS_BYTES, stream, a); }
#else
    a.ph_lo = 0; a.ph_hi = N_PHASES;
    hipLaunchKernelGGL(hymba_fwd, dim3(grid), dim3(NWAVES * 64), LDS_BYTES, stream, a);
#endif
}
```

```cpp
#include <hip/hip_runtime.h>
#include <cstdio>
#include <cstdint>

#ifndef DUP_ATT
#define DUP_ATT 1
#endif
#ifndef DUP_CS
#define DUP_CS 1
#endif
#ifndef DUP_G1
#define DUP_G1 1
#endif
#ifndef DUP_MIX
#define DUP_MIX 1
#endif
#ifndef DUP_E1
#define DUP_E1 1
#endif
#ifndef DUP_P0
#define DUP_P0 1
#endif
#ifndef MK_PER_PHASE
#define MK_PER_PHASE 0
#endif

#define LAS __attribute__((address_space(3)))
#define GAS __attribute__((address_space(1)))
typedef unsigned short bf16_t;
typedef short bf16x8 __attribute__((ext_vector_type(8)));
typedef short s16x4 __attribute__((ext_vector_type(4)));
typedef float f32x4 __attribute__((ext_vector_type(4)));
typedef float f32x2 __attribute__((ext_vector_type(2)));
typedef float f32x16 __attribute__((ext_vector_type(16)));
typedef unsigned u32x4 __attribute__((ext_vector_type(4)));
typedef unsigned u32x2 __attribute__((ext_vector_type(2)));

constexpr int NB = 8, SEQ = 4096, NMETA = 16, DM = 1024, DEPTH = 2;
constexpr int NREAL = NB * SEQ;
constexpr int NTOK = NREAL + NMETA;
constexpr int MROWS = 33024;
constexpr int DUMMY_ROW = NTOK;
constexpr int PJ = 2304;
constexpr int NIN = 2560;
constexpr int DINSRC = 2312;
constexpr int PQ = 512, PK = 1024, PV = 1536, PU = 2048;
constexpr int MX_ATT = 0, MX_SSM = 512, MX_CONV = 768;
constexpr int NCLS = 24;
constexpr float EPS = 1e-6f;
constexpr float LOG2E = 1.4426950408889634f;
constexpr int H1CAP = 40960;

constexpr size_t MiB = 1u << 20;
constexpr size_t WS_CTL = 0, CTL_BYTES = 1 * MiB;
constexpr size_t WS_WIN = 2 * MiB, WS_WOUT = 12 * MiB, WS_W13 = 16 * MiB, WS_W2C = 48 * MiB, WS_WR = 96 * MiB;
constexpr size_t WS_H = 100 * MiB, WS_PROJ = 165 * MiB, WS_MIX = 311 * MiB, WS_H1 = 376 * MiB;
constexpr size_t WS_FLOG = 416 * MiB, WS_SSQ1 = 418 * MiB, WS_SSQ2 = 421 * MiB, WS_SSQA = 424 * MiB, WS_SSQS = 426 * MiB, WS_TINFO = 429 * MiB, WS_LIST = 430 * MiB, WS_S5T = 434 * MiB, WS_END = 440 * MiB;
constexpr int CW_TMO = 0, CW_BAR = 4096, CW_CNT = 16384;

constexpr int RING_BYTES = 131072;
constexpr int LDSCTL_OFF = RING_BYTES;
constexpr int LDS_BYTES = 147456;
constexpr int NWAVES = 8;

#define LDS_WAIT() asm volatile("s_waitcnt lgkmcnt(0)" ::: "memory")
#define VM_WAIT() asm volatile("s_waitcnt vmcnt(0)" ::: "memory")

__device__ __forceinline__ unsigned f2bf(float f) { unsigned u = __float_as_uint(f); return (u + 0x7fffu + ((u >> 16) & 1u)) >> 16; }
__device__ __forceinline__ unsigned pk2(float lo, float hi) { return f2bf(lo) | (f2bf(hi) << 16); }
__device__ __forceinline__ float bflo(unsigned w) { return __uint_as_float(w << 16); }
__device__ __forceinline__ float bfhi(unsigned w) { return __uint_as_float(w & 0xffff0000u); }
__device__ __forceinline__ float bf2f(bf16_t b) { return __uint_as_float(((unsigned)b) << 16); }
__device__ __forceinline__ unsigned cvt_pk_bf16(float lo, float hi) { unsigned r; asm volatile("v_cvt_pk_bf16_f32 %0, %1, %2" : "=v"(r) : "v"(lo), "v"(hi)); return r; }
__device__ __forceinline__ float wave_sum(float v) {
#pragma unroll
    for (int o = 1; o < 64; o <<= 1) v += __shfl_xor(v, o);
    return v;
}
__device__ __forceinline__ float fast_exp2(float x) { return __builtin_amdgcn_exp2f(x); }
__device__ __forceinline__ float fast_rcp(float x) { return __builtin_amdgcn_rcpf(x); }
__device__ __forceinline__ float sigmoidf_(float x) { return fast_rcp(1.f + fast_exp2(-x * LOG2E)); }
__device__ __forceinline__ float siluf_(float x) { return x * sigmoidf_(x); }
__device__ __forceinline__ int rowof(int b, int t) { return t < NMETA ? NREAL + t : b * SEQ + (t - NMETA); }

namespace pg8 {
constexpr int BM = 256, BK = 64, HALF = 128, HTB = HALF * BK * 2, STAGE_BYTES = 8 * HTB;
__host__ __device__ __forceinline__ int lds_byte(int r, int c) { const int st = (r >> 4) * 2 + (c >> 5), rr = r & 15, cc = c & 31, ob = rr * 64 + cc * 2; return st * 1024 + (ob ^ (((ob >> 9) & 1) << 5)); }
__host__ __device__ __forceinline__ void stage_rc(int b, int& R, int& C) { const int st = b / 1024, sb = b % 1024, swz = sb ^ (((sb >> 9) & 1) << 5); R = (st >> 1) * 16 + swz / 64; C = (st & 1) * 32 + (swz % 64) / 2; }
__host__ __device__ __forceinline__ int perm32(int rho) { const int n = rho >> 4, i = rho & 15; return 8 * (i >> 2) + 4 * n + (i & 3); }

struct Unit { int pm, pn, cls, p0; };

template <class Epi, class Sched, bool ALIGN_EPI, bool GATHER, bool BSPLIT = false>
__device__ __forceinline__ void gemm_phase(LAS unsigned char* lds, const int tid, const int K, const int ldb, const Sched& S, const Epi& E) {
    const int wid = __builtin_amdgcn_readfirstlane(tid >> 6), lane = tid & 63, wr = wid >> 2, wc = wid & 3, fr = lane & 15, fq = lane >> 4;
    const int nt = K / BK;
    unsigned voffA[2], voffB[2]; int RA[2], CA[2];
#pragma unroll
    for (int i = 0; i < 2; ++i) { int R, C; stage_rc(tid * 16 + i * 8192, R, C); const int Rb = (R & ~31) + perm32(R & 31);
        voffA[i] = (unsigned)(R * K + C) * 2u; voffB[i] = (unsigned)(Rb * ldb + C) * 2u; RA[i] = R; CA[i] = C; }
    const size_t kstep = (size_t)(BK * 2);
    const size_t hstepA = (size_t)HALF * K * 2, hstepB = (size_t)HALF * ldb * 2;
    const size_t pstepA = (size_t)64 * K * 2, pstepB = (size_t)64 * ldb * 2;
    const unsigned ldsw = (unsigned)wid * 1024u;
    const int aoff = lds_byte(wr * 64 + fr, fq * 8), boff = lds_byte(wc * 32 + fr, fq * 8);
#define PG8_SA(b, h) (((b) * 2 + (h)) * HTB)
#define PG8_SB(b, h) ((4 + (b) * 2 + (h)) * HTB)
#define PG8_STAGE(bufoff, gbase, voff) do { _Pragma("unroll") for (int _i = 0; _i < 2; ++_i) \
        __builtin_amdgcn_global_load_lds((const unsigned*)((const char*)(gbase) + (voff)[_i]), (LAS unsigned*)(lds + (bufoff) + ldsw + _i * 8192), 16, 0, 0); } while (0)
#define PG8_STAGE1(bufoff, gbase, voff1, step) do { _Pragma("unroll") for (int _i = 0; _i < 2; ++_i) \
        __builtin_amdgcn_global_load_lds((const unsigned*)((const char*)(gbase) + (size_t)_i * (step) + (voff1)), (LAS unsigned*)(lds + (bufoff) + ldsw + _i * 8192), 16, 0, 0); } while (0)
#define PG8_LDA(dst, b, h) do { _Pragma("unroll") for (int m = 0; m < 4; ++m) _Pragma("unroll") for (int k = 0; k < 2; ++k) dst[m][k] = *(const LAS bf16x8*)(lds + PG8_SA(b, h) + aoff + m * 2048 + k * 1024); } while (0)
#define PG8_LDB(dst, b, h) do { _Pragma("unroll") for (int n = 0; n < 2; ++n) _Pragma("unroll") for (int k = 0; k < 2; ++k) dst[n][k] = *(const LAS bf16x8*)(lds + PG8_SB(b, h) + boff + n * 2048 + k * 1024); } while (0)
#define PG8_MMA(ai, bj, At, Bt) do { __builtin_amdgcn_s_setprio(1); _Pragma("unroll") for (int m = 0; m < 4; ++m) _Pragma("unroll") for (int n = 0; n < 2; ++n) _Pragma("unroll") for (int k = 0; k < 2; ++k) \
        acc[ai][bj][m][n] = __builtin_amdgcn_mfma_f32_16x16x32_bf16(Bt[n][k], At[m][k], acc[ai][bj][m][n], 0, 0, 0); __builtin_amdgcn_s_setprio(0); } while (0)
#define PG8_WAIT_V(n) asm volatile("s_waitcnt vmcnt(" #n ")" ::: "memory")
#define PG8_WAIT_L(n) asm volatile("s_waitcnt lgkmcnt(" #n ")" ::: "memory")
#define PG8_BAR __builtin_amdgcn_s_barrier()
#define PG8_SCHED __builtin_amdgcn_sched_barrier(0)
    Unit cur, nxt; int ui = 0;
    if (!S.next(0, cur)) return;
    f32x4 acc[2][2][4][2];
#pragma unroll
    for (int a = 0; a < 2; ++a)
#pragma unroll
        for (int b = 0; b < 2; ++b)
#pragma unroll
            for (int m = 0; m < 4; ++m)
#pragma unroll
                for (int n = 0; n < 2; ++n) acc[a][b][m][n] = (f32x4){0.f, 0.f, 0.f, 0.f};
    bf16x8 At[4][2], B0[2][2], B1[2][2];
    const char* cA = S.abase(cur); const char* cB = S.bbase(cur);
    const char* cB2 = cB; const int ksp = BSPLIT ? nt / 2 : (1 << 30);
    if constexpr (BSPLIT) cB2 = S.bbase2(cur) - (size_t)ksp * kstep;
    unsigned oC[2][2], oN[2][2];
    if constexpr (GATHER) {
#pragma unroll
        for (int h = 0; h < 2; ++h)
#pragma unroll
            for (int i = 0; i < 2; ++i) oC[h][i] = (unsigned)S.rowtok(cur, h * HALF + RA[i]) * (unsigned)(K * 2) + (unsigned)(CA[i] * 2);
    }
    PG8_STAGE1(PG8_SB(0, 0), cB, voffB[0], pstepB); PG8_STAGE1(PG8_SB(0, 1), cB + hstepB, voffB[0], pstepB);
    if constexpr (GATHER) { PG8_STAGE(PG8_SA(0, 0), cA, oC[0]); PG8_STAGE(PG8_SA(0, 1), cA, oC[1]); }
    else { PG8_STAGE1(PG8_SA(0, 0), cA, voffA[0], pstepA); PG8_STAGE1(PG8_SA(0, 1), cA + hstepA, voffA[0], pstepA); }
    if (wr == 1) PG8_BAR;
    PG8_WAIT_V(2); PG8_BAR;
    PG8_STAGE1(PG8_SB(1, 0), cB + kstep, voffB[0], pstepB);
    if constexpr (GATHER) { PG8_STAGE(PG8_SA(1, 0), cA + kstep, oC[0]); } else { PG8_STAGE1(PG8_SA(1, 0), cA + kstep, voffA[0], pstepA); }
    PG8_STAGE1(PG8_SB(1, 1), cB + hstepB + kstep, voffB[0], pstepB);
    PG8_WAIT_V(6); PG8_BAR;
    for (;;) {
        const bool has_next = S.next(ui + 1, nxt);
        const char* nA = has_next ? S.abase(nxt) : cA; const char* nB = has_next ? S.bbase(nxt) : cB;
        const char* nB2 = nB; if constexpr (BSPLIT) nB2 = has_next ? S.bbase2(nxt) - (size_t)ksp * kstep : cB2;
        if constexpr (GATHER) {
#pragma unroll
            for (int h = 0; h < 2; ++h)
#pragma unroll
                for (int i = 0; i < 2; ++i) oN[h][i] = has_next ? (unsigned)S.rowtok(nxt, h * HALF + RA[i]) * (unsigned)(K * 2) + (unsigned)(CA[i] * 2) : oC[h][i];
        }
        for (int t = 0; t < nt; t += 2) {
            const bool last = (t == nt - 2);
            const char* a1 = cA + (size_t)(t + 1) * kstep;
            const char* a2 = last ? nA : cA + (size_t)(t + 2) * kstep; const char* b2 = last ? nB : ((t + 2 < ksp) ? cB : cB2) + (size_t)(t + 2) * kstep;
            const char* a3 = a2 + kstep; const char* b3 = b2 + kstep;
            unsigned s0[2], s1[2];
            if constexpr (GATHER) { s0[0] = last ? oN[0][0] : oC[0][0]; s0[1] = last ? oN[0][1] : oC[0][1]; s1[0] = last ? oN[1][0] : oC[1][0]; s1[1] = last ? oN[1][1] : oC[1][1]; }
            PG8_LDB(B0, 0, 0); PG8_LDB(B1, 0, 1); PG8_SCHED; PG8_LDA(At, 0, 0);
            if constexpr (GATHER) { PG8_STAGE(PG8_SA(1, 1), a1, oC[1]); } else { PG8_STAGE1(PG8_SA(1, 1), a1 + hstepA, voffA[0], pstepA); }
            PG8_WAIT_V(8); PG8_WAIT_L(0); PG8_BAR; PG8_MMA(0, 0, At, B0); PG8_MMA(0, 1, At, B1); PG8_BAR; PG8_SCHED;
            PG8_LDA(At, 0, 1); PG8_STAGE1(PG8_SB(0, 0), b2, voffB[0], pstepB); PG8_STAGE1(PG8_SB(0, 1), b2 + hstepB, voffB[0], pstepB);
            if constexpr (GATHER) { PG8_STAGE(PG8_SA(0, 0), a2, s0); } else { PG8_STAGE1(PG8_SA(0, 0), a2, voffA[0], pstepA); }
            PG8_WAIT_V(8); PG8_WAIT_L(0); PG8_BAR; PG8_MMA(1, 0, At, B0); PG8_MMA(1, 1, At, B1); PG8_BAR; PG8_SCHED;
            PG8_LDB(B0, 1, 0); PG8_LDB(B1, 1, 1); PG8_SCHED; PG8_LDA(At, 1, 0);
            if constexpr (GATHER) { PG8_STAGE(PG8_SA(0, 1), a2, s1); } else { PG8_STAGE1(PG8_SA(0, 1), a2 + hstepA, voffA[0], pstepA); }
            PG8_WAIT_V(8); PG8_WAIT_L(0); PG8_BAR; PG8_MMA(0, 0, At, B0); PG8_MMA(0, 1, At, B1); PG8_BAR; PG8_SCHED;
            PG8_LDA(At, 1, 1); PG8_STAGE1(PG8_SB(1, 0), b3, voffB[0], pstepB); PG8_STAGE1(PG8_SB(1, 1), b3 + hstepB, voffB[0], pstepB);
            if constexpr (GATHER) { PG8_STAGE(PG8_SA(1, 0), a3, s0); } else { PG8_STAGE1(PG8_SA(1, 0), a3, voffA[0], pstepA); }
            PG8_WAIT_V(8); PG8_WAIT_L(0); PG8_BAR; PG8_MMA(1, 0, At, B0); PG8_MMA(1, 1, At, B1); PG8_BAR; PG8_SCHED;
        }
        if constexpr (ALIGN_EPI) { if (wr == 0) PG8_BAR; }
        { int ln_; asm volatile("v_mbcnt_lo_u32_b32 %0, -1, 0\n\tv_mbcnt_hi_u32_b32 %0, -1, %0" : "=v"(ln_)); E(acc, cur, wr, wc, ln_ & 15, ln_ >> 4); }
        if (!has_next) break;
#pragma unroll
        for (int a = 0; a < 2; ++a)
#pragma unroll
            for (int b = 0; b < 2; ++b)
#pragma unroll
                for (int m = 0; m < 4; ++m)
#pragma unroll
                    for (int n = 0; n < 2; ++n) acc[a][b][m][n] = (f32x4){0.f, 0.f, 0.f, 0.f};
        cur = nxt; cA = nA; cB = nB; cB2 = nB2; ++ui;
        if constexpr (GATHER) {
#pragma unroll
            for (int h = 0; h < 2; ++h)
#pragma unroll
                for (int i = 0; i < 2; ++i) oC[h][i] = oN[h][i];
        }
        if constexpr (ALIGN_EPI) { if (wr == 1) PG8_BAR; }
    }
    PG8_WAIT_V(0);
    if constexpr (!ALIGN_EPI) { if (wr == 0) PG8_BAR; }
    PG8_BAR;
#undef PG8_SA
#undef PG8_SB
#undef PG8_STAGE
#undef PG8_STAGE1
#undef PG8_LDA
#undef PG8_LDB
#undef PG8_MMA
#undef PG8_WAIT_V
#undef PG8_WAIT_L
#undef PG8_BAR
#undef PG8_SCHED
}
}
using pg8::Unit;

struct DenseOrder {
    const char* A; const char* Bt; size_t tstepA, tstepB; int nM, nN, nwg, G, c;
    __device__ __forceinline__ void init(const void* A_, const void* Bt_, int M, int N, int K, int ldb, int G_, int c_) {
        A = (const char*)A_; Bt = (const char*)Bt_; tstepA = (size_t)256 * K * 2; tstepB = (size_t)256 * ldb * 2; nM = M / 256; nN = N / 256; nwg = nM * nN; G = G_; c = c_; }
    __device__ __forceinline__ bool next(int i, Unit& u) const {
        const long L = (long)i * G + c; if (L >= nwg) return false;
        int wgid = (int)L; { const int q = nwg / 8, r = nwg % 8, xcd = wgid % 8, off = wgid / 8; wgid = (xcd < r ? xcd * (q + 1) : r * (q + 1) + (xcd - r) * q) + off; }
        const int nig = 8 * nN, gid = wgid / nig, fm = gid * 8, gsz = (nM - fm) < 8 ? (nM - fm) : 8;
        u.pm = fm + ((wgid % nig) % gsz); u.pn = (wgid % nig) / gsz; u.cls = 0; u.p0 = 0; return true;
    }
    __device__ __forceinline__ const char* abase(const Unit& u) const { return A + (size_t)u.pm * tstepA; }
    __device__ __forceinline__ const char* bbase(const Unit& u) const { return Bt + (size_t)u.pn * tstepB; }
    __device__ __forceinline__ const char* bbase2(const Unit& u) const { return bbase(u); }
    __device__ __forceinline__ int rowtok(const Unit&, int) const { return 0; }
};

__device__ __forceinline__ void cls_experts(int cls, int& eA, int& eB) { const int g = cls / 6, p = cls % 6; const int a = (p >= 3) + (p >= 5), b = p < 3 ? p + 1 : (p < 5 ? p - 1 : 3); eA = 4 * g + a; eB = 4 * g + b; }
struct ExpertOrder {
    const LAS int* tb; const LAS int* cn; const int* list; const char* A; const char* W; int G, c, mode, layer;
    __device__ __forceinline__ bool next(int i, Unit& u) const {
        const int nwg = __builtin_amdgcn_readfirstlane(tb[NCLS]) * 4; const long L = (long)i * G + c; if (L >= nwg) return false;
        int wgid = (int)L; { const int q = nwg / 8, r = nwg % 8, xcd = wgid % 8, off = wgid / 8; wgid = (xcd < r ? xcd * (q + 1) : r * (q + 1) + (xcd - r) * q) + off; }
        const int rt = wgid >> 2; int cls = 0;
        for (int k = 1; k < NCLS; ++k) cls += (rt >= tb[k]) ? 1 : 0;
        cls = __builtin_amdgcn_readfirstlane(cls);
        u.pm = rt; u.pn = wgid & 3; u.cls = cls; u.p0 = __builtin_amdgcn_readfirstlane((rt - tb[cls]) * 256); return true;
    }
    __device__ __forceinline__ const char* abase(const Unit& u) const { return mode == 1 ? A : A + (size_t)u.pm * (256 * 512 * 2); }
    __device__ __forceinline__ const char* bbase(const Unit& u) const {
        if (mode == 1) { int eA, eB; cls_experts(u.cls, eA, eB); const int e = (u.pn >> 1) ? eB : eA; return W + ((size_t)(layer * 16 + e) * 512 + (size_t)(u.pn & 1) * 256) * (1024 * 2); }
        int eA, eB; cls_experts(u.cls, eA, eB); return W + ((size_t)(layer * 16 + eA) * 1024 + (size_t)u.pn * 256) * (256 * 2);
    }
    __device__ __forceinline__ const char* bbase2(const Unit& u) const { int eA, eB; cls_experts(u.cls, eA, eB); return W + ((size_t)(layer * 16 + eB) * 1024 + (size_t)u.pn * 256) * (256 * 2); }
    __device__ __forceinline__ int rowtok(const Unit& u, int rr) const { const int pos = u.p0 + rr; return pos < cn[u.cls] ? list[(size_t)u.cls * NTOK + pos] : DUMMY_ROW; }
};

__device__ __forceinline__ float row_rstd16(const float* ssq, int row, int fq, float inv_n) {
    const f32x4 v = *(const f32x4*)(ssq + (size_t)row * 16 + 4 * fq);
    float s = (v.x + v.y) + (v.z + v.w);
    s += __shfl_xor(s, 16); s += __shfl_xor(s, 32);
    return rsqrtf(s * inv_n + EPS);
}

struct EpiProj {
    bf16_t* proj; float* flog; const float* ssq1; const float* fb;
    __device__ __forceinline__ void operator()(const f32x4 (&acc)[2][2][4][2], const Unit& u, int wr, int wc, int fr, int fq) const {
#pragma unroll
        for (int ai = 0; ai < 2; ++ai)
#pragma unroll
            for (int m = 0; m < 4; ++m) {
                const int row = u.pm * 256 + ai * 128 + wr * 64 + m * 16 + fr;
                const float rs = row_rstd16(ssq1, row, fq, 1.f / DM);
                if (u.pn < 9) {
#pragma unroll
                    for (int bj = 0; bj < 2; ++bj) { const f32x4 v0 = acc[ai][bj][m][0] * rs, v1 = acc[ai][bj][m][1] * rs; u32x4 w;
                        w.x = cvt_pk_bf16(v0[0], v0[1]); w.y = cvt_pk_bf16(v0[2], v0[3]); w.z = cvt_pk_bf16(v1[0], v1[1]); w.w = cvt_pk_bf16(v1[2], v1[3]);
                        *(u32x4*)(proj + (size_t)row * PJ + u.pn * 256 + bj * 128 + wc * 32 + 8 * fq) = w; }
                } else if (wc == 0 && fq == 0) {
                    f32x4 o0, o1;
#pragma unroll
                    for (int e = 0; e < 4; ++e) { const float f0 = acc[ai][0][m][0][e] * rs + fb[e], f1 = acc[ai][0][m][1][e] * rs + fb[4 + e];
                        o0[e] = -log2f(1.f + exp2f(-f0 * LOG2E)); o1[e] = -log2f(1.f + exp2f(-f1 * LOG2E)); }
                    *(f32x4*)(flog + (size_t)row * 8) = o0; *(f32x4*)(flog + (size_t)row * 8 + 4) = o1;
                }
            }
    }
};
template <bool TOKMAP> struct EpiRes {
    bf16_t* h; float* ssq; const LAS int* cn; const int* list;
    __device__ __forceinline__ void operator()(const f32x4 (&acc)[2][2][4][2], const Unit& u, int wr, int wc, int fr, int fq) const {
#pragma unroll
        for (int ai = 0; ai < 2; ++ai)
#pragma unroll
            for (int m = 0; m < 4; ++m) {
                const int rr = ai * 128 + wr * 64 + m * 16 + fr; int row;
                if constexpr (TOKMAP) { const int pos = u.p0 + rr; row = pos < cn[u.cls] ? list[(size_t)u.cls * NTOK + pos] : DUMMY_ROW; } else row = u.pm * 256 + rr;
                float sq = 0.f;
#pragma unroll
                for (int bj = 0; bj < 2; ++bj) { bf16_t* p = h + (size_t)row * DM + u.pn * 256 + bj * 128 + wc * 32 + 8 * fq; const u32x4 o = *(const u32x4*)p;
                    const f32x4 a0 = acc[ai][bj][m][0], a1 = acc[ai][bj][m][1]; u32x4 w;
                    w.x = cvt_pk_bf16(bflo(o.x) + a0[0], bfhi(o.x) + a0[1]); w.y = cvt_pk_bf16(bflo(o.y) + a0[2], bfhi(o.y) + a0[3]);
                    w.z = cvt_pk_bf16(bflo(o.z) + a1[0], bfhi(o.z) + a1[1]); w.w = cvt_pk_bf16(bflo(o.w) + a1[2], bfhi(o.w) + a1[3]);
                    *(u32x4*)p = w;
                    sq += bflo(w.x) * bflo(w.x) + bfhi(w.x) * bfhi(w.x) + bflo(w.y) * bflo(w.y) + bfhi(w.y) * bfhi(w.y) + bflo(w.z) * bflo(w.z) + bfhi(w.z) * bfhi(w.z) + bflo(w.w) * bflo(w.w) + bfhi(w.w) * bfhi(w.w); }
                sq += __shfl_xor(sq, 16); sq += __shfl_xor(sq, 32);
                if (fq == 0) ssq[(size_t)row * 16 + u.pn * 4 + wc] = sq;
                if (m & 1) asm volatile("" ::: "memory");
            }
    }
};
struct EpiE1 {
    bf16_t* H1; const float* tinfo; const LAS int* cn; const int* list;
    __device__ __forceinline__ void operator()(const f32x4 (&acc)[2][2][4][2], const Unit& u, int wr, int wc, int fr, int fq) const {
#pragma unroll
        for (int ai = 0; ai < 2; ++ai)
#pragma unroll
            for (int m = 0; m < 4; ++m) {
                const int rr = ai * 128 + wr * 64 + m * 16 + fr; const int pos = u.p0 + rr;
                const int tok = pos < cn[u.cls] ? list[(size_t)u.cls * NTOK + pos] : DUMMY_ROW;
                const f32x4 ti = *(const f32x4*)(tinfo + (size_t)tok * 4);
                const float rs = ti.x, gate = (u.pn >> 1) ? ti.z : ti.y;
                float o[8];
#pragma unroll
                for (int n = 0; n < 2; ++n)
#pragma unroll
                    for (int e = 0; e < 4; ++e) { const float a = acc[ai][0][m][n][e] * rs, b = acc[ai][1][m][n][e] * rs; o[n * 4 + e] = gate * siluf_(a) * b; }
                u32x4 w; w.x = cvt_pk_bf16(o[0], o[1]); w.y = cvt_pk_bf16(o[2], o[3]); w.z = cvt_pk_bf16(o[4], o[5]); w.w = cvt_pk_bf16(o[6], o[7]);
                *(u32x4*)(H1 + (size_t)(u.pm * 256 + rr) * 512 + (u.pn >> 1) * 256 + (u.pn & 1) * 128 + wc * 32 + 8 * fq) = w;
            }
    }
};

__device__ __forceinline__ void meta_gemm16(const bf16_t* A, const bf16_t* Bt, int K, int n0, int wave, int lane, f32x4 (&acc)[2]) {
    const int m = lane & 15, q4 = lane >> 4;
    acc[0] = (f32x4){0.f, 0.f, 0.f, 0.f}; acc[1] = acc[0];
    const bf16_t* ap = A + (size_t)m * K + 8 * q4;
    const bf16_t* bp0 = Bt + (size_t)(n0 + 32 * wave + m) * K + 8 * q4; const bf16_t* bp1 = bp0 + (size_t)16 * K;
#pragma unroll 4
    for (int k0 = 0; k0 < K; k0 += 32) {
        const bf16x8 a = *(const bf16x8*)(ap + k0), b0 = *(const bf16x8*)(bp0 + k0), b1 = *(const bf16x8*)(bp1 + k0);
        acc[0] = __builtin_amdgcn_mfma_f32_16x16x32_bf16(b0, a, acc[0], 0, 0, 0);
        acc[1] = __builtin_amdgcn_mfma_f32_16x16x32_bf16(b1, a, acc[1], 0, 0, 0);
    }
}

#define XB_TMO      128
#define XB_XCNT(j)  (256  + 64 * (j))
#define XB_XSUB(j)  (1280 + 64 * (j))
#define XB_XGEN(j)  (2304 + 64 * (j))
#define XB_TOP      3328
#define XB_TOPGEN   3392
#define XCD_BAR_WORDS 3456
#define XB_SPIN_CAP (1u << 18)
__device__ __forceinline__ unsigned xb_ld(unsigned* p)              { return __hip_atomic_load(p, __ATOMIC_RELAXED, __HIP_MEMORY_SCOPE_AGENT); }
__device__ __forceinline__ unsigned xb_add(unsigned* p, unsigned v) { return __hip_atomic_fetch_add(p, v, __ATOMIC_RELAXED, __HIP_MEMORY_SCOPE_AGENT); }
__device__ __forceinline__ unsigned xb_xcc_id() { return (unsigned)__builtin_amdgcn_s_getreg((3 << 11) | 20) & 0xFu; }
#define XB_SPIN(cond, bar) do { unsigned _sp = 0; while (cond) { __builtin_amdgcn_s_sleep(1); \
    if ((++_sp & 255u) == 0u) { if (xb_ld(&(bar)[XB_TMO])) break; if (_sp > XB_SPIN_CAP) { atomicAdd(&(bar)[XB_TMO], 1u); break; } } } } while (0)
struct XcdBarrier { unsigned* bar; unsigned x; volatile LAS unsigned* st; };
__device__ __forceinline__ XcdBarrier xcd_barrier_post(unsigned* bar, volatile LAS unsigned* st) {
    XcdBarrier b; b.bar = bar; b.x = xb_xcc_id(); b.st = st;
    if (threadIdx.x == 0) (void)xb_add(&bar[XB_XCNT(b.x)], 1u);
    return b;
}
__device__ __forceinline__ void xcd_barrier_complete(unsigned* bar, unsigned x, unsigned& nloc, unsigned& nx) {
    const unsigned G = gridDim.x * gridDim.y * gridDim.z;
    unsigned sum, cnt, mine, sp = 0u;
    for (;;) {
        sum = 0u; cnt = 0u; mine = 0u;
#pragma unroll
        for (unsigned j = 0; j < 16; ++j) { const unsigned c = xb_ld(&bar[XB_XCNT(j)]); sum += c; cnt += (c > 0u) ? 1u : 0u; mine = (j == x) ? c : mine; }
        if (sum == G) break;
        __builtin_amdgcn_s_sleep(1);
        if ((++sp & 255u) == 0u) { if (xb_ld(&bar[XB_TMO])) break; if (sp > XB_SPIN_CAP) { atomicAdd(&bar[XB_TMO], 1u); break; } }
    }
    nloc = mine > 0u ? mine : 1u; nx = cnt > 0u ? cnt : 1u;
}
__device__ __forceinline__ void xcd_barrier(const XcdBarrier& b, const bool leader_thread) {
    asm volatile("s_waitcnt vmcnt(0)" ::: "memory");
    __syncthreads();
    if (leader_thread) {
        unsigned* bar = b.bar; asm volatile("" : "+s"(bar));
        __builtin_amdgcn_s_waitcnt(0);
        unsigned nloc = b.st[0], nx = b.st[1];
        if (nloc == 0u) { xcd_barrier_complete(bar, b.x, nloc, nx); b.st[0] = nloc; b.st[1] = nx; }
        const unsigned old = xb_add(&bar[XB_XSUB(b.x)], 1u);
        const unsigned gen = old / nloc;
        if (old + 1u == (gen + 1u) * nloc) {
            __builtin_amdgcn_fence(__ATOMIC_RELEASE, "agent");
            asm volatile("s_waitcnt vmcnt(0)" ::: "memory");
            const unsigned og = xb_add(&bar[XB_TOP], 1u);
            const unsigned tg = og / nx;
            if (og + 1u == (tg + 1u) * nx) xb_add(&bar[XB_TOPGEN], 1u);
            else XB_SPIN(xb_ld(&bar[XB_TOPGEN]) == tg, bar);
            __builtin_amdgcn_fence(__ATOMIC_ACQUIRE, "agent");
            xb_add(&bar[XB_XGEN(b.x)], 1u);
            asm volatile("s_waitcnt vmcnt(0)" ::: "memory");
        } else {
            XB_SPIN(xb_ld(&bar[XB_XGEN(b.x)]) == gen, bar);
            __builtin_amdgcn_fence(__ATOMIC_ACQUIRE, "agent");
            asm volatile("s_waitcnt vmcnt(0)" ::: "memory");
        }
    }
    __syncthreads();
}

template <class Get>
__device__ __forceinline__ void tr_item(const Get& get, bf16_t* dst, int dpitch, int k0, int n0, LAS float* scr, int lane) {
    float tv[32];
#pragma unroll
    for (int i = 0; i < 32; ++i) tv[i] = get(k0 + 2 * i + (lane >> 5), n0 + (lane & 31));
#pragma unroll
    for (int i = 0; i < 32; ++i) scr[(2 * i + (lane >> 5)) * 33 + (lane & 31)] = tv[i];
    LDS_WAIT(); asm volatile("" ::: "memory");
    const int c = lane & 7;
#pragma unroll
    for (int j = 0; j < 4; ++j) { const int n = (lane >> 3) + 8 * j; const LAS float* s = scr + (8 * c) * 33 + n;
        u32x4 o; o.x = pk2(s[0 * 33], s[1 * 33]); o.y = pk2(s[2 * 33], s[3 * 33]); o.z = pk2(s[4 * 33], s[5 * 33]); o.w = pk2(s[6 * 33], s[7 * 33]);
        *(u32x4*)(dst + (size_t)(n0 + n) * dpitch + k0 + 8 * c) = o; }
    LDS_WAIT(); asm volatile("" ::: "memory");
}
struct GetWin { const float* w; const float* g;
    __device__ __forceinline__ float operator()(int k, int n) const { int src; if (n < 2048) src = n; else if (n < 2304) src = n + 8; else if (n < 2312) src = n - 256; else return 0.f;
        float v = w[(size_t)k * DINSRC + src] * g[k]; if (n >= PQ && n < PK) v *= 0.125f * LOG2E; return v; } };
struct GetWout { const float* w; const float* ga; const float* gs;
    __device__ __forceinline__ float operator()(int k, int n) const { const int src = k < 768 ? k + 256 : k - 768; const float gn = k < 512 ? ga[k] : (k < 768 ? gs[k - 512] : 1.f);
        return w[(size_t)src * DM + n] * gn; } };
struct GetW13 { const float* w1; const float* w3; const float* g;
    __device__ __forceinline__ float operator()(int k, int n) const { const int u = n >> 8, hf = (n >> 7) & 1, j = n & 127; const uintptr_t wp = (uintptr_t)w1 + (uintptr_t)hf * ((uintptr_t)w3 - (uintptr_t)w1); return ((const float*)wp)[(size_t)k * 256 + u * 128 + j] * g[k]; } };
struct GetW2 { const float* w;
    __device__ __forceinline__ float operator()(int k, int n) const { return w[(size_t)k * DM + n]; } };
struct GetWr { const float* rg; const float* re; const float* g; int lo;
    __device__ __forceinline__ float operator()(int k, int n) const { float v = 0.f; if (n < 4) v = rg[(size_t)k * 4 + n]; else if (n < 20) v = re[(size_t)k * 16 + (n - 4)]; v *= g[k];
        if (lo) v = v - __uint_as_float(f2bf(v) << 16); return v; } };

constexpr int AT_SLOT = 16384, AT_CS = 81920, AT_WT = AT_CS + 4608 * 4;
__device__ __forceinline__ int crow(int r, int hi) { return (r & 3) + 8 * (r >> 2) + 4 * hi; }
__device__ __forceinline__ void attn_prefix(LAS unsigned char* lds, const int tid, const float* flog, int b, int h) {
    const int lane = tid & 63; const int w = __builtin_amdgcn_readfirstlane(tid >> 6);
    LAS float* cs = (LAS float*)(lds + AT_CS); LAS float* wt = (LAS float*)(lds + AT_WT);
    float v[9]; float run = 0.f;
#pragma unroll
    for (int i = 0; i < 9; ++i) { const int j = tid * 9 + i; float x = 0.f; if (j < NMETA + SEQ) x = flog[(size_t)rowof(b, j) * 8 + h]; run += x; v[i] = run; }
    float inc = run;
#pragma unroll
    for (int o = 1; o < 64; o <<= 1) { const float t = __shfl_up(inc, o); if (lane >= o) inc += t; }
    if (lane == 63) wt[w] = inc;
    __syncthreads();
    float base = inc - run;
    for (int k = 0; k < w; ++k) base += wt[k];
#pragma unroll
    for (int i = 0; i < 9; ++i) cs[tid * 9 + i] = base + v[i];
    __syncthreads();
}
__device__ __forceinline__ void at_glds16(const void* gsrc, unsigned lds_dst) { unsigned keep;
    asm volatile("s_mov_b32 %0, m0\n\ts_mov_b32 m0, %2\n\ts_nop 0\n\tglobal_load_lds_dwordx4 %1, off\n\ts_mov_b32 m0, %0" : "=&s"(keep) : "v"(gsrc), "s"(lds_dst) : "memory"); }
constexpr float AT_THR = 8.f;
__device__ __forceinline__ void attn_unit(LAS unsigned char* lds, const int tid, const bf16_t* proj, bf16_t* mixed, float* ssqa, int b, int h, int qt) {
    const int lane = tid & 63, r32 = lane & 31, hi = lane >> 5; const int w = __builtin_amdgcn_readfirstlane(tid >> 6);
    const LAS float* cs = (const LAS float*)(lds + AT_CS);
    const int qrel = 32 * w + r32;
    const int qrow = qt >= 0 ? b * SEQ + 256 * qt + qrel : NREAL + (qrel & 15);
    const int qkey = qt >= 0 ? NMETA + 256 * qt + qrel : (qrel & 15);
    const int qkey_w0 = qt >= 0 ? NMETA + 256 * qt + 32 * w : 0;
    const float cq = cs[qkey];
    bf16x8 qr[4];
#pragma unroll
    for (int d0 = 0; d0 < 4; ++d0) qr[d0] = *(const bf16x8*)(proj + (size_t)qrow * PJ + PQ + h * 64 + d0 * 16 + hi * 8);
    const int ntiles = qt >= 0 ? 1 + 4 * (qt + 1) : 1;
    const int wnt = qt >= 0 ? 4 * qt + (w >> 1) + 2 : 1;
    const int vr = 16 * (w & 3) + (lane >> 2);
    const unsigned ldsb = (unsigned)(uintptr_t)lds;
#define AT_DMA(jj) do { int kr_, vr_; if ((jj) == 0) { kr_ = NREAL + (lane < 15 ? lane : 15); vr_ = NREAL + (vr < 15 ? vr : 15); } else { kr_ = b * SEQ + 64 * ((jj) - 1) + lane; vr_ = b * SEQ + 64 * ((jj) - 1) + vr; } \
        const int so_ = AT_SLOTOF(sj, (jj) - jbase) + w * 1024; \
        at_glds16(proj + (size_t)kr_ * PJ + PK + h * 64 + w * 8, (unsigned)__builtin_amdgcn_readfirstlane(ldsb + so_)); \
        at_glds16(proj + (size_t)vr_ * PJ + PV + h * 64 + (w >> 2) * 32 + (lane & 3) * 8, (unsigned)__builtin_amdgcn_readfirstlane(ldsb + so_ + 8192)); } while (0)
#define AT_WAITBAR(n) asm volatile("s_waitcnt vmcnt(" #n ") lgkmcnt(0)\n\ts_barrier" ::: "memory")
    float mref = 0.f, lrun = 0.f; f32x16 o0 = {}, o1 = {};
    const int kfo = hi * 1024 + r32 * 16;
    const int vb = 8192 + ((lane >> 4) & 1) * 32 + (lane & 3) * 8 + (4 * hi + ((lane & 15) >> 2)) * 64;
    const LAS float* csl = cs + 4 * hi;
    bf16x8 kf[8];
#define AT_KLOAD(P0, P1, jjn) do { const int kb_ = (jjn) == 0 ? 0 : NMETA + 64 * ((jjn) - 1); const float cqm = cq - mref; const int so_ = AT_SLOTOF(sj, (jjn) - jbase); \
        _Pragma("unroll") for (int d0 = 0; d0 < 4; ++d0) { kf[2 * d0] = *(const LAS bf16x8*)(lds + so_ + kfo + d0 * 2048); kf[2 * d0 + 1] = *(const LAS bf16x8*)(lds + so_ + kfo + d0 * 2048 + 512); } \
        _Pragma("unroll") for (int g_ = 0; g_ < 4; ++g_) { const f32x4 c0_ = *(const LAS f32x4*)(csl + kb_ + 8 * g_), c1_ = *(const LAS f32x4*)(csl + kb_ + 32 + 8 * g_); \
            _Pragma("unroll") for (int e_ = 0; e_ < 4; ++e_) { P0[4 * g_ + e_] = cqm - c0_[e_]; P1[4 * g_ + e_] = cqm - c1_[e_]; } } \
        __builtin_amdgcn_sched_barrier(0); } while (0)
#define AT_QKM(P0, P1) do { _Pragma("unroll") for (int d0 = 0; d0 < 4; ++d0) { \
            P0 = __builtin_amdgcn_mfma_f32_32x32x16_bf16(kf[2 * d0], qr[d0], P0, 0, 0, 0); P1 = __builtin_amdgcn_mfma_f32_32x32x16_bf16(kf[2 * d0 + 1], qr[d0], P1, 0, 0, 0); } \
        __builtin_amdgcn_sched_barrier(0); } while (0)
#define AT_MX3(a, b, c) __builtin_fmaxf(__builtin_fmaxf((a), (b)), (c))
#define AT_SMPV(P0, P1, N0, N1, jj, pend) do { const int kb_ = (jj) == 0 ? 0 : NMETA + 64 * ((jj) - 1); \
        const LAS unsigned char* Vb_ = lds + AT_SLOTOF(sj, (jj) - jbase) + vb; s16x4 va_[8], vc_[8]; \
        _Pragma("unroll") for (int ks = 0; ks < 4; ++ks) { \
            va_[2 * ks] = __builtin_bit_cast(s16x4, __builtin_amdgcn_ds_read_tr16_b64_v4i16((LAS s16x4*)(Vb_ + ks * 1024))); \
            va_[2 * ks + 1] = __builtin_bit_cast(s16x4, __builtin_amdgcn_ds_read_tr16_b64_v4i16((LAS s16x4*)(Vb_ + ks * 1024 + 512))); } \
        __builtin_amdgcn_sched_barrier(0); \
        if ((jj) == 0 || kb_ + 63 > qkey_w0) { const int lim_ = (jj) == 0 ? (qkey < 15 ? qkey : 15) : qkey; \
            _Pragma("unroll") for (int r = 0; r < 16; ++r) { const int j_ = kb_ + crow(r, hi); if (j_ > lim_) P0[r] = -INFINITY; if (j_ + 32 > lim_) P1[r] = -INFINITY; } } \
        float ra_ = AT_MX3(P0[0], P0[1], P1[0]), rb_ = AT_MX3(P0[2], P0[3], P1[1]); ra_ = AT_MX3(ra_, P1[2], P1[3]); \
        _Pragma("unroll") for (int r = 4; r < 16; r += 4) { ra_ = AT_MX3(ra_, P0[r], P0[r + 1]); rb_ = AT_MX3(rb_, P0[r + 2], P0[r + 3]); ra_ = AT_MX3(ra_, P1[r], P1[r + 1]); rb_ = AT_MX3(rb_, P1[r + 2], P1[r + 3]); } \
        float rm_ = fmaxf(ra_, rb_); \
        rm_ = fmaxf(rm_, __shfl_xor(rm_, 32)); \
        if ((jj) == 0 || __any(rm_ > AT_THR)) { const float dl_ = (jj) == 0 ? rm_ : fmaxf(rm_, 0.f); mref += dl_; const float f_ = (jj) == 0 ? 1.f : fast_exp2(-dl_); lrun *= f_; \
            _Pragma("unroll") for (int r = 0; r < 16; ++r) { P0[r] -= dl_; P1[r] -= dl_; o0[r] *= f_; o1[r] *= f_; } \
            if (pend) { _Pragma("unroll") for (int r = 0; r < 16; ++r) { N0[r] -= dl_; N1[r] -= dl_; } } } \
        float rs_ = 0.f; \
        _Pragma("unroll") for (int r = 0; r < 16; ++r) { P0[r] = fast_exp2(P0[r]); P1[r] = fast_exp2(P1[r]); rs_ += P0[r] + P1[r]; } \
        lrun += rs_; \
        u32x4 pw_[4]; \
        _Pragma("unroll") for (int i = 0; i < 4; ++i) { pw_[0][i] = cvt_pk_bf16(P0[2 * i], P0[2 * i + 1]); pw_[1][i] = cvt_pk_bf16(P0[8 + 2 * i], P0[8 + 2 * i + 1]); \
            pw_[2][i] = cvt_pk_bf16(P1[2 * i], P1[2 * i + 1]); pw_[3][i] = cvt_pk_bf16(P1[8 + 2 * i], P1[8 + 2 * i + 1]); } \
        __builtin_amdgcn_sched_barrier(0); \
        _Pragma("unroll") for (int ks = 0; ks < 4; ++ks) { \
            vc_[2 * ks] = __builtin_bit_cast(s16x4, __builtin_amdgcn_ds_read_tr16_b64_v4i16((LAS s16x4*)(Vb_ + 4096 + ks * 1024))); \
            vc_[2 * ks + 1] = __builtin_bit_cast(s16x4, __builtin_amdgcn_ds_read_tr16_b64_v4i16((LAS s16x4*)(Vb_ + 4096 + ks * 1024 + 512))); } \
        _Pragma("unroll") for (int ks = 0; ks < 4; ++ks) { \
            const bf16x8 va = {va_[2 * ks][0], va_[2 * ks][1], va_[2 * ks][2], va_[2 * ks][3], va_[2 * ks + 1][0], va_[2 * ks + 1][1], va_[2 * ks + 1][2], va_[2 * ks + 1][3]}; \
            o0 = __builtin_amdgcn_mfma_f32_32x32x16_bf16(va, __builtin_bit_cast(bf16x8, pw_[ks]), o0, 0, 0, 0); } \
        __builtin_amdgcn_sched_barrier(0); \
        _Pragma("unroll") for (int ks = 0; ks < 4; ++ks) { \
            const bf16x8 vbb = {vc_[2 * ks][0], vc_[2 * ks][1], vc_[2 * ks][2], vc_[2 * ks][3], vc_[2 * ks + 1][0], vc_[2 * ks + 1][1], vc_[2 * ks + 1][2], vc_[2 * ks + 1][3]}; \
            o1 = __builtin_amdgcn_mfma_f32_32x32x16_bf16(vbb, __builtin_bit_cast(bf16x8, pw_[ks]), o1, 0, 0, 0); } \
        __builtin_amdgcn_sched_barrier(0); } while (0)
#define AT_STEP(C0, C1, N0, N1, jj) do { \
        const bool dma_ = (jj) + 4 < ntiles; \
        if (dma_) AT_DMA((jj) + 4); \
        const bool pend_ = (jj) + 1 < wnt; \
        if (pend_) AT_QKM(N0, N1); \
        if ((jj) < wnt) AT_SMPV(C0, C1, N0, N1, jj, pend_); \
        if ((jj) + 2 < wnt) AT_KLOAD(C0, C1, (jj) + 2); \
        if (dma_) AT_WAITBAR(2); else AT_WAITBAR(0); } while (0)
    int sj = 0, jbase = 0;
#define AT_SLOTOF(s_, k_) (((s_) + (k_) * AT_SLOT) >= 5 * AT_SLOT ? ((s_) + (k_) * AT_SLOT) - 5 * AT_SLOT : ((s_) + (k_) * AT_SLOT))
    AT_DMA(0);
    if (ntiles > 1) AT_DMA(1);
    if (ntiles > 2) AT_DMA(2);
    if (ntiles > 3) { AT_DMA(3); AT_WAITBAR(2); } else AT_WAITBAR(0);
    f32x16 pa0, pa1, pb0, pb1;
    AT_KLOAD(pa0, pa1, 0); AT_QKM(pa0, pa1);
    if (1 < wnt) AT_KLOAD(pb0, pb1, 1);
#pragma unroll 1
    for (int jj = 0; jj < ntiles; jj += 2) {
        jbase = jj;
        AT_STEP(pa0, pa1, pb0, pb1, jj);
        if (jj + 1 < ntiles) AT_STEP(pb0, pb1, pa0, pa1, jj + 1);
        sj = AT_SLOTOF(sj, 2);
    }
#undef AT_SLOTOF
#undef AT_KLOAD
#undef AT_QKM
#undef AT_MX3
#undef AT_DMA
#undef AT_WAITBAR
#undef AT_SMPV
#undef AT_STEP
    const float ltot = lrun + __shfl_xor(lrun, 32);
    const float inv = 1.f / ltot;
    float sq = 0.f;
#pragma unroll
    for (int r = 0; r < 16; ++r) { o0[r] *= inv; o1[r] *= inv; sq += o0[r] * o0[r] + o1[r] * o1[r]; }
    sq += __shfl_xor(sq, 32);
    const bool st = qt >= 0 || qrel < 16;
    if (st) {
        bf16_t* op = mixed + (size_t)qrow * DM + MX_ATT + h * 64;
#pragma unroll
        for (int g = 0; g < 4; ++g) { u32x2 w0, w1; w0.x = cvt_pk_bf16(o0[4 * g], o0[4 * g + 1]); w0.y = cvt_pk_bf16(o0[4 * g + 2], o0[4 * g + 3]); w1.x = cvt_pk_bf16(o1[4 * g], o1[4 * g + 1]); w1.y = cvt_pk_bf16(o1[4 * g + 2], o1[4 * g + 3]);
            *(u32x2*)(op + 8 * g + 4 * hi) = w0; *(u32x2*)(op + 32 + 8 * g + 4 * hi) = w1; }
        if (hi == 0) ssqa[(size_t)qrow * 8 + h] = sq;
    }
    __syncthreads();
}

constexpr int CV_U = 0, CV_Y = 65536;
__device__ __forceinline__ void conv_subtile(LAS unsigned char* lds, const int tid, const bf16_t* proj, bf16_t* mixed, const float* cw, const float* cb, const float* lg, const float* lb, int b, int t0, int nvalid) {
    const int lane = tid & 63; const int w = __builtin_amdgcn_readfirstlane(tid >> 6);
    LAS float* ub = (LAS float*)(lds + CV_U); LAS float* yb = (LAS float*)(lds + CV_Y);
    for (int idx = tid; idx < 62 * 64; idx += 512) {
        const int rr = idx >> 6, cq4 = (idx & 63) * 4; const int t = t0 - 30 + rr; f32x4 u = {0.f, 0.f, 0.f, 0.f};
        if (t >= 0 && t < NMETA + SEQ) { const bf16_t* p = proj + (size_t)rowof(b, t) * PJ + cq4; const u32x2 a = *(const u32x2*)p, g = *(const u32x2*)(p + 256);
            u[0] = bflo(a.x) * sigmoidf_(bflo(g.x)); u[1] = bfhi(a.x) * sigmoidf_(bfhi(g.x)); u[2] = bflo(a.y) * sigmoidf_(bflo(g.y)); u[3] = bfhi(a.y) * sigmoidf_(bfhi(g.y)); }
        *(LAS f32x4*)(ub + rr * 256 + cq4) = u;
    }
    __syncthreads();
    {
        const int c = tid & 255, rh = tid >> 8;
        float wv[31];
#pragma unroll
        for (int j = 0; j < 31; ++j) wv[j] = cw[j * 256 + c];
        float acc[16];
#pragma unroll
        for (int i = 0; i < 16; ++i) acc[i] = 0.f;
#pragma unroll
        for (int rr = 0; rr < 46; ++rr) { const float uv = ub[(16 * rh + rr) * 256 + c];
#pragma unroll
            for (int i = 0; i < 16; ++i) if (rr - i >= 0 && rr - i <= 30) acc[i] += wv[rr - i] * uv; }
        const float bb = cb[c];
#pragma unroll
        for (int i = 0; i < 16; ++i) yb[(16 * rh + i) * 256 + c] = acc[i] + bb;
    }
    __syncthreads();
    {
        const f32x4 g4 = *(const f32x4*)(lg + 4 * lane), b4 = *(const f32x4*)(lb + 4 * lane);
#pragma unroll
        for (int i = 0; i < 4; ++i) { const int rr = 4 * w + i; const f32x4 y = *(const LAS f32x4*)(yb + rr * 256 + 4 * lane);
            const float mu = wave_sum((y[0] + y[1]) + (y[2] + y[3])) * (1.f / 256.f);
            const f32x4 d = y - mu; const float var = wave_sum((d[0] * d[0] + d[1] * d[1]) + (d[2] * d[2] + d[3] * d[3])) * (1.f / 256.f);
            const float rs = rsqrtf(var + EPS); f32x4 o;
#pragma unroll
            for (int e = 0; e < 4; ++e) o[e] = siluf_(d[e] * rs * g4[e] + b4[e]);
            if (rr < nvalid) { u32x2 wv2; wv2.x = cvt_pk_bf16(o[0], o[1]); wv2.y = cvt_pk_bf16(o[2], o[3]); *(u32x2*)(mixed + (size_t)rowof(b, t0 + rr) * DM + MX_CONV + 4 * lane) = wv2; } }
    }
    __syncthreads();
}

struct S5P { const float *lre, *lim, *ldt, *bre, *bim, *cre, *cim, *dsk, *gw, *gb; };
__device__ __forceinline__ float gelu_tanh(float x) { const float u = 0.7978845608028654f * (x + 0.044715f * x * x * x); const float e = fast_exp2(2.f * LOG2E * u); const float th = 1.f - 2.f * fast_rcp(e + 1.f); return 0.5f * x * (1.f + th); }
__device__ __forceinline__ void s5_seq_unit(const S5P& P, const bf16_t* proj, bf16_t* mixed, float* ssqs, int b, int g, int lane) {
    const int p = lane;
    const float dt = expf(P.ldt[g]);
    const float lr = P.lre[g * 64 + p], li = P.lim[g * 64 + p];
    const float mag = expf(lr * dt);
    const double turns = (double)li * (double)dt * 0.15915494309189535; const float fr = (float)(turns - floor(turns));
    const float ar = mag * __builtin_amdgcn_cosf(fr), ai = mag * __builtin_amdgcn_sinf(fr);
    const float nr = ar - 1.f, ni = ai, den = lr * lr + li * li;
    const float fre = (nr * lr + ni * li) / den, fim = (ni * lr - nr * li) / den;
    float bbr[16], bbi[16], cr[16], ci[16];
#pragma unroll
    for (int h = 0; h < 16; ++h) { const float br = P.bre[(g * 64 + p) * 16 + h], bi = P.bim[(g * 64 + p) * 16 + h]; bbr[h] = fre * br - fim * bi; bbi[h] = fre * bi + fim * br;
        cr[h] = P.cre[(g * 16 + h) * 64 + p]; ci[h] = P.cim[(g * 16 + h) * 64 + p]; }
    const int hl = ((lane >> 5) & 1) * 8 + ((lane >> 4) & 1) * 4 + ((lane >> 3) & 1) * 2 + ((lane >> 2) & 1);
    const float dsk = P.dsk[g * 16 + hl], gbk = P.gb[g * 16 + hl];
    float gwk[16];
#pragma unroll
    for (int h = 0; h < 16; ++h) gwk[h] = P.gw[(g * 16 + h) * 16 + hl];
    float xr = 0.f, xi = 0.f;
    u32x4 nua = *(const u32x4*)(proj + (size_t)rowof(b, 0) * PJ + PU + 16 * g), nub = *(const u32x4*)(proj + (size_t)rowof(b, 0) * PJ + PU + 16 * g + 8);
#pragma unroll 1
    for (int t = 0; t < NMETA + SEQ; ++t) {
        const int row = rowof(b, t);
        const u32x4 ua = nua, ub = nub;
        { const int tn = t + 1 < NMETA + SEQ ? t + 1 : t; const bf16_t* np = proj + (size_t)rowof(b, tn) * PJ + PU + 16 * g; nua = *(const u32x4*)np; nub = *(const u32x4*)(np + 8); }
        float u[16]; u[0] = bflo(ua.x); u[1] = bfhi(ua.x); u[2] = bflo(ua.y); u[3] = bfhi(ua.y); u[4] = bflo(ua.z); u[5] = bfhi(ua.z); u[6] = bflo(ua.w); u[7] = bfhi(ua.w);
        u[8] = bflo(ub.x); u[9] = bfhi(ub.x); u[10] = bflo(ub.y); u[11] = bfhi(ub.y); u[12] = bflo(ub.z); u[13] = bfhi(ub.z); u[14] = bflo(ub.w); u[15] = bfhi(ub.w);
        float bur = 0.f, bui = 0.f;
#pragma unroll
        for (int h = 0; h < 16; ++h) { bur += bbr[h] * u[h]; bui += bbi[h] * u[h]; }
        const float nxr = ar * xr - ai * xi + bur, nxi = ar * xi + ai * xr + bui; xr = nxr; xi = nxi;
        float v[16];
#pragma unroll
        for (int h = 0; h < 16; ++h) v[h] = cr[h] * xr - ci[h] * xi;
        float v8[8], v4[4], v2[2], v1;
        { const bool up = (lane >> 5) & 1;
#pragma unroll
          for (int i = 0; i < 8; ++i) { const float send = up ? v[i] : v[i + 8], keep = up ? v[i + 8] : v[i]; v8[i] = keep + __shfl_xor(send, 32); } }
        { const bool up = (lane >> 4) & 1;
#pragma unroll
          for (int i = 0; i < 4; ++i) { const float send = up ? v8[i] : v8[i + 4], keep = up ? v8[i + 4] : v8[i]; v4[i] = keep + __shfl_xor(send, 16); } }
        { const bool up = (lane >> 3) & 1;
#pragma unroll
          for (int i = 0; i < 2; ++i) { const float send = up ? v4[i] : v4[i + 2], keep = up ? v4[i + 2] : v4[i]; v2[i] = keep + __shfl_xor(send, 8); } }
        { const bool up = (lane >> 2) & 1; const float send = up ? v2[0] : v2[1], keep = up ? v2[1] : v2[0]; v1 = keep + __shfl_xor(send, 4); }
        v1 += __shfl_xor(v1, 2); v1 += __shfl_xor(v1, 1);
        float uh = u[0];
#pragma unroll
        for (int h = 1; h < 16; ++h) uh = (hl == h) ? u[h] : uh;
        const float y = v1 + dsk * uh;
        const float zg = gelu_tanh(y);
        float gate = gbk;
#pragma unroll
        for (int h = 0; h < 16; ++h) { const int src = ((h >> 3) & 1) * 32 + ((h >> 2) & 1) * 16 + ((h >> 1) & 1) * 8 + (h & 1) * 4; gate += __shfl(zg, src) * gwk[h]; }
        const float outv = zg * sigmoidf_(gate);
        float sq = outv * outv;
        sq += __shfl_xor(sq, 32); sq += __shfl_xor(sq, 16); sq += __shfl_xor(sq, 8); sq += __shfl_xor(sq, 4);
        if (t >= NMETA || b == 0) {
            if ((lane & 3) == 0) mixed[(size_t)row * DM + MX_SSM + 16 * g + hl] = (bf16_t)f2bf(outv);
            if (lane == 0) ssqs[(size_t)row * 16 + g] = sq;
        }
    }
}

constexpr size_t S5T_BYTES = 163840;
constexpr int S5_KT = 0, S5_WS = 8704, S5_WC = 74240, S5_MD = 139776, S5_MC = 142848;
constexpr int S5L_KT = 0, S5L_W = 8704, S5L_EX = 78336, S5L_MD = 82944, S5L_MC = 86016;
__device__ __forceinline__ void s5_tables_block(LAS unsigned char* lds, const int tid, const S5P& P, int g, unsigned char* tbl) {
    typedef float f2 __attribute__((ext_vector_type(2)));
    LAS f2* pw = (LAS f2*)lds;
    LAS f2* Bb = (LAS f2*)(lds + 8704);
    LAS f2* Cc = (LAS f2*)(lds + 16896);
    if (tid < 64) {
        const int p = tid;
        const float dt = expf(P.ldt[g]);
        const float lr = P.lre[g * 64 + p], li = P.lim[g * 64 + p];
        const float mag = expf(lr * dt);
        const double turns = (double)li * (double)dt * 0.15915494309189535; const float fr = (float)(turns - floor(turns));
        const float ar = mag * __builtin_amdgcn_cosf(fr), ai = mag * __builtin_amdgcn_sinf(fr);
        const float nr = ar - 1.f, ni = ai, den = lr * lr + li * li;
        const float fre = (nr * lr + ni * li) / den, fim = (ni * lr - nr * li) / den;
        float xr = 1.f, xi = 0.f;
        for (int t = 0; t <= 16; ++t) { pw[t * 64 + p] = (f2){xr, xi}; const float nxr = xr * ar - xi * ai, nxi = xr * ai + xi * ar; xr = nxr; xi = nxi; }
        const f2 M = pw[16 * 64 + p];
        float* MD = (float*)(tbl + S5_MD); float* MC = (float*)(tbl + S5_MC);
        float mr = M.x, mi = M.y;
        for (int k = 0; k < 6; ++k) { MD[(k * 64 + p) * 2] = mr; MD[(k * 64 + p) * 2 + 1] = mi; const float n1 = mr * mr - mi * mi, n2 = 2.f * mr * mi; mr = n1; mi = n2; }
        xr = 1.f; xi = 0.f;
        for (int c = 0; c < 32; ++c) { MC[(c * 64 + p) * 2] = xr; MC[(c * 64 + p) * 2 + 1] = xi; const float nxr = xr * M.x - xi * M.y, nxi = xr * M.y + xi * M.x; xr = nxr; xi = nxi; }
        for (int h = 0; h < 16; ++h) { const float br = P.bre[(g * 64 + p) * 16 + h], bi = P.bim[(g * 64 + p) * 16 + h]; Bb[p * 16 + h] = (f2){fre * br - fim * bi, fre * bi + fim * br}; }
    }
    for (int e = tid; e < 1024; e += 512) Cc[e] = (f2){P.cre[g * 1024 + e], P.cim[g * 1024 + e]};
    __syncthreads();
    bf16_t* KT = (bf16_t*)(tbl + S5_KT); bf16_t* WSg = (bf16_t*)(tbl + S5_WS); bf16_t* WCg = (bf16_t*)(tbl + S5_WC);
    for (int e = tid; e < 17 * 256; e += 512) {
        const int t1 = e >> 8, h = (e >> 4) & 15, h2 = e & 15; float acc = 0.f;
        if (t1 > 0) { const int tau = t1 - 1;
            for (int p = 0; p < 64; ++p) { const f2 a = pw[tau * 64 + p], bb = Bb[p * 16 + h2], c = Cc[h * 64 + p]; const float zr = a.x * bb.x - a.y * bb.y, zi = a.x * bb.y + a.y * bb.x; acc += c.x * zr - c.y * zi; }
            if (tau == 0 && h == h2) acc += P.dsk[g * 16 + h]; }
        KT[e] = (bf16_t)f2bf(acc);
    }
    for (int e = tid; e < 128 * 256; e += 512) {
        const int r = e >> 8, ri = r >> 6, p = r & 63, q = e & 255, j = q >> 4, h2 = q & 15;
        const f2 a = pw[(15 - j) * 64 + p], bb = Bb[p * 16 + h2]; const float zr = a.x * bb.x - a.y * bb.y, zi = a.x * bb.y + a.y * bb.x;
        WSg[e] = (bf16_t)f2bf(ri ? zi : zr);
    }
    for (int e = tid; e < 256 * 128; e += 512) {
        const int row = e >> 7, i = row >> 4, h = row & 15, q = e & 127; const int blk = q >> 5, sq_ = (q >> 4) & 1, hh = (q >> 3) & 1, j = q & 7;
        const int n = 32 * blk + 16 * sq_ + 8 * (j >> 2) + 4 * hh + (j & 3); const int ri = n >> 6, p = n & 63;
        const f2 a = pw[(i + 1) * 64 + p], c = Cc[h * 64 + p]; const float zr = c.x * a.x - c.y * a.y, zi = c.x * a.y + c.y * a.x;
        WCg[e] = (bf16_t)f2bf(ri ? -zi : zr);
    }
    __syncthreads();
}

__device__ __forceinline__ void s5_unit(LAS unsigned char* lds, const int tid, const unsigned char* tbl, const float* gw, const float* gb, const bf16_t* proj, bf16_t* mixed, float* ssqs, int b, int g) {
    typedef float f2 __attribute__((ext_vector_type(2)));
    const int lane = tid & 63, c = lane & 31, hi = lane >> 5; const int w = __builtin_amdgcn_readfirstlane(tid >> 6);
    for (int q = tid; q < 544; q += 512) *(LAS u32x4*)(lds + S5L_KT + q * 16) = *(const u32x4*)(tbl + S5_KT + q * 16);
#pragma unroll
    for (int it = 0; it < 8; ++it) { const int q = tid + 512 * it; *(LAS u32x4*)(lds + S5L_W + (q >> 5) * 528 + (q & 31) * 16) = *(const u32x4*)(tbl + S5_WS + q * 16); }
    if (tid < 192) *(LAS u32x4*)(lds + S5L_MD + tid * 16) = *(const u32x4*)(tbl + S5_MD + tid * 16);
#pragma unroll
    for (int it = 0; it < 4; ++it) { const int q = tid + 512 * it; *(LAS u32x2*)(lds + S5L_MC + (q >> 6) * 520 + (q & 63) * 8) = *(const u32x2*)(tbl + S5_MC + q * 8); }
    __syncthreads();
    const bf16_t* ubase = proj + PU + 16 * g + 8 * hi;
    const LAS unsigned char* mdb = lds + S5L_MD + hi * 32;
    const LAS unsigned char* mcb = lds + S5L_MC + c * 520 + hi * 32;
    LAS float* EX = (LAS float*)(lds + S5L_EX) + 4 * hi;
    const LAS unsigned char* wsb = lds + S5L_W + c * 528 + hi * 16;
    const LAS unsigned char* wcb = lds + S5L_W + c * 272 + hi * 16;
    f32x16 sa[4];
#pragma unroll
    for (int k = 0; k < 4; ++k) sa[k] = (f32x16){};
    {
        const int cc = 32 * w + c;
        const bf16_t* up = ubase + (size_t)rowof(b, 16 * cc) * PJ;
#pragma unroll
        for (int s0 = 0; s0 < 16; s0 += 4) {
            bf16x8 uf[4];
#pragma unroll
            for (int s = 0; s < 4; ++s) { uf[s] = *(const bf16x8*)up; up += PJ; asm volatile("" : "+v"(up)); }
#pragma unroll
            for (int s = 0; s < 4; ++s) {
#pragma unroll
                for (int blk = 0; blk < 4; ++blk) { const bf16x8 A = *(const LAS bf16x8*)(wsb + blk * (32 * 528) + (s0 + s) * 32); sa[blk] = __builtin_amdgcn_mfma_f32_32x32x16_bf16(A, uf[s], sa[blk], 0, 0, 0); }
                __builtin_amdgcn_sched_barrier(0); }
        }
    }
#pragma unroll
    for (int k = 0; k < 5; ++k) { const int d = 1 << k;
#pragma unroll
        for (int pb = 0; pb < 2; ++pb)
#pragma unroll
            for (int r = 0; r < 16; ++r) { const f2 m = *(const LAS f2*)(mdb + (k * 64 + 32 * pb + (r & 3) + 8 * (r >> 2)) * 8);
                const float yr = __shfl_up(sa[pb][r], d, 32), yi = __shfl_up(sa[2 + pb][r], d, 32);
                if (c >= d) { sa[pb][r] += m.x * yr - m.y * yi; sa[2 + pb][r] += m.x * yi + m.y * yr; }
                if ((r & 3) == 3) __builtin_amdgcn_sched_barrier(0); }
    }
    if (c == 31) {
#pragma unroll
        for (int pb = 0; pb < 2; ++pb)
#pragma unroll
            for (int r = 0; r < 16; ++r) { const int p0 = 32 * pb + (r & 3) + 8 * (r >> 2); EX[w * 128 + p0] = sa[pb][r]; EX[w * 128 + 64 + p0] = sa[2 + pb][r]; }
    }
    __syncthreads();
#pragma unroll
    for (int it = 0; it < 8; ++it) { const int q = tid + 512 * it; *(LAS u32x4*)(lds + S5L_W + (q >> 4) * 272 + (q & 15) * 16) = *(const u32x4*)(tbl + S5_WC + q * 16); }
    __syncthreads();
    const int npass = w == 0 ? 2 : 1;
#pragma unroll 1
    for (int pass = 0; pass < npass; ++pass) {
        const int nprev = pass == 0 ? w : 8;
        const int cc = pass == 0 ? 32 * w + c : 256;
        if (pass == 1) {
#pragma unroll
            for (int k = 0; k < 4; ++k) sa[k] = (f32x16){};
        }
        {
            float cr[2][16], ci[2][16];
#pragma unroll
            for (int pb = 0; pb < 2; ++pb)
#pragma unroll
                for (int r = 0; r < 16; ++r) { cr[pb][r] = 0.f; ci[pb][r] = 0.f; }
#pragma unroll 1
            for (int wp = 0; wp < nprev; ++wp) {
                const LAS float* exw = EX + wp * 128;
#pragma unroll
                for (int pb = 0; pb < 2; ++pb)
#pragma unroll
                    for (int r = 0; r < 16; ++r) { const int p0 = 32 * pb + (r & 3) + 8 * (r >> 2); const f2 m = *(const LAS f2*)(mdb + (5 * 64 + p0) * 8); const float er = exw[p0], ei = exw[64 + p0];
                        const float nr = m.x * cr[pb][r] - m.y * ci[pb][r] + er, ni = m.x * ci[pb][r] + m.y * cr[pb][r] + ei; cr[pb][r] = nr; ci[pb][r] = ni;
                        if ((r & 7) == 7) __builtin_amdgcn_sched_barrier(0); }
            }
#pragma unroll
            for (int pb = 0; pb < 2; ++pb)
#pragma unroll
                for (int r = 0; r < 16; ++r) { const f2 m = *(const LAS f2*)(mcb + (32 * pb + (r & 3) + 8 * (r >> 2)) * 8);
                    float xr = __shfl_up(sa[pb][r], 1, 32), xi = __shfl_up(sa[2 + pb][r], 1, 32); if (c == 0) { xr = 0.f; xi = 0.f; }
                    sa[pb][r] = xr + m.x * cr[pb][r] - m.y * ci[pb][r]; sa[2 + pb][r] = xi + m.x * ci[pb][r] + m.y * cr[pb][r];
                    if ((r & 7) == 7) __builtin_amdgcn_sched_barrier(0); }
        }
        bf16x8 xf[4][2];
#pragma unroll
        for (int blk = 0; blk < 4; ++blk)
#pragma unroll
            for (int s = 0; s < 2; ++s) { u32x4 t; t.x = cvt_pk_bf16(sa[blk][8 * s], sa[blk][8 * s + 1]); t.y = cvt_pk_bf16(sa[blk][8 * s + 2], sa[blk][8 * s + 3]); t.z = cvt_pk_bf16(sa[blk][8 * s + 4], sa[blk][8 * s + 5]); t.w = cvt_pk_bf16(sa[blk][8 * s + 6], sa[blk][8 * s + 7]); xf[blk][s] = __builtin_bit_cast(bf16x8, t); }
        const int io = (lane >> 4) & 1, kk = lane & 15;
        bf16x8 Gf0, Gf1;
        { unsigned pkd[4];
    #pragma unroll
          for (int jj = 0; jj < 4; ++jj) { const int j0 = 2 * jj, j1 = 2 * jj + 1; const int h0 = 8 * (j0 >> 2) + 4 * hi + (j0 & 3), h1 = 8 * (j1 >> 2) + 4 * hi + (j1 & 3); pkd[jj] = pk2(gw[h0 * 16 + kk], gw[h1 * 16 + kk]); }
          const u32x4 wv = {pkd[0], pkd[1], pkd[2], pkd[3]}, zz = {0u, 0u, 0u, 0u};
          Gf0 = __builtin_bit_cast(bf16x8, io == 0 ? wv : zz); Gf1 = __builtin_bit_cast(bf16x8, io == 1 ? wv : zz); }
        float gbv[8];
    #pragma unroll
        for (int q = 0; q < 8; ++q) gbv[q] = gb[(q & 3) + 8 * (q >> 2) + 4 * hi];
        const int ktb = S5L_KT + ((lane >> 4) & 1) * 512 + (lane & 15) * 32 + hi * 16;
        const bool stok = pass == 0 ? (cc > 0 || b == 0) : (c == 0);
#pragma unroll
        for (int half = 0; half < 2; ++half) {
            __builtin_amdgcn_sched_barrier(0);
            f32x16 ya[4];
#pragma unroll
            for (int rl = 0; rl < 4; ++rl) ya[rl] = (f32x16){};
            const bf16_t* up = ubase + (size_t)rowof(b, 16 * cc) * PJ;
#pragma unroll
            for (int s0 = 0; s0 < 8 * half + 8; s0 += 4) {
                bf16x8 uf[4];
#pragma unroll
                for (int s = 0; s < 4; ++s) { uf[s] = *(const bf16x8*)up; up += PJ; asm volatile("" : "+v"(up)); }
#pragma unroll
                for (int s = 0; s < 4; ++s) {
#pragma unroll
                    for (int rl = 0; rl < 4; ++rl) { const int rb = 4 * half + rl; if (s0 + s <= 2 * rb + 1) { const bf16x8 A = *(const LAS bf16x8*)(lds + ktb + (2 * rb - (s0 + s) + 1) * 512); ya[rl] = __builtin_amdgcn_mfma_f32_32x32x16_bf16(A, uf[s], ya[rl], 0, 0, 0); } }
                    __builtin_amdgcn_sched_barrier(0); }
            }
#pragma unroll
            for (int rl = 0; rl < 4; ++rl) {
#pragma unroll
                for (int blk = 0; blk < 4; ++blk)
#pragma unroll
                    for (int s = 0; s < 2; ++s) { const bf16x8 A = *(const LAS bf16x8*)(wcb + (4 * half + rl) * (32 * 272) + (blk * 2 + s) * 32); ya[rl] = __builtin_amdgcn_mfma_f32_32x32x16_bf16(A, xf[blk][s], ya[rl], 0, 0, 0); }
                __builtin_amdgcn_sched_barrier(0);
            }
#pragma unroll
            for (int rl = 0; rl < 4; ++rl) {
                const int rb = 4 * half + rl;
                float zg[16];
#pragma unroll
                for (int r = 0; r < 16; ++r) zg[r] = gelu_tanh(ya[rl][r]);
                u32x4 z0, z1; z0.x = cvt_pk_bf16(zg[0], zg[1]); z0.y = cvt_pk_bf16(zg[2], zg[3]); z0.z = cvt_pk_bf16(zg[4], zg[5]); z0.w = cvt_pk_bf16(zg[6], zg[7]);
                z1.x = cvt_pk_bf16(zg[8], zg[9]); z1.y = cvt_pk_bf16(zg[10], zg[11]); z1.z = cvt_pk_bf16(zg[12], zg[13]); z1.w = cvt_pk_bf16(zg[14], zg[15]);
                f32x16 gt = (f32x16){};
                gt = __builtin_amdgcn_mfma_f32_32x32x16_bf16(Gf0, __builtin_bit_cast(bf16x8, z0), gt, 0, 0, 0);
                gt = __builtin_amdgcn_mfma_f32_32x32x16_bf16(Gf1, __builtin_bit_cast(bf16x8, z1), gt, 0, 0, 0);
#pragma unroll
                for (int il = 0; il < 2; ++il) {
                    float o[8]; float sq = 0.f;
#pragma unroll
                    for (int q = 0; q < 8; ++q) { o[q] = zg[8 * il + q] * sigmoidf_(gt[8 * il + q] + gbv[q]); sq += o[q] * o[q]; }
                    sq += __shfl_xor(sq, 32);
                    if (stok) { const int row = rowof(b, 16 * cc + 2 * rb + il); bf16_t* op = mixed + (size_t)row * DM + MX_SSM + 16 * g + 4 * hi;
                        u32x2 w0, w1; w0.x = cvt_pk_bf16(o[0], o[1]); w0.y = cvt_pk_bf16(o[2], o[3]); w1.x = cvt_pk_bf16(o[4], o[5]); w1.y = cvt_pk_bf16(o[6], o[7]);
                        *(u32x2*)op = w0; *(u32x2*)(op + 8) = w1;
                        if (hi == 0) ssqs[(size_t)row * 16 + g] = sq; }
                }
                __builtin_amdgcn_sched_barrier(0);
            }
        }
    }
    __syncthreads();
}

struct Args { const float* in[31]; float* out; unsigned char* ws; int ph_lo, ph_hi; };
constexpr int N_PHASES = 16;
#define PHASE_IDS() int tid; { int ln_; asm volatile("v_mbcnt_lo_u32_b32 %0, -1, 0\n\tv_mbcnt_hi_u32_b32 %0, -1, %0" : "=v"(ln_)); tid = wave0 * 64 + ln_; } unsigned char* ws = ws0; asm volatile("" : "+s"(ws)); const int lane = tid & 63; const int wave = __builtin_amdgcn_readfirstlane(tid >> 6); (void)lane; (void)wave

__global__ void __launch_bounds__(NWAVES * 64, 2) hymba_fwd(Args args) {
    extern __shared__ __attribute__((aligned(16))) unsigned char lds_raw[];
    LAS unsigned char* lds = (LAS unsigned char*)lds_raw;
    volatile LAS unsigned* MISC = (volatile LAS unsigned*)(lds + LDSCTL_OFF);
    LAS int* TB = (LAS int*)(lds + LDSCTL_OFF + 256);
    LAS int* CN = (LAS int*)(lds + LDSCTL_OFF + 512);
    LAS int* HIST = (LAS int*)(lds + LDSCTL_OFF + 768);
    const int wave0 = __builtin_amdgcn_readfirstlane(threadIdx.x >> 6);
    const int G = gridDim.x; const int bx = blockIdx.x; const int vcu = (G % 8 == 0) ? (bx % 8) * (G / 8) + bx / 8 : bx;
    unsigned char* const ws0 = args.ws;
    unsigned* const ctl = (unsigned*)(ws0 + WS_CTL);
    for (int u = threadIdx.x; u < (LDS_BYTES - LDSCTL_OFF) / 4; u += NWAVES * 64) ((LAS unsigned*)(lds + LDSCTL_OFF))[u] = 0u;
    __syncthreads();
    const int lo = args.ph_lo, hi = args.ph_hi;
    XcdBarrier bar; bar.bar = ctl + CW_BAR; bar.x = 0; bar.st = nullptr;
    if (hi - lo > 1) bar = xcd_barrier_post(ctl + CW_BAR, MISC + 8);
#define IN(k) (lo <= (k) && (k) < hi)
#define SEAM(k) do { if (IN(k) && IN((k) + 1)) { PHASE_IDS(); xcd_barrier(bar, tid == 0); } } while (0)
#define WSP(T, off) ((T*)(ws + (off)))

    for (int rep_ = 0; rep_ < DUP_P0; ++rep_) if (IN(0)) {
        PHASE_IDS();
        bf16_t* WinT = WSP(bf16_t, WS_WIN); bf16_t* WoutT = WSP(bf16_t, WS_WOUT); bf16_t* W13T = WSP(bf16_t, WS_W13); bf16_t* W2C = WSP(bf16_t, WS_W2C); bf16_t* WrT = WSP(bf16_t, WS_WR);
        bf16_t* hbuf = WSP(bf16_t, WS_H); float* ssq1 = WSP(float, WS_SSQ1); float* tinfo = WSP(float, WS_TINFO);
#pragma unroll 1
        for (int lg = vcu; lg < 32; lg += G) { const int l = lg >> 4, g = lg & 15;
            const S5P SP{args.in[10] + l * 1024, args.in[11] + l * 1024, args.in[12] + l * 16, args.in[13] + (size_t)l * 16384, args.in[14] + (size_t)l * 16384, args.in[15] + (size_t)l * 16384, args.in[16] + (size_t)l * 16384,
                         args.in[17] + l * 256, args.in[18] + (size_t)l * 4096, args.in[19] + l * 256};
            int tidp = tid; asm volatile("" : "+v"(tidp));
            s5_tables_block(lds, tidp, SP, g, ws + WS_S5T + (size_t)lg * S5T_BYTES); }
        LAS float* scr = (LAS float*)(lds + wave * 16384);
        const int gw = vcu * NWAVES + wave, NGW = G * NWAVES;
        constexpr int I_WIN = 16 * 80, I_WOUT = 16 * 32, I_W13 = 16 * 16, I_W2 = 4 * 32, I_WR = 16;
        constexpr int T_WIN = 2 * I_WIN, T_WOUT = 2 * I_WOUT, T_W13 = 32 * I_W13, T_W2 = 32 * I_W2, T_WR = 4 * I_WR;
        constexpr int NITEMS = T_WIN + T_WOUT + T_W13 + T_W2 + T_WR;
        const int nskip = G >= 64 ? 32 : 0; const int igw = (vcu - nskip) * NWAVES + wave, INGW = (G - nskip) * NWAVES;
#pragma unroll 1
        for (int it = igw; it < NITEMS && vcu >= nskip; it += INGW) {
            int r = it;
            if (r < T_WIN) { const int l = r / I_WIN, q = r % I_WIN, kb = q / 80, nb = q % 80; GetWin gt{args.in[3] + (size_t)l * DM * DINSRC, args.in[2] + l * DM};
                tr_item(gt, WinT + (size_t)l * NIN * DM, DM, 64 * kb, 32 * nb, scr, lane); continue; } r -= T_WIN;
            if (r < T_WOUT) { const int l = r / I_WOUT, q = r % I_WOUT, kb = q / 32, nb = q % 32; GetWout gt{args.in[21] + (size_t)l * DM * DM, args.in[9] + l * 512, args.in[20] + l * 256};
                tr_item(gt, WoutT + (size_t)l * DM * DM, DM, 64 * kb, 32 * nb, scr, lane); continue; } r -= T_WOUT;
            if (r < T_W13) { const int le = r / I_W13, q = r % I_W13, kb = q / 16, nb = q % 16; const int l = le / 16; GetW13 gt{args.in[27] + (size_t)le * DM * 256, args.in[28] + (size_t)le * DM * 256, args.in[22] + l * DM};
                tr_item(gt, W13T + (size_t)le * 512 * DM, DM, 64 * kb, 32 * nb, scr, lane); continue; } r -= T_W13;
            if (r < T_W2) { const int le = r / I_W2, q = r % I_W2, kb = q / 32, nb = q % 32; GetW2 gt{args.in[29] + (size_t)le * 256 * DM};
                tr_item(gt, W2C + (size_t)le * DM * 256, 256, 64 * kb, 32 * nb, scr, lane); continue; } r -= T_W2;
            { const int lh = r / I_WR, kb = r % I_WR; const int l = lh >> 1, lo_ = lh & 1; GetWr gt{args.in[23] + (size_t)l * DM * 4, args.in[25] + (size_t)l * DM * 16, args.in[22] + l * DM, lo_};
                tr_item(gt, WrT + (size_t)lh * 32 * DM, DM, 64 * kb, 0, scr, lane); }
        }
#pragma unroll 1
        for (int r0 = 2 * gw; r0 < MROWS; r0 += 2 * NGW) {
            f32x4 v[2][4];
#pragma unroll
            for (int q = 0; q < 2; ++q) { const int r = r0 + q;
#pragma unroll
                for (int j = 0; j < 4; ++j) { if (r < NREAL) v[q][j] = *(const f32x4*)(args.in[0] + (size_t)r * DM + 4 * lane + 256 * j); else if (r < NTOK) v[q][j] = *(const f32x4*)(args.in[1] + (size_t)(r - NREAL) * DM + 4 * lane + 256 * j); else v[q][j] = (f32x4){0.f, 0.f, 0.f, 0.f}; } }
#pragma unroll
            for (int q = 0; q < 2; ++q) { const int r = r0 + q; float s = 0.f;
#pragma unroll
                for (int j = 0; j < 4; ++j) { u32x2 w; w.x = pk2(v[q][j][0], v[q][j][1]); w.y = pk2(v[q][j][2], v[q][j][3]); *(u32x2*)(hbuf + (size_t)r * DM + 4 * lane + 256 * j) = w;
                    s += bflo(w.x) * bflo(w.x) + bfhi(w.x) * bfhi(w.x) + bflo(w.y) * bflo(w.y) + bfhi(w.y) * bfhi(w.y); }
                s = wave_sum(s);
                if (lane < 16) ssq1[(size_t)r * 16 + lane] = lane == 0 ? s : 0.f;
                if (r >= NTOK && lane < 4) tinfo[(size_t)r * 4 + lane] = 0.f; }
        }
    }
    SEAM(0);

#pragma unroll 1
    for (int l = 0; l < DEPTH; ++l) {
        const int P = 1 + 7 * l;
        for (int rep_ = 0; rep_ < DUP_G1; ++rep_) if (IN(P)) {
            PHASE_IDS();
            bf16_t* hbuf = WSP(bf16_t, WS_H); bf16_t* proj = WSP(bf16_t, WS_PROJ); float* flog = WSP(float, WS_FLOG); const float* ssq1 = WSP(float, WS_SSQ1);
            const bf16_t* Win = WSP(bf16_t, WS_WIN) + (size_t)l * NIN * DM; const float* fb = args.in[4] + l * 8;
            DenseOrder S; S.init(hbuf, Win, NREAL, NIN, DM, DM, G, bx);
            EpiProj E{proj, flog, ssq1, fb};
            pg8::gemm_phase<EpiProj, DenseOrder, true, false>(lds, tid, DM, DM, S, E);
#pragma unroll 1
            for (int cb = bx; cb < 10; cb += G) {
                f32x4 acc[2]; meta_gemm16(hbuf + (size_t)NREAL * DM, Win, DM, cb * 256, wave, lane, acc);
                const int m = lane & 15, q4 = lane >> 4, row = NREAL + m;
                const float rs = row_rstd16(ssq1, row, q4, 1.f / DM);
#pragma unroll
                for (int j = 0; j < 2; ++j) { const f32x4 v = acc[j] * rs; const int col = cb * 256 + 32 * wave + 16 * j + 4 * q4;
                    if (cb < 9) { u32x2 w; w.x = cvt_pk_bf16(v[0], v[1]); w.y = cvt_pk_bf16(v[2], v[3]); *(u32x2*)(proj + (size_t)row * PJ + col) = w; }
                    else if (wave == 0 && j == 0 && q4 < 2) { f32x4 o;
#pragma unroll
                        for (int e = 0; e < 4; ++e) { const float f = v[e] + fb[4 * q4 + e]; o[e] = -log2f(1.f + exp2f(-f * LOG2E)); }
                        *(f32x4*)(flog + (size_t)row * 8 + 4 * q4) = o; } }
            }
        }
        SEAM(P);
        for (int rep_ = 0; rep_ < DUP_MIX; ++rep_) if (IN(P + 1)) {
            PHASE_IDS();
            const bf16_t* proj = WSP(bf16_t, WS_PROJ); bf16_t* mixed = WSP(bf16_t, WS_MIX); const float* flog = WSP(float, WS_FLOG); float* ssqa = WSP(float, WS_SSQA); float* ssqs = WSP(float, WS_SSQS);
            for (int repa_ = 0; repa_ < DUP_ATT; ++repa_)
#pragma unroll 1
            for (int vc = vcu; vc < 256; vc += G) {
                int bh = vc >> 2; asm volatile("" : "+s"(bh));
                const int b = bh >> 3, h = bh & 7;
                attn_prefix(lds, tid, flog, b, h);
#pragma unroll 1
                for (int i = 0; i < 4; ++i) { const int s = (vc & 3) * 2 + (i >> 1); int qt = (i & 1) ? 15 - s : s; asm volatile("" : "+s"(qt)); int tid3 = tid; asm volatile("" : "+v"(tid3)); attn_unit(lds, tid3, proj, mixed, ssqa, b, h, qt); }
            }
#pragma unroll 1
            for (int vc = vcu; vc < 8; vc += G) { int hh = vc; asm volatile("" : "+s"(hh)); int tid3 = tid; asm volatile("" : "+v"(tid3)); attn_prefix(lds, tid3, flog, 0, hh); attn_unit(lds, tid3, proj, mixed, ssqa, 0, hh, -1); }
            const float* cw = args.in[5] + (size_t)l * 31 * 256; const float* cbp = args.in[6] + l * 256; const float* clg = args.in[7] + l * 256; const float* clb = args.in[8] + l * 256;
            for (int repc_ = 0; repc_ < DUP_CS; ++repc_)
#pragma unroll 1
            for (int vc = vcu; vc < 256; vc += G) {
                int tid2 = tid; asm volatile("" : "+v"(tid2));
                if ((vc & 1) == 0) { const int ci = vc >> 1;
#pragma unroll 1
                    for (int s = 0; s < 8; ++s) conv_subtile(lds, tid2, proj, mixed, cw, cbp, clg, clb, ci >> 4, NMETA + 256 * (ci & 15) + 32 * s, 32);
                } else {
                    if (vc == 1) conv_subtile(lds, tid2, proj, mixed, cw, cbp, clg, clb, 0, 0, 16);
                    int ug = vc >> 1; asm volatile("" : "+s"(ug));
                    s5_unit(lds, tid2, ws + WS_S5T + (size_t)(l * 16 + (ug & 15)) * S5T_BYTES, args.in[18] + (size_t)l * 4096 + (ug & 15) * 256, args.in[19] + l * 256 + (ug & 15) * 16, proj, mixed, ssqs, ug >> 4, ug & 15);
                }
            }
        }
        SEAM(P + 1);
        if (IN(P + 2)) {
            PHASE_IDS();
            bf16_t* mixed = WSP(bf16_t, WS_MIX); const float* ssqa = WSP(float, WS_SSQA); const float* ssqs = WSP(float, WS_SSQS);
            const int gw = vcu * NWAVES + wave, NGW = G * NWAVES;
#pragma unroll 1
            for (int r = gw; r < NTOK; r += NGW) {
                float sa = lane < 8 ? ssqa[(size_t)r * 8 + lane] : 0.f, ss = lane < 16 ? ssqs[(size_t)r * 16 + lane] : 0.f;
                sa = wave_sum(sa); ss = wave_sum(ss);
                const float ra = rsqrtf(sa * (1.f / 512.f) + EPS), rsm = rsqrtf(ss * (1.f / 256.f) + EPS);
                bf16_t* p = mixed + (size_t)r * DM;
                u32x4 a = *(u32x4*)(p + 8 * lane);
                a.x = cvt_pk_bf16(bflo(a.x) * ra, bfhi(a.x) * ra); a.y = cvt_pk_bf16(bflo(a.y) * ra, bfhi(a.y) * ra); a.z = cvt_pk_bf16(bflo(a.z) * ra, bfhi(a.z) * ra); a.w = cvt_pk_bf16(bflo(a.w) * ra, bfhi(a.w) * ra);
                *(u32x4*)(p + 8 * lane) = a;
                u32x2 s2 = *(u32x2*)(p + MX_SSM + 4 * lane);
                s2.x = cvt_pk_bf16(bflo(s2.x) * rsm, bfhi(s2.x) * rsm); s2.y = cvt_pk_bf16(bflo(s2.y) * rsm, bfhi(s2.y) * rsm);
                *(u32x2*)(p + MX_SSM + 4 * lane) = s2;
            }
        }
        SEAM(P + 2);
        if (IN(P + 3)) {
            PHASE_IDS();
            bf16_t* hbuf = WSP(bf16_t, WS_H); const bf16_t* mixed = WSP(bf16_t, WS_MIX); float* ssq2 = WSP(float, WS_SSQ2); const bf16_t* Wo = WSP(bf16_t, WS_WOUT) + (size_t)l * DM * DM;
            DenseOrder S; S.init(mixed, Wo, NREAL, DM, DM, DM, G, bx);
            EpiRes<false> E{hbuf, ssq2, CN, nullptr};
            pg8::gemm_phase<EpiRes<false>, DenseOrder, true, false>(lds, tid, DM, DM, S, E);
            LAS float* mscr = (LAS float*)lds;
#pragma unroll 1
            for (int cb = bx; cb < 4; cb += G) {
                f32x4 acc[2]; meta_gemm16(mixed + (size_t)NREAL * DM, Wo, DM, cb * 256, wave, lane, acc);
                const int m = lane & 15, q4 = lane >> 4, row = NREAL + m; float sq = 0.f;
#pragma unroll
                for (int j = 0; j < 2; ++j) { bf16_t* p = hbuf + (size_t)row * DM + cb * 256 + 32 * wave + 16 * j + 4 * q4; const u32x2 o = *(const u32x2*)p; u32x2 w;
                    w.x = cvt_pk_bf16(bflo(o.x) + acc[j][0], bfhi(o.x) + acc[j][1]); w.y = cvt_pk_bf16(bflo(o.y) + acc[j][2], bfhi(o.y) + acc[j][3]); *(u32x2*)p = w;
                    sq += bflo(w.x) * bflo(w.x) + bfhi(w.x) * bfhi(w.x) + bflo(w.y) * bflo(w.y) + bfhi(w.y) * bfhi(w.y); }
                sq += __shfl_xor(sq, 16); sq += __shfl_xor(sq, 32);
                if (q4 == 0) mscr[m * 8 + wave] = sq;
                __syncthreads();
                if (wave == 0) ssq2[(size_t)row * 16 + cb * 4 + q4] = mscr[m * 8 + 2 * q4] + mscr[m * 8 + 2 * q4 + 1];
                __syncthreads();
            }
        }
        SEAM(P + 3);
        if (IN(P + 4)) {
            PHASE_IDS();
            const bf16_t* hbuf = WSP(bf16_t, WS_H); const float* ssq2 = WSP(float, WS_SSQ2); float* tinfo = WSP(float, WS_TINFO); int* list = WSP(int, WS_LIST);
            unsigned* gcnt = ctl + CW_CNT + l * 32;
            const bf16_t* Whi = WSP(bf16_t, WS_WR) + (size_t)(2 * l) * 32 * DM; const bf16_t* Wlo = Whi + (size_t)32 * DM;
            LAS float* scr = (LAS float*)(lds + wave * 4352);
#pragma unroll 1
            for (int base = 0; base < 1025; base += G * 4) {
                const int grp = base + bx * 4 + wave;
                const bool active = wave < 4 && grp < 1025;
                int cls = 0, posl = 0, tok = 0; bool valid = false; float rstd = 0.f, gA = 0.f, gB = 0.f;
                if (active) {
                    const int r32 = lane & 31, hh = lane >> 5; const int rowA = grp * 32 + r32 < NTOK ? grp * 32 + r32 : DUMMY_ROW;
                    f32x16 acc = {};
                    const bf16_t* ap = hbuf + (size_t)rowA * DM + 8 * hh; const bf16_t* bh_ = Whi + (size_t)r32 * DM + 8 * hh; const bf16_t* bl_ = Wlo + (size_t)r32 * DM + 8 * hh;
#pragma unroll 4
                    for (int k0 = 0; k0 < DM; k0 += 16) { const bf16x8 a = *(const bf16x8*)(ap + k0), b0 = *(const bf16x8*)(bh_ + k0), b1 = *(const bf16x8*)(bl_ + k0);
                        acc = __builtin_amdgcn_mfma_f32_32x32x16_bf16(a, b0, acc, 0, 0, 0); acc = __builtin_amdgcn_mfma_f32_32x32x16_bf16(a, b1, acc, 0, 0, 0); }
#pragma unroll
                    for (int r = 0; r < 16; ++r) scr[crow(r, hh) * 33 + r32] = acc[r];
                    LDS_WAIT(); asm volatile("" ::: "memory");
                    tok = grp * 32 + r32; valid = hh == 0 && tok < NTOK;
                    if (valid) {
                        float s = 0.f;
#pragma unroll
                        for (int q = 0; q < 4; ++q) { const f32x4 v = *(const f32x4*)(ssq2 + (size_t)tok * 16 + 4 * q); s += (v.x + v.y) + (v.z + v.w); }
                        rstd = rsqrtf(s * (1.f / DM) + EPS);
                        float lg[4]; const float* bg = args.in[24] + l * 4; const float* be = args.in[26] + l * 16;
#pragma unroll
                        for (int i = 0; i < 4; ++i) lg[i] = scr[r32 * 33 + i] * rstd + bg[i];
                        int gs = 0; float mx = lg[0];
#pragma unroll
                        for (int i = 1; i < 4; ++i) if (lg[i] > mx) { mx = lg[i]; gs = i; }
                        float se = 0.f;
#pragma unroll
                        for (int i = 0; i < 4; ++i) se += expf(lg[i] - mx);
                        const float pg = 1.f / se;
                        float le[4];
#pragma unroll
                        for (int i = 0; i < 4; ++i) le[i] = scr[r32 * 33 + 4 + 4 * gs + i] * rstd + be[4 * gs + i];
                        int i1 = 0; float v1 = le[0];
#pragma unroll
                        for (int i = 1; i < 4; ++i) if (le[i] > v1) { v1 = le[i]; i1 = i; }
                        int i2 = -1; float v2 = -INFINITY;
#pragma unroll
                        for (int i = 0; i < 4; ++i) if (i != i1 && le[i] > v2) { v2 = le[i]; i2 = i; }
                        const float w1 = pg / (1.f + expf(v2 - v1)), w2 = pg - w1;
                        const int a = i1 < i2 ? i1 : i2, bb = i1 < i2 ? i2 : i1;
                        gA = i1 < i2 ? w1 : w2; gB = i1 < i2 ? w2 : w1;
                        cls = gs * 6 + (a == 0 ? bb - 1 : (a == 1 ? bb + 1 : 5));
                        posl = __hip_atomic_fetch_add(&HIST[cls], 1, __ATOMIC_RELAXED, __HIP_MEMORY_SCOPE_WORKGROUP);
                    }
                }
                __syncthreads();
                if (tid < NCLS) { const int n = HIST[tid]; HIST[32 + tid] = n ? (int)__hip_atomic_fetch_add(gcnt + tid, (unsigned)n, __ATOMIC_RELAXED, __HIP_MEMORY_SCOPE_AGENT) : 0; }
                __syncthreads();
                if (valid) { const int pos = HIST[32 + cls] + posl; list[(size_t)cls * NTOK + pos] = tok; *(f32x4*)(tinfo + (size_t)tok * 4) = (f32x4){rstd, gA, gB, 0.f}; }
                __syncthreads();
                if (tid < NCLS) HIST[tid] = 0;
                __syncthreads();
            }
        }
        SEAM(P + 4);
        if (IN(P + 5) || IN(P + 6)) {
            unsigned* gcnt = ctl + CW_CNT + l * 32;
            PHASE_IDS();
            if (tid == 0) { int run = 0; for (int c = 0; c < NCLS; ++c) { const int n = (int)__hip_atomic_load(gcnt + c, __ATOMIC_RELAXED, __HIP_MEMORY_SCOPE_AGENT); CN[c] = n; TB[c] = run; run += (n + 255) >> 8; } TB[NCLS] = run; }
            __syncthreads();
        }
        for (int rep_ = 0; rep_ < DUP_E1; ++rep_) if (IN(P + 5)) {
            PHASE_IDS();
            const int* list = WSP(int, WS_LIST);
            ExpertOrder S{TB, CN, list, (const char*)WSP(bf16_t, WS_H), (const char*)WSP(bf16_t, WS_W13), G, bx, 1, l};
            EpiE1 E{WSP(bf16_t, WS_H1), WSP(float, WS_TINFO), CN, list};
            pg8::gemm_phase<EpiE1, ExpertOrder, true, true>(lds, tid, DM, DM, S, E);
        }
        SEAM(P + 5);
        if (IN(P + 6)) {
            PHASE_IDS();
            const int* list = WSP(int, WS_LIST);
            ExpertOrder S{TB, CN, list, (const char*)WSP(bf16_t, WS_H1), (const char*)WSP(bf16_t, WS_W2C), G, bx, 2, l};
            EpiRes<true> E{WSP(bf16_t, WS_H), WSP(float, WS_SSQ1), CN, list};
            pg8::gemm_phase<EpiRes<true>, ExpertOrder, true, false, true>(lds, tid, 512, 256, S, E);
        }
        SEAM(P + 6);
    }
    if (IN(15)) {
        PHASE_IDS();
        const bf16_t* hbuf = WSP(bf16_t, WS_H); const float* ssq1 = WSP(float, WS_SSQ1);
        const int gw = vcu * NWAVES + wave, NGW = G * NWAVES; const float* gF = args.in[30];
        f32x4 gv[4];
#pragma unroll
        for (int j = 0; j < 4; ++j) gv[j] = *(const f32x4*)(gF + 4 * lane + 256 * j);
#pragma unroll 1
        for (int r = gw; r < NREAL; r += NGW) {
            float s = lane < 16 ? ssq1[(size_t)r * 16 + lane] : 0.f; s = wave_sum(s);
            const float rs = rsqrtf(s * (1.f / DM) + EPS);
#pragma unroll
            for (int j = 0; j < 4; ++j) { const u32x2 w = *(const u32x2*)(hbuf + (size_t)r * DM + 4 * lane + 256 * j);
                f32x4 o; o[0] = bflo(w.x) * rs * gv[j][0]; o[1] = bfhi(w.x) * rs * gv[j][1]; o[2] = bflo(w.y) * rs * gv[j][2]; o[3] = bfhi(w.y) * rs * gv[j][3];
                *(f32x4*)(args.out + (size_t)r * DM + 4 * lane + 256 * j) = o; }
        }
    }
#undef IN
#undef SEAM
#undef WSP
}

extern "C" void kernel_launch(void* const* d_in, const int* in_sizes, int n_in, void* d_out, int out_size, void* d_ws, size_t ws_size, hipStream_t stream) {
    static int grid = 0;
    if (grid == 0) {
        if (n_in != 31 || out_size != NREAL * DM || ws_size < WS_END) { fprintf(stderr, "kernel_launch: unexpected shapes (n_in %d, out %d, ws %zu)\n", n_in, out_size, ws_size); grid = -1; return; }
        int dev = 0, cus = 0, per_cu = 0;
        if (hipGetDevice(&dev) != hipSuccess || hipDeviceGetAttribute(&cus, hipDeviceAttributeMultiprocessorCount, dev) != hipSuccess) { grid = -1; return; }
        if (hipFuncSetAttribute((const void*)hymba_fwd, hipFuncAttributeMaxDynamicSharedMemorySize, LDS_BYTES) != hipSuccess) { fprintf(stderr, "kernel_launch: hipFuncSetAttribute failed\n"); grid = -1; return; }
        if (hipOccupancyMaxActiveBlocksPerMultiprocessor(&per_cu, (const void*)hymba_fwd, NWAVES * 64, LDS_BYTES) != hipSuccess || per_cu < 1) { fprintf(stderr, "kernel_launch: occupancy query says %d\n", per_cu); }
        (void)hipGetLastError();
        grid = cus;
    }
    if (grid < 0) return;
    (void)in_sizes;
    if (hipMemsetAsync((char*)d_ws + WS_CTL, 0, CTL_BYTES, stream) != hipSuccess) return;
    Args a{};
    for (int i = 0; i < 31; ++i) a.in[i] = (const float*)d_in[i];
    a.out = (float*)d_out; a.ws = (unsigned char*)d_ws;
#if MK_PER_PHASE
    for (int p = 0; p < N_PHASES; ++p) { a.ph_lo = p; a.ph_hi = p + 1; hipLaunchKernelGGL(hymba_fwd, dim3(grid), dim3(NWAVES * 64), LDS_BYTES, stream, a); }
#else
    a.ph_lo = 0; a.ph_hi = N_PHASES;
    hipLaunchKernelGGL(hymba_fwd, dim3(grid), dim3(NWAVES * 64), LDS_BYTES, stream, a);
#endif
}
```

```cpp
#include <hip/hip_runtime.h>
#include <cstdio>
#include <cstdint>

#ifndef DUP_ATT
#define DUP_ATT 1
#endif
#ifndef DUP_CS
#define DUP_CS 1
#endif
#ifndef DUP_G1
#define DUP_G1 1
#endif
#ifndef DUP_MIX
#define DUP_MIX 1
#endif
#ifndef DUP_E1
#define DUP_E1 1
#endif
#ifndef DUP_P0
#define DUP_P0 1
#endif
#ifndef MK_PER_PHASE
#define MK_PER_PHASE 0
#endif

#define LAS __attribute__((address_space(3)))
#define GAS __attribute__((address_space(1)))
typedef unsigned short bf16_t;
typedef short bf16x8 __attribute__((ext_vector_type(8)));
typedef short s16x4 __attribute__((ext_vector_type(4)));
typedef float f32x4 __attribute__((ext_vector_type(4)));
typedef float f32x2 __attribute__((ext_vector_type(2)));
typedef float f32x16 __attribute__((ext_vector_type(16)));
typedef unsigned u32x4 __attribute__((ext_vector_type(4)));
typedef unsigned u32x2 __attribute__((ext_vector_type(2)));

constexpr int NB = 8, SEQ = 4096, NMETA = 16, DM = 1024, DEPTH = 2;
constexpr int NREAL = NB * SEQ;
constexpr int NTOK = NREAL + NMETA;
constexpr int MROWS = 33024;
constexpr int DUMMY_ROW = NTOK;
constexpr int PJ = 2304;
constexpr int NIN = 2560;
constexpr int DINSRC = 2312;
constexpr int PQ = 512, PK = 1024, PV = 1536, PU = 2048;
constexpr int MX_ATT = 0, MX_SSM = 512, MX_CONV = 768;
constexpr int NCLS = 24;
constexpr float EPS = 1e-6f;
constexpr float LOG2E = 1.4426950408889634f;
constexpr int H1CAP = 40960;

constexpr size_t MiB = 1u << 20;
constexpr size_t WS_CTL = 0, CTL_BYTES = 1 * MiB;
constexpr size_t WS_WIN = 2 * MiB, WS_WOUT = 12 * MiB, WS_W13 = 16 * MiB, WS_W2C = 48 * MiB, WS_WR = 96 * MiB;
constexpr size_t WS_H = 100 * MiB, WS_PROJ = 165 * MiB, WS_MIX = 311 * MiB, WS_H1 = 376 * MiB;
constexpr size_t WS_FLOG = 416 * MiB, WS_SSQ1 = 418 * MiB, WS_SSQ2 = 421 * MiB, WS_SSQA = 424 * MiB, WS_SSQS = 426 * MiB, WS_TINFO = 429 * MiB, WS_LIST = 430 * MiB, WS_S5T = 434 * MiB, WS_END = 440 * MiB;
constexpr int CW_TMO = 0, CW_BAR = 4096, CW_CNT = 16384;

constexpr int RING_BYTES = 131072;
constexpr int LDSCTL_OFF = RING_BYTES;
constexpr int LDS_BYTES = 147456;
constexpr int NWAVES = 8;

#define LDS_WAIT() asm volatile("s_waitcnt lgkmcnt(0)" ::: "memory")
#define VM_WAIT() asm volatile("s_waitcnt vmcnt(0)" ::: "memory")

__device__ __forceinline__ unsigned f2bf(float f) { unsigned u = __float_as_uint(f); return (u + 0x7fffu + ((u >> 16) & 1u)) >> 16; }
__device__ __forceinline__ unsigned pk2(float lo, float hi) { return f2bf(lo) | (f2bf(hi) << 16); }
__device__ __forceinline__ float bflo(unsigned w) { return __uint_as_float(w << 16); }
__device__ __forceinline__ float bfhi(unsigned w) { return __uint_as_float(w & 0xffff0000u); }
__device__ __forceinline__ float bf2f(bf16_t b) { return __uint_as_float(((unsigned)b) << 16); }
__device__ __forceinline__ unsigned cvt_pk_bf16(float lo, float hi) { unsigned r; asm volatile("v_cvt_pk_bf16_f32 %0, %1, %2" : "=v"(r) : "v"(lo), "v"(hi)); return r; }
__device__ __forceinline__ float wave_sum(float v) {
#pragma unroll
    for (int o = 1; o < 64; o <<= 1) v += __shfl_xor(v, o);
    return v;
}
__device__ __forceinline__ float fast_exp2(float x) { return __builtin_amdgcn_exp2f(x); }
__device__ __forceinline__ float fast_rcp(float x) { return __builtin_amdgcn_rcpf(x); }
__device__ __forceinline__ float sigmoidf_(float x) { return fast_rcp(1.f + fast_exp2(-x * LOG2E)); }
__device__ __forceinline__ float siluf_(float x) { return x * sigmoidf_(x); }
__device__ __forceinline__ int rowof(int b, int t) { return t < NMETA ? NREAL + t : b * SEQ + (t - NMETA); }

namespace pg8 {
constexpr int BM = 256, BK = 64, HALF = 128, HTB = HALF * BK * 2, STAGE_BYTES = 8 * HTB;
__host__ __device__ __forceinline__ int lds_byte(int r, int c) { const int st = (r >> 4) * 2 + (c >> 5), rr = r & 15, cc = c & 31, ob = rr * 64 + cc * 2; return st * 1024 + (ob ^ (((ob >> 9) & 1) << 5)); }
__host__ __device__ __forceinline__ void stage_rc(int b, int& R, int& C) { const int st = b / 1024, sb = b % 1024, swz = sb ^ (((sb >> 9) & 1) << 5); R = (st >> 1) * 16 + swz / 64; C = (st & 1) * 32 + (swz % 64) / 2; }
__host__ __device__ __forceinline__ int perm32(int rho) { const int n = rho >> 4, i = rho & 15; return 8 * (i >> 2) + 4 * n + (i & 3); }

struct Unit { int pm, pn, cls, p0; };

template <class Epi, class Sched, bool ALIGN_EPI, bool GATHER, bool BSPLIT = false>
__device__ __forceinline__ void gemm_phase(LAS unsigned char* lds, const int tid, const int K, const int ldb, const Sched& S, const Epi& E) {
    const int wid = __builtin_amdgcn_readfirstlane(tid >> 6), lane = tid & 63, wr = wid >> 2, wc = wid & 3, fr = lane & 15, fq = lane >> 4;
    const int nt = K / BK;
    unsigned voffA[2], voffB[2]; int RA[2], CA[2];
#pragma unroll
    for (int i = 0; i < 2; ++i) { int R, C; stage_rc(tid * 16 + i * 8192, R, C); const int Rb = (R & ~31) + perm32(R & 31);
        voffA[i] = (unsigned)(R * K + C) * 2u; voffB[i] = (unsigned)(Rb * ldb + C) * 2u; RA[i] = R; CA[i] = C; }
    const size_t kstep = (size_t)(BK * 2);
    const size_t hstepA = (size_t)HALF * K * 2, hstepB = (size_t)HALF * ldb * 2;
    const size_t pstepA = (size_t)64 * K * 2, pstepB = (size_t)64 * ldb * 2;
    const unsigned ldsw = (unsigned)wid * 1024u;
    const int aoff = lds_byte(wr * 64 + fr, fq * 8), boff = lds_byte(wc * 32 + fr, fq * 8);
#define PG8_SA(b, h) (((b) * 2 + (h)) * HTB)
#define PG8_SB(b, h) ((4 + (b) * 2 + (h)) * HTB)
#define PG8_STAGE(bufoff, gbase, voff) do { _Pragma("unroll") for (int _i = 0; _i < 2; ++_i) \
        __builtin_amdgcn_global_load_lds((const unsigned*)((const char*)(gbase) + (voff)[_i]), (LAS unsigned*)(lds + (bufoff) + ldsw + _i * 8192), 16, 0, 0); } while (0)
#define PG8_STAGE1(bufoff, gbase, voff1, step) do { _Pragma("unroll") for (int _i = 0; _i < 2; ++_i) \
        __builtin_amdgcn_global_load_lds((const unsigned*)((const char*)(gbase) + (size_t)_i * (step) + (voff1)), (LAS unsigned*)(lds + (bufoff) + ldsw + _i * 8192), 16, 0, 0); } while (0)
#define PG8_LDA(dst, b, h) do { _Pragma("unroll") for (int m = 0; m < 4; ++m) _Pragma("unroll") for (int k = 0; k < 2; ++k) dst[m][k] = *(const LAS bf16x8*)(lds + PG8_SA(b, h) + aoff + m * 2048 + k * 1024); } while (0)
#define PG8_LDB(dst, b, h) do { _Pragma("unroll") for (int n = 0; n < 2; ++n) _Pragma("unroll") for (int k = 0; k < 2; ++k) dst[n][k] = *(const LAS bf16x8*)(lds + PG8_SB(b, h) + boff + n * 2048 + k * 1024); } while (0)
#define PG8_MMA(ai, bj, At, Bt) do { __builtin_amdgcn_s_setprio(1); _Pragma("unroll") for (int m = 0; m < 4; ++m) _Pragma("unroll") for (int n = 0; n < 2; ++n) _Pragma("unroll") for (int k = 0; k < 2; ++k) \
        acc[ai][bj][m][n] = __builtin_amdgcn_mfma_f32_16x16x32_bf16(Bt[n][k], At[m][k], acc[ai][bj][m][n], 0, 0, 0); __builtin_amdgcn_s_setprio(0); } while (0)
#define PG8_WAIT_V(n) asm volatile("s_waitcnt vmcnt(" #n ")" ::: "memory")
#define PG8_WAIT_L(n) asm volatile("s_waitcnt lgkmcnt(" #n ")" ::: "memory")
#define PG8_BAR __builtin_amdgcn_s_barrier()
#define PG8_SCHED __builtin_amdgcn_sched_barrier(0)
    Unit cur, nxt; int ui = 0;
    if (!S.next(0, cur)) return;
    f32x4 acc[2][2][4][2];
#pragma unroll
    for (int a = 0; a < 2; ++a)
#pragma unroll
        for (int b = 0; b < 2; ++b)
#pragma unroll
            for (int m = 0; m < 4; ++m)
#pragma unroll
                for (int n = 0; n < 2; ++n) acc[a][b][m][n] = (f32x4){0.f, 0.f, 0.f, 0.f};
    bf16x8 At[4][2], B0[2][2], B1[2][2];
    const char* cA = S.abase(cur); const char* cB = S.bbase(cur);
    const char* cB2 = cB; const int ksp = BSPLIT ? nt / 2 : (1 << 30);
    if constexpr (BSPLIT) cB2 = S.bbase2(cur) - (size_t)ksp * kstep;
    unsigned oC[2][2], oN[2][2];
    if constexpr (GATHER) {
#pragma unroll
        for (int h = 0; h < 2; ++h)
#pragma unroll
            for (int i = 0; i < 2; ++i) oC[h][i] = (unsigned)S.rowtok(cur, h * HALF + RA[i]) * (unsigned)(K * 2) + (unsigned)(CA[i] * 2);
    }
    PG8_STAGE1(PG8_SB(0, 0), cB, voffB[0], pstepB); PG8_STAGE1(PG8_SB(0, 1), cB + hstepB, voffB[0], pstepB);
    if constexpr (GATHER) { PG8_STAGE(PG8_SA(0, 0), cA, oC[0]); PG8_STAGE(PG8_SA(0, 1), cA, oC[1]); }
    else { PG8_STAGE1(PG8_SA(0, 0), cA, voffA[0], pstepA); PG8_STAGE1(PG8_SA(0, 1), cA + hstepA, voffA[0], pstepA); }
    if (wr == 1) PG8_BAR;
    PG8_WAIT_V(2); PG8_BAR;
    PG8_STAGE1(PG8_SB(1, 0), cB + kstep, voffB[0], pstepB);
    if constexpr (GATHER) { PG8_STAGE(PG8_SA(1, 0), cA + kstep, oC[0]); } else { PG8_STAGE1(PG8_SA(1, 0), cA + kstep, voffA[0], pstepA); }
    PG8_STAGE1(PG8_SB(1, 1), cB + hstepB + kstep, voffB[0], pstepB);
    PG8_WAIT_V(6); PG8_BAR;
    for (;;) {
        const bool has_next = S.next(ui + 1, nxt);
        const char* nA = has_next ? S.abase(nxt) : cA; const char* nB = has_next ? S.bbase(nxt) : cB;
        const char* nB2 = nB; if constexpr (BSPLIT) nB2 = has_next ? S.bbase2(nxt) - (size_t)ksp * kstep : cB2;
        if constexpr (GATHER) {
#pragma unroll
            for (int h = 0; h < 2; ++h)
#pragma unroll
                for (int i = 0; i < 2; ++i) oN[h][i] = has_next ? (unsigned)S.rowtok(nxt, h * HALF + RA[i]) * (unsigned)(K * 2) + (unsigned)(CA[i] * 2) : oC[h][i];
        }
        for (int t = 0; t < nt; t += 2) {
            const bool last = (t == nt - 2);
            const char* a1 = cA + (size_t)(t + 1) * kstep;
            const char* a2 = last ? nA : cA + (size_t)(t + 2) * kstep; const char* b2 = last ? nB : ((t + 2 < ksp) ? cB : cB2) + (size_t)(t + 2) * kstep;
            const char* a3 = a2 + kstep; const char* b3 = b2 + kstep;
            unsigned s0[2], s1[2];
            if constexpr (GATHER) { s0[0] = last ? oN[0][0] : oC[0][0]; s0[1] = last ? oN[0][1] : oC[0][1]; s1[0] = last ? oN[1][0] : oC[1][0]; s1[1] = last ? oN[1][1] : oC[1][1]; }
            PG8_LDB(B0, 0, 0); PG8_LDB(B1, 0, 1); PG8_SCHED; PG8_LDA(At, 0, 0);
            if constexpr (GATHER) { PG8_STAGE(PG8_SA(1, 1), a1, oC[1]); } else { PG8_STAGE1(PG8_SA(1, 1), a1 + hstepA, voffA[0], pstepA); }
            PG8_WAIT_V(8); PG8_WAIT_L(0); PG8_BAR; PG8_MMA(0, 0, At, B0); PG8_MMA(0, 1, At, B1); PG8_BAR; PG8_SCHED;
            PG8_LDA(At, 0, 1); PG8_STAGE1(PG8_SB(0, 0), b2, voffB[0], pstepB); PG8_STAGE1(PG8_SB(0, 1), b2 + hstepB, voffB[0], pstepB);
            if constexpr (GATHER) { PG8_STAGE(PG8_SA(0, 0), a2, s0); } else { PG8_STAGE1(PG8_SA(0, 0), a2, voffA[0], pstepA); }
            PG8_WAIT_V(8); PG8_WAIT_L(0); PG8_BAR; PG8_MMA(1, 0, At, B0); PG8_MMA(1, 1, At, B1); PG8_BAR; PG8_SCHED;
            PG8_LDB(B0, 1, 0); PG8_LDB(B1, 1, 1); PG8_SCHED; PG8_LDA(At, 1, 0);
            if constexpr (GATHER) { PG8_STAGE(PG8_SA(0, 1), a2, s1); } else { PG8_STAGE1(PG8_SA(0, 1), a2 + hstepA, voffA[0], pstepA); }
            PG8_WAIT_V(8); PG8_WAIT_L(0); PG8_BAR; PG8_MMA(0, 0, At, B0); PG8_MMA(0, 1, At, B1); PG8_BAR; PG8_SCHED;
            PG8_LDA(At, 1, 1); PG8_STAGE1(PG8_SB(1, 0), b3, voffB[0], pstepB); PG8_STAGE1(PG8_SB(1, 1), b3 + hstepB, voffB[0], pstepB);
            if constexpr (GATHER) { PG8_STAGE(PG8_SA(1, 0), a3, s0); } else { PG8_STAGE1(PG8_SA(1, 0), a3, voffA[0], pstepA); }
            PG8_WAIT_V(8); PG8_WAIT_L(0); PG8_BAR; PG8_MMA(1, 0, At, B0); PG8_MMA(1, 1, At, B1); PG8_BAR; PG8_SCHED;
        }
        if constexpr (ALIGN_EPI) { if (wr == 0) PG8_BAR; }
        { int ln_; asm volatile("v_mbcnt_lo_u32_b32 %0, -1, 0\n\tv_mbcnt_hi_u32_b32 %0, -1, %0" : "=v"(ln_)); E(acc, cur, wr, wc, ln_ & 15, ln_ >> 4); }
        if (!has_next) break;
#pragma unroll
        for (int a = 0; a < 2; ++a)
#pragma unroll
            for (int b = 0; b < 2; ++b)
#pragma unroll
                for (int m = 0; m < 4; ++m)
#pragma unroll
                    for (int n = 0; n < 2; ++n) acc[a][b][m][n] = (f32x4){0.f, 0.f, 0.f, 0.f};
        cur = nxt; cA = nA; cB = nB; cB2 = nB2; ++ui;
        if constexpr (GATHER) {
#pragma unroll
            for (int h = 0; h < 2; ++h)
#pragma unroll
                for (int i = 0; i < 2; ++i) oC[h][i] = oN[h][i];
        }
        if constexpr (ALIGN_EPI) { if (wr == 1) PG8_BAR; }
    }
    PG8_WAIT_V(0);
    if constexpr (!ALIGN_EPI) { if (wr == 0) PG8_BAR; }
    PG8_BAR;
#undef PG8_SA
#undef PG8_SB
#undef PG8_STAGE
#undef PG8_STAGE1
#undef PG8_LDA
#undef PG8_LDB
#undef PG8_MMA
#undef PG8_WAIT_V
#undef PG8_WAIT_L
#undef PG8_BAR
#undef PG8_SCHED
}
}
using pg8::Unit;

struct DenseOrder {
    const char* A; const char* Bt; size_t tstepA, tstepB; int nM, nN, nwg, G, c;
    __device__ __forceinline__ void init(const void* A_, const void* Bt_, int M, int N, int K, int ldb, int G_, int c_) {
        A = (const char*)A_; Bt = (const char*)Bt_; tstepA = (size_t)256 * K * 2; tstepB = (size_t)256 * ldb * 2; nM = M / 256; nN = N / 256; nwg = nM * nN; G = G_; c = c_; }
    __device__ __forceinline__ bool next(int i, Unit& u) const {
        const long L = (long)i * G + c; if (L >= nwg) return false;
        int wgid = (int)L; { const int q = nwg / 8, r = nwg % 8, xcd = wgid % 8, off = wgid / 8; wgid = (xcd < r ? xcd * (q + 1) : r * (q + 1) + (xcd - r) * q) + off; }
        const int nig = 8 * nN, gid = wgid / nig, fm = gid * 8, gsz = (nM - fm) < 8 ? (nM - fm) : 8;
        u.pm = fm + ((wgid % nig) % gsz); u.pn = (wgid % nig) / gsz; u.cls = 0; u.p0 = 0; return true;
    }
    __device__ __forceinline__ const char* abase(const Unit& u) const { return A + (size_t)u.pm * tstepA; }
    __device__ __forceinline__ const char* bbase(const Unit& u) const { return Bt + (size_t)u.pn * tstepB; }
    __device__ __forceinline__ const char* bbase2(const Unit& u) const { return bbase(u); }
    __device__ __forceinline__ int rowtok(const Unit&, int) const { return 0; }
};

__device__ __forceinline__ void cls_experts(int cls, int& eA, int& eB) { const int g = cls / 6, p = cls % 6; const int a = (p >= 3) + (p >= 5), b = p < 3 ? p + 1 : (p < 5 ? p - 1 : 3); eA = 4 * g + a; eB = 4 * g + b; }
struct ExpertOrder {
    const LAS int* tb; const LAS int* cn; const int* list; const char* A; const char* W; int G, c, mode, layer;
    __device__ __forceinline__ bool next(int i, Unit& u) const {
        const int nwg = __builtin_amdgcn_readfirstlane(tb[NCLS]) * 4; const long L = (long)i * G + c; if (L >= nwg) return false;
        int wgid = (int)L; { const int q = nwg / 8, r = nwg % 8, xcd = wgid % 8, off = wgid / 8; wgid = (xcd < r ? xcd * (q + 1) : r * (q + 1) + (xcd - r) * q) + off; }
        const int rt = wgid >> 2; int cls = 0;
        for (int k = 1; k < NCLS; ++k) cls += (rt >= tb[k]) ? 1 : 0;
        cls = __builtin_amdgcn_readfirstlane(cls);
        u.pm = rt; u.pn = wgid & 3; u.cls = cls; u.p0 = __builtin_amdgcn_readfirstlane((rt - tb[cls]) * 256); return true;
    }
    __device__ __forceinline__ const char* abase(const Unit& u) const { return mode == 1 ? A : A + (size_t)u.pm * (256 * 512 * 2); }
    __device__ __forceinline__ const char* bbase(const Unit& u) const {
        if (mode == 1) { int eA, eB; cls_experts(u.cls, eA, eB); const int e = (u.pn >> 1) ? eB : eA; return W + ((size_t)(layer * 16 + e) * 512 + (size_t)(u.pn & 1) * 256) * (1024 * 2); }
        int eA, eB; cls_experts(u.cls, eA, eB); return W + ((size_t)(layer * 16 + eA) * 1024 + (size_t)u.pn * 256) * (256 * 2);
    }
    __device__ __forceinline__ const char* bbase2(const Unit& u) const { int eA, eB; cls_experts(u.cls, eA, eB); return W + ((size_t)(layer * 16 + eB) * 1024 + (size_t)u.pn * 256) * (256 * 2); }
    __device__ __forceinline__ int rowtok(const Unit& u, int rr) const { const int pos = u.p0 + rr; return pos < cn[u.cls] ? list[(size_t)u.cls * NTOK + pos] : DUMMY_ROW; }
};

__device__ __forceinline__ float row_rstd16(const float* ssq, int row, int fq, float inv_n) {
    const f32x4 v = *(const f32x4*)(ssq + (size_t)row * 16 + 4 * fq);
    float s = (v.x + v.y) + (v.z + v.w);
    s += __shfl_xor(s, 16); s += __shfl_xor(s, 32);
    return rsqrtf(s * inv_n + EPS);
}

struct EpiProj {
    bf16_t* proj; float* flog; const float* ssq1; const float* fb;
    __device__ __forceinline__ void operator()(const f32x4 (&acc)[2][2][4][2], const Unit& u, int wr, int wc, int fr, int fq) const {
#pragma unroll
        for (int ai = 0; ai < 2; ++ai)
#pragma unroll
            for (int m = 0; m < 4; ++m) {
                const int row = u.pm * 256 + ai * 128 + wr * 64 + m * 16 + fr;
                const float rs = row_rstd16(ssq1, row, fq, 1.f / DM);
                if (u.pn < 9) {
#pragma unroll
                    for (int bj = 0; bj < 2; ++bj) { const f32x4 v0 = acc[ai][bj][m][0] * rs, v1 = acc[ai][bj][m][1] * rs; u32x4 w;
                        w.x = cvt_pk_bf16(v0[0], v0[1]); w.y = cvt_pk_bf16(v0[2], v0[3]); w.z = cvt_pk_bf16(v1[0], v1[1]); w.w = cvt_pk_bf16(v1[2], v1[3]);
                        *(u32x4*)(proj + (size_t)row * PJ + u.pn * 256 + bj * 128 + wc * 32 + 8 * fq) = w; }
                } else if (wc == 0 && fq == 0) {
                    f32x4 o0, o1;
#pragma unroll
                    for (int e = 0; e < 4; ++e) { const float f0 = acc[ai][0][m][0][e] * rs + fb[e], f1 = acc[ai][0][m][1][e] * rs + fb[4 + e];
                        o0[e] = -log2f(1.f + exp2f(-f0 * LOG2E)); o1[e] = -log2f(1.f + exp2f(-f1 * LOG2E)); }
                    *(f32x4*)(flog + (size_t)row * 8) = o0; *(f32x4*)(flog + (size_t)row * 8 + 4) = o1;
                }
            }
    }
};
template <bool TOKMAP> struct EpiRes {
    bf16_t* h; float* ssq; const LAS int* cn; const int* list;
    __device__ __forceinline__ void operator()(const f32x4 (&acc)[2][2][4][2], const Unit& u, int wr, int wc, int fr, int fq) const {
#pragma unroll
        for (int ai = 0; ai < 2; ++ai)
#pragma unroll
            for (int m = 0; m < 4; ++m) {
                const int rr = ai * 128 + wr * 64 + m * 16 + fr; int row;
                if constexpr (TOKMAP) { const int pos = u.p0 + rr; row = pos < cn[u.cls] ? list[(size_t)u.cls * NTOK + pos] : DUMMY_ROW; } else row = u.pm * 256 + rr;
                float sq = 0.f;
#pragma unroll
                for (int bj = 0; bj < 2; ++bj) { bf16_t* p = h + (size_t)row * DM + u.pn * 256 + bj * 128 + wc * 32 + 8 * fq; const u32x4 o = *(const u32x4*)p;
                    const f32x4 a0 = acc[ai][bj][m][0], a1 = acc[ai][bj][m][1]; u32x4 w;
                    w.x = cvt_pk_bf16(bflo(o.x) + a0[0], bfhi(o.x) + a0[1]); w.y = cvt_pk_bf16(bflo(o.y) + a0[2], bfhi(o.y) + a0[3]);
                    w.z = cvt_pk_bf16(bflo(o.z) + a1[0], bfhi(o.z) + a1[1]); w.w = cvt_pk_bf16(bflo(o.w) + a1[2], bfhi(o.w) + a1[3]);
                    *(u32x4*)p = w;
                    sq += bflo(w.x) * bflo(w.x) + bfhi(w.x) * bfhi(w.x) + bflo(w.y) * bflo(w.y) + bfhi(w.y) * bfhi(w.y) + bflo(w.z) * bflo(w.z) + bfhi(w.z) * bfhi(w.z) + bflo(w.w) * bflo(w.w) + bfhi(w.w) * bfhi(w.w); }
                sq += __shfl_xor(sq, 16); sq += __shfl_xor(sq, 32);
                if (fq == 0) ssq[(size_t)row * 16 + u.pn * 4 + wc] = sq;
                if (m & 1) asm volatile("" ::: "memory");
            }
    }
};
struct EpiE1 {
    bf16_t* H1; const float* tinfo; const LAS int* cn; const int* list;
    __device__ __forceinline__ void operator()(const f32x4 (&acc)[2][2][4][2], const Unit& u, int wr, int wc, int fr, int fq) const {
#pragma unroll
        for (int ai = 0; ai < 2; ++ai)
#pragma unroll
            for (int m = 0; m < 4; ++m) {
                const int rr = ai * 128 + wr * 64 + m * 16 + fr; const int pos = u.p0 + rr;
                const int tok = pos < cn[u.cls] ? list[(size_t)u.cls * NTOK + pos] : DUMMY_ROW;
                const f32x4 ti = *(const f32x4*)(tinfo + (size_t)tok * 4);
                const float rs = ti.x, gate = (u.pn >> 1) ? ti.z : ti.y;
                float o[8];
#pragma unroll
                for (int n = 0; n < 2; ++n)
#pragma unroll
                    for (int e = 0; e < 4; ++e) { const float a = acc[ai][0][m][n][e] * rs, b = acc[ai][1][m][n][e] * rs; o[n * 4 + e] = gate * siluf_(a) * b; }
                u32x4 w; w.x = cvt_pk_bf16(o[0], o[1]); w.y = cvt_pk_bf16(o[2], o[3]); w.z = cvt_pk_bf16(o[4], o[5]); w.w = cvt_pk_bf16(o[6], o[7]);
                *(u32x4*)(H1 + (size_t)(u.pm * 256 + rr) * 512 + (u.pn >> 1) * 256 + (u.pn & 1) * 128 + wc * 32 + 8 * fq) = w;
            }
    }
};

__device__ __forceinline__ void meta_gemm16(const bf16_t* A, const bf16_t* Bt, int K, int n0, int wave, int lane, f32x4 (&acc)[2]) {
    const int m = lane & 15, q4 = lane >> 4;
    acc[0] = (f32x4){0.f, 0.f, 0.f, 0.f}; acc[1] = acc[0];
    const bf16_t* ap = A + (size_t)m * K + 8 * q4;
    const bf16_t* bp0 = Bt + (size_t)(n0 + 32 * wave + m) * K + 8 * q4; const bf16_t* bp1 = bp0 + (size_t)16 * K;
#pragma unroll 4
    for (int k0 = 0; k0 < K; k0 += 32) {
        const bf16x8 a = *(const bf16x8*)(ap + k0), b0 = *(const bf16x8*)(bp0 + k0), b1 = *(const bf16x8*)(bp1 + k0);
        acc[0] = __builtin_amdgcn_mfma_f32_16x16x32_bf16(b0, a, acc[0], 0, 0, 0);
        acc[1] = __builtin_amdgcn_mfma_f32_16x16x32_bf16(b1, a, acc[1], 0, 0, 0);
    }
}

#define XB_TMO      128
#define XB_XCNT(j)  (256  + 64 * (j))
#define XB_XSUB(j)  (1280 + 64 * (j))
#define XB_XGEN(j)  (2304 + 64 * (j))
#define XB_TOP      3328
#define XB_TOPGEN   3392
#define XCD_BAR_WORDS 3456
#define XB_SPIN_CAP (1u << 18)
__device__ __forceinline__ unsigned xb_ld(unsigned* p)              { return __hip_atomic_load(p, __ATOMIC_RELAXED, __HIP_MEMORY_SCOPE_AGENT); }
__device__ __forceinline__ unsigned xb_add(unsigned* p, unsigned v) { return __hip_atomic_fetch_add(p, v, __ATOMIC_RELAXED, __HIP_MEMORY_SCOPE_AGENT); }
__device__ __forceinline__ unsigned xb_xcc_id() { return (unsigned)__builtin_amdgcn_s_getreg((3 << 11) | 20) & 0xFu; }
#define XB_SPIN(cond, bar) do { unsigned _sp = 0; while (cond) { __builtin_amdgcn_s_sleep(1); \
    if ((++_sp & 255u) == 0u) { if (xb_ld(&(bar)[XB_TMO])) break; if (_sp > XB_SPIN_CAP) { atomicAdd(&(bar)[XB_TMO], 1u); break; } } } } while (0)
struct XcdBarrier { unsigned* bar; unsigned x; volatile LAS unsigned* st; };
__device__ __forceinline__ XcdBarrier xcd_barrier_post(unsigned* bar, volatile LAS unsigned* st) {
    XcdBarrier b; b.bar = bar; b.x = xb_xcc_id(); b.st = st;
    if (threadIdx.x == 0) (void)xb_add(&bar[XB_XCNT(b.x)], 1u);
    return b;
}
__device__ __forceinline__ void xcd_barrier_complete(unsigned* bar, unsigned x, unsigned& nloc, unsigned& nx) {
    const unsigned G = gridDim.x * gridDim.y * gridDim.z;
    unsigned sum, cnt, mine, sp = 0u;
    for (;;) {
        sum = 0u; cnt = 0u; mine = 0u;
#pragma unroll
        for (unsigned j = 0; j < 16; ++j) { const unsigned c = xb_ld(&bar[XB_XCNT(j)]); sum += c; cnt += (c > 0u) ? 1u : 0u; mine = (j == x) ? c : mine; }
        if (sum == G) break;
        __builtin_amdgcn_s_sleep(1);
        if ((++sp & 255u) == 0u) { if (xb_ld(&bar[XB_TMO])) break; if (sp > XB_SPIN_CAP) { atomicAdd(&bar[XB_TMO], 1u); break; } }
    }
    nloc = mine > 0u ? mine : 1u; nx = cnt > 0u ? cnt : 1u;
}
__device__ __forceinline__ void xcd_barrier(const XcdBarrier& b, const bool leader_thread) {
    asm volatile("s_waitcnt vmcnt(0)" ::: "memory");
    __syncthreads();
    if (leader_thread) {
        unsigned* bar = b.bar; asm volatile("" : "+s"(bar));
        __builtin_amdgcn_s_waitcnt(0);
        unsigned nloc = b.st[0], nx = b.st[1];
        if (nloc == 0u) { xcd_barrier_complete(bar, b.x, nloc, nx); b.st[0] = nloc; b.st[1] = nx; }
        const unsigned old = xb_add(&bar[XB_XSUB(b.x)], 1u);
        const unsigned gen = old / nloc;
        if (old + 1u == (gen + 1u) * nloc) {
            __builtin_amdgcn_fence(__ATOMIC_RELEASE, "agent");
            asm volatile("s_waitcnt vmcnt(0)" ::: "memory");
            const unsigned og = xb_add(&bar[XB_TOP], 1u);
            const unsigned tg = og / nx;
            if (og + 1u == (tg + 1u) * nx) xb_add(&bar[XB_TOPGEN], 1u);
            else XB_SPIN(xb_ld(&bar[XB_TOPGEN]) == tg, bar);
            __builtin_amdgcn_fence(__ATOMIC_ACQUIRE, "agent");
            xb_add(&bar[XB_XGEN(b.x)], 1u);
            asm volatile("s_waitcnt vmcnt(0)" ::: "memory");
        } else {
            XB_SPIN(xb_ld(&bar[XB_XGEN(b.x)]) == gen, bar);
            __builtin_amdgcn_fence(__ATOMIC_ACQUIRE, "agent");
            asm volatile("s_waitcnt vmcnt(0)" ::: "memory");
        }
    }
    __syncthreads();
}

template <class Get>
__device__ __forceinline__ void tr_item(const Get& get, bf16_t* dst, int dpitch, int k0, int n0, LAS float* scr, int lane) {
    float tv[32];
#pragma unroll
    for (int i = 0; i < 32; ++i) tv[i] = get(k0 + 2 * i + (lane >> 5), n0 + (lane & 31));
#pragma unroll
    for (int i = 0; i < 32; ++i) scr[(2 * i + (lane >> 5)) * 33 + (lane & 31)] = tv[i];
    LDS_WAIT(); asm volatile("" ::: "memory");
    const int c = lane & 7;
#pragma unroll
    for (int j = 0; j < 4; ++j) { const int n = (lane >> 3) + 8 * j; const LAS float* s = scr + (8 * c) * 33 + n;
        u32x4 o; o.x = pk2(s[0 * 33], s[1 * 33]); o.y = pk2(s[2 * 33], s[3 * 33]); o.z = pk2(s[4 * 33], s[5 * 33]); o.w = pk2(s[6 * 33], s[7 * 33]);
        *(u32x4*)(dst + (size_t)(n0 + n) * dpitch + k0 + 8 * c) = o; }
    LDS_WAIT(); asm volatile("" ::: "memory");
}
struct GetWin { const float* w; const float* g;
    __device__ __forceinline__ float operator()(int k, int n) const { int src; if (n < 2048) src = n; else if (n < 2304) src = n + 8; else if (n < 2312) src = n - 256; else return 0.f;
        float v = w[(size_t)k * DINSRC + src] * g[k]; if (n >= PQ && n < PK) v *= 0.125f * LOG2E; return v; } };
struct GetWout { const float* w; const float* ga; const float* gs;
    __device__ __forceinline__ float operator()(int k, int n) const { const int src = k < 768 ? k + 256 : k - 768; const float gn = k < 512 ? ga[k] : (k < 768 ? gs[k - 512] : 1.f);
        return w[(size_t)src * DM + n] * gn; } };
struct GetW13 { const float* w1; const float* w3; const float* g;
    __device__ __forceinline__ float operator()(int k, int n) const { const int u = n >> 8, hf = (n >> 7) & 1, j = n & 127; const uintptr_t wp = (uintptr_t)w1 + (uintptr_t)hf * ((uintptr_t)w3 - (uintptr_t)w1); return ((const float*)wp)[(size_t)k * 256 + u * 128 + j] * g[k]; } };
struct GetW2 { const float* w;
    __device__ __forceinline__ float operator()(int k, int n) const { return w[(size_t)k * DM + n]; } };
struct GetWr { const float* rg; const float* re; const float* g; int lo;
    __device__ __forceinline__ float operator()(int k, int n) const { float v = 0.f; if (n < 4) v = rg[(size_t)k * 4 + n]; else if (n < 20) v = re[(size_t)k * 16 + (n - 4)]; v *= g[k];
        if (lo) v = v - __uint_as_float(f2bf(v) << 16); return v; } };

constexpr int AT_SLOT = 16384, AT_CS = 81920, AT_WT = AT_CS + 4608 * 4;
__device__ __forceinline__ int crow(int r, int hi) { return (r & 3) + 8 * (r >> 2) + 4 * hi; }
__device__ __forceinline__ void attn_prefix(LAS unsigned char* lds, const int tid, const float* flog, int b, int h) {
    const int lane = tid & 63; const int w = __builtin_amdgcn_readfirstlane(tid >> 6);
    LAS float* cs = (LAS float*)(lds + AT_CS); LAS float* wt = (LAS float*)(lds + AT_WT);
    float v[9]; float run = 0.f;
#pragma unroll
    for (int i = 0; i < 9; ++i) { const int j = tid * 9 + i; float x = 0.f; if (j < NMETA + SEQ) x = flog[(size_t)rowof(b, j) * 8 + h]; run += x; v[i] = run; }
    float inc = run;
#pragma unroll
    for (int o = 1; o < 64; o <<= 1) { const float t = __shfl_up(inc, o); if (lane >= o) inc += t; }
    if (lane == 63) wt[w] = inc;
    __syncthreads();
    float base = inc - run;
    for (int k = 0; k < w; ++k) base += wt[k];
#pragma unroll
    for (int i = 0; i < 9; ++i) cs[tid * 9 + i] = base + v[i];
    __syncthreads();
}
__device__ __forceinline__ void at_glds16(const void* gsrc, unsigned lds_dst) { unsigned keep;
    asm volatile("s_mov_b32 %0, m0\n\ts_mov_b32 m0, %2\n\ts_nop 0\n\tglobal_load_lds_dwordx4 %1, off\n\ts_mov_b32 m0, %0" : "=&s"(keep) : "v"(gsrc), "s"(lds_dst) : "memory"); }
constexpr float AT_THR = 8.f;
__device__ __forceinline__ void attn_unit(LAS unsigned char* lds, const int tid, const bf16_t* proj, bf16_t* mixed, float* ssqa, int b, int h, int qt) {
    const int lane = tid & 63, r32 = lane & 31, hi = lane >> 5; const int w = __builtin_amdgcn_readfirstlane(tid >> 6);
    const LAS float* cs = (const LAS float*)(lds + AT_CS);
    const int qrel = 32 * w + r32;
    const int qrow = qt >= 0 ? b * SEQ + 256 * qt + qrel : NREAL + (qrel & 15);
    const int qkey = qt >= 0 ? NMETA + 256 * qt + qrel : (qrel & 15);
    const int qkey_w0 = qt >= 0 ? NMETA + 256 * qt + 32 * w : 0;
    const float cq = cs[qkey];
    bf16x8 qr[4];
#pragma unroll
    for (int d0 = 0; d0 < 4; ++d0) qr[d0] = *(const bf16x8*)(proj + (size_t)qrow * PJ + PQ + h * 64 + d0 * 16 + hi * 8);
    const int ntiles = qt >= 0 ? 1 + 4 * (qt + 1) : 1;
    const int wnt = qt >= 0 ? 4 * qt + (w >> 1) + 2 : 1;
    const int vr = 16 * (w & 3) + (lane >> 2);
    const unsigned ldsb = (unsigned)(uintptr_t)lds;
#define AT_DMA(jj) do { int kr_, vr_; if ((jj) == 0) { kr_ = NREAL + (lane < 15 ? lane : 15); vr_ = NREAL + (vr < 15 ? vr : 15); } else { kr_ = b * SEQ + 64 * ((jj) - 1) + lane; vr_ = b * SEQ + 64 * ((jj) - 1) + vr; } \
        const int so_ = AT_SLOTOF(sj, (jj) - jbase) + w * 1024; \
        at_glds16(proj + (size_t)kr_ * PJ + PK + h * 64 + w * 8, (unsigned)__builtin_amdgcn_readfirstlane(ldsb + so_)); \
        at_glds16(proj + (size_t)vr_ * PJ + PV + h * 64 + (w >> 2) * 32 + (lane & 3) * 8, (unsigned)__builtin_amdgcn_readfirstlane(ldsb + so_ + 8192)); } while (0)
#define AT_WAITBAR(n) asm volatile("s_waitcnt vmcnt(" #n ") lgkmcnt(0)\n\ts_barrier" ::: "memory")
    float mref = 0.f, lrun = 0.f; f32x16 o0 = {}, o1 = {};
    const int kfo = hi * 1024 + r32 * 16;
    const int vb = 8192 + ((lane >> 4) & 1) * 32 + (lane & 3) * 8 + (4 * hi + ((lane & 15) >> 2)) * 64;
    const LAS float* csl = cs + 4 * hi;
    bf16x8 kf[8];
#define AT_KLOAD(P0, P1, jjn) do { const int kb_ = (jjn) == 0 ? 0 : NMETA + 64 * ((jjn) - 1); const float cqm = cq - mref; const int so_ = AT_SLOTOF(sj, (jjn) - jbase); \
        _Pragma("unroll") for (int d0 = 0; d0 < 4; ++d0) { kf[2 * d0] = *(const LAS bf16x8*)(lds + so_ + kfo + d0 * 2048); kf[2 * d0 + 1] = *(const LAS bf16x8*)(lds + so_ + kfo + d0 * 2048 + 512); } \
        _Pragma("unroll") for (int g_ = 0; g_ < 4; ++g_) { const f32x4 c0_ = *(const LAS f32x4*)(csl + kb_ + 8 * g_), c1_ = *(const LAS f32x4*)(csl + kb_ + 32 + 8 * g_); \
            _Pragma("unroll") for (int e_ = 0; e_ < 4; ++e_) { P0[4 * g_ + e_] = cqm - c0_[e_]; P1[4 * g_ + e_] = cqm - c1_[e_]; } } \
        __builtin_amdgcn_sched_barrier(0); } while (0)
#define AT_QKM(P0, P1) do { _Pragma("unroll") for (int d0 = 0; d0 < 4; ++d0) { \
            P0 = __builtin_amdgcn_mfma_f32_32x32x16_bf16(kf[2 * d0], qr[d0], P0, 0, 0, 0); P1 = __builtin_amdgcn_mfma_f32_32x32x16_bf16(kf[2 * d0 + 1], qr[d0], P1, 0, 0, 0); } \
        __builtin_amdgcn_sched_barrier(0); } while (0)
#define AT_MX3(a, b, c) __builtin_fmaxf(__builtin_fmaxf((a), (b)), (c))
#define AT_SMPV(P0, P1, N0, N1, jj, pend) do { const int kb_ = (jj) == 0 ? 0 : NMETA + 64 * ((jj) - 1); \
        const LAS unsigned char* Vb_ = lds + AT_SLOTOF(sj, (jj) - jbase) + vb; s16x4 va_[8], vc_[8]; \
        _Pragma("unroll") for (int ks = 0; ks < 4; ++ks) { \
            va_[2 * ks] = __builtin_bit_cast(s16x4, __builtin_amdgcn_ds_read_tr16_b64_v4i16((LAS s16x4*)(Vb_ + ks * 1024))); \
            va_[2 * ks + 1] = __builtin_bit_cast(s16x4, __builtin_amdgcn_ds_read_tr16_b64_v4i16((LAS s16x4*)(Vb_ + ks * 1024 + 512))); } \
        __builtin_amdgcn_sched_barrier(0); \
        if ((jj) == 0 || kb_ + 63 > qkey_w0) { const int lim_ = (jj) == 0 ? (qkey < 15 ? qkey : 15) : qkey; \
            _Pragma("unroll") for (int r = 0; r < 16; ++r) { const int j_ = kb_ + crow(r, hi); if (j_ > lim_) P0[r] = -INFINITY; if (j_ + 32 > lim_) P1[r] = -INFINITY; } } \
        float ra_ = AT_MX3(P0[0], P0[1], P1[0]), rb_ = AT_MX3(P0[2], P0[3], P1[1]); ra_ = AT_MX3(ra_, P1[2], P1[3]); \
        _Pragma("unroll") for (int r = 4; r < 16; r += 4) { ra_ = AT_MX3(ra_, P0[r], P0[r + 1]); rb_ = AT_MX3(rb_, P0[r + 2], P0[r + 3]); ra_ = AT_MX3(ra_, P1[r], P1[r + 1]); rb_ = AT_MX3(rb_, P1[r + 2], P1[r + 3]); } \
        float rm_ = fmaxf(ra_, rb_); \
        rm_ = fmaxf(rm_, __shfl_xor(rm_, 32)); \
        if ((jj) == 0 || __any(rm_ > AT_THR)) { const float dl_ = (jj) == 0 ? rm_ : fmaxf(rm_, 0.f); mref += dl_; const float f_ = (jj) == 0 ? 1.f : fast_exp2(-dl_); lrun *= f_; \
            _Pragma("unroll") for (int r = 0; r < 16; ++r) { P0[r] -= dl_; P1[r] -= dl_; o0[r] *= f_; o1[r] *= f_; } \
            if (pend) { _Pragma("unroll") for (int r = 0; r < 16; ++r) { N0[r] -= dl_; N1[r] -= dl_; } } } \
        float rs_ = 0.f; \
        _Pragma("unroll") for (int r = 0; r < 16; ++r) { P0[r] = fast_exp2(P0[r]); P1[r] = fast_exp2(P1[r]); rs_ += P0[r] + P1[r]; } \
        lrun += rs_; \
        u32x4 pw_[4]; \
        _Pragma("unroll") for (int i = 0; i < 4; ++i) { pw_[0][i] = cvt_pk_bf16(P0[2 * i], P0[2 * i + 1]); pw_[1][i] = cvt_pk_bf16(P0[8 + 2 * i], P0[8 + 2 * i + 1]); \
            pw_[2][i] = cvt_pk_bf16(P1[2 * i], P1[2 * i + 1]); pw_[3][i] = cvt_pk_bf16(P1[8 + 2 * i], P1[8 + 2 * i + 1]); } \
        __builtin_amdgcn_sched_barrier(0); \
        _Pragma("unroll") for (int ks = 0; ks < 4; ++ks) { \
            vc_[2 * ks] = __builtin_bit_cast(s16x4, __builtin_amdgcn_ds_read_tr16_b64_v4i16((LAS s16x4*)(Vb_ + 4096 + ks * 1024))); \
            vc_[2 * ks + 1] = __builtin_bit_cast(s16x4, __builtin_amdgcn_ds_read_tr16_b64_v4i16((LAS s16x4*)(Vb_ + 4096 + ks * 1024 + 512))); } \
        _Pragma("unroll") for (int ks = 0; ks < 4; ++ks) { \
            const bf16x8 va = {va_[2 * ks][0], va_[2 * ks][1], va_[2 * ks][2], va_[2 * ks][3], va_[2 * ks + 1][0], va_[2 * ks + 1][1], va_[2 * ks + 1][2], va_[2 * ks + 1][3]}; \
            o0 = __builtin_amdgcn_mfma_f32_32x32x16_bf16(va, __builtin_bit_cast(bf16x8, pw_[ks]), o0, 0, 0, 0); } \
        __builtin_amdgcn_sched_barrier(0); \
        _Pragma("unroll") for (int ks = 0; ks < 4; ++ks) { \
            const bf16x8 vbb = {vc_[2 * ks][0], vc_[2 * ks][1], vc_[2 * ks][2], vc_[2 * ks][3], vc_[2 * ks + 1][0], vc_[2 * ks + 1][1], vc_[2 * ks + 1][2], vc_[2 * ks + 1][3]}; \
            o1 = __builtin_amdgcn_mfma_f32_32x32x16_bf16(vbb, __builtin_bit_cast(bf16x8, pw_[ks]), o1, 0, 0, 0); } \
        __builtin_amdgcn_sched_barrier(0); } while (0)
#define AT_STEP(C0, C1, N0, N1, jj) do { \
        const bool dma_ = (jj) + 4 < ntiles; \
        if (dma_) AT_DMA((jj) + 4); \
        const bool pend_ = (jj) + 1 < wnt; \
        if (pend_) AT_QKM(N0, N1); \
        if ((jj) < wnt) AT_SMPV(C0, C1, N0, N1, jj, pend_); \
        if ((jj) + 2 < wnt) AT_KLOAD(C0, C1, (jj) + 2); \
        if (dma_) AT_WAITBAR(2); else AT_WAITBAR(0); } while (0)
    int sj = 0, jbase = 0;
#define AT_SLOTOF(s_, k_) (((s_) + (k_) * AT_SLOT) >= 5 * AT_SLOT ? ((s_) + (k_) * AT_SLOT) - 5 * AT_SLOT : ((s_) + (k_) * AT_SLOT))
    AT_DMA(0);
    if (ntiles > 1) AT_DMA(1);
    if (ntiles > 2) AT_DMA(2);
    if (ntiles > 3) { AT_DMA(3); AT_WAITBAR(2); } else AT_WAITBAR(0);
    f32x16 pa0, pa1, pb0, pb1;
    AT_KLOAD(pa0, pa1, 0); AT_QKM(pa0, pa1);
    if (1 < wnt) AT_KLOAD(pb0, pb1, 1);
#pragma unroll 1
    for (int jj = 0; jj < ntiles; jj += 2) {
        jbase = jj;
        AT_STEP(pa0, pa1, pb0, pb1, jj);
        if (jj + 1 < ntiles) AT_STEP(pb0, pb1, pa0, pa1, jj + 1);
        sj = AT_SLOTOF(sj, 2);
    }
#undef AT_SLOTOF
#undef AT_KLOAD
#undef AT_QKM
#undef AT_MX3
#undef AT_DMA
#undef AT_WAITBAR
#undef AT_SMPV
#undef AT_STEP
    const float ltot = lrun + __shfl_xor(lrun, 32);
    const float inv = 1.f / ltot;
    float sq = 0.f;
#pragma unroll
    for (int r = 0; r < 16; ++r) { o0[r] *= inv; o1[r] *= inv; sq += o0[r] * o0[r] + o1[r] * o1[r]; }
    sq += __shfl_xor(sq, 32);
    const bool st = qt >= 0 || qrel < 16;
    if (st) {
        bf16_t* op = mixed + (size_t)qrow * DM + MX_ATT + h * 64;
#pragma unroll
        for (int g = 0; g < 4; ++g) { u32x2 w0, w1; w0.x = cvt_pk_bf16(o0[4 * g], o0[4 * g + 1]); w0.y = cvt_pk_bf16(o0[4 * g + 2], o0[4 * g + 3]); w1.x = cvt_pk_bf16(o1[4 * g], o1[4 * g + 1]); w1.y = cvt_pk_bf16(o1[4 * g + 2], o1[4 * g + 3]);
            *(u32x2*)(op + 8 * g + 4 * hi) = w0; *(u32x2*)(op + 32 + 8 * g + 4 * hi) = w1; }
        if (hi == 0) ssqa[(size_t)qrow * 8 + h] = sq;
    }
    __syncthreads();
}

__device__ __forceinline__ void conv_unit(LAS unsigned char* lds, const int tid, const bf16_t* proj, bf16_t* mixed, const float* cw, const float* cb, const float* lg, const float* lb, int b, int tbase, int nsub, int nvalid) {
    const int lane = tid & 63; const int w = __builtin_amdgcn_readfirstlane(tid >> 6);
    LAS float* ub = (LAS float*)lds;
    const int cp = tid & 127, rg = tid >> 7;
    f32x2 wv[31];
#pragma unroll
    for (int j = 0; j < 31; ++j) wv[j] = *(const f32x2*)(cw + j * 256 + 2 * cp);
    const f32x2 bb = *(const f32x2*)(cb + 2 * cp);
    const f32x4 g4 = *(const f32x4*)(lg + 4 * lane), b4 = *(const f32x4*)(lb + 4 * lane);
#pragma unroll 1
    for (int sb = 0; sb < nsub; ++sb) {
        const int t0 = tbase + 64 * sb;
        for (int idx = tid; idx < 94 * 64; idx += 512) {
            const int rr = idx >> 6, cq4 = (idx & 63) * 4; const int t = t0 - 30 + rr; f32x4 u = {0.f, 0.f, 0.f, 0.f};
            if (t >= 0 && t < NMETA + SEQ) { const bf16_t* p = proj + (size_t)rowof(b, t) * PJ + cq4; const u32x2 a = *(const u32x2*)p, g = *(const u32x2*)(p + 256);
                u[0] = bflo(a.x) * sigmoidf_(bflo(g.x)); u[1] = bfhi(a.x) * sigmoidf_(bfhi(g.x)); u[2] = bflo(a.y) * sigmoidf_(bflo(g.y)); u[3] = bfhi(a.y) * sigmoidf_(bfhi(g.y)); }
            *(LAS f32x4*)(ub + rr * 256 + cq4) = u;
        }
        __syncthreads();
        f32x2 acc[16];
#pragma unroll
        for (int i = 0; i < 16; ++i) acc[i] = (f32x2){0.f, 0.f};
#pragma unroll
        for (int rr = 0; rr < 46; ++rr) { const f32x2 uv = *(const LAS f32x2*)(ub + (16 * rg + rr) * 256 + 2 * cp);
#pragma unroll
            for (int i = 0; i < 16; ++i) if (rr - i >= 0 && rr - i <= 30) acc[i] += wv[rr - i] * uv; }
        __syncthreads();
#pragma unroll
        for (int i = 0; i < 16; ++i) *(LAS f32x2*)(ub + (16 * rg + i) * 256 + 2 * cp) = acc[i] + bb;
        __syncthreads();
#pragma unroll
        for (int i = 0; i < 8; ++i) { const int rr = 8 * w + i; const f32x4 y = *(const LAS f32x4*)(ub + rr * 256 + 4 * lane);
            const float mu = wave_sum((y[0] + y[1]) + (y[2] + y[3])) * (1.f / 256.f);
            const f32x4 d = y - mu; const float var = wave_sum((d[0] * d[0] + d[1] * d[1]) + (d[2] * d[2] + d[3] * d[3])) * (1.f / 256.f);
            const float rs = rsqrtf(var + EPS); f32x4 o;
#pragma unroll
            for (int e = 0; e < 4; ++e) o[e] = siluf_(d[e] * rs * g4[e] + b4[e]);
            if (rr < nvalid) { u32x2 wv2; wv2.x = cvt_pk_bf16(o[0], o[1]); wv2.y = cvt_pk_bf16(o[2], o[3]); *(u32x2*)(mixed + (size_t)rowof(b, t0 + rr) * DM + MX_CONV + 4 * lane) = wv2; } }
        __syncthreads();
    }
}

struct S5P { const float *lre, *lim, *ldt, *bre, *bim, *cre, *cim, *dsk, *gw, *gb; };
__device__ __forceinline__ float gelu_tanh(float x) { const float u = 0.7978845608028654f * (x + 0.044715f * x * x * x); const float e = fast_exp2(2.f * LOG2E * u); const float th = 1.f - 2.f * fast_rcp(e + 1.f); return 0.5f * x * (1.f + th); }
__device__ __forceinline__ void s5_seq_unit(const S5P& P, const bf16_t* proj, bf16_t* mixed, float* ssqs, int b, int g, int lane) {
    const int p = lane;
    const float dt = expf(P.ldt[g]);
    const float lr = P.lre[g * 64 + p], li = P.lim[g * 64 + p];
    const float mag = expf(lr * dt);
    const double turns = (double)li * (double)dt * 0.15915494309189535; const float fr = (float)(turns - floor(turns));
    const float ar = mag * __builtin_amdgcn_cosf(fr), ai = mag * __builtin_amdgcn_sinf(fr);
    const float nr = ar - 1.f, ni = ai, den = lr * lr + li * li;
    const float fre = (nr * lr + ni * li) / den, fim = (ni * lr - nr * li) / den;
    float bbr[16], bbi[16], cr[16], ci[16];
#pragma unroll
    for (int h = 0; h < 16; ++h) { const float br = P.bre[(g * 64 + p) * 16 + h], bi = P.bim[(g * 64 + p) * 16 + h]; bbr[h] = fre * br - fim * bi; bbi[h] = fre * bi + fim * br;
        cr[h] = P.cre[(g * 16 + h) * 64 + p]; ci[h] = P.cim[(g * 16 + h) * 64 + p]; }
    const int hl = ((lane >> 5) & 1) * 8 + ((lane >> 4) & 1) * 4 + ((lane >> 3) & 1) * 2 + ((lane >> 2) & 1);
    const float dsk = P.dsk[g * 16 + hl], gbk = P.gb[g * 16 + hl];
    float gwk[16];
#pragma unroll
    for (int h = 0; h < 16; ++h) gwk[h] = P.gw[(g * 16 + h) * 16 + hl];
    float xr = 0.f, xi = 0.f;
    u32x4 nua = *(const u32x4*)(proj + (size_t)rowof(b, 0) * PJ + PU + 16 * g), nub = *(const u32x4*)(proj + (size_t)rowof(b, 0) * PJ + PU + 16 * g + 8);
#pragma unroll 1
    for (int t = 0; t < NMETA + SEQ; ++t) {
        const int row = rowof(b, t);
        const u32x4 ua = nua, ub = nub;
        { const int tn = t + 1 < NMETA + SEQ ? t + 1 : t; const bf16_t* np = proj + (size_t)rowof(b, tn) * PJ + PU + 16 * g; nua = *(const u32x4*)np; nub = *(const u32x4*)(np + 8); }
        float u[16]; u[0] = bflo(ua.x); u[1] = bfhi(ua.x); u[2] = bflo(ua.y); u[3] = bfhi(ua.y); u[4] = bflo(ua.z); u[5] = bfhi(ua.z); u[6] = bflo(ua.w); u[7] = bfhi(ua.w);
        u[8] = bflo(ub.x); u[9] = bfhi(ub.x); u[10] = bflo(ub.y); u[11] = bfhi(ub.y); u[12] = bflo(ub.z); u[13] = bfhi(ub.z); u[14] = bflo(ub.w); u[15] = bfhi(ub.w);
        float bur = 0.f, bui = 0.f;
#pragma unroll
        for (int h = 0; h < 16; ++h) { bur += bbr[h] * u[h]; bui += bbi[h] * u[h]; }
        const float nxr = ar * xr - ai * xi + bur, nxi = ar * xi + ai * xr + bui; xr = nxr; xi = nxi;
        float v[16];
#pragma unroll
        for (int h = 0; h < 16; ++h) v[h] = cr[h] * xr - ci[h] * xi;
        float v8[8], v4[4], v2[2], v1;
        { const bool up = (lane >> 5) & 1;
#pragma unroll
          for (int i = 0; i < 8; ++i) { const float send = up ? v[i] : v[i + 8], keep = up ? v[i + 8] : v[i]; v8[i] = keep + __shfl_xor(send, 32); } }
        { const bool up = (lane >> 4) & 1;
#pragma unroll
          for (int i = 0; i < 4; ++i) { const float send = up ? v8[i] : v8[i + 4], keep = up ? v8[i + 4] : v8[i]; v4[i] = keep + __shfl_xor(send, 16); } }
        { const bool up = (lane >> 3) & 1;
#pragma unroll
          for (int i = 0; i < 2; ++i) { const float send = up ? v4[i] : v4[i + 2], keep = up ? v4[i + 2] : v4[i]; v2[i] = keep + __shfl_xor(send, 8); } }
        { const bool up = (lane >> 2) & 1; const float send = up ? v2[0] : v2[1], keep = up ? v2[1] : v2[0]; v1 = keep + __shfl_xor(send, 4); }
        v1 += __shfl_xor(v1, 2); v1 += __shfl_xor(v1, 1);
        float uh = u[0];
#pragma unroll
        for (int h = 1; h < 16; ++h) uh = (hl == h) ? u[h] : uh;
        const float y = v1 + dsk * uh;
        const float zg = gelu_tanh(y);
        float gate = gbk;
#pragma unroll
        for (int h = 0; h < 16; ++h) { const int src = ((h >> 3) & 1) * 32 + ((h >> 2) & 1) * 16 + ((h >> 1) & 1) * 8 + (h & 1) * 4; gate += __shfl(zg, src) * gwk[h]; }
        const float outv = zg * sigmoidf_(gate);
        float sq = outv * outv;
        sq += __shfl_xor(sq, 32); sq += __shfl_xor(sq, 16); sq += __shfl_xor(sq, 8); sq += __shfl_xor(sq, 4);
        if (t >= NMETA || b == 0) {
            if ((lane & 3) == 0) mixed[(size_t)row * DM + MX_SSM + 16 * g + hl] = (bf16_t)f2bf(outv);
            if (lane == 0) ssqs[(size_t)row * 16 + g] = sq;
        }
    }
}

constexpr size_t S5T_BYTES = 163840;
constexpr int S5_KT = 0, S5_WS = 8704, S5_WC = 74240, S5_MD = 139776, S5_MC = 142848;
constexpr int S5L_KT = 0, S5L_W = 8704, S5L_EX = 78336, S5L_MD = 82944, S5L_MC = 86016;
__device__ __forceinline__ void s5_tables_block(LAS unsigned char* lds, const int tid, const S5P& P, int g, unsigned char* tbl) {
    typedef float f2 __attribute__((ext_vector_type(2)));
    LAS f2* pw = (LAS f2*)lds;
    LAS f2* Bb = (LAS f2*)(lds + 8704);
    LAS f2* Cc = (LAS f2*)(lds + 16896);
    if (tid < 64) {
        const int p = tid;
        const float dt = expf(P.ldt[g]);
        const float lr = P.lre[g * 64 + p], li = P.lim[g * 64 + p];
        const float mag = expf(lr * dt);
        const double turns = (double)li * (double)dt * 0.15915494309189535; const float fr = (float)(turns - floor(turns));
        const float ar = mag * __builtin_amdgcn_cosf(fr), ai = mag * __builtin_amdgcn_sinf(fr);
        const float nr = ar - 1.f, ni = ai, den = lr * lr + li * li;
        const float fre = (nr * lr + ni * li) / den, fim = (ni * lr - nr * li) / den;
        float xr = 1.f, xi = 0.f;
        for (int t = 0; t <= 16; ++t) { pw[t * 64 + p] = (f2){xr, xi}; const float nxr = xr * ar - xi * ai, nxi = xr * ai + xi * ar; xr = nxr; xi = nxi; }
        const f2 M = pw[16 * 64 + p];
        float* MD = (float*)(tbl + S5_MD); float* MC = (float*)(tbl + S5_MC);
        float mr = M.x, mi = M.y;
        for (int k = 0; k < 6; ++k) { MD[(k * 64 + p) * 2] = mr; MD[(k * 64 + p) * 2 + 1] = mi; const float n1 = mr * mr - mi * mi, n2 = 2.f * mr * mi; mr = n1; mi = n2; }
        xr = 1.f; xi = 0.f;
        for (int c = 0; c < 32; ++c) { MC[(c * 64 + p) * 2] = xr; MC[(c * 64 + p) * 2 + 1] = xi; const float nxr = xr * M.x - xi * M.y, nxi = xr * M.y + xi * M.x; xr = nxr; xi = nxi; }
        for (int h = 0; h < 16; ++h) { const float br = P.bre[(g * 64 + p) * 16 + h], bi = P.bim[(g * 64 + p) * 16 + h]; Bb[p * 16 + h] = (f2){fre * br - fim * bi, fre * bi + fim * br}; }
    }
    for (int e = tid; e < 1024; e += 512) Cc[e] = (f2){P.cre[g * 1024 + e], P.cim[g * 1024 + e]};
    __syncthreads();
    bf16_t* KT = (bf16_t*)(tbl + S5_KT); bf16_t* WSg = (bf16_t*)(tbl + S5_WS); bf16_t* WCg = (bf16_t*)(tbl + S5_WC);
    for (int e = tid; e < 17 * 256; e += 512) {
        const int t1 = e >> 8, h = (e >> 4) & 15, h2 = e & 15; float acc = 0.f;
        if (t1 > 0) { const int tau = t1 - 1;
            for (int p = 0; p < 64; ++p) { const f2 a = pw[tau * 64 + p], bb = Bb[p * 16 + h2], c = Cc[h * 64 + p]; const float zr = a.x * bb.x - a.y * bb.y, zi = a.x * bb.y + a.y * bb.x; acc += c.x * zr - c.y * zi; }
            if (tau == 0 && h == h2) acc += P.dsk[g * 16 + h]; }
        KT[e] = (bf16_t)f2bf(acc);
    }
    for (int e = tid; e < 128 * 256; e += 512) {
        const int r = e >> 8, ri = r >> 6, p = r & 63, q = e & 255, j = q >> 4, h2 = q & 15;
        const f2 a = pw[(15 - j) * 64 + p], bb = Bb[p * 16 + h2]; const float zr = a.x * bb.x - a.y * bb.y, zi = a.x * bb.y + a.y * bb.x;
        WSg[e] = (bf16_t)f2bf(ri ? zi : zr);
    }
    for (int e = tid; e < 256 * 128; e += 512) {
        const int row = e >> 7, i = row >> 4, h = row & 15, q = e & 127; const int blk = q >> 5, sq_ = (q >> 4) & 1, hh = (q >> 3) & 1, j = q & 7;
        const int n = 32 * blk + 16 * sq_ + 8 * (j >> 2) + 4 * hh + (j & 3); const int ri = n >> 6, p = n & 63;
        const f2 a = pw[(i + 1) * 64 + p], c = Cc[h * 64 + p]; const float zr = c.x * a.x - c.y * a.y, zi = c.x * a.y + c.y * a.x;
        WCg[e] = (bf16_t)f2bf(ri ? -zi : zr);
    }
    __syncthreads();
}

__device__ __forceinline__ void s5_unit(LAS unsigned char* lds, const int tid, const unsigned char* tbl, const float* gw, const float* gb, const bf16_t* proj, bf16_t* mixed, float* ssqs, int b, int g) {
    typedef float f2 __attribute__((ext_vector_type(2)));
    const int lane = tid & 63, c = lane & 31, hi = lane >> 5; const int w = __builtin_amdgcn_readfirstlane(tid >> 6);
    for (int q = tid; q < 544; q += 512) *(LAS u32x4*)(lds + S5L_KT + q * 16) = *(const u32x4*)(tbl + S5_KT + q * 16);
#pragma unroll
    for (int it = 0; it < 8; ++it) { const int q = tid + 512 * it; *(LAS u32x4*)(lds + S5L_W + (q >> 5) * 528 + (q & 31) * 16) = *(const u32x4*)(tbl + S5_WS + q * 16); }
    if (tid < 192) *(LAS u32x4*)(lds + S5L_MD + tid * 16) = *(const u32x4*)(tbl + S5_MD + tid * 16);
#pragma unroll
    for (int it = 0; it < 4; ++it) { const int q = tid + 512 * it; *(LAS u32x2*)(lds + S5L_MC + (q >> 6) * 520 + (q & 63) * 8) = *(const u32x2*)(tbl + S5_MC + q * 8); }
    __syncthreads();
    const bf16_t* ubase = proj + PU + 16 * g + 8 * hi;
    const LAS unsigned char* mdb = lds + S5L_MD + hi * 32;
    const LAS unsigned char* mcb = lds + S5L_MC + c * 520 + hi * 32;
    LAS float* EX = (LAS float*)(lds + S5L_EX) + 4 * hi;
    const LAS unsigned char* wsb = lds + S5L_W + c * 528 + hi * 16;
    const LAS unsigned char* wcb = lds + S5L_W + c * 272 + hi * 16;
    f32x16 sa[4];
#pragma unroll
    for (int k = 0; k < 4; ++k) sa[k] = (f32x16){};
    {
        const int cc = 32 * w + c;
        const bf16_t* up = ubase + (size_t)rowof(b, 16 * cc) * PJ;
#pragma unroll
        for (int s0 = 0; s0 < 16; s0 += 4) {
            bf16x8 uf[4];
#pragma unroll
            for (int s = 0; s < 4; ++s) { uf[s] = *(const bf16x8*)up; up += PJ; asm volatile("" : "+v"(up)); }
#pragma unroll
            for (int s = 0; s < 4; ++s) {
#pragma unroll
                for (int blk = 0; blk < 4; ++blk) { const bf16x8 A = *(const LAS bf16x8*)(wsb + blk * (32 * 528) + (s0 + s) * 32); sa[blk] = __builtin_amdgcn_mfma_f32_32x32x16_bf16(A, uf[s], sa[blk], 0, 0, 0); }
                __builtin_amdgcn_sched_barrier(0); }
        }
    }
#pragma unroll
    for (int k = 0; k < 5; ++k) { const int d = 1 << k;
#pragma unroll
        for (int pb = 0; pb < 2; ++pb)
#pragma unroll
            for (int r = 0; r < 16; ++r) { const f2 m = *(const LAS f2*)(mdb + (k * 64 + 32 * pb + (r & 3) + 8 * (r >> 2)) * 8);
                const float yr = __shfl_up(sa[pb][r], d, 32), yi = __shfl_up(sa[2 + pb][r], d, 32);
                if (c >= d) { sa[pb][r] += m.x * yr - m.y * yi; sa[2 + pb][r] += m.x * yi + m.y * yr; }
                if ((r & 3) == 3) __builtin_amdgcn_sched_barrier(0); }
    }
    if (c == 31) {
#pragma unroll
        for (int pb = 0; pb < 2; ++pb)
#pragma unroll
            for (int r = 0; r < 16; ++r) { const int p0 = 32 * pb + (r & 3) + 8 * (r >> 2); EX[w * 128 + p0] = sa[pb][r]; EX[w * 128 + 64 + p0] = sa[2 + pb][r]; }
    }
    __syncthreads();
#pragma unroll
    for (int it = 0; it < 8; ++it) { const int q = tid + 512 * it; *(LAS u32x4*)(lds + S5L_W + (q >> 4) * 272 + (q & 15) * 16) = *(const u32x4*)(tbl + S5_WC + q * 16); }
    __syncthreads();
    const int npass = 2;
#pragma unroll 1
    for (int pass = 0; pass < npass; ++pass) {
        const int nprev = pass == 0 ? w : 8;
        const int cc = pass == 0 ? 32 * w + c : 256;
        if (pass == 1) {
#pragma unroll
            for (int k = 0; k < 4; ++k) sa[k] = (f32x16){};
        }
        {
            float cr[2][16], ci[2][16];
#pragma unroll
            for (int pb = 0; pb < 2; ++pb)
#pragma unroll
                for (int r = 0; r < 16; ++r) { cr[pb][r] = 0.f; ci[pb][r] = 0.f; }
#pragma unroll 1
            for (int wp = 0; wp < nprev; ++wp) {
                const LAS float* exw = EX + wp * 128;
#pragma unroll
                for (int pb = 0; pb < 2; ++pb)
#pragma unroll
                    for (int r = 0; r < 16; ++r) { const int p0 = 32 * pb + (r & 3) + 8 * (r >> 2); const f2 m = *(const LAS f2*)(mdb + (5 * 64 + p0) * 8); const float er = exw[p0], ei = exw[64 + p0];
                        const float nr = m.x * cr[pb][r] - m.y * ci[pb][r] + er, ni = m.x * ci[pb][r] + m.y * cr[pb][r] + ei; cr[pb][r] = nr; ci[pb][r] = ni;
                        if ((r & 7) == 7) __builtin_amdgcn_sched_barrier(0); }
            }
#pragma unroll
            for (int pb = 0; pb < 2; ++pb)
#pragma unroll
                for (int r = 0; r < 16; ++r) { const f2 m = *(const LAS f2*)(mcb + (32 * pb + (r & 3) + 8 * (r >> 2)) * 8);
                    float xr = __shfl_up(sa[pb][r], 1, 32), xi = __shfl_up(sa[2 + pb][r], 1, 32); if (c == 0) { xr = 0.f; xi = 0.f; }
                    sa[pb][r] = xr + m.x * cr[pb][r] - m.y * ci[pb][r]; sa[2 + pb][r] = xi + m.x * ci[pb][r] + m.y * cr[pb][r];
                    if ((r & 7) == 7) __builtin_amdgcn_sched_barrier(0); }
        }
        bf16x8 xf[4][2];
#pragma unroll
        for (int blk = 0; blk < 4; ++blk)
#pragma unroll
            for (int s = 0; s < 2; ++s) { u32x4 t; t.x = cvt_pk_bf16(sa[blk][8 * s], sa[blk][8 * s + 1]); t.y = cvt_pk_bf16(sa[blk][8 * s + 2], sa[blk][8 * s + 3]); t.z = cvt_pk_bf16(sa[blk][8 * s + 4], sa[blk][8 * s + 5]); t.w = cvt_pk_bf16(sa[blk][8 * s + 6], sa[blk][8 * s + 7]); xf[blk][s] = __builtin_bit_cast(bf16x8, t); }
        const int io = (lane >> 4) & 1, kk = lane & 15;
        bf16x8 Gf0, Gf1;
        { unsigned pkd[4];
    #pragma unroll
          for (int jj = 0; jj < 4; ++jj) { const int j0 = 2 * jj, j1 = 2 * jj + 1; const int h0 = 8 * (j0 >> 2) + 4 * hi + (j0 & 3), h1 = 8 * (j1 >> 2) + 4 * hi + (j1 & 3); pkd[jj] = pk2(gw[h0 * 16 + kk], gw[h1 * 16 + kk]); }
          const u32x4 wv = {pkd[0], pkd[1], pkd[2], pkd[3]}, zz = {0u, 0u, 0u, 0u};
          Gf0 = __builtin_bit_cast(bf16x8, io == 0 ? wv : zz); Gf1 = __builtin_bit_cast(bf16x8, io == 1 ? wv : zz); }
        float gbv[8];
    #pragma unroll
        for (int q = 0; q < 8; ++q) gbv[q] = gb[(q & 3) + 8 * (q >> 2) + 4 * hi];
        const int ktb = S5L_KT + ((lane >> 4) & 1) * 512 + (lane & 15) * 32 + hi * 16;
        const bool stok = pass == 0 ? (cc > 0 || b == 0) : (c == 0);
#pragma unroll
        for (int half = 0; half < 2; ++half) {
            __builtin_amdgcn_sched_barrier(0);
            f32x16 ya[4];
#pragma unroll
            for (int rl = 0; rl < 4; ++rl) ya[rl] = (f32x16){};
            const bf16_t* up = ubase + (size_t)rowof(b, 16 * cc) * PJ;
#pragma unroll
            for (int s0 = 0; s0 < 8 * half + 8; s0 += 4) {
                bf16x8 uf[4];
#pragma unroll
                for (int s = 0; s < 4; ++s) { uf[s] = *(const bf16x8*)up; up += PJ; asm volatile("" : "+v"(up)); }
#pragma unroll
                for (int s = 0; s < 4; ++s) {
#pragma unroll
                    for (int rl = 0; rl < 4; ++rl) { const int rb = 4 * half + rl; if (s0 + s <= 2 * rb + 1 && (pass == 0 || rb == w)) { const bf16x8 A = *(const LAS bf16x8*)(lds + ktb + (2 * rb - (s0 + s) + 1) * 512); ya[rl] = __builtin_amdgcn_mfma_f32_32x32x16_bf16(A, uf[s], ya[rl], 0, 0, 0); } }
                    __builtin_amdgcn_sched_barrier(0); }
            }
#pragma unroll
            for (int rl = 0; rl < 4; ++rl) if (pass == 0 || 4 * half + rl == w) {
#pragma unroll
                for (int blk = 0; blk < 4; ++blk)
#pragma unroll
                    for (int s = 0; s < 2; ++s) { const bf16x8 A = *(const LAS bf16x8*)(wcb + (4 * half + rl) * (32 * 272) + (blk * 2 + s) * 32); ya[rl] = __builtin_amdgcn_mfma_f32_32x32x16_bf16(A, xf[blk][s], ya[rl], 0, 0, 0); }
                __builtin_amdgcn_sched_barrier(0);
            }
#pragma unroll
            for (int rl = 0; rl < 4; ++rl) if (pass == 0 || 4 * half + rl == w) {
                const int rb = 4 * half + rl;
                float zg[16];
#pragma unroll
                for (int r = 0; r < 16; ++r) zg[r] = gelu_tanh(ya[rl][r]);
                u32x4 z0, z1; z0.x = cvt_pk_bf16(zg[0], zg[1]); z0.y = cvt_pk_bf16(zg[2], zg[3]); z0.z = cvt_pk_bf16(zg[4], zg[5]); z0.w = cvt_pk_bf16(zg[6], zg[7]);
                z1.x = cvt_pk_bf16(zg[8], zg[9]); z1.y = cvt_pk_bf16(zg[10], zg[11]); z1.z = cvt_pk_bf16(zg[12], zg[13]); z1.w = cvt_pk_bf16(zg[14], zg[15]);
                f32x16 gt = (f32x16){};
                gt = __builtin_amdgcn_mfma_f32_32x32x16_bf16(Gf0, __builtin_bit_cast(bf16x8, z0), gt, 0, 0, 0);
                gt = __builtin_amdgcn_mfma_f32_32x32x16_bf16(Gf1, __builtin_bit_cast(bf16x8, z1), gt, 0, 0, 0);
#pragma unroll
                for (int il = 0; il < 2; ++il) {
                    float o[8]; float sq = 0.f;
#pragma unroll
                    for (int q = 0; q < 8; ++q) { o[q] = zg[8 * il + q] * sigmoidf_(gt[8 * il + q] + gbv[q]); sq += o[q] * o[q]; }
                    sq += __shfl_xor(sq, 32);
                    if (stok) { const int row = rowof(b, 16 * cc + 2 * rb + il); bf16_t* op = mixed + (size_t)row * DM + MX_SSM + 16 * g + 4 * hi;
                        u32x2 w0, w1; w0.x = cvt_pk_bf16(o[0], o[1]); w0.y = cvt_pk_bf16(o[2], o[3]); w1.x = cvt_pk_bf16(o[4], o[5]); w1.y = cvt_pk_bf16(o[6], o[7]);
                        *(u32x2*)op = w0; *(u32x2*)(op + 8) = w1;
                        if (hi == 0) ssqs[(size_t)row * 16 + g] = sq; }
                }
                __builtin_amdgcn_sched_barrier(0);
            }
        }
    }
    __syncthreads();
}

struct Args { const float* in[31]; float* out; unsigned char* ws; int ph_lo, ph_hi; };
constexpr int N_PHASES = 16;
#define PHASE_IDS() int tid; { int ln_; asm volatile("v_mbcnt_lo_u32_b32 %0, -1, 0\n\tv_mbcnt_hi_u32_b32 %0, -1, %0" : "=v"(ln_)); tid = wave0 * 64 + ln_; } unsigned char* ws = ws0; asm volatile("" : "+s"(ws)); const int lane = tid & 63; const int wave = __builtin_amdgcn_readfirstlane(tid >> 6); (void)lane; (void)wave

__global__ void __launch_bounds__(NWAVES * 64, 2) hymba_fwd(Args args) {
    extern __shared__ __attribute__((aligned(16))) unsigned char lds_raw[];
    LAS unsigned char* lds = (LAS unsigned char*)lds_raw;
    volatile LAS unsigned* MISC = (volatile LAS unsigned*)(lds + LDSCTL_OFF);
    LAS int* TB = (LAS int*)(lds + LDSCTL_OFF + 256);
    LAS int* CN = (LAS int*)(lds + LDSCTL_OFF + 512);
    LAS int* HIST = (LAS int*)(lds + LDSCTL_OFF + 768);
    const int wave0 = __builtin_amdgcn_readfirstlane(threadIdx.x >> 6);
    const int G = gridDim.x; const int bx = blockIdx.x; const int vcu = (G % 8 == 0) ? (bx % 8) * (G / 8) + bx / 8 : bx;
    unsigned char* const ws0 = args.ws;
    unsigned* const ctl = (unsigned*)(ws0 + WS_CTL);
    for (int u = threadIdx.x; u < (LDS_BYTES - LDSCTL_OFF) / 4; u += NWAVES * 64) ((LAS unsigned*)(lds + LDSCTL_OFF))[u] = 0u;
    __syncthreads();
    const int lo = args.ph_lo, hi = args.ph_hi;
    XcdBarrier bar; bar.bar = ctl + CW_BAR; bar.x = 0; bar.st = nullptr;
    if (hi - lo > 1) bar = xcd_barrier_post(ctl + CW_BAR, MISC + 8);
#define IN(k) (lo <= (k) && (k) < hi)
#define SEAM(k) do { if (IN(k) && IN((k) + 1)) { PHASE_IDS(); xcd_barrier(bar, tid == 0); } } while (0)
#define WSP(T, off) ((T*)(ws + (off)))

    for (int rep_ = 0; rep_ < DUP_P0; ++rep_) if (IN(0)) {
        PHASE_IDS();
        bf16_t* WinT = WSP(bf16_t, WS_WIN); bf16_t* WoutT = WSP(bf16_t, WS_WOUT); bf16_t* W13T = WSP(bf16_t, WS_W13); bf16_t* W2C = WSP(bf16_t, WS_W2C); bf16_t* WrT = WSP(bf16_t, WS_WR);
        bf16_t* hbuf = WSP(bf16_t, WS_H); float* ssq1 = WSP(float, WS_SSQ1); float* tinfo = WSP(float, WS_TINFO);
#pragma unroll 1
        for (int lg = vcu; lg < 32; lg += G) { const int l = lg >> 4, g = lg & 15;
            const S5P SP{args.in[10] + l * 1024, args.in[11] + l * 1024, args.in[12] + l * 16, args.in[13] + (size_t)l * 16384, args.in[14] + (size_t)l * 16384, args.in[15] + (size_t)l * 16384, args.in[16] + (size_t)l * 16384,
                         args.in[17] + l * 256, args.in[18] + (size_t)l * 4096, args.in[19] + l * 256};
            int tidp = tid; asm volatile("" : "+v"(tidp));
            s5_tables_block(lds, tidp, SP, g, ws + WS_S5T + (size_t)lg * S5T_BYTES); }
        LAS float* scr = (LAS float*)(lds + wave * 16384);
        const int gw = vcu * NWAVES + wave, NGW = G * NWAVES;
        constexpr int I_WIN = 16 * 80, I_WOUT = 16 * 32, I_W13 = 16 * 16, I_W2 = 4 * 32, I_WR = 16;
        constexpr int T_WIN = 2 * I_WIN, T_WOUT = 2 * I_WOUT, T_W13 = 32 * I_W13, T_W2 = 32 * I_W2, T_WR = 4 * I_WR;
        constexpr int NITEMS = T_WIN + T_WOUT + T_W13 + T_W2 + T_WR;
        const int nskip = G >= 64 ? 32 : 0; const int igw = (vcu - nskip) * NWAVES + wave, INGW = (G - nskip) * NWAVES;
#pragma unroll 1
        for (int it = igw; it < NITEMS && vcu >= nskip; it += INGW) {
            int r = it;
            if (r < T_WIN) { const int l = r / I_WIN, q = r % I_WIN, kb = q / 80, nb = q % 80; GetWin gt{args.in[3] + (size_t)l * DM * DINSRC, args.in[2] + l * DM};
                tr_item(gt, WinT + (size_t)l * NIN * DM, DM, 64 * kb, 32 * nb, scr, lane); continue; } r -= T_WIN;
            if (r < T_WOUT) { const int l = r / I_WOUT, q = r % I_WOUT, kb = q / 32, nb = q % 32; GetWout gt{args.in[21] + (size_t)l * DM * DM, args.in[9] + l * 512, args.in[20] + l * 256};
                tr_item(gt, WoutT + (size_t)l * DM * DM, DM, 64 * kb, 32 * nb, scr, lane); continue; } r -= T_WOUT;
            if (r < T_W13) { const int le = r / I_W13, q = r % I_W13, kb = q / 16, nb = q % 16; const int l = le / 16; GetW13 gt{args.in[27] + (size_t)le * DM * 256, args.in[28] + (size_t)le * DM * 256, args.in[22] + l * DM};
                tr_item(gt, W13T + (size_t)le * 512 * DM, DM, 64 * kb, 32 * nb, scr, lane); continue; } r -= T_W13;
            if (r < T_W2) { const int le = r / I_W2, q = r % I_W2, kb = q / 32, nb = q % 32; GetW2 gt{args.in[29] + (size_t)le * 256 * DM};
                tr_item(gt, W2C + (size_t)le * DM * 256, 256, 64 * kb, 32 * nb, scr, lane); continue; } r -= T_W2;
            { const int lh = r / I_WR, kb = r % I_WR; const int l = lh >> 1, lo_ = lh & 1; GetWr gt{args.in[23] + (size_t)l * DM * 4, args.in[25] + (size_t)l * DM * 16, args.in[22] + l * DM, lo_};
                tr_item(gt, WrT + (size_t)lh * 32 * DM, DM, 64 * kb, 0, scr, lane); }
        }
#pragma unroll 1
        for (int r0 = 2 * gw; r0 < MROWS; r0 += 2 * NGW) {
            f32x4 v[2][4];
#pragma unroll
            for (int q = 0; q < 2; ++q) { const int r = r0 + q;
#pragma unroll
                for (int j = 0; j < 4; ++j) { if (r < NREAL) v[q][j] = *(const f32x4*)(args.in[0] + (size_t)r * DM + 4 * lane + 256 * j); else if (r < NTOK) v[q][j] = *(const f32x4*)(args.in[1] + (size_t)(r - NREAL) * DM + 4 * lane + 256 * j); else v[q][j] = (f32x4){0.f, 0.f, 0.f, 0.f}; } }
#pragma unroll
            for (int q = 0; q < 2; ++q) { const int r = r0 + q; float s = 0.f;
#pragma unroll
                for (int j = 0; j < 4; ++j) { u32x2 w; w.x = pk2(v[q][j][0], v[q][j][1]); w.y = pk2(v[q][j][2], v[q][j][3]); *(u32x2*)(hbuf + (size_t)r * DM + 4 * lane + 256 * j) = w;
                    s += bflo(w.x) * bflo(w.x) + bfhi(w.x) * bfhi(w.x) + bflo(w.y) * bflo(w.y) + bfhi(w.y) * bfhi(w.y); }
                s = wave_sum(s);
                if (lane < 16) ssq1[(size_t)r * 16 + lane] = lane == 0 ? s : 0.f;
                if (r >= NTOK && lane < 4) tinfo[(size_t)r * 4 + lane] = 0.f; }
        }
    }
    SEAM(0);

#pragma unroll 1
    for (int l = 0; l < DEPTH; ++l) {
        const int P = 1 + 7 * l;
        for (int rep_ = 0; rep_ < DUP_G1; ++rep_) if (IN(P)) {
            PHASE_IDS();
            bf16_t* hbuf = WSP(bf16_t, WS_H); bf16_t* proj = WSP(bf16_t, WS_PROJ); float* flog = WSP(float, WS_FLOG); const float* ssq1 = WSP(float, WS_SSQ1);
            const bf16_t* Win = WSP(bf16_t, WS_WIN) + (size_t)l * NIN * DM; const float* fb = args.in[4] + l * 8;
            DenseOrder S; S.init(hbuf, Win, NREAL, NIN, DM, DM, G, bx);
            EpiProj E{proj, flog, ssq1, fb};
            pg8::gemm_phase<EpiProj, DenseOrder, true, false>(lds, tid, DM, DM, S, E);
#pragma unroll 1
            for (int cb = bx; cb < 10; cb += G) {
                f32x4 acc[2]; meta_gemm16(hbuf + (size_t)NREAL * DM, Win, DM, cb * 256, wave, lane, acc);
                const int m = lane & 15, q4 = lane >> 4, row = NREAL + m;
                const float rs = row_rstd16(ssq1, row, q4, 1.f / DM);
#pragma unroll
                for (int j = 0; j < 2; ++j) { const f32x4 v = acc[j] * rs; const int col = cb * 256 + 32 * wave + 16 * j + 4 * q4;
                    if (cb < 9) { u32x2 w; w.x = cvt_pk_bf16(v[0], v[1]); w.y = cvt_pk_bf16(v[2], v[3]); *(u32x2*)(proj + (size_t)row * PJ + col) = w; }
                    else if (wave == 0 && j == 0 && q4 < 2) { f32x4 o;
#pragma unroll
                        for (int e = 0; e < 4; ++e) { const float f = v[e] + fb[4 * q4 + e]; o[e] = -log2f(1.f + exp2f(-f * LOG2E)); }
                        *(f32x4*)(flog + (size_t)row * 8 + 4 * q4) = o; } }
            }
        }
        SEAM(P);
        for (int rep_ = 0; rep_ < DUP_MIX; ++rep_) if (IN(P + 1)) {
            PHASE_IDS();
            const bf16_t* proj = WSP(bf16_t, WS_PROJ); bf16_t* mixed = WSP(bf16_t, WS_MIX); const float* flog = WSP(float, WS_FLOG); float* ssqa = WSP(float, WS_SSQA); float* ssqs = WSP(float, WS_SSQS);
            for (int repa_ = 0; repa_ < DUP_ATT; ++repa_)
#pragma unroll 1
            for (int vc = vcu; vc < 256; vc += G) {
                int bh = vc >> 2; asm volatile("" : "+s"(bh));
                const int b = bh >> 3, h = bh & 7;
                attn_prefix(lds, tid, flog, b, h);
#pragma unroll 1
                for (int i = 0; i < 4; ++i) { const int s = (vc & 3) * 2 + (i >> 1); int qt = (i & 1) ? 15 - s : s; asm volatile("" : "+s"(qt)); int tid3 = tid; asm volatile("" : "+v"(tid3)); attn_unit(lds, tid3, proj, mixed, ssqa, b, h, qt); }
            }
#pragma unroll 1
            for (int vc = vcu; vc < 8; vc += G) { int hh = vc; asm volatile("" : "+s"(hh)); int tid3 = tid; asm volatile("" : "+v"(tid3)); attn_prefix(lds, tid3, flog, 0, hh); attn_unit(lds, tid3, proj, mixed, ssqa, 0, hh, -1); }
            const float* cw = args.in[5] + (size_t)l * 31 * 256; const float* cbp = args.in[6] + l * 256; const float* clg = args.in[7] + l * 256; const float* clb = args.in[8] + l * 256;
            for (int repc_ = 0; repc_ < DUP_CS; ++repc_)
#pragma unroll 1
            for (int vc = vcu; vc < 256; vc += G) {
                int tid2 = tid; asm volatile("" : "+v"(tid2));
                if ((vc & 1) == 0) { const int ci = vc >> 1;
                    conv_unit(lds, tid2, proj, mixed, cw, cbp, clg, clb, ci >> 4, NMETA + 256 * (ci & 15), 4, 64);
                } else {
                    if (vc == 1) conv_unit(lds, tid2, proj, mixed, cw, cbp, clg, clb, 0, 0, 1, 16);
                    int ug = vc >> 1; asm volatile("" : "+s"(ug));
                    s5_unit(lds, tid2, ws + WS_S5T + (size_t)(l * 16 + (ug & 15)) * S5T_BYTES, args.in[18] + (size_t)l * 4096 + (ug & 15) * 256, args.in[19] + l * 256 + (ug & 15) * 16, proj, mixed, ssqs, ug >> 4, ug & 15);
                }
            }
        }
        SEAM(P + 1);
        if (IN(P + 2)) {
            PHASE_IDS();
            bf16_t* mixed = WSP(bf16_t, WS_MIX); const float* ssqa = WSP(float, WS_SSQA); const float* ssqs = WSP(float, WS_SSQS);
            const int gw = vcu * NWAVES + wave, NGW = G * NWAVES;
#pragma unroll 1
            for (int r = gw; r < NTOK; r += NGW) {
                float sa = lane < 8 ? ssqa[(size_t)r * 8 + lane] : 0.f, ss = lane < 16 ? ssqs[(size_t)r * 16 + lane] : 0.f;
                sa = wave_sum(sa); ss = wave_sum(ss);
                const float ra = rsqrtf(sa * (1.f / 512.f) + EPS), rsm = rsqrtf(ss * (1.f / 256.f) + EPS);
                bf16_t* p = mixed + (size_t)r * DM;
                u32x4 a = *(u32x4*)(p + 8 * lane);
                a.x = cvt_pk_bf16(bflo(a.x) * ra, bfhi(a.x) * ra); a.y = cvt_pk_bf16(bflo(a.y) * ra, bfhi(a.y) * ra); a.z = cvt_pk_bf16(bflo(a.z) * ra, bfhi(a.z) * ra); a.w = cvt_pk_bf16(bflo(a.w) * ra, bfhi(a.w) * ra);
                *(u32x4*)(p + 8 * lane) = a;
                u32x2 s2 = *(u32x2*)(p + MX_SSM + 4 * lane);
                s2.x = cvt_pk_bf16(bflo(s2.x) * rsm, bfhi(s2.x) * rsm); s2.y = cvt_pk_bf16(bflo(s2.y) * rsm, bfhi(s2.y) * rsm);
                *(u32x2*)(p + MX_SSM + 4 * lane) = s2;
            }
        }
        SEAM(P + 2);
        if (IN(P + 3)) {
            PHASE_IDS();
            bf16_t* hbuf = WSP(bf16_t, WS_H); const bf16_t* mixed = WSP(bf16_t, WS_MIX); float* ssq2 = WSP(float, WS_SSQ2); const bf16_t* Wo = WSP(bf16_t, WS_WOUT) + (size_t)l * DM * DM;
            DenseOrder S; S.init(mixed, Wo, NREAL, DM, DM, DM, G, bx);
            EpiRes<false> E{hbuf, ssq2, CN, nullptr};
            pg8::gemm_phase<EpiRes<false>, DenseOrder, true, false>(lds, tid, DM, DM, S, E);
            LAS float* mscr = (LAS float*)lds;
#pragma unroll 1
            for (int cb = bx; cb < 4; cb += G) {
                f32x4 acc[2]; meta_gemm16(mixed + (size_t)NREAL * DM, Wo, DM, cb * 256, wave, lane, acc);
                const int m = lane & 15, q4 = lane >> 4, row = NREAL + m; float sq = 0.f;
#pragma unroll
                for (int j = 0; j < 2; ++j) { bf16_t* p = hbuf + (size_t)row * DM + cb * 256 + 32 * wave + 16 * j + 4 * q4; const u32x2 o = *(const u32x2*)p; u32x2 w;
                    w.x = cvt_pk_bf16(bflo(o.x) + acc[j][0], bfhi(o.x) + acc[j][1]); w.y = cvt_pk_bf16(bflo(o.y) + acc[j][2], bfhi(o.y) + acc[j][3]); *(u32x2*)p = w;
                    sq += bflo(w.x) * bflo(w.x) + bfhi(w.x) * bfhi(w.x) + bflo(w.y) * bflo(w.y) + bfhi(w.y) * bfhi(w.y); }
                sq += __shfl_xor(sq, 16); sq += __shfl_xor(sq, 32);
                if (q4 == 0) mscr[m * 8 + wave] = sq;
                __syncthreads();
                if (wave == 0) ssq2[(size_t)row * 16 + cb * 4 + q4] = mscr[m * 8 + 2 * q4] + mscr[m * 8 + 2 * q4 + 1];
                __syncthreads();
            }
        }
        SEAM(P + 3);
        if (IN(P + 4)) {
            PHASE_IDS();
            const bf16_t* hbuf = WSP(bf16_t, WS_H); const float* ssq2 = WSP(float, WS_SSQ2); float* tinfo = WSP(float, WS_TINFO); int* list = WSP(int, WS_LIST);
            unsigned* gcnt = ctl + CW_CNT + l * 32;
            const bf16_t* Whi = WSP(bf16_t, WS_WR) + (size_t)(2 * l) * 32 * DM; const bf16_t* Wlo = Whi + (size_t)32 * DM;
            LAS float* scr = (LAS float*)(lds + wave * 4352);
#pragma unroll 1
            for (int base = 0; base < 1025; base += G * 4) {
                const int grp = base + bx * 4 + wave;
                const bool active = wave < 4 && grp < 1025;
                int cls = 0, posl = 0, tok = 0; bool valid = false; float rstd = 0.f, gA = 0.f, gB = 0.f;
                if (active) {
                    const int r32 = lane & 31, hh = lane >> 5; const int rowA = grp * 32 + r32 < NTOK ? grp * 32 + r32 : DUMMY_ROW;
                    f32x16 acc = {};
                    const bf16_t* ap = hbuf + (size_t)rowA * DM + 8 * hh; const bf16_t* bh_ = Whi + (size_t)r32 * DM + 8 * hh; const bf16_t* bl_ = Wlo + (size_t)r32 * DM + 8 * hh;
#pragma unroll 4
                    for (int k0 = 0; k0 < DM; k0 += 16) { const bf16x8 a = *(const bf16x8*)(ap + k0), b0 = *(const bf16x8*)(bh_ + k0), b1 = *(const bf16x8*)(bl_ + k0);
                        acc = __builtin_amdgcn_mfma_f32_32x32x16_bf16(a, b0, acc, 0, 0, 0); acc = __builtin_amdgcn_mfma_f32_32x32x16_bf16(a, b1, acc, 0, 0, 0); }
#pragma unroll
                    for (int r = 0; r < 16; ++r) scr[crow(r, hh) * 33 + r32] = acc[r];
                    LDS_WAIT(); asm volatile("" ::: "memory");
                    tok = grp * 32 + r32; valid = hh == 0 && tok < NTOK;
                    if (valid) {
                        float s = 0.f;
#pragma unroll
                        for (int q = 0; q < 4; ++q) { const f32x4 v = *(const f32x4*)(ssq2 + (size_t)tok * 16 + 4 * q); s += (v.x + v.y) + (v.z + v.w); }
                        rstd = rsqrtf(s * (1.f / DM) + EPS);
                        float lg[4]; const float* bg = args.in[24] + l * 4; const float* be = args.in[26] + l * 16;
#pragma unroll
                        for (int i = 0; i < 4; ++i) lg[i] = scr[r32 * 33 + i] * rstd + bg[i];
                        int gs = 0; float mx = lg[0];
#pragma unroll
                        for (int i = 1; i < 4; ++i) if (lg[i] > mx) { mx = lg[i]; gs = i; }
                        float se = 0.f;
#pragma unroll
                        for (int i = 0; i < 4; ++i) se += expf(lg[i] - mx);
                        const float pg = 1.f / se;
                        float le[4];
#pragma unroll
                        for (int i = 0; i < 4; ++i) le[i] = scr[r32 * 33 + 4 + 4 * gs + i] * rstd + be[4 * gs + i];
                        int i1 = 0; float v1 = le[0];
#pragma unroll
                        for (int i = 1; i < 4; ++i) if (le[i] > v1) { v1 = le[i]; i1 = i; }
                        int i2 = -1; float v2 = -INFINITY;
#pragma unroll
                        for (int i = 0; i < 4; ++i) if (i != i1 && le[i] > v2) { v2 = le[i]; i2 = i; }
                        const float w1 = pg / (1.f + expf(v2 - v1)), w2 = pg - w1;
                        const int a = i1 < i2 ? i1 : i2, bb = i1 < i2 ? i2 : i1;
                        gA = i1 < i2 ? w1 : w2; gB = i1 < i2 ? w2 : w1;
                        cls = gs * 6 + (a == 0 ? bb - 1 : (a == 1 ? bb + 1 : 5));
                        posl = __hip_atomic_fetch_add(&HIST[cls], 1, __ATOMIC_RELAXED, __HIP_MEMORY_SCOPE_WORKGROUP);
                    }
                }
                __syncthreads();
                if (tid < NCLS) { const int n = HIST[tid]; HIST[32 + tid] = n ? (int)__hip_atomic_fetch_add(gcnt + tid, (unsigned)n, __ATOMIC_RELAXED, __HIP_MEMORY_SCOPE_AGENT) : 0; }
                __syncthreads();
                if (valid) { const int pos = HIST[32 + cls] + posl; list[(size_t)cls * NTOK + pos] = tok; *(f32x4*)(tinfo + (size_t)tok * 4) = (f32x4){rstd, gA, gB, 0.f}; }
                __syncthreads();
                if (tid < NCLS) HIST[tid] = 0;
                __syncthreads();
            }
        }
        SEAM(P + 4);
        if (IN(P + 5) || IN(P + 6)) {
            unsigned* gcnt = ctl + CW_CNT + l * 32;
            PHASE_IDS();
            if (tid == 0) { int run = 0; for (int c = 0; c < NCLS; ++c) { const int n = (int)__hip_atomic_load(gcnt + c, __ATOMIC_RELAXED, __HIP_MEMORY_SCOPE_AGENT); CN[c] = n; TB[c] = run; run += (n + 255) >> 8; } TB[NCLS] = run; }
            __syncthreads();
        }
        for (int rep_ = 0; rep_ < DUP_E1; ++rep_) if (IN(P + 5)) {
            PHASE_IDS();
            const int* list = WSP(int, WS_LIST);
            ExpertOrder S{TB, CN, list, (const char*)WSP(bf16_t, WS_H), (const char*)WSP(bf16_t, WS_W13), G, bx, 1, l};
            EpiE1 E{WSP(bf16_t, WS_H1), WSP(float, WS_TINFO), CN, list};
            pg8::gemm_phase<EpiE1, ExpertOrder, true, true>(lds, tid, DM, DM, S, E);
        }
        SEAM(P + 5);
        if (IN(P + 6)) {
            PHASE_IDS();
            const int* list = WSP(int, WS_LIST);
            ExpertOrder S{TB, CN, list, (const char*)WSP(bf16_t, WS_H1), (const char*)WSP(bf16_t, WS_W2C), G, bx, 2, l};
            EpiRes<true> E{WSP(bf16_t, WS_H), WSP(float, WS_SSQ1), CN, list};
            pg8::gemm_phase<EpiRes<true>, ExpertOrder, true, false, true>(lds, tid, 512, 256, S, E);
        }
        SEAM(P + 6);
    }
    if (IN(15)) {
        PHASE_IDS();
        const bf16_t* hbuf = WSP(bf16_t, WS_H); const float* ssq1 = WSP(float, WS_SSQ1);
        const int gw = vcu * NWAVES + wave, NGW = G * NWAVES; const float* gF = args.in[30];
        f32x4 gv[4];
#pragma unroll
        for (int j = 0; j < 4; ++j) gv[j] = *(const f32x4*)(gF + 4 * lane + 256 * j);
#pragma unroll 1
        for (int r = gw; r < NREAL; r += NGW) {
            float s = lane < 16 ? ssq1[(size_t)r * 16 + lane] : 0.f; s = wave_sum(s);
            const float rs = rsqrtf(s * (1.f / DM) + EPS);
#pragma unroll
            for (int j = 0; j < 4; ++j) { const u32x2 w = *(const u32x2*)(hbuf + (size_t)r * DM + 4 * lane + 256 * j);
                f32x4 o; o[0] = bflo(w.x) * rs * gv[j][0]; o[1] = bfhi(w.x) * rs * gv[j][1]; o[2] = bflo(w.y) * rs * gv[j][2]; o[3] = bfhi(w.y) * rs * gv[j][3];
                *(f32x4*)(args.out + (size_t)r * DM + 4 * lane + 256 * j) = o; }
        }
    }
#undef IN
#undef SEAM
#undef WSP
}

extern "C" void kernel_launch(void* const* d_in, const int* in_sizes, int n_in, void* d_out, int out_size, void* d_ws, size_t ws_size, hipStream_t stream) {
    static int grid = 0;
    if (grid == 0) {
        if (n_in != 31 || out_size != NREAL * DM || ws_size < WS_END) { fprintf(stderr, "kernel_launch: unexpected shapes (n_in %d, out %d, ws %zu)\n", n_in, out_size, ws_size); grid = -1; return; }
        int dev = 0, cus = 0, per_cu = 0;
        if (hipGetDevice(&dev) != hipSuccess || hipDeviceGetAttribute(&cus, hipDeviceAttributeMultiprocessorCount, dev) != hipSuccess) { grid = -1; return; }
        if (hipFuncSetAttribute((const void*)hymba_fwd, hipFuncAttributeMaxDynamicSharedMemorySize, LDS_BYTES) != hipSuccess) { fprintf(stderr, "kernel_launch: hipFuncSetAttribute failed\n"); grid = -1; return; }
        if (hipOccupancyMaxActiveBlocksPerMultiprocessor(&per_cu, (const void*)hymba_fwd, NWAVES * 64, LDS_BYTES) != hipSuccess || per_cu < 1) { fprintf(stderr, "kernel_launch: occupancy query says %d\n", per_cu); }
        (void)hipGetLastError();
        grid = cus;
    }
    if (grid < 0) return;
    (void)in_sizes;
    if (hipMemsetAsync((char*)d_ws + WS_CTL, 0, CTL_BYTES, stream) != hipSuccess) return;
    Args a{};
    for (int i = 0; i < 31; ++i) a.in[i] = (const float*)d_in[i];
    a.out = (float*)d_out; a.ws = (unsigned char*)d_ws;
#if MK_PER_PHASE
    for (int p = 0; p < N_PHASES; ++p) { a.ph_lo = p; a.ph_hi = p + 1; hipLaunchKernelGGL(hymba_fwd, dim3(grid), dim3(NWAVES * 64), LDS_BYTES, stream, a); }
#else
    a.ph_lo = 0; a.ph_hi = N_PHASES;
    hipLaunchKernelGGL(hymba_fwd, dim3(grid), dim3(NWAVES * 64), LDS_BYTES, stream, a);
#endif
}
```

```cpp
#include <hip/hip_runtime.h>
#include <cstdio>
#include <cstdint>

#ifndef PROBE_A
#define PROBE_A -1
#endif
#ifndef PROBE_B
#define PROBE_B -1
#endif
#ifndef PROBE_BLOCK
#define PROBE_BLOCK 0
#endif
#ifndef PROBE_SCALE
#define PROBE_SCALE 4.0f
#endif
constexpr int CW_TS = 20480;
#ifndef DUP_ATT
#define DUP_ATT 1
#endif
#ifndef DUP_CS
#define DUP_CS 1
#endif
#ifndef DUP_G1
#define DUP_G1 1
#endif
#ifndef DUP_MIX
#define DUP_MIX 1
#endif
#ifndef DUP_E1
#define DUP_E1 1
#endif
#ifndef DUP_P0
#define DUP_P0 1
#endif
#ifndef MK_PER_PHASE
#define MK_PER_PHASE 0
#endif

#define LAS __attribute__((address_space(3)))
#define GAS __attribute__((address_space(1)))
typedef unsigned short bf16_t;
typedef short bf16x8 __attribute__((ext_vector_type(8)));
typedef short s16x4 __attribute__((ext_vector_type(4)));
typedef float f32x4 __attribute__((ext_vector_type(4)));
typedef float f32x2 __attribute__((ext_vector_type(2)));
typedef float f32x16 __attribute__((ext_vector_type(16)));
typedef unsigned u32x4 __attribute__((ext_vector_type(4)));
typedef unsigned u32x2 __attribute__((ext_vector_type(2)));

constexpr int NB = 8, SEQ = 4096, NMETA = 16, DM = 1024, DEPTH = 2;
constexpr int NREAL = NB * SEQ;
constexpr int NTOK = NREAL + NMETA;
constexpr int MROWS = 33024;
constexpr int DUMMY_ROW = NTOK;
constexpr int PJ = 2304;
constexpr int NIN = 2560;
constexpr int DINSRC = 2312;
constexpr int PQ = 512, PK = 1024, PV = 1536, PU = 2048;
constexpr int MX_ATT = 0, MX_SSM = 512, MX_CONV = 768;
constexpr int NCLS = 24;
constexpr float EPS = 1e-6f;
constexpr float LOG2E = 1.4426950408889634f;
constexpr int H1CAP = 40960;

constexpr size_t MiB = 1u << 20;
constexpr size_t WS_CTL = 0, CTL_BYTES = 1 * MiB;
constexpr size_t WS_WIN = 2 * MiB, WS_WOUT = 12 * MiB, WS_W13 = 16 * MiB, WS_W2C = 48 * MiB, WS_WR = 96 * MiB;
constexpr size_t WS_H = 100 * MiB, WS_PROJ = 165 * MiB, WS_MIX = 311 * MiB, WS_H1 = 376 * MiB;
constexpr size_t WS_FLOG = 416 * MiB, WS_SSQ1 = 418 * MiB, WS_SSQ2 = 421 * MiB, WS_SSQA = 424 * MiB, WS_SSQS = 426 * MiB, WS_TINFO = 429 * MiB, WS_LIST = 430 * MiB, WS_S5T = 434 * MiB, WS_END = 440 * MiB;
constexpr int CW_TMO = 0, CW_BAR = 4096, CW_CNT = 16384;

constexpr int RING_BYTES = 131072;
constexpr int LDSCTL_OFF = RING_BYTES;
constexpr int LDS_BYTES = 147456;
constexpr int NWAVES = 8;

#define LDS_WAIT() asm volatile("s_waitcnt lgkmcnt(0)" ::: "memory")
#define VM_WAIT() asm volatile("s_waitcnt vmcnt(0)" ::: "memory")

__device__ __forceinline__ unsigned f2bf(float f) { unsigned u = __float_as_uint(f); return (u + 0x7fffu + ((u >> 16) & 1u)) >> 16; }
__device__ __forceinline__ unsigned pk2(float lo, float hi) { return f2bf(lo) | (f2bf(hi) << 16); }
__device__ __forceinline__ float bflo(unsigned w) { return __uint_as_float(w << 16); }
__device__ __forceinline__ float bfhi(unsigned w) { return __uint_as_float(w & 0xffff0000u); }
__device__ __forceinline__ float bf2f(bf16_t b) { return __uint_as_float(((unsigned)b) << 16); }
__device__ __forceinline__ unsigned cvt_pk_bf16(float lo, float hi) { unsigned r; asm volatile("v_cvt_pk_bf16_f32 %0, %1, %2" : "=v"(r) : "v"(lo), "v"(hi)); return r; }
__device__ __forceinline__ float wave_sum(float v) {
#pragma unroll
    for (int o = 1; o < 64; o <<= 1) v += __shfl_xor(v, o);
    return v;
}
__device__ __forceinline__ float fast_exp2(float x) { return __builtin_amdgcn_exp2f(x); }
__device__ __forceinline__ float fast_rcp(float x) { return __builtin_amdgcn_rcpf(x); }
__device__ __forceinline__ float sigmoidf_(float x) { return fast_rcp(1.f + fast_exp2(-x * LOG2E)); }
__device__ __forceinline__ float siluf_(float x) { return x * sigmoidf_(x); }
__device__ __forceinline__ int rowof(int b, int t) { return t < NMETA ? NREAL + t : b * SEQ + (t - NMETA); }

namespace pg8 {
constexpr int BM = 256, BK = 64, HALF = 128, HTB = HALF * BK * 2, STAGE_BYTES = 8 * HTB;
__host__ __device__ __forceinline__ int lds_byte(int r, int c) { const int st = (r >> 4) * 2 + (c >> 5), rr = r & 15, cc = c & 31, ob = rr * 64 + cc * 2; return st * 1024 + (ob ^ (((ob >> 9) & 1) << 5)); }
__host__ __device__ __forceinline__ void stage_rc(int b, int& R, int& C) { const int st = b / 1024, sb = b % 1024, swz = sb ^ (((sb >> 9) & 1) << 5); R = (st >> 1) * 16 + swz / 64; C = (st & 1) * 32 + (swz % 64) / 2; }
__host__ __device__ __forceinline__ int perm32(int rho) { const int n = rho >> 4, i = rho & 15; return 8 * (i >> 2) + 4 * n + (i & 3); }

struct Unit { int pm, pn, cls, p0; };

template <class Epi, class Sched, bool ALIGN_EPI, bool GATHER, bool BSPLIT = false>
__device__ __forceinline__ void gemm_phase(LAS unsigned char* lds, const int tid, const int K, const int ldb, const Sched& S, const Epi& E) {
    const int wid = __builtin_amdgcn_readfirstlane(tid >> 6), lane = tid & 63, wr = wid >> 2, wc = wid & 3, fr = lane & 15, fq = lane >> 4;
    const int nt = K / BK;
    unsigned voffA[2], voffB[2]; int RA[2], CA[2];
#pragma unroll
    for (int i = 0; i < 2; ++i) { int R, C; stage_rc(tid * 16 + i * 8192, R, C); const int Rb = (R & ~31) + perm32(R & 31);
        voffA[i] = (unsigned)(R * K + C) * 2u; voffB[i] = (unsigned)(Rb * ldb + C) * 2u; RA[i] = R; CA[i] = C; }
    const size_t kstep = (size_t)(BK * 2);
    const size_t hstepA = (size_t)HALF * K * 2, hstepB = (size_t)HALF * ldb * 2;
    const size_t pstepA = (size_t)64 * K * 2, pstepB = (size_t)64 * ldb * 2;
    const unsigned ldsw = (unsigned)wid * 1024u;
    const int aoff = lds_byte(wr * 64 + fr, fq * 8), boff = lds_byte(wc * 32 + fr, fq * 8);
#define PG8_SA(b, h) (((b) * 2 + (h)) * HTB)
#define PG8_SB(b, h) ((4 + (b) * 2 + (h)) * HTB)
#define PG8_STAGE(bufoff, gbase, voff) do { _Pragma("unroll") for (int _i = 0; _i < 2; ++_i) \
        __builtin_amdgcn_global_load_lds((const unsigned*)((const char*)(gbase) + (voff)[_i]), (LAS unsigned*)(lds + (bufoff) + ldsw + _i * 8192), 16, 0, 0); } while (0)
#define PG8_STAGE1(bufoff, gbase, voff1, step) do { _Pragma("unroll") for (int _i = 0; _i < 2; ++_i) \
        __builtin_amdgcn_global_load_lds((const unsigned*)((const char*)(gbase) + (size_t)_i * (step) + (voff1)), (LAS unsigned*)(lds + (bufoff) + ldsw + _i * 8192), 16, 0, 0); } while (0)
#define PG8_LDA(dst, b, h) do { _Pragma("unroll") for (int m = 0; m < 4; ++m) _Pragma("unroll") for (int k = 0; k < 2; ++k) dst[m][k] = *(const LAS bf16x8*)(lds + PG8_SA(b, h) + aoff + m * 2048 + k * 1024); } while (0)
#define PG8_LDB(dst, b, h) do { _Pragma("unroll") for (int n = 0; n < 2; ++n) _Pragma("unroll") for (int k = 0; k < 2; ++k) dst[n][k] = *(const LAS bf16x8*)(lds + PG8_SB(b, h) + boff + n * 2048 + k * 1024); } while (0)
#define PG8_MMA(ai, bj, At, Bt) do { __builtin_amdgcn_s_setprio(1); _Pragma("unroll") for (int m = 0; m < 4; ++m) _Pragma("unroll") for (int n = 0; n < 2; ++n) _Pragma("unroll") for (int k = 0; k < 2; ++k) \
        acc[ai][bj][m][n] = __builtin_amdgcn_mfma_f32_16x16x32_bf16(Bt[n][k], At[m][k], acc[ai][bj][m][n], 0, 0, 0); __builtin_amdgcn_s_setprio(0); } while (0)
#define PG8_WAIT_V(n) asm volatile("s_waitcnt vmcnt(" #n ")" ::: "memory")
#define PG8_WAIT_L(n) asm volatile("s_waitcnt lgkmcnt(" #n ")" ::: "memory")
#define PG8_BAR __builtin_amdgcn_s_barrier()
#define PG8_SCHED __builtin_amdgcn_sched_barrier(0)
    Unit cur, nxt; int ui = 0;
    if (!S.next(0, cur)) return;
    f32x4 acc[2][2][4][2];
#pragma unroll
    for (int a = 0; a < 2; ++a)
#pragma unroll
        for (int b = 0; b < 2; ++b)
#pragma unroll
            for (int m = 0; m < 4; ++m)
#pragma unroll
                for (int n = 0; n < 2; ++n) acc[a][b][m][n] = (f32x4){0.f, 0.f, 0.f, 0.f};
    bf16x8 At[4][2], B0[2][2], B1[2][2];
    const char* cA = S.abase(cur); const char* cB = S.bbase(cur);
    const char* cB2 = cB; const int ksp = BSPLIT ? nt / 2 : (1 << 30);
    if constexpr (BSPLIT) cB2 = S.bbase2(cur) - (size_t)ksp * kstep;
    unsigned oC[2][2], oN[2][2];
    if constexpr (GATHER) {
#pragma unroll
        for (int h = 0; h < 2; ++h)
#pragma unroll
            for (int i = 0; i < 2; ++i) oC[h][i] = (unsigned)S.rowtok(cur, h * HALF + RA[i]) * (unsigned)(K * 2) + (unsigned)(CA[i] * 2);
    }
    PG8_STAGE1(PG8_SB(0, 0), cB, voffB[0], pstepB); PG8_STAGE1(PG8_SB(0, 1), cB + hstepB, voffB[0], pstepB);
    if constexpr (GATHER) { PG8_STAGE(PG8_SA(0, 0), cA, oC[0]); PG8_STAGE(PG8_SA(0, 1), cA, oC[1]); }
    else { PG8_STAGE1(PG8_SA(0, 0), cA, voffA[0], pstepA); PG8_STAGE1(PG8_SA(0, 1), cA + hstepA, voffA[0], pstepA); }
    if (wr == 1) PG8_BAR;
    PG8_WAIT_V(2); PG8_BAR;
    PG8_STAGE1(PG8_SB(1, 0), cB + kstep, voffB[0], pstepB);
    if constexpr (GATHER) { PG8_STAGE(PG8_SA(1, 0), cA + kstep, oC[0]); } else { PG8_STAGE1(PG8_SA(1, 0), cA + kstep, voffA[0], pstepA); }
    PG8_STAGE1(PG8_SB(1, 1), cB + hstepB + kstep, voffB[0], pstepB);
    PG8_WAIT_V(6); PG8_BAR;
    for (;;) {
        const bool has_next = S.next(ui + 1, nxt);
        const char* nA = has_next ? S.abase(nxt) : cA; const char* nB = has_next ? S.bbase(nxt) : cB;
        const char* nB2 = nB; if constexpr (BSPLIT) nB2 = has_next ? S.bbase2(nxt) - (size_t)ksp * kstep : cB2;
        if constexpr (GATHER) {
#pragma unroll
            for (int h = 0; h < 2; ++h)
#pragma unroll
                for (int i = 0; i < 2; ++i) oN[h][i] = has_next ? (unsigned)S.rowtok(nxt, h * HALF + RA[i]) * (unsigned)(K * 2) + (unsigned)(CA[i] * 2) : oC[h][i];
        }
        for (int t = 0; t < nt; t += 2) {
            const bool last = (t == nt - 2);
            const char* a1 = cA + (size_t)(t + 1) * kstep;
            const char* a2 = last ? nA : cA + (size_t)(t + 2) * kstep; const char* b2 = last ? nB : ((t + 2 < ksp) ? cB : cB2) + (size_t)(t + 2) * kstep;
            const char* a3 = a2 + kstep; const char* b3 = b2 + kstep;
            unsigned s0[2], s1[2];
            if constexpr (GATHER) { s0[0] = last ? oN[0][0] : oC[0][0]; s0[1] = last ? oN[0][1] : oC[0][1]; s1[0] = last ? oN[1][0] : oC[1][0]; s1[1] = last ? oN[1][1] : oC[1][1]; }
            PG8_LDB(B0, 0, 0); PG8_LDB(B1, 0, 1); PG8_SCHED; PG8_LDA(At, 0, 0);
            if constexpr (GATHER) { PG8_STAGE(PG8_SA(1, 1), a1, oC[1]); } else { PG8_STAGE1(PG8_SA(1, 1), a1 + hstepA, voffA[0], pstepA); }
            PG8_WAIT_V(8); PG8_WAIT_L(0); PG8_BAR; PG8_MMA(0, 0, At, B0); PG8_MMA(0, 1, At, B1); PG8_BAR; PG8_SCHED;
            PG8_LDA(At, 0, 1); PG8_STAGE1(PG8_SB(0, 0), b2, voffB[0], pstepB); PG8_STAGE1(PG8_SB(0, 1), b2 + hstepB, voffB[0], pstepB);
            if constexpr (GATHER) { PG8_STAGE(PG8_SA(0, 0), a2, s0); } else { PG8_STAGE1(PG8_SA(0, 0), a2, voffA[0], pstepA); }
            PG8_WAIT_V(8); PG8_WAIT_L(0); PG8_BAR; PG8_MMA(1, 0, At, B0); PG8_MMA(1, 1, At, B1); PG8_BAR; PG8_SCHED;
            PG8_LDB(B0, 1, 0); PG8_LDB(B1, 1, 1); PG8_SCHED; PG8_LDA(At, 1, 0);
            if constexpr (GATHER) { PG8_STAGE(PG8_SA(0, 1), a2, s1); } else { PG8_STAGE1(PG8_SA(0, 1), a2 + hstepA, voffA[0], pstepA); }
            PG8_WAIT_V(8); PG8_WAIT_L(0); PG8_BAR; PG8_MMA(0, 0, At, B0); PG8_MMA(0, 1, At, B1); PG8_BAR; PG8_SCHED;
            PG8_LDA(At, 1, 1); PG8_STAGE1(PG8_SB(1, 0), b3, voffB[0], pstepB); PG8_STAGE1(PG8_SB(1, 1), b3 + hstepB, voffB[0], pstepB);
            if constexpr (GATHER) { PG8_STAGE(PG8_SA(1, 0), a3, s0); } else { PG8_STAGE1(PG8_SA(1, 0), a3, voffA[0], pstepA); }
            PG8_WAIT_V(8); PG8_WAIT_L(0); PG8_BAR; PG8_MMA(1, 0, At, B0); PG8_MMA(1, 1, At, B1); PG8_BAR; PG8_SCHED;
        }
        if constexpr (ALIGN_EPI) { if (wr == 0) PG8_BAR; }
        { int ln_; asm volatile("v_mbcnt_lo_u32_b32 %0, -1, 0\n\tv_mbcnt_hi_u32_b32 %0, -1, %0" : "=v"(ln_)); E(acc, cur, wr, wc, ln_ & 15, ln_ >> 4); }
        if (!has_next) break;
#pragma unroll
        for (int a = 0; a < 2; ++a)
#pragma unroll
            for (int b = 0; b < 2; ++b)
#pragma unroll
                for (int m = 0; m < 4; ++m)
#pragma unroll
                    for (int n = 0; n < 2; ++n) acc[a][b][m][n] = (f32x4){0.f, 0.f, 0.f, 0.f};
        cur = nxt; cA = nA; cB = nB; cB2 = nB2; ++ui;
        if constexpr (GATHER) {
#pragma unroll
            for (int h = 0; h < 2; ++h)
#pragma unroll
                for (int i = 0; i < 2; ++i) oC[h][i] = oN[h][i];
        }
        if constexpr (ALIGN_EPI) { if (wr == 1) PG8_BAR; }
    }
    PG8_WAIT_V(0);
    if constexpr (!ALIGN_EPI) { if (wr == 0) PG8_BAR; }
    PG8_BAR;
#undef PG8_SA
#undef PG8_SB
#undef PG8_STAGE
#undef PG8_STAGE1
#undef PG8_LDA
#undef PG8_LDB
#undef PG8_MMA
#undef PG8_WAIT_V
#undef PG8_WAIT_L
#undef PG8_BAR
#undef PG8_SCHED
}
}
using pg8::Unit;

struct DenseOrder {
    const char* A; const char* Bt; size_t tstepA, tstepB; int nM, nN, nwg, G, c;
    __device__ __forceinline__ void init(const void* A_, const void* Bt_, int M, int N, int K, int ldb, int G_, int c_) {
        A = (const char*)A_; Bt = (const char*)Bt_; tstepA = (size_t)256 * K * 2; tstepB = (size_t)256 * ldb * 2; nM = M / 256; nN = N / 256; nwg = nM * nN; G = G_; c = c_; }
    __device__ __forceinline__ bool next(int i, Unit& u) const {
        const long L = (long)i * G + c; if (L >= nwg) return false;
        int wgid = (int)L; { const int q = nwg / 8, r = nwg % 8, xcd = wgid % 8, off = wgid / 8; wgid = (xcd < r ? xcd * (q + 1) : r * (q + 1) + (xcd - r) * q) + off; }
        const int nig = 8 * nN, gid = wgid / nig, fm = gid * 8, gsz = (nM - fm) < 8 ? (nM - fm) : 8;
        u.pm = fm + ((wgid % nig) % gsz); u.pn = (wgid % nig) / gsz; u.cls = 0; u.p0 = 0; return true;
    }
    __device__ __forceinline__ const char* abase(const Unit& u) const { return A + (size_t)u.pm * tstepA; }
    __device__ __forceinline__ const char* bbase(const Unit& u) const { return Bt + (size_t)u.pn * tstepB; }
    __device__ __forceinline__ const char* bbase2(const Unit& u) const { return bbase(u); }
    __device__ __forceinline__ int rowtok(const Unit&, int) const { return 0; }
};

__device__ __forceinline__ void cls_experts(int cls, int& eA, int& eB) { const int g = cls / 6, p = cls % 6; const int a = (p >= 3) + (p >= 5), b = p < 3 ? p + 1 : (p < 5 ? p - 1 : 3); eA = 4 * g + a; eB = 4 * g + b; }
struct ExpertOrder {
    const LAS int* tb; const LAS int* cn; const int* list; const char* A; const char* W; int G, c, mode, layer;
    __device__ __forceinline__ bool next(int i, Unit& u) const {
        const int nwg = __builtin_amdgcn_readfirstlane(tb[NCLS]) * 4; const long L = (long)i * G + c; if (L >= nwg) return false;
        int wgid = (int)L; { const int q = nwg / 8, r = nwg % 8, xcd = wgid % 8, off = wgid / 8; wgid = (xcd < r ? xcd * (q + 1) : r * (q + 1) + (xcd - r) * q) + off; }
        const int rt = wgid >> 2; int cls = 0;
        for (int k = 1; k < NCLS; ++k) cls += (rt >= tb[k]) ? 1 : 0;
        cls = __builtin_amdgcn_readfirstlane(cls);
        u.pm = rt; u.pn = wgid & 3; u.cls = cls; u.p0 = __builtin_amdgcn_readfirstlane((rt - tb[cls]) * 256); return true;
    }
    __device__ __forceinline__ const char* abase(const Unit& u) const { return mode == 1 ? A : A + (size_t)u.pm * (256 * 512 * 2); }
    __device__ __forceinline__ const char* bbase(const Unit& u) const {
        if (mode == 1) { int eA, eB; cls_experts(u.cls, eA, eB); const int e = (u.pn >> 1) ? eB : eA; return W + ((size_t)(layer * 16 + e) * 512 + (size_t)(u.pn & 1) * 256) * (1024 * 2); }
        int eA, eB; cls_experts(u.cls, eA, eB); return W + ((size_t)(layer * 16 + eA) * 1024 + (size_t)u.pn * 256) * (256 * 2);
    }
    __device__ __forceinline__ const char* bbase2(const Unit& u) const { int eA, eB; cls_experts(u.cls, eA, eB); return W + ((size_t)(layer * 16 + eB) * 1024 + (size_t)u.pn * 256) * (256 * 2); }
    __device__ __forceinline__ int rowtok(const Unit& u, int rr) const { const int pos = u.p0 + rr; return pos < cn[u.cls] ? list[(size_t)u.cls * NTOK + pos] : DUMMY_ROW; }
};

__device__ __forceinline__ float row_rstd16(const float* ssq, int row, int fq, float inv_n) {
    const f32x4 v = *(const f32x4*)(ssq + (size_t)row * 16 + 4 * fq);
    float s = (v.x + v.y) + (v.z + v.w);
    s += __shfl_xor(s, 16); s += __shfl_xor(s, 32);
    return rsqrtf(s * inv_n + EPS);
}

struct EpiProj {
    bf16_t* proj; float* flog; const float* ssq1; const float* fb;
    __device__ __forceinline__ void operator()(const f32x4 (&acc)[2][2][4][2], const Unit& u, int wr, int wc, int fr, int fq) const {
#pragma unroll
        for (int ai = 0; ai < 2; ++ai)
#pragma unroll
            for (int m = 0; m < 4; ++m) {
                const int row = u.pm * 256 + ai * 128 + wr * 64 + m * 16 + fr;
                const float rs = row_rstd16(ssq1, row, fq, 1.f / DM);
                if (u.pn < 9) {
#pragma unroll
                    for (int bj = 0; bj < 2; ++bj) { const f32x4 v0 = acc[ai][bj][m][0] * rs, v1 = acc[ai][bj][m][1] * rs; u32x4 w;
                        w.x = cvt_pk_bf16(v0[0], v0[1]); w.y = cvt_pk_bf16(v0[2], v0[3]); w.z = cvt_pk_bf16(v1[0], v1[1]); w.w = cvt_pk_bf16(v1[2], v1[3]);
                        *(u32x4*)(proj + (size_t)row * PJ + u.pn * 256 + bj * 128 + wc * 32 + 8 * fq) = w; }
                } else if (wc == 0 && fq == 0) {
                    f32x4 o0, o1;
#pragma unroll
                    for (int e = 0; e < 4; ++e) { const float f0 = acc[ai][0][m][0][e] * rs + fb[e], f1 = acc[ai][0][m][1][e] * rs + fb[4 + e];
                        o0[e] = -log2f(1.f + exp2f(-f0 * LOG2E)); o1[e] = -log2f(1.f + exp2f(-f1 * LOG2E)); }
                    *(f32x4*)(flog + (size_t)row * 8) = o0; *(f32x4*)(flog + (size_t)row * 8 + 4) = o1;
                }
            }
    }
};
template <bool TOKMAP> struct EpiRes {
    bf16_t* h; float* ssq; const LAS int* cn; const int* list;
    __device__ __forceinline__ void operator()(const f32x4 (&acc)[2][2][4][2], const Unit& u, int wr, int wc, int fr, int fq) const {
#pragma unroll
        for (int ai = 0; ai < 2; ++ai)
#pragma unroll
            for (int m = 0; m < 4; ++m) {
                const int rr = ai * 128 + wr * 64 + m * 16 + fr; int row;
                if constexpr (TOKMAP) { const int pos = u.p0 + rr; row = pos < cn[u.cls] ? list[(size_t)u.cls * NTOK + pos] : DUMMY_ROW; } else row = u.pm * 256 + rr;
                float sq = 0.f;
#pragma unroll
                for (int bj = 0; bj < 2; ++bj) { bf16_t* p = h + (size_t)row * DM + u.pn * 256 + bj * 128 + wc * 32 + 8 * fq; const u32x4 o = *(const u32x4*)p;
                    const f32x4 a0 = acc[ai][bj][m][0], a1 = acc[ai][bj][m][1]; u32x4 w;
                    w.x = cvt_pk_bf16(bflo(o.x) + a0[0], bfhi(o.x) + a0[1]); w.y = cvt_pk_bf16(bflo(o.y) + a0[2], bfhi(o.y) + a0[3]);
                    w.z = cvt_pk_bf16(bflo(o.z) + a1[0], bfhi(o.z) + a1[1]); w.w = cvt_pk_bf16(bflo(o.w) + a1[2], bfhi(o.w) + a1[3]);
                    *(u32x4*)p = w;
                    sq += bflo(w.x) * bflo(w.x) + bfhi(w.x) * bfhi(w.x) + bflo(w.y) * bflo(w.y) + bfhi(w.y) * bfhi(w.y) + bflo(w.z) * bflo(w.z) + bfhi(w.z) * bfhi(w.z) + bflo(w.w) * bflo(w.w) + bfhi(w.w) * bfhi(w.w); }
                sq += __shfl_xor(sq, 16); sq += __shfl_xor(sq, 32);
                if (fq == 0) ssq[(size_t)row * 16 + u.pn * 4 + wc] = sq;
            }
    }
};
struct EpiE1 {
    bf16_t* H1; const float* tinfo; const LAS int* cn; const int* list;
    __device__ __forceinline__ void operator()(const f32x4 (&acc)[2][2][4][2], const Unit& u, int wr, int wc, int fr, int fq) const {
#pragma unroll
        for (int ai = 0; ai < 2; ++ai)
#pragma unroll
            for (int m = 0; m < 4; ++m) {
                const int rr = ai * 128 + wr * 64 + m * 16 + fr; const int pos = u.p0 + rr;
                const int tok = pos < cn[u.cls] ? list[(size_t)u.cls * NTOK + pos] : DUMMY_ROW;
                const f32x4 ti = *(const f32x4*)(tinfo + (size_t)tok * 4);
                const float rs = ti.x, gate = (u.pn >> 1) ? ti.z : ti.y;
                float o[8];
#pragma unroll
                for (int n = 0; n < 2; ++n)
#pragma unroll
                    for (int e = 0; e < 4; ++e) { const float a = acc[ai][0][m][n][e] * rs, b = acc[ai][1][m][n][e] * rs; o[n * 4 + e] = gate * siluf_(a) * b; }
                u32x4 w; w.x = cvt_pk_bf16(o[0], o[1]); w.y = cvt_pk_bf16(o[2], o[3]); w.z = cvt_pk_bf16(o[4], o[5]); w.w = cvt_pk_bf16(o[6], o[7]);
                *(u32x4*)(H1 + (size_t)(u.pm * 256 + rr) * 512 + (u.pn >> 1) * 256 + (u.pn & 1) * 128 + wc * 32 + 8 * fq) = w;
            }
    }
};

__device__ __forceinline__ void meta_gemm16(const bf16_t* A, const bf16_t* Bt, int K, int n0, int wave, int lane, f32x4 (&acc)[2]) {
    const int m = lane & 15, q4 = lane >> 4;
    acc[0] = (f32x4){0.f, 0.f, 0.f, 0.f}; acc[1] = acc[0];
    const bf16_t* ap = A + (size_t)m * K + 8 * q4;
    const bf16_t* bp0 = Bt + (size_t)(n0 + 32 * wave + m) * K + 8 * q4; const bf16_t* bp1 = bp0 + (size_t)16 * K;
#pragma unroll 8
    for (int k0 = 0; k0 < K; k0 += 32) {
        const bf16x8 a = *(const bf16x8*)(ap + k0), b0 = *(const bf16x8*)(bp0 + k0), b1 = *(const bf16x8*)(bp1 + k0);
        acc[0] = __builtin_amdgcn_mfma_f32_16x16x32_bf16(b0, a, acc[0], 0, 0, 0);
        acc[1] = __builtin_amdgcn_mfma_f32_16x16x32_bf16(b1, a, acc[1], 0, 0, 0);
    }
}

#define XB_TMO      128
#define XB_XCNT(j)  (256  + 64 * (j))
#define XB_XSUB(j)  (1280 + 64 * (j))
#define XB_XGEN(j)  (2304 + 64 * (j))
#define XB_TOP      3328
#define XB_TOPGEN   3392
#define XCD_BAR_WORDS 3456
#define XB_SPIN_CAP (1u << 18)
__device__ __forceinline__ unsigned xb_ld(unsigned* p)              { return __hip_atomic_load(p, __ATOMIC_RELAXED, __HIP_MEMORY_SCOPE_AGENT); }
__device__ __forceinline__ unsigned xb_add(unsigned* p, unsigned v) { return __hip_atomic_fetch_add(p, v, __ATOMIC_RELAXED, __HIP_MEMORY_SCOPE_AGENT); }
__device__ __forceinline__ unsigned xb_xcc_id() { return (unsigned)__builtin_amdgcn_s_getreg((3 << 11) | 20) & 0xFu; }
#define XB_SPIN(cond, bar) do { unsigned _sp = 0; while (cond) { __builtin_amdgcn_s_sleep(1); \
    if ((++_sp & 255u) == 0u) { if (xb_ld(&(bar)[XB_TMO])) break; if (_sp > XB_SPIN_CAP) { atomicAdd(&(bar)[XB_TMO], 1u); break; } } } } while (0)
struct XcdBarrier { unsigned* bar; unsigned x; volatile LAS unsigned* st; };
__device__ __forceinline__ XcdBarrier xcd_barrier_post(unsigned* bar, volatile LAS unsigned* st) {
    XcdBarrier b; b.bar = bar; b.x = xb_xcc_id(); b.st = st;
    if (threadIdx.x == 0) (void)xb_add(&bar[XB_XCNT(b.x)], 1u);
    return b;
}
__device__ __forceinline__ void xcd_barrier_complete(unsigned* bar, unsigned x, unsigned& nloc, unsigned& nx) {
    const unsigned G = gridDim.x * gridDim.y * gridDim.z;
    unsigned sum, cnt, mine, sp = 0u;
    for (;;) {
        sum = 0u; cnt = 0u; mine = 0u;
#pragma unroll
        for (unsigned j = 0; j < 16; ++j) { const unsigned c = xb_ld(&bar[XB_XCNT(j)]); sum += c; cnt += (c > 0u) ? 1u : 0u; mine = (j == x) ? c : mine; }
        if (sum == G) break;
        __builtin_amdgcn_s_sleep(1);
        if ((++sp & 255u) == 0u) { if (xb_ld(&bar[XB_TMO])) break; if (sp > XB_SPIN_CAP) { atomicAdd(&bar[XB_TMO], 1u); break; } }
    }
    nloc = mine > 0u ? mine : 1u; nx = cnt > 0u ? cnt : 1u;
}
__device__ __forceinline__ void xcd_barrier(const XcdBarrier& b, const bool leader_thread) {
    asm volatile("s_waitcnt vmcnt(0)" ::: "memory");
    __syncthreads();
    if (leader_thread) {
        unsigned* bar = b.bar; asm volatile("" : "+s"(bar));
        __builtin_amdgcn_s_waitcnt(0);
        unsigned nloc = b.st[0], nx = b.st[1];
        if (nloc == 0u) { xcd_barrier_complete(bar, b.x, nloc, nx); b.st[0] = nloc; b.st[1] = nx; }
        const unsigned old = xb_add(&bar[XB_XSUB(b.x)], 1u);
        const unsigned gen = old / nloc;
        if (old + 1u == (gen + 1u) * nloc) {
            __builtin_amdgcn_fence(__ATOMIC_RELEASE, "agent");
            asm volatile("s_waitcnt vmcnt(0)" ::: "memory");
            const unsigned og = xb_add(&bar[XB_TOP], 1u);
            const unsigned tg = og / nx;
            if (og + 1u == (tg + 1u) * nx) xb_add(&bar[XB_TOPGEN], 1u);
            else XB_SPIN(xb_ld(&bar[XB_TOPGEN]) == tg, bar);
            __builtin_amdgcn_fence(__ATOMIC_ACQUIRE, "agent");
            xb_add(&bar[XB_XGEN(b.x)], 1u);
            asm volatile("s_waitcnt vmcnt(0)" ::: "memory");
        } else {
            XB_SPIN(xb_ld(&bar[XB_XGEN(b.x)]) == gen, bar);
            __builtin_amdgcn_fence(__ATOMIC_ACQUIRE, "agent");
            asm volatile("s_waitcnt vmcnt(0)" ::: "memory");
        }
    }
    __syncthreads();
}

template <class Get>
__device__ __forceinline__ void tr_item(const Get& get, bf16_t* dst, int dpitch, int k0, int n0, LAS float* scr, int lane) {
    float tv[32];
#pragma unroll
    for (int i = 0; i < 32; ++i) tv[i] = get(k0 + 2 * i + (lane >> 5), n0 + (lane & 31));
#pragma unroll
    for (int i = 0; i < 32; ++i) scr[(2 * i + (lane >> 5)) * 33 + (lane & 31)] = tv[i];
    LDS_WAIT(); asm volatile("" ::: "memory");
    const int c = lane & 7;
#pragma unroll
    for (int j = 0; j < 4; ++j) { const int n = (lane >> 3) + 8 * j; const LAS float* s = scr + (8 * c) * 33 + n;
        u32x4 o; o.x = pk2(s[0 * 33], s[1 * 33]); o.y = pk2(s[2 * 33], s[3 * 33]); o.z = pk2(s[4 * 33], s[5 * 33]); o.w = pk2(s[6 * 33], s[7 * 33]);
        *(u32x4*)(dst + (size_t)(n0 + n) * dpitch + k0 + 8 * c) = o; }
    LDS_WAIT(); asm volatile("" ::: "memory");
}
struct GetWin { const float* w; const float* g;
    __device__ __forceinline__ float operator()(int k, int n) const { int src; if (n < 2048) src = n; else if (n < 2304) src = n + 8; else if (n < 2312) src = n - 256; else return 0.f;
        float v = w[(size_t)k * DINSRC + src] * g[k]; if (n >= PQ && n < PK) v *= 0.125f * LOG2E; return v; } };
struct GetWout { const float* w; const float* ga; const float* gs;
    __device__ __forceinline__ float operator()(int k, int n) const { const int src = k < 768 ? k + 256 : k - 768; const float gn = k < 512 ? ga[k] : (k < 768 ? gs[k - 512] : 1.f);
        return w[(size_t)src * DM + n] * gn; } };
struct GetW13 { const float* w1; const float* w3; const float* g;
    __device__ __forceinline__ float operator()(int k, int n) const { const int u = n >> 8, hf = (n >> 7) & 1, j = n & 127; const uintptr_t wp = (uintptr_t)w1 + (uintptr_t)hf * ((uintptr_t)w3 - (uintptr_t)w1); return ((const float*)wp)[(size_t)k * 256 + u * 128 + j] * g[k]; } };
struct GetW2 { const float* w;
    __device__ __forceinline__ float operator()(int k, int n) const { return w[(size_t)k * DM + n]; } };
struct GetWr { const float* rg; const float* re; const float* g; int lo;
    __device__ __forceinline__ float operator()(int k, int n) const { float v = 0.f; if (n < 4) v = rg[(size_t)k * 4 + n]; else if (n < 20) v = re[(size_t)k * 16 + (n - 4)]; v *= g[k];
        if (lo) v = v - __uint_as_float(f2bf(v) << 16); return v; } };

constexpr int AT_SLOT = 16384, AT_CS = 81920, AT_WT = AT_CS + 4608 * 4;
__device__ __forceinline__ int crow(int r, int hi) { return (r & 3) + 8 * (r >> 2) + 4 * hi; }
__device__ __forceinline__ void attn_prefix(LAS unsigned char* lds, const int tid, const float* flog, int b, int h) {
    const int lane = tid & 63; const int w = __builtin_amdgcn_readfirstlane(tid >> 6);
    LAS float* cs = (LAS float*)(lds + AT_CS); LAS float* wt = (LAS float*)(lds + AT_WT);
    float v[9]; float run = 0.f;
#pragma unroll
    for (int i = 0; i < 9; ++i) { const int j = tid * 9 + i; float x = 0.f; if (j < NMETA + SEQ) x = flog[(size_t)rowof(b, j) * 8 + h]; run += x; v[i] = run; }
    float inc = run;
#pragma unroll
    for (int o = 1; o < 64; o <<= 1) { const float t = __shfl_up(inc, o); if (lane >= o) inc += t; }
    if (lane == 63) wt[w] = inc;
    __syncthreads();
    float base = inc - run;
    for (int k = 0; k < w; ++k) base += wt[k];
#pragma unroll
    for (int i = 0; i < 9; ++i) cs[tid * 9 + i] = base + v[i];
    __syncthreads();
}
__device__ __forceinline__ void at_glds16(const void* gsrc, unsigned lds_dst) { unsigned keep;
    asm volatile("s_mov_b32 %0, m0\n\ts_mov_b32 m0, %2\n\ts_nop 0\n\tglobal_load_lds_dwordx4 %1, off\n\ts_mov_b32 m0, %0" : "=&s"(keep) : "v"(gsrc), "s"(lds_dst) : "memory"); }
constexpr float AT_THR = 8.f;
__device__ __forceinline__ void attn_unit(LAS unsigned char* lds, const int tid, const bf16_t* proj, bf16_t* mixed, float* ssqa, int b, int h, int qt) {
    const int lane = tid & 63, r32 = lane & 31, hi = lane >> 5; const int w = __builtin_amdgcn_readfirstlane(tid >> 6);
    const LAS float* cs = (const LAS float*)(lds + AT_CS);
    const int qrel = 32 * w + r32;
    const int qrow = qt >= 0 ? b * SEQ + 256 * qt + qrel : NREAL + (qrel & 15);
    const int qkey = qt >= 0 ? NMETA + 256 * qt + qrel : (qrel & 15);
    const int qkey_w0 = qt >= 0 ? NMETA + 256 * qt + 32 * w : 0;
    const float cq = cs[qkey];
    bf16x8 qr[4];
#pragma unroll
    for (int d0 = 0; d0 < 4; ++d0) qr[d0] = *(const bf16x8*)(proj + (size_t)qrow * PJ + PQ + h * 64 + d0 * 16 + hi * 8);
    const int ntiles = qt >= 0 ? 1 + 4 * (qt + 1) : 1;
    const int wnt = qt >= 0 ? 4 * qt + (w >> 1) + 2 : 1;
    const int vr = 16 * (w & 3) + (lane >> 2);
    const unsigned ldsb = (unsigned)(uintptr_t)lds;
#define AT_DMA(jj) do { int kr_, vr_; if ((jj) == 0) { kr_ = NREAL + (lane < 15 ? lane : 15); vr_ = NREAL + (vr < 15 ? vr : 15); } else { kr_ = b * SEQ + 64 * ((jj) - 1) + lane; vr_ = b * SEQ + 64 * ((jj) - 1) + vr; } \
        const int so_ = AT_SLOTOF(sj, (jj) - jbase) + w * 1024; \
        at_glds16(proj + (size_t)kr_ * PJ + PK + h * 64 + w * 8, (unsigned)__builtin_amdgcn_readfirstlane(ldsb + so_)); \
        at_glds16(proj + (size_t)vr_ * PJ + PV + h * 64 + (w >> 2) * 32 + (lane & 3) * 8, (unsigned)__builtin_amdgcn_readfirstlane(ldsb + so_ + 8192)); } while (0)
#define AT_WAITBAR(n) asm volatile("s_waitcnt vmcnt(" #n ") lgkmcnt(0)\n\ts_barrier" ::: "memory")
    float mref = 0.f, lrun = 0.f; f32x16 o0 = {}, o1 = {};
    const int kfo = hi * 1024 + r32 * 16;
    const int vb = 8192 + ((lane >> 4) & 1) * 32 + (lane & 3) * 8 + (4 * hi + ((lane & 15) >> 2)) * 64;
    const LAS float* csl = cs + 4 * hi;
    bf16x8 kf[8];
#define AT_KLOAD(P0, P1, jjn) do { const int kb_ = (jjn) == 0 ? 0 : NMETA + 64 * ((jjn) - 1); const float cqm = cq - mref; const int so_ = AT_SLOTOF(sj, (jjn) - jbase); \
        _Pragma("unroll") for (int d0 = 0; d0 < 4; ++d0) { kf[2 * d0] = *(const LAS bf16x8*)(lds + so_ + kfo + d0 * 2048); kf[2 * d0 + 1] = *(const LAS bf16x8*)(lds + so_ + kfo + d0 * 2048 + 512); } \
        _Pragma("unroll") for (int g_ = 0; g_ < 4; ++g_) { const f32x4 c0_ = *(const LAS f32x4*)(csl + kb_ + 8 * g_), c1_ = *(const LAS f32x4*)(csl + kb_ + 32 + 8 * g_); \
            _Pragma("unroll") for (int e_ = 0; e_ < 4; ++e_) { P0[4 * g_ + e_] = cqm - c0_[e_]; P1[4 * g_ + e_] = cqm - c1_[e_]; } } \
        __builtin_amdgcn_sched_barrier(0); } while (0)
#define AT_QKM(P0, P1) do { _Pragma("unroll") for (int d0 = 0; d0 < 4; ++d0) { \
            P0 = __builtin_amdgcn_mfma_f32_32x32x16_bf16(kf[2 * d0], qr[d0], P0, 0, 0, 0); P1 = __builtin_amdgcn_mfma_f32_32x32x16_bf16(kf[2 * d0 + 1], qr[d0], P1, 0, 0, 0); } \
        __builtin_amdgcn_sched_barrier(0); } while (0)
#define AT_MX3(a, b, c) __builtin_fmaxf(__builtin_fmaxf((a), (b)), (c))
#define AT_SMPV(P0, P1, N0, N1, jj, pend) do { const int kb_ = (jj) == 0 ? 0 : NMETA + 64 * ((jj) - 1); \
        const LAS unsigned char* Vb_ = lds + AT_SLOTOF(sj, (jj) - jbase) + vb; s16x4 va_[8], vc_[8]; \
        _Pragma("unroll") for (int ks = 0; ks < 4; ++ks) { \
            va_[2 * ks] = __builtin_bit_cast(s16x4, __builtin_amdgcn_ds_read_tr16_b64_v4i16((LAS s16x4*)(Vb_ + ks * 1024))); \
            va_[2 * ks + 1] = __builtin_bit_cast(s16x4, __builtin_amdgcn_ds_read_tr16_b64_v4i16((LAS s16x4*)(Vb_ + ks * 1024 + 512))); } \
        __builtin_amdgcn_sched_barrier(0); \
        if ((jj) == 0 || kb_ + 63 > qkey_w0) { const int lim_ = (jj) == 0 ? (qkey < 15 ? qkey : 15) : qkey; \
            _Pragma("unroll") for (int r = 0; r < 16; ++r) { const int j_ = kb_ + crow(r, hi); if (j_ > lim_) P0[r] = -INFINITY; if (j_ + 32 > lim_) P1[r] = -INFINITY; } } \
        float ra_ = AT_MX3(P0[0], P0[1], P1[0]), rb_ = AT_MX3(P0[2], P0[3], P1[1]); ra_ = AT_MX3(ra_, P1[2], P1[3]); \
        _Pragma("unroll") for (int r = 4; r < 16; r += 4) { ra_ = AT_MX3(ra_, P0[r], P0[r + 1]); rb_ = AT_MX3(rb_, P0[r + 2], P0[r + 3]); ra_ = AT_MX3(ra_, P1[r], P1[r + 1]); rb_ = AT_MX3(rb_, P1[r + 2], P1[r + 3]); } \
        float rm_ = fmaxf(ra_, rb_); \
        rm_ = fmaxf(rm_, __shfl_xor(rm_, 32)); \
        if ((jj) == 0 || __any(rm_ > AT_THR)) { const float dl_ = (jj) == 0 ? rm_ : fmaxf(rm_, 0.f); mref += dl_; const float f_ = (jj) == 0 ? 1.f : fast_exp2(-dl_); lrun *= f_; \
            _Pragma("unroll") for (int r = 0; r < 16; ++r) { P0[r] -= dl_; P1[r] -= dl_; o0[r] *= f_; o1[r] *= f_; } \
            if (pend) { _Pragma("unroll") for (int r = 0; r < 16; ++r) { N0[r] -= dl_; N1[r] -= dl_; } } } \
        float rs_ = 0.f; \
        _Pragma("unroll") for (int r = 0; r < 16; ++r) { P0[r] = fast_exp2(P0[r]); P1[r] = fast_exp2(P1[r]); rs_ += P0[r] + P1[r]; } \
        lrun += rs_; \
        u32x4 pw_[4]; \
        _Pragma("unroll") for (int i = 0; i < 4; ++i) { pw_[0][i] = cvt_pk_bf16(P0[2 * i], P0[2 * i + 1]); pw_[1][i] = cvt_pk_bf16(P0[8 + 2 * i], P0[8 + 2 * i + 1]); \
            pw_[2][i] = cvt_pk_bf16(P1[2 * i], P1[2 * i + 1]); pw_[3][i] = cvt_pk_bf16(P1[8 + 2 * i], P1[8 + 2 * i + 1]); } \
        __builtin_amdgcn_sched_barrier(0); \
        _Pragma("unroll") for (int ks = 0; ks < 4; ++ks) { \
            vc_[2 * ks] = __builtin_bit_cast(s16x4, __builtin_amdgcn_ds_read_tr16_b64_v4i16((LAS s16x4*)(Vb_ + 4096 + ks * 1024))); \
            vc_[2 * ks + 1] = __builtin_bit_cast(s16x4, __builtin_amdgcn_ds_read_tr16_b64_v4i16((LAS s16x4*)(Vb_ + 4096 + ks * 1024 + 512))); } \
        _Pragma("unroll") for (int ks = 0; ks < 4; ++ks) { \
            const bf16x8 va = {va_[2 * ks][0], va_[2 * ks][1], va_[2 * ks][2], va_[2 * ks][3], va_[2 * ks + 1][0], va_[2 * ks + 1][1], va_[2 * ks + 1][2], va_[2 * ks + 1][3]}; \
            o0 = __builtin_amdgcn_mfma_f32_32x32x16_bf16(va, __builtin_bit_cast(bf16x8, pw_[ks]), o0, 0, 0, 0); } \
        __builtin_amdgcn_sched_barrier(0); \
        _Pragma("unroll") for (int ks = 0; ks < 4; ++ks) { \
            const bf16x8 vbb = {vc_[2 * ks][0], vc_[2 * ks][1], vc_[2 * ks][2], vc_[2 * ks][3], vc_[2 * ks + 1][0], vc_[2 * ks + 1][1], vc_[2 * ks + 1][2], vc_[2 * ks + 1][3]}; \
            o1 = __builtin_amdgcn_mfma_f32_32x32x16_bf16(vbb, __builtin_bit_cast(bf16x8, pw_[ks]), o1, 0, 0, 0); } \
        __builtin_amdgcn_sched_barrier(0); } while (0)
#define AT_STEP(C0, C1, N0, N1, jj) do { \
        const bool dma_ = (jj) + 4 < ntiles; \
        if (dma_) AT_DMA((jj) + 4); \
        const bool pend_ = (jj) + 1 < wnt; \
        if (pend_) AT_QKM(N0, N1); \
        if ((jj) < wnt) AT_SMPV(C0, C1, N0, N1, jj, pend_); \
        if ((jj) + 2 < wnt) AT_KLOAD(C0, C1, (jj) + 2); \
        if (dma_) AT_WAITBAR(2); else AT_WAITBAR(0); } while (0)
    int sj = 0, jbase = 0;
#define AT_SLOTOF(s_, k_) (((s_) + (k_) * AT_SLOT) >= 5 * AT_SLOT ? ((s_) + (k_) * AT_SLOT) - 5 * AT_SLOT : ((s_) + (k_) * AT_SLOT))
    AT_DMA(0);
    if (ntiles > 1) AT_DMA(1);
    if (ntiles > 2) AT_DMA(2);
    if (ntiles > 3) { AT_DMA(3); AT_WAITBAR(2); } else AT_WAITBAR(0);
    f32x16 pa0, pa1, pb0, pb1;
    AT_KLOAD(pa0, pa1, 0); AT_QKM(pa0, pa1);
    if (1 < wnt) AT_KLOAD(pb0, pb1, 1);
#pragma unroll 1
    for (int jj = 0; jj < ntiles; jj += 2) {
        jbase = jj;
        AT_STEP(pa0, pa1, pb0, pb1, jj);
        if (jj + 1 < ntiles) AT_STEP(pb0, pb1, pa0, pa1, jj + 1);
        sj = AT_SLOTOF(sj, 2);
    }
#undef AT_SLOTOF
#undef AT_KLOAD
#undef AT_QKM
#undef AT_MX3
#undef AT_DMA
#undef AT_WAITBAR
#undef AT_SMPV
#undef AT_STEP
    const float ltot = lrun + __shfl_xor(lrun, 32);
    const float inv = 1.f / ltot;
    float sq = 0.f;
#pragma unroll
    for (int r = 0; r < 16; ++r) { o0[r] *= inv; o1[r] *= inv; sq += o0[r] * o0[r] + o1[r] * o1[r]; }
    sq += __shfl_xor(sq, 32);
    const bool st = qt >= 0 || qrel < 16;
    if (st) {
        bf16_t* op = mixed + (size_t)qrow * DM + MX_ATT + h * 64;
#pragma unroll
        for (int g = 0; g < 4; ++g) { u32x2 w0, w1; w0.x = cvt_pk_bf16(o0[4 * g], o0[4 * g + 1]); w0.y = cvt_pk_bf16(o0[4 * g + 2], o0[4 * g + 3]); w1.x = cvt_pk_bf16(o1[4 * g], o1[4 * g + 1]); w1.y = cvt_pk_bf16(o1[4 * g + 2], o1[4 * g + 3]);
            *(u32x2*)(op + 8 * g + 4 * hi) = w0; *(u32x2*)(op + 32 + 8 * g + 4 * hi) = w1; }
        if (hi == 0) ssqa[(size_t)qrow * 8 + h] = sq;
    }
    __syncthreads();
}

__device__ __forceinline__ void conv_unit(LAS unsigned char* lds, const int tid, const bf16_t* proj, bf16_t* mixed, const float* cw, const float* cb, const float* lg, const float* lb, int b, int tbase, int nsub, int nvalid) {
    const int lane = tid & 63; const int w = __builtin_amdgcn_readfirstlane(tid >> 6);
    LAS float* ub = (LAS float*)lds;
    const int cp = tid & 127, rg = tid >> 7;
#pragma unroll 1
    for (int sb = 0; sb < nsub; ++sb) {
        const int t0 = tbase + 64 * sb;
        {
            u32x2 av[12], gv[12];
#pragma unroll
            for (int it = 0; it < 12; ++it) { const int idx = tid + 512 * it; const int rr = idx >> 6, cq4 = (idx & 63) * 4; const int t = t0 - 30 + rr; av[it] = (u32x2){0u, 0u}; gv[it] = (u32x2){0u, 0u};
                if (rr < 94 && t >= 0 && t < NMETA + SEQ) { const bf16_t* p = proj + (size_t)rowof(b, t) * PJ + cq4; av[it] = *(const u32x2*)p; gv[it] = *(const u32x2*)(p + 256); } }
#pragma unroll
            for (int it = 0; it < 12; ++it) { const int idx = tid + 512 * it; const int rr = idx >> 6, cq4 = (idx & 63) * 4; f32x4 u;
                u[0] = bflo(av[it].x) * sigmoidf_(bflo(gv[it].x)); u[1] = bfhi(av[it].x) * sigmoidf_(bfhi(gv[it].x)); u[2] = bflo(av[it].y) * sigmoidf_(bflo(gv[it].y)); u[3] = bfhi(av[it].y) * sigmoidf_(bfhi(gv[it].y));
                if (rr < 94) *(LAS f32x4*)(ub + rr * 256 + cq4) = u; }
        }
        f32x2 wv[31];
#pragma unroll
        for (int j = 0; j < 31; ++j) wv[j] = *(const f32x2*)(cw + j * 256 + 2 * cp);
        __syncthreads();
        f32x2 acc[16];
#pragma unroll
        for (int i = 0; i < 16; ++i) acc[i] = (f32x2){0.f, 0.f};
#pragma unroll
        for (int rr = 0; rr < 46; ++rr) { const f32x2 uv = *(const LAS f32x2*)(ub + (16 * rg + rr) * 256 + 2 * cp);
#pragma unroll
            for (int i = 0; i < 16; ++i) if (rr - i >= 0 && rr - i <= 30) acc[i] += wv[rr - i] * uv; }
        __syncthreads();
        { const f32x2 bb = *(const f32x2*)(cb + 2 * cp);
#pragma unroll
        for (int i = 0; i < 16; ++i) *(LAS f32x2*)(ub + (16 * rg + i) * 256 + 2 * cp) = acc[i] + bb; }
        const f32x4 g4 = *(const f32x4*)(lg + 4 * lane), b4 = *(const f32x4*)(lb + 4 * lane);
        __syncthreads();
#pragma unroll
        for (int i = 0; i < 8; ++i) { const int rr = 8 * w + i; const f32x4 y = *(const LAS f32x4*)(ub + rr * 256 + 4 * lane);
            const float mu = wave_sum((y[0] + y[1]) + (y[2] + y[3])) * (1.f / 256.f);
            const f32x4 d = y - mu; const float var = wave_sum((d[0] * d[0] + d[1] * d[1]) + (d[2] * d[2] + d[3] * d[3])) * (1.f / 256.f);
            const float rs = rsqrtf(var + EPS); f32x4 o;
#pragma unroll
            for (int e = 0; e < 4; ++e) o[e] = siluf_(d[e] * rs * g4[e] + b4[e]);
            if (rr < nvalid) { u32x2 wv2; wv2.x = cvt_pk_bf16(o[0], o[1]); wv2.y = cvt_pk_bf16(o[2], o[3]); *(u32x2*)(mixed + (size_t)rowof(b, t0 + rr) * DM + MX_CONV + 4 * lane) = wv2; } }
        __syncthreads();
    }
}

struct S5P { const float *lre, *lim, *ldt, *bre, *bim, *cre, *cim, *dsk, *gw, *gb; };
__device__ __forceinline__ float gelu_tanh(float x) { const float u = 0.7978845608028654f * (x + 0.044715f * x * x * x); const float e = fast_exp2(2.f * LOG2E * u); const float th = 1.f - 2.f * fast_rcp(e + 1.f); return 0.5f * x * (1.f + th); }
__device__ __forceinline__ void s5_seq_unit(const S5P& P, const bf16_t* proj, bf16_t* mixed, float* ssqs, int b, int g, int lane) {
    const int p = lane;
    const float dt = expf(P.ldt[g]);
    const float lr = P.lre[g * 64 + p], li = P.lim[g * 64 + p];
    const float mag = expf(lr * dt);
    const double turns = (double)li * (double)dt * 0.15915494309189535; const float fr = (float)(turns - floor(turns));
    const float ar = mag * __builtin_amdgcn_cosf(fr), ai = mag * __builtin_amdgcn_sinf(fr);
    const float nr = ar - 1.f, ni = ai, den = lr * lr + li * li;
    const float fre = (nr * lr + ni * li) / den, fim = (ni * lr - nr * li) / den;
    float bbr[16], bbi[16], cr[16], ci[16];
#pragma unroll
    for (int h = 0; h < 16; ++h) { const float br = P.bre[(g * 64 + p) * 16 + h], bi = P.bim[(g * 64 + p) * 16 + h]; bbr[h] = fre * br - fim * bi; bbi[h] = fre * bi + fim * br;
        cr[h] = P.cre[(g * 16 + h) * 64 + p]; ci[h] = P.cim[(g * 16 + h) * 64 + p]; }
    const int hl = ((lane >> 5) & 1) * 8 + ((lane >> 4) & 1) * 4 + ((lane >> 3) & 1) * 2 + ((lane >> 2) & 1);
    const float dsk = P.dsk[g * 16 + hl], gbk = P.gb[g * 16 + hl];
    float gwk[16];
#pragma unroll
    for (int h = 0; h < 16; ++h) gwk[h] = P.gw[(g * 16 + h) * 16 + hl];
    float xr = 0.f, xi = 0.f;
    u32x4 nua = *(const u32x4*)(proj + (size_t)rowof(b, 0) * PJ + PU + 16 * g), nub = *(const u32x4*)(proj + (size_t)rowof(b, 0) * PJ + PU + 16 * g + 8);
#pragma unroll 1
    for (int t = 0; t < NMETA + SEQ; ++t) {
        const int row = rowof(b, t);
        const u32x4 ua = nua, ub = nub;
        { const int tn = t + 1 < NMETA + SEQ ? t + 1 : t; const bf16_t* np = proj + (size_t)rowof(b, tn) * PJ + PU + 16 * g; nua = *(const u32x4*)np; nub = *(const u32x4*)(np + 8); }
        float u[16]; u[0] = bflo(ua.x); u[1] = bfhi(ua.x); u[2] = bflo(ua.y); u[3] = bfhi(ua.y); u[4] = bflo(ua.z); u[5] = bfhi(ua.z); u[6] = bflo(ua.w); u[7] = bfhi(ua.w);
        u[8] = bflo(ub.x); u[9] = bfhi(ub.x); u[10] = bflo(ub.y); u[11] = bfhi(ub.y); u[12] = bflo(ub.z); u[13] = bfhi(ub.z); u[14] = bflo(ub.w); u[15] = bfhi(ub.w);
        float bur = 0.f, bui = 0.f;
#pragma unroll
        for (int h = 0; h < 16; ++h) { bur += bbr[h] * u[h]; bui += bbi[h] * u[h]; }
        const float nxr = ar * xr - ai * xi + bur, nxi = ar * xi + ai * xr + bui; xr = nxr; xi = nxi;
        float v[16];
#pragma unroll
        for (int h = 0; h < 16; ++h) v[h] = cr[h] * xr - ci[h] * xi;
        float v8[8], v4[4], v2[2], v1;
        { const bool up = (lane >> 5) & 1;
#pragma unroll
          for (int i = 0; i < 8; ++i) { const float send = up ? v[i] : v[i + 8], keep = up ? v[i + 8] : v[i]; v8[i] = keep + __shfl_xor(send, 32); } }
        { const bool up = (lane >> 4) & 1;
#pragma unroll
          for (int i = 0; i < 4; ++i) { const float send = up ? v8[i] : v8[i + 4], keep = up ? v8[i + 4] : v8[i]; v4[i] = keep + __shfl_xor(send, 16); } }
        { const bool up = (lane >> 3) & 1;
#pragma unroll
          for (int i = 0; i < 2; ++i) { const float send = up ? v4[i] : v4[i + 2], keep = up ? v4[i + 2] : v4[i]; v2[i] = keep + __shfl_xor(send, 8); } }
        { const bool up = (lane >> 2) & 1; const float send = up ? v2[0] : v2[1], keep = up ? v2[1] : v2[0]; v1 = keep + __shfl_xor(send, 4); }
        v1 += __shfl_xor(v1, 2); v1 += __shfl_xor(v1, 1);
        float uh = u[0];
#pragma unroll
        for (int h = 1; h < 16; ++h) uh = (hl == h) ? u[h] : uh;
        const float y = v1 + dsk * uh;
        const float zg = gelu_tanh(y);
        float gate = gbk;
#pragma unroll
        for (int h = 0; h < 16; ++h) { const int src = ((h >> 3) & 1) * 32 + ((h >> 2) & 1) * 16 + ((h >> 1) & 1) * 8 + (h & 1) * 4; gate += __shfl(zg, src) * gwk[h]; }
        const float outv = zg * sigmoidf_(gate);
        float sq = outv * outv;
        sq += __shfl_xor(sq, 32); sq += __shfl_xor(sq, 16); sq += __shfl_xor(sq, 8); sq += __shfl_xor(sq, 4);
        if (t >= NMETA || b == 0) {
            if ((lane & 3) == 0) mixed[(size_t)row * DM + MX_SSM + 16 * g + hl] = (bf16_t)f2bf(outv);
            if (lane == 0) ssqs[(size_t)row * 16 + g] = sq;
        }
    }
}

constexpr size_t S5T_BYTES = 163840;
constexpr int S5_KT = 0, S5_WS = 8704, S5_WC = 74240, S5_MD = 139776, S5_MC = 142848;
constexpr int S5L_KT = 0, S5L_W = 8704, S5L_EX = 78336, S5L_MD = 82944, S5L_MC = 86016;
__device__ __forceinline__ void s5_tables_block(LAS unsigned char* lds, const int tid, const S5P& P, int g, unsigned char* tbl) {
    typedef float f2 __attribute__((ext_vector_type(2)));
    LAS f2* pw = (LAS f2*)lds;
    LAS f2* Bb = (LAS f2*)(lds + 8704);
    LAS f2* Cc = (LAS f2*)(lds + 16896);
    if (tid < 64) {
        const int p = tid;
        const float dt = expf(P.ldt[g]);
        const float lr = P.lre[g * 64 + p], li = P.lim[g * 64 + p];
        const float mag = expf(lr * dt);
        const double turns = (double)li * (double)dt * 0.15915494309189535; const float fr = (float)(turns - floor(turns));
        const float ar = mag * __builtin_amdgcn_cosf(fr), ai = mag * __builtin_amdgcn_sinf(fr);
        const float nr = ar - 1.f, ni = ai, den = lr * lr + li * li;
        const float fre = (nr * lr + ni * li) / den, fim = (ni * lr - nr * li) / den;
        float xr = 1.f, xi = 0.f;
        for (int t = 0; t <= 16; ++t) { pw[t * 64 + p] = (f2){xr, xi}; const float nxr = xr * ar - xi * ai, nxi = xr * ai + xi * ar; xr = nxr; xi = nxi; }
        const f2 M = pw[16 * 64 + p];
        float* MD = (float*)(tbl + S5_MD); float* MC = (float*)(tbl + S5_MC);
        float mr = M.x, mi = M.y;
        for (int k = 0; k < 6; ++k) { MD[(k * 64 + p) * 2] = mr; MD[(k * 64 + p) * 2 + 1] = mi; const float n1 = mr * mr - mi * mi, n2 = 2.f * mr * mi; mr = n1; mi = n2; }
        xr = 1.f; xi = 0.f;
        for (int c = 0; c < 32; ++c) { MC[(c * 64 + p) * 2] = xr; MC[(c * 64 + p) * 2 + 1] = xi; const float nxr = xr * M.x - xi * M.y, nxi = xr * M.y + xi * M.x; xr = nxr; xi = nxi; }
        for (int h = 0; h < 16; ++h) { const float br = P.bre[(g * 64 + p) * 16 + h], bi = P.bim[(g * 64 + p) * 16 + h]; Bb[p * 16 + h] = (f2){fre * br - fim * bi, fre * bi + fim * br}; }
    }
    for (int e = tid; e < 1024; e += 512) Cc[e] = (f2){P.cre[g * 1024 + e], P.cim[g * 1024 + e]};
    __syncthreads();
    bf16_t* KT = (bf16_t*)(tbl + S5_KT); bf16_t* WSg = (bf16_t*)(tbl + S5_WS); bf16_t* WCg = (bf16_t*)(tbl + S5_WC);
    for (int e = tid; e < 17 * 256; e += 512) {
        const int t1 = e >> 8, h = (e >> 4) & 15, h2 = e & 15; float acc = 0.f;
        if (t1 > 0) { const int tau = t1 - 1;
            for (int p = 0; p < 64; ++p) { const f2 a = pw[tau * 64 + p], bb = Bb[p * 16 + h2], c = Cc[h * 64 + p]; const float zr = a.x * bb.x - a.y * bb.y, zi = a.x * bb.y + a.y * bb.x; acc += c.x * zr - c.y * zi; }
            if (tau == 0 && h == h2) acc += P.dsk[g * 16 + h]; }
        KT[e] = (bf16_t)f2bf(acc);
    }
    for (int e = tid; e < 128 * 256; e += 512) {
        const int r = e >> 8, ri = r >> 6, p = r & 63, q = e & 255, j = q >> 4, h2 = q & 15;
        const f2 a = pw[(15 - j) * 64 + p], bb = Bb[p * 16 + h2]; const float zr = a.x * bb.x - a.y * bb.y, zi = a.x * bb.y + a.y * bb.x;
        WSg[e] = (bf16_t)f2bf(ri ? zi : zr);
    }
    for (int e = tid; e < 256 * 128; e += 512) {
        const int row = e >> 7, i = row >> 4, h = row & 15, q = e & 127; const int blk = q >> 5, sq_ = (q >> 4) & 1, hh = (q >> 3) & 1, j = q & 7;
        const int n = 32 * blk + 16 * sq_ + 8 * (j >> 2) + 4 * hh + (j & 3); const int ri = n >> 6, p = n & 63;
        const f2 a = pw[(i + 1) * 64 + p], c = Cc[h * 64 + p]; const float zr = c.x * a.x - c.y * a.y, zi = c.x * a.y + c.y * a.x;
        WCg[e] = (bf16_t)f2bf(ri ? -zi : zr);
    }
    __syncthreads();
}

__device__ __forceinline__ void s5_unit(LAS unsigned char* lds, const int tid, const unsigned char* tbl, const float* gw, const float* gb, const bf16_t* proj, bf16_t* mixed, float* ssqs, int b, int g) {
    typedef float f2 __attribute__((ext_vector_type(2)));
    const int lane = tid & 63, c = lane & 31, hi = lane >> 5; const int w = __builtin_amdgcn_readfirstlane(tid >> 6);
    for (int q = tid; q < 544; q += 512) *(LAS u32x4*)(lds + S5L_KT + q * 16) = *(const u32x4*)(tbl + S5_KT + q * 16);
#pragma unroll
    for (int it = 0; it < 8; ++it) { const int q = tid + 512 * it; *(LAS u32x4*)(lds + S5L_W + (q >> 5) * 528 + (q & 31) * 16) = *(const u32x4*)(tbl + S5_WS + q * 16); }
    if (tid < 192) *(LAS u32x4*)(lds + S5L_MD + tid * 16) = *(const u32x4*)(tbl + S5_MD + tid * 16);
#pragma unroll
    for (int it = 0; it < 4; ++it) { const int q = tid + 512 * it; *(LAS u32x2*)(lds + S5L_MC + (q >> 6) * 520 + (q & 63) * 8) = *(const u32x2*)(tbl + S5_MC + q * 8); }
    __syncthreads();
    const bf16_t* ubase = proj + PU + 16 * g + 8 * hi;
    const LAS unsigned char* mdb = lds + S5L_MD + hi * 32;
    const LAS unsigned char* mcb = lds + S5L_MC + c * 520 + hi * 32;
    LAS float* EX = (LAS float*)(lds + S5L_EX) + 4 * hi;
    const LAS unsigned char* wsb = lds + S5L_W + c * 528 + hi * 16;
    const LAS unsigned char* wcb = lds + S5L_W + c * 272 + hi * 16;
    f32x16 sa[4];
#pragma unroll
    for (int k = 0; k < 4; ++k) sa[k] = (f32x16){};
    {
        const int cc = 32 * w + c;
        const bf16_t* up = ubase + (size_t)rowof(b, 16 * cc) * PJ;
#pragma unroll
        for (int s0 = 0; s0 < 16; s0 += 8) {
            bf16x8 uf[8];
#pragma unroll
            for (int s = 0; s < 8; ++s) { uf[s] = *(const bf16x8*)up; up += PJ; asm volatile("" : "+v"(up)); }
            __builtin_amdgcn_sched_barrier(0);
#pragma unroll
            for (int s = 0; s < 8; ++s) {
#pragma unroll
                for (int blk = 0; blk < 4; ++blk) { const bf16x8 A = *(const LAS bf16x8*)(wsb + blk * (32 * 528) + (s0 + s) * 32); sa[blk] = __builtin_amdgcn_mfma_f32_32x32x16_bf16(A, uf[s], sa[blk], 0, 0, 0); }
                __builtin_amdgcn_sched_barrier(0); }
        }
    }
#pragma unroll
    for (int k = 0; k < 5; ++k) { const int d = 1 << k;
#pragma unroll
        for (int pb = 0; pb < 2; ++pb)
#pragma unroll
            for (int r = 0; r < 16; ++r) { const f2 m = *(const LAS f2*)(mdb + (k * 64 + 32 * pb + (r & 3) + 8 * (r >> 2)) * 8);
                const float yr = __shfl_up(sa[pb][r], d, 32), yi = __shfl_up(sa[2 + pb][r], d, 32);
                if (c >= d) { sa[pb][r] += m.x * yr - m.y * yi; sa[2 + pb][r] += m.x * yi + m.y * yr; }
                if ((r & 3) == 3) __builtin_amdgcn_sched_barrier(0); }
    }
    if (c == 31) {
#pragma unroll
        for (int pb = 0; pb < 2; ++pb)
#pragma unroll
            for (int r = 0; r < 16; ++r) { const int p0 = 32 * pb + (r & 3) + 8 * (r >> 2); EX[w * 128 + p0] = sa[pb][r]; EX[w * 128 + 64 + p0] = sa[2 + pb][r]; }
    }
    __syncthreads();
#pragma unroll
    for (int it = 0; it < 8; ++it) { const int q = tid + 512 * it; *(LAS u32x4*)(lds + S5L_W + (q >> 4) * 272 + (q & 15) * 16) = *(const u32x4*)(tbl + S5_WC + q * 16); }
    __syncthreads();
    const int npass = 2;
#pragma unroll 1
    for (int pass = 0; pass < npass; ++pass) {
        const int nprev = pass == 0 ? w : 8;
        const int cc = pass == 0 ? 32 * w + c : 256;
        if (pass == 1) {
#pragma unroll
            for (int k = 0; k < 4; ++k) sa[k] = (f32x16){};
        }
        {
            float cr[2][16], ci[2][16];
#pragma unroll
            for (int pb = 0; pb < 2; ++pb)
#pragma unroll
                for (int r = 0; r < 16; ++r) { cr[pb][r] = 0.f; ci[pb][r] = 0.f; }
#pragma unroll 1
            for (int wp = 0; wp < nprev; ++wp) {
                const LAS float* exw = EX + wp * 128;
#pragma unroll
                for (int pb = 0; pb < 2; ++pb)
#pragma unroll
                    for (int r = 0; r < 16; ++r) { const int p0 = 32 * pb + (r & 3) + 8 * (r >> 2); const f2 m = *(const LAS f2*)(mdb + (5 * 64 + p0) * 8); const float er = exw[p0], ei = exw[64 + p0];
                        const float nr = m.x * cr[pb][r] - m.y * ci[pb][r] + er, ni = m.x * ci[pb][r] + m.y * cr[pb][r] + ei; cr[pb][r] = nr; ci[pb][r] = ni;
                        if ((r & 7) == 7) __builtin_amdgcn_sched_barrier(0); }
            }
#pragma unroll
            for (int pb = 0; pb < 2; ++pb)
#pragma unroll
                for (int r = 0; r < 16; ++r) { const f2 m = *(const LAS f2*)(mcb + (32 * pb + (r & 3) + 8 * (r >> 2)) * 8);
                    float xr = __shfl_up(sa[pb][r], 1, 32), xi = __shfl_up(sa[2 + pb][r], 1, 32); if (c == 0) { xr = 0.f; xi = 0.f; }
                    sa[pb][r] = xr + m.x * cr[pb][r] - m.y * ci[pb][r]; sa[2 + pb][r] = xi + m.x * ci[pb][r] + m.y * cr[pb][r];
                    if ((r & 7) == 7) __builtin_amdgcn_sched_barrier(0); }
        }
        bf16x8 xf[4][2];
#pragma unroll
        for (int blk = 0; blk < 4; ++blk)
#pragma unroll
            for (int s = 0; s < 2; ++s) { u32x4 t; t.x = cvt_pk_bf16(sa[blk][8 * s], sa[blk][8 * s + 1]); t.y = cvt_pk_bf16(sa[blk][8 * s + 2], sa[blk][8 * s + 3]); t.z = cvt_pk_bf16(sa[blk][8 * s + 4], sa[blk][8 * s + 5]); t.w = cvt_pk_bf16(sa[blk][8 * s + 6], sa[blk][8 * s + 7]); xf[blk][s] = __builtin_bit_cast(bf16x8, t); }
        const int io = (lane >> 4) & 1, kk = lane & 15;
        bf16x8 Gf0, Gf1;
        { unsigned pkd[4];
    #pragma unroll
          for (int jj = 0; jj < 4; ++jj) { const int j0 = 2 * jj, j1 = 2 * jj + 1; const int h0 = 8 * (j0 >> 2) + 4 * hi + (j0 & 3), h1 = 8 * (j1 >> 2) + 4 * hi + (j1 & 3); pkd[jj] = pk2(gw[h0 * 16 + kk], gw[h1 * 16 + kk]); }
          const u32x4 wv = {pkd[0], pkd[1], pkd[2], pkd[3]}, zz = {0u, 0u, 0u, 0u};
          Gf0 = __builtin_bit_cast(bf16x8, io == 0 ? wv : zz); Gf1 = __builtin_bit_cast(bf16x8, io == 1 ? wv : zz); }
        float gbv[8];
    #pragma unroll
        for (int q = 0; q < 8; ++q) gbv[q] = gb[(q & 3) + 8 * (q >> 2) + 4 * hi];
        const int ktb = S5L_KT + ((lane >> 4) & 1) * 512 + (lane & 15) * 32 + hi * 16;
        const bool stok = pass == 0 ? (cc > 0 || b == 0) : (c == 0);
#pragma unroll
        for (int half = 0; half < 2; ++half) {
            __builtin_amdgcn_sched_barrier(0);
            f32x16 ya[4];
#pragma unroll
            for (int rl = 0; rl < 4; ++rl) ya[rl] = (f32x16){};
            int hi2 = hi; asm volatile("" : "+v"(hi2));
            const bf16_t* up = proj + PU + 16 * g + 8 * hi2 + (size_t)rowof(b, 16 * cc) * PJ;
#pragma unroll
            for (int s0 = 0; s0 < 8 * half + 8; s0 += 8) {
                bf16x8 uf[8];
#pragma unroll
                for (int s = 0; s < 8; ++s) { uf[s] = *(const bf16x8*)up; up += PJ; asm volatile("" : "+v"(up)); }
                __builtin_amdgcn_sched_barrier(0);
#pragma unroll
                for (int s = 0; s < 8; ++s) {
#pragma unroll
                    for (int rl = 0; rl < 4; ++rl) { const int rb = 4 * half + rl; if (s0 + s <= 2 * rb + 1 && (pass == 0 || rb == w)) { const bf16x8 A = *(const LAS bf16x8*)(lds + ktb + (2 * rb - (s0 + s) + 1) * 512); ya[rl] = __builtin_amdgcn_mfma_f32_32x32x16_bf16(A, uf[s], ya[rl], 0, 0, 0); } }
                    __builtin_amdgcn_sched_barrier(0); }
            }
#pragma unroll
            for (int rl = 0; rl < 4; ++rl) if (pass == 0 || 4 * half + rl == w) {
#pragma unroll
                for (int blk = 0; blk < 4; ++blk)
#pragma unroll
                    for (int s = 0; s < 2; ++s) { const bf16x8 A = *(const LAS bf16x8*)(wcb + (4 * half + rl) * (32 * 272) + (blk * 2 + s) * 32); ya[rl] = __builtin_amdgcn_mfma_f32_32x32x16_bf16(A, xf[blk][s], ya[rl], 0, 0, 0); }
                __builtin_amdgcn_sched_barrier(0);
            }
#pragma unroll
            for (int rl = 0; rl < 4; ++rl) if (pass == 0 || 4 * half + rl == w) {
                const int rb = 4 * half + rl;
                float zg[16];
#pragma unroll
                for (int r = 0; r < 16; ++r) zg[r] = gelu_tanh(ya[rl][r]);
                u32x4 z0, z1; z0.x = cvt_pk_bf16(zg[0], zg[1]); z0.y = cvt_pk_bf16(zg[2], zg[3]); z0.z = cvt_pk_bf16(zg[4], zg[5]); z0.w = cvt_pk_bf16(zg[6], zg[7]);
                z1.x = cvt_pk_bf16(zg[8], zg[9]); z1.y = cvt_pk_bf16(zg[10], zg[11]); z1.z = cvt_pk_bf16(zg[12], zg[13]); z1.w = cvt_pk_bf16(zg[14], zg[15]);
                f32x16 gt = (f32x16){};
                gt = __builtin_amdgcn_mfma_f32_32x32x16_bf16(Gf0, __builtin_bit_cast(bf16x8, z0), gt, 0, 0, 0);
                gt = __builtin_amdgcn_mfma_f32_32x32x16_bf16(Gf1, __builtin_bit_cast(bf16x8, z1), gt, 0, 0, 0);
#pragma unroll
                for (int il = 0; il < 2; ++il) {
                    float o[8]; float sq = 0.f;
#pragma unroll
                    for (int q = 0; q < 8; ++q) { o[q] = zg[8 * il + q] * sigmoidf_(gt[8 * il + q] + gbv[q]); sq += o[q] * o[q]; }
                    sq += __shfl_xor(sq, 32);
                    if (stok) { const int row = rowof(b, 16 * cc + 2 * rb + il); bf16_t* op = mixed + (size_t)row * DM + MX_SSM + 16 * g + 4 * hi;
                        u32x2 w0, w1; w0.x = cvt_pk_bf16(o[0], o[1]); w0.y = cvt_pk_bf16(o[2], o[3]); w1.x = cvt_pk_bf16(o[4], o[5]); w1.y = cvt_pk_bf16(o[6], o[7]);
                        *(u32x2*)op = w0; *(u32x2*)(op + 8) = w1;
                        if (hi == 0) ssqs[(size_t)row * 16 + g] = sq; }
                }
                __builtin_amdgcn_sched_barrier(0);
            }
        }
    }
    __syncthreads();
}

struct Args { const float* in[31]; float* out; unsigned char* ws; int ph_lo, ph_hi; };
constexpr int N_PHASES = 16;
#define PHASE_IDS() int tid; { int ln_; asm volatile("v_mbcnt_lo_u32_b32 %0, -1, 0\n\tv_mbcnt_hi_u32_b32 %0, -1, %0" : "=v"(ln_)); tid = wave0 * 64 + ln_; } unsigned char* ws = ws0; asm volatile("" : "+s"(ws)); const int lane = tid & 63; const int wave = __builtin_amdgcn_readfirstlane(tid >> 6); (void)lane; (void)wave

__global__ void __launch_bounds__(NWAVES * 64, 2) hymba_fwd(Args args) {
    extern __shared__ __attribute__((aligned(16))) unsigned char lds_raw[];
    LAS unsigned char* lds = (LAS unsigned char*)lds_raw;
    volatile LAS unsigned* MISC = (volatile LAS unsigned*)(lds + LDSCTL_OFF);
    LAS int* TB = (LAS int*)(lds + LDSCTL_OFF + 256);
    LAS int* CN = (LAS int*)(lds + LDSCTL_OFF + 512);
    LAS int* HIST = (LAS int*)(lds + LDSCTL_OFF + 768);
    const int wave0 = __builtin_amdgcn_readfirstlane(threadIdx.x >> 6);
    const int G = gridDim.x; const int bx = blockIdx.x; const int vcu = (G % 8 == 0) ? (bx % 8) * (G / 8) + bx / 8 : bx;
    unsigned char* const ws0 = args.ws;
    unsigned* const ctl = (unsigned*)(ws0 + WS_CTL);
    for (int u = threadIdx.x; u < (LDS_BYTES - LDSCTL_OFF) / 4; u += NWAVES * 64) ((LAS unsigned*)(lds + LDSCTL_OFF))[u] = 0u;
    __syncthreads();
    const int lo = args.ph_lo, hi = args.ph_hi;
    XcdBarrier bar; bar.bar = ctl + CW_BAR; bar.x = 0; bar.st = nullptr;
    if (hi - lo > 1) bar = xcd_barrier_post(ctl + CW_BAR, MISC + 8);
#define IN(k) (lo <= (k) && (k) < hi)
#define SEAM(k) do { if (IN(k) && IN((k) + 1)) { PHASE_IDS(); xcd_barrier(bar, tid == 0); } STAMP((k) + 1); } while (0)
#define WSP(T, off) ((T*)(ws + (off)))
#define STAMP(id) do { if (PROBE_A >= 0 && (int)blockIdx.x == PROBE_BLOCK && ((id) == PROBE_A || (id) == PROBE_B)) { PHASE_IDS(); if (tid == 0) ((unsigned long long*)(ctl + CW_TS))[id] = __builtin_amdgcn_s_memrealtime(); } } while (0)
    STAMP(0);

    for (int rep_ = 0; rep_ < DUP_P0; ++rep_) if (IN(0)) {
        PHASE_IDS();
        bf16_t* WinT = WSP(bf16_t, WS_WIN); bf16_t* WoutT = WSP(bf16_t, WS_WOUT); bf16_t* W13T = WSP(bf16_t, WS_W13); bf16_t* W2C = WSP(bf16_t, WS_W2C); bf16_t* WrT = WSP(bf16_t, WS_WR);
        bf16_t* hbuf = WSP(bf16_t, WS_H); float* ssq1 = WSP(float, WS_SSQ1); float* tinfo = WSP(float, WS_TINFO);
#pragma unroll 1
        for (int lg = vcu; lg < 32; lg += G) { const int l = lg >> 4, g = lg & 15;
            const S5P SP{args.in[10] + l * 1024, args.in[11] + l * 1024, args.in[12] + l * 16, args.in[13] + (size_t)l * 16384, args.in[14] + (size_t)l * 16384, args.in[15] + (size_t)l * 16384, args.in[16] + (size_t)l * 16384,
                         args.in[17] + l * 256, args.in[18] + (size_t)l * 4096, args.in[19] + l * 256};
            int tidp = tid; asm volatile("" : "+v"(tidp));
            s5_tables_block(lds, tidp, SP, g, ws + WS_S5T + (size_t)lg * S5T_BYTES); }
        LAS float* scr = (LAS float*)(lds + wave * 16384);
        const int gw = vcu * NWAVES + wave, NGW = G * NWAVES;
        constexpr int I_WIN = 16 * 80, I_WOUT = 16 * 32, I_W13 = 16 * 16, I_W2 = 4 * 32, I_WR = 16;
        constexpr int T_WIN = 2 * I_WIN, T_WOUT = 2 * I_WOUT, T_W13 = 32 * I_W13, T_W2 = 32 * I_W2, T_WR = 4 * I_WR;
        constexpr int NITEMS = T_WIN + T_WOUT + T_W13 + T_W2 + T_WR;
        const int nskip = G >= 64 ? 32 : 0; const int igw = (vcu - nskip) * NWAVES + wave, INGW = (G - nskip) * NWAVES;
#pragma unroll 1
        for (int it = igw; it < NITEMS && vcu >= nskip; it += INGW) {
            int r = it;
            if (r < T_WIN) { const int l = r / I_WIN, q = r % I_WIN, kb = q / 80, nb = q % 80; GetWin gt{args.in[3] + (size_t)l * DM * DINSRC, args.in[2] + l * DM};
                tr_item(gt, WinT + (size_t)l * NIN * DM, DM, 64 * kb, 32 * nb, scr, lane); continue; } r -= T_WIN;
            if (r < T_WOUT) { const int l = r / I_WOUT, q = r % I_WOUT, kb = q / 32, nb = q % 32; GetWout gt{args.in[21] + (size_t)l * DM * DM, args.in[9] + l * 512, args.in[20] + l * 256};
                tr_item(gt, WoutT + (size_t)l * DM * DM, DM, 64 * kb, 32 * nb, scr, lane); continue; } r -= T_WOUT;
            if (r < T_W13) { const int le = r / I_W13, q = r % I_W13, kb = q / 16, nb = q % 16; const int l = le / 16; GetW13 gt{args.in[27] + (size_t)le * DM * 256, args.in[28] + (size_t)le * DM * 256, args.in[22] + l * DM};
                tr_item(gt, W13T + (size_t)le * 512 * DM, DM, 64 * kb, 32 * nb, scr, lane); continue; } r -= T_W13;
            if (r < T_W2) { const int le = r / I_W2, q = r % I_W2, kb = q / 32, nb = q % 32; GetW2 gt{args.in[29] + (size_t)le * 256 * DM};
                tr_item(gt, W2C + (size_t)le * DM * 256, 256, 64 * kb, 32 * nb, scr, lane); continue; } r -= T_W2;
            { const int lh = r / I_WR, kb = r % I_WR; const int l = lh >> 1, lo_ = lh & 1; GetWr gt{args.in[23] + (size_t)l * DM * 4, args.in[25] + (size_t)l * DM * 16, args.in[22] + l * DM, lo_};
                tr_item(gt, WrT + (size_t)lh * 32 * DM, DM, 64 * kb, 0, scr, lane); }
        }
#pragma unroll 1
        for (int r0 = 2 * gw; r0 < MROWS; r0 += 2 * NGW) {
            f32x4 v[2][4];
#pragma unroll
            for (int q = 0; q < 2; ++q) { const int r = r0 + q;
#pragma unroll
                for (int j = 0; j < 4; ++j) { if (r < NREAL) v[q][j] = *(const f32x4*)(args.in[0] + (size_t)r * DM + 4 * lane + 256 * j); else if (r < NTOK) v[q][j] = *(const f32x4*)(args.in[1] + (size_t)(r - NREAL) * DM + 4 * lane + 256 * j); else v[q][j] = (f32x4){0.f, 0.f, 0.f, 0.f}; } }
#pragma unroll
            for (int q = 0; q < 2; ++q) { const int r = r0 + q; float s = 0.f;
#pragma unroll
                for (int j = 0; j < 4; ++j) { u32x2 w; w.x = pk2(v[q][j][0], v[q][j][1]); w.y = pk2(v[q][j][2], v[q][j][3]); *(u32x2*)(hbuf + (size_t)r * DM + 4 * lane + 256 * j) = w;
                    s += bflo(w.x) * bflo(w.x) + bfhi(w.x) * bfhi(w.x) + bflo(w.y) * bflo(w.y) + bfhi(w.y) * bfhi(w.y); }
                s = wave_sum(s);
                if (lane < 16) ssq1[(size_t)r * 16 + lane] = lane == 0 ? s : 0.f;
                if (r >= NTOK && lane < 4) tinfo[(size_t)r * 4 + lane] = 0.f; }
        }
    }
    SEAM(0);

#pragma unroll 1
    for (int l = 0; l < DEPTH; ++l) {
        const int P = 1 + 7 * l;
        for (int rep_ = 0; rep_ < DUP_G1; ++rep_) if (IN(P)) {
            PHASE_IDS();
            bf16_t* hbuf = WSP(bf16_t, WS_H); bf16_t* proj = WSP(bf16_t, WS_PROJ); float* flog = WSP(float, WS_FLOG); const float* ssq1 = WSP(float, WS_SSQ1);
            const bf16_t* Win = WSP(bf16_t, WS_WIN) + (size_t)l * NIN * DM; const float* fb = args.in[4] + l * 8;
            DenseOrder S; S.init(hbuf, Win, NREAL, NIN, DM, DM, G, bx);
            EpiProj E{proj, flog, ssq1, fb};
            pg8::gemm_phase<EpiProj, DenseOrder, true, false>(lds, tid, DM, DM, S, E);
#pragma unroll 1
            for (int cb = bx; cb < 10; cb += G) {
                f32x4 acc[2]; meta_gemm16(hbuf + (size_t)NREAL * DM, Win, DM, cb * 256, wave, lane, acc);
                const int m = lane & 15, q4 = lane >> 4, row = NREAL + m;
                const float rs = row_rstd16(ssq1, row, q4, 1.f / DM);
#pragma unroll
                for (int j = 0; j < 2; ++j) { const f32x4 v = acc[j] * rs; const int col = cb * 256 + 32 * wave + 16 * j + 4 * q4;
                    if (cb < 9) { u32x2 w; w.x = cvt_pk_bf16(v[0], v[1]); w.y = cvt_pk_bf16(v[2], v[3]); *(u32x2*)(proj + (size_t)row * PJ + col) = w; }
                    else if (wave == 0 && j == 0 && q4 < 2) { f32x4 o;
#pragma unroll
                        for (int e = 0; e < 4; ++e) { const float f = v[e] + fb[4 * q4 + e]; o[e] = -log2f(1.f + exp2f(-f * LOG2E)); }
                        *(f32x4*)(flog + (size_t)row * 8 + 4 * q4) = o; } }
            }
        }
        SEAM(P);
        for (int rep_ = 0; rep_ < DUP_MIX; ++rep_) if (IN(P + 1)) {
            PHASE_IDS();
            const bf16_t* proj = WSP(bf16_t, WS_PROJ); bf16_t* mixed = WSP(bf16_t, WS_MIX); const float* flog = WSP(float, WS_FLOG); float* ssqa = WSP(float, WS_SSQA); float* ssqs = WSP(float, WS_SSQS);
            for (int repa_ = 0; repa_ < DUP_ATT; ++repa_)
#pragma unroll 1
            for (int vc = vcu; vc < 256; vc += G) {
                int bh = vc >> 2; asm volatile("" : "+s"(bh));
                const int b = bh >> 3, h = bh & 7;
                attn_prefix(lds, tid, flog, b, h);
#pragma unroll 1
                for (int i = 0; i < 4; ++i) { const int s = (vc & 3) * 2 + (i >> 1); int qt = (i & 1) ? 15 - s : s; asm volatile("" : "+s"(qt)); int tid3 = tid; asm volatile("" : "+v"(tid3)); attn_unit(lds, tid3, proj, mixed, ssqa, b, h, qt); }
            }
#pragma unroll 1
            for (int vc = vcu; vc < 8; vc += G) { int hh = vc; asm volatile("" : "+s"(hh)); int tid3 = tid; asm volatile("" : "+v"(tid3)); attn_prefix(lds, tid3, flog, 0, hh); attn_unit(lds, tid3, proj, mixed, ssqa, 0, hh, -1); }
            STAMP(20 + l * 4);
            const float* cw = args.in[5] + (size_t)l * 31 * 256; const float* cbp = args.in[6] + l * 256; const float* clg = args.in[7] + l * 256; const float* clb = args.in[8] + l * 256;
            for (int repc_ = 0; repc_ < DUP_CS; ++repc_)
#pragma unroll 1
            for (int vc = vcu; vc < 256; vc += G) {
                int tid2 = tid; asm volatile("" : "+v"(tid2));
                if ((vc & 1) == 0) { const int ci = vc >> 1;
                    conv_unit(lds, tid2, proj, mixed, cw, cbp, clg, clb, ci >> 4, NMETA + 256 * (ci & 15), 4, 64);
                } else {
                    if (vc == 1) conv_unit(lds, tid2, proj, mixed, cw, cbp, clg, clb, 0, 0, 1, 16);
                    int ug = vc >> 1; asm volatile("" : "+s"(ug));
                    s5_unit(lds, tid2, ws + WS_S5T + (size_t)(l * 16 + (ug & 15)) * S5T_BYTES, args.in[18] + (size_t)l * 4096 + (ug & 15) * 256, args.in[19] + l * 256 + (ug & 15) * 16, proj, mixed, ssqs, ug >> 4, ug & 15);
                }
            }
        }
        if (IN(P + 1)) STAMP(21 + l * 4);
        SEAM(P + 1);
        if (IN(P + 2)) {
            PHASE_IDS();
            bf16_t* mixed = WSP(bf16_t, WS_MIX); const float* ssqa = WSP(float, WS_SSQA); const float* ssqs = WSP(float, WS_SSQS);
            const int gw = vcu * NWAVES + wave, NGW = G * NWAVES;
#pragma unroll 1
            for (int r = gw; r < NTOK; r += NGW) {
                float sa = lane < 8 ? ssqa[(size_t)r * 8 + lane] : 0.f, ss = lane < 16 ? ssqs[(size_t)r * 16 + lane] : 0.f;
                sa = wave_sum(sa); ss = wave_sum(ss);
                const float ra = rsqrtf(sa * (1.f / 512.f) + EPS), rsm = rsqrtf(ss * (1.f / 256.f) + EPS);
                bf16_t* p = mixed + (size_t)r * DM;
                u32x4 a = *(u32x4*)(p + 8 * lane);
                a.x = cvt_pk_bf16(bflo(a.x) * ra, bfhi(a.x) * ra); a.y = cvt_pk_bf16(bflo(a.y) * ra, bfhi(a.y) * ra); a.z = cvt_pk_bf16(bflo(a.z) * ra, bfhi(a.z) * ra); a.w = cvt_pk_bf16(bflo(a.w) * ra, bfhi(a.w) * ra);
                *(u32x4*)(p + 8 * lane) = a;
                u32x2 s2 = *(u32x2*)(p + MX_SSM + 4 * lane);
                s2.x = cvt_pk_bf16(bflo(s2.x) * rsm, bfhi(s2.x) * rsm); s2.y = cvt_pk_bf16(bflo(s2.y) * rsm, bfhi(s2.y) * rsm);
                *(u32x2*)(p + MX_SSM + 4 * lane) = s2;
            }
        }
        SEAM(P + 2);
        if (IN(P + 3)) {
            PHASE_IDS();
            bf16_t* hbuf = WSP(bf16_t, WS_H); const bf16_t* mixed = WSP(bf16_t, WS_MIX); float* ssq2 = WSP(float, WS_SSQ2); const bf16_t* Wo = WSP(bf16_t, WS_WOUT) + (size_t)l * DM * DM;
            DenseOrder S; S.init(mixed, Wo, NREAL, DM, DM, DM, G, bx);
            EpiRes<false> E{hbuf, ssq2, CN, nullptr};
            pg8::gemm_phase<EpiRes<false>, DenseOrder, true, false>(lds, tid, DM, DM, S, E);
            LAS float* mscr = (LAS float*)lds;
#pragma unroll 1
            for (int cb = bx; cb < 4; cb += G) {
                f32x4 acc[2]; meta_gemm16(mixed + (size_t)NREAL * DM, Wo, DM, cb * 256, wave, lane, acc);
                const int m = lane & 15, q4 = lane >> 4, row = NREAL + m; float sq = 0.f;
#pragma unroll
                for (int j = 0; j < 2; ++j) { bf16_t* p = hbuf + (size_t)row * DM + cb * 256 + 32 * wave + 16 * j + 4 * q4; const u32x2 o = *(const u32x2*)p; u32x2 w;
                    w.x = cvt_pk_bf16(bflo(o.x) + acc[j][0], bfhi(o.x) + acc[j][1]); w.y = cvt_pk_bf16(bflo(o.y) + acc[j][2], bfhi(o.y) + acc[j][3]); *(u32x2*)p = w;
                    sq += bflo(w.x) * bflo(w.x) + bfhi(w.x) * bfhi(w.x) + bflo(w.y) * bflo(w.y) + bfhi(w.y) * bfhi(w.y); }
                sq += __shfl_xor(sq, 16); sq += __shfl_xor(sq, 32);
                if (q4 == 0) mscr[m * 8 + wave] = sq;
                __syncthreads();
                if (wave == 0) ssq2[(size_t)row * 16 + cb * 4 + q4] = mscr[m * 8 + 2 * q4] + mscr[m * 8 + 2 * q4 + 1];
                __syncthreads();
            }
        }
        SEAM(P + 3);
        if (IN(P + 4)) {
            PHASE_IDS();
            const bf16_t* hbuf = WSP(bf16_t, WS_H); const float* ssq2 = WSP(float, WS_SSQ2); float* tinfo = WSP(float, WS_TINFO); int* list = WSP(int, WS_LIST);
            unsigned* gcnt = ctl + CW_CNT + l * 32;
            const bf16_t* Whi = WSP(bf16_t, WS_WR) + (size_t)(2 * l) * 32 * DM; const bf16_t* Wlo = Whi + (size_t)32 * DM;
            LAS float* scr = (LAS float*)(lds + wave * 4352);
#pragma unroll 1
            for (int base = 0; base < 1025; base += G * 4) {
                const int grp = base + bx * 4 + wave;
                const bool active = wave < 4 && grp < 1025;
                int cls = 0, posl = 0, tok = 0; bool valid = false; float rstd = 0.f, gA = 0.f, gB = 0.f;
                if (active) {
                    const int r32 = lane & 31, hh = lane >> 5; const int rowA = grp * 32 + r32 < NTOK ? grp * 32 + r32 : DUMMY_ROW;
                    f32x16 acc = {};
                    const bf16_t* ap = hbuf + (size_t)rowA * DM + 8 * hh; const bf16_t* bh_ = Whi + (size_t)r32 * DM + 8 * hh; const bf16_t* bl_ = Wlo + (size_t)r32 * DM + 8 * hh;
#pragma unroll 8
                    for (int k0 = 0; k0 < DM; k0 += 16) { const bf16x8 a = *(const bf16x8*)(ap + k0), b0 = *(const bf16x8*)(bh_ + k0), b1 = *(const bf16x8*)(bl_ + k0);
                        acc = __builtin_amdgcn_mfma_f32_32x32x16_bf16(a, b0, acc, 0, 0, 0); acc = __builtin_amdgcn_mfma_f32_32x32x16_bf16(a, b1, acc, 0, 0, 0); }
#pragma unroll
                    for (int r = 0; r < 16; ++r) scr[crow(r, hh) * 33 + r32] = acc[r];
                    LDS_WAIT(); asm volatile("" ::: "memory");
                    tok = grp * 32 + r32; valid = hh == 0 && tok < NTOK;
                    if (valid) {
                        float s = 0.f;
#pragma unroll
                        for (int q = 0; q < 4; ++q) { const f32x4 v = *(const f32x4*)(ssq2 + (size_t)tok * 16 + 4 * q); s += (v.x + v.y) + (v.z + v.w); }
                        rstd = rsqrtf(s * (1.f / DM) + EPS);
                        float lg[4]; const float* bg = args.in[24] + l * 4; const float* be = args.in[26] + l * 16;
#pragma unroll
                        for (int i = 0; i < 4; ++i) lg[i] = scr[r32 * 33 + i] * rstd + bg[i];
                        int gs = 0; float mx = lg[0];
#pragma unroll
                        for (int i = 1; i < 4; ++i) if (lg[i] > mx) { mx = lg[i]; gs = i; }
                        float se = 0.f;
#pragma unroll
                        for (int i = 0; i < 4; ++i) se += expf(lg[i] - mx);
                        const float pg = 1.f / se;
                        float le[4];
#pragma unroll
                        for (int i = 0; i < 4; ++i) le[i] = scr[r32 * 33 + 4 + 4 * gs + i] * rstd + be[4 * gs + i];
                        int i1 = 0; float v1 = le[0];
#pragma unroll
                        for (int i = 1; i < 4; ++i) if (le[i] > v1) { v1 = le[i]; i1 = i; }
                        int i2 = -1; float v2 = -INFINITY;
#pragma unroll
                        for (int i = 0; i < 4; ++i) if (i != i1 && le[i] > v2) { v2 = le[i]; i2 = i; }
                        const float w1 = pg / (1.f + expf(v2 - v1)), w2 = pg - w1;
                        const int a = i1 < i2 ? i1 : i2, bb = i1 < i2 ? i2 : i1;
                        gA = i1 < i2 ? w1 : w2; gB = i1 < i2 ? w2 : w1;
                        cls = gs * 6 + (a == 0 ? bb - 1 : (a == 1 ? bb + 1 : 5));
                        posl = __hip_atomic_fetch_add(&HIST[cls], 1, __ATOMIC_RELAXED, __HIP_MEMORY_SCOPE_WORKGROUP);
                    }
                }
                __syncthreads();
                if (tid < NCLS) { const int n = HIST[tid]; HIST[32 + tid] = n ? (int)__hip_atomic_fetch_add(gcnt + tid, (unsigned)n, __ATOMIC_RELAXED, __HIP_MEMORY_SCOPE_AGENT) : 0; }
                __syncthreads();
                if (valid) { const int pos = HIST[32 + cls] + posl; list[(size_t)cls * NTOK + pos] = tok; *(f32x4*)(tinfo + (size_t)tok * 4) = (f32x4){rstd, gA, gB, 0.f}; }
                __syncthreads();
                if (tid < NCLS) HIST[tid] = 0;
                __syncthreads();
            }
        }
        SEAM(P + 4);
        if (IN(P + 5) || IN(P + 6)) {
            unsigned* gcnt = ctl + CW_CNT + l * 32;
            PHASE_IDS();
            if (tid == 0) { int run = 0; for (int c = 0; c < NCLS; ++c) { const int n = (int)__hip_atomic_load(gcnt + c, __ATOMIC_RELAXED, __HIP_MEMORY_SCOPE_AGENT); CN[c] = n; TB[c] = run; run += (n + 255) >> 8; } TB[NCLS] = run; }
            __syncthreads();
        }
        for (int rep_ = 0; rep_ < DUP_E1; ++rep_) if (IN(P + 5)) {
            PHASE_IDS();
            const int* list = WSP(int, WS_LIST);
            ExpertOrder S{TB, CN, list, (const char*)WSP(bf16_t, WS_H), (const char*)WSP(bf16_t, WS_W13), G, bx, 1, l};
            EpiE1 E{WSP(bf16_t, WS_H1), WSP(float, WS_TINFO), CN, list};
            pg8::gemm_phase<EpiE1, ExpertOrder, true, true>(lds, tid, DM, DM, S, E);
        }
        SEAM(P + 5);
        if (IN(P + 6)) {
            PHASE_IDS();
            const int* list = WSP(int, WS_LIST);
            ExpertOrder S{TB, CN, list, (const char*)WSP(bf16_t, WS_H1), (const char*)WSP(bf16_t, WS_W2C), G, bx, 2, l};
            EpiRes<true> E{WSP(bf16_t, WS_H), WSP(float, WS_SSQ1), CN, list};
            pg8::gemm_phase<EpiRes<true>, ExpertOrder, true, false, true>(lds, tid, 512, 256, S, E);
        }
        SEAM(P + 6);
    }
    if (IN(15)) {
        PHASE_IDS();
        const bf16_t* hbuf = WSP(bf16_t, WS_H); const float* ssq1 = WSP(float, WS_SSQ1);
        const int gw = vcu * NWAVES + wave, NGW = G * NWAVES; const float* gF = args.in[30];
        f32x4 gv[4];
#pragma unroll
        for (int j = 0; j < 4; ++j) gv[j] = *(const f32x4*)(gF + 4 * lane + 256 * j);
#pragma unroll 1
        for (int r = gw; r < NREAL; r += NGW) {
            float s = lane < 16 ? ssq1[(size_t)r * 16 + lane] : 0.f; s = wave_sum(s);
            const float rs = rsqrtf(s * (1.f / DM) + EPS);
#pragma unroll
            for (int j = 0; j < 4; ++j) { const u32x2 w = *(const u32x2*)(hbuf + (size_t)r * DM + 4 * lane + 256 * j);
                f32x4 o; o[0] = bflo(w.x) * rs * gv[j][0]; o[1] = bfhi(w.x) * rs * gv[j][1]; o[2] = bflo(w.y) * rs * gv[j][2]; o[3] = bfhi(w.y) * rs * gv[j][3];
                if (PROBE_A >= 0 && r == 0 && lane == 0 && j == 0) { const unsigned long long ta = __hip_atomic_load((unsigned long long*)(ctl + CW_TS) + (PROBE_A < 0 ? 0 : PROBE_A), __ATOMIC_RELAXED, __HIP_MEMORY_SCOPE_AGENT), tb = __hip_atomic_load((unsigned long long*)(ctl + CW_TS) + (PROBE_B < 0 ? 0 : PROBE_B), __ATOMIC_RELAXED, __HIP_MEMORY_SCOPE_AGENT); o[0] += (float)(long long)(tb - ta) * (0.01f / PROBE_SCALE); }
                *(f32x4*)(args.out + (size_t)r * DM + 4 * lane + 256 * j) = o; }
        }
    }
#undef IN
#undef SEAM
#undef WSP
}

extern "C" void kernel_launch(void* const* d_in, const int* in_sizes, int n_in, void* d_out, int out_size, void* d_ws, size_t ws_size, hipStream_t stream) {
    static int grid = 0;
    if (grid == 0) {
        if (n_in != 31 || out_size != NREAL * DM || ws_size < WS_END) { fprintf(stderr, "kernel_launch: unexpected shapes (n_in %d, out %d, ws %zu)\n", n_in, out_size, ws_size); grid = -1; return; }
        int dev = 0, cus = 0, per_cu = 0;
        if (hipGetDevice(&dev) != hipSuccess || hipDeviceGetAttribute(&cus, hipDeviceAttributeMultiprocessorCount, dev) != hipSuccess) { grid = -1; return; }
        if (hipFuncSetAttribute((const void*)hymba_fwd, hipFuncAttributeMaxDynamicSharedMemorySize, LDS_BYTES) != hipSuccess) { fprintf(stderr, "kernel_launch: hipFuncSetAttribute failed\n"); grid = -1; return; }
        if (hipOccupancyMaxActiveBlocksPerMultiprocessor(&per_cu, (const void*)hymba_fwd, NWAVES * 64, LDS_BYTES) != hipSuccess || per_cu < 1) { fprintf(stderr, "kernel_launch: occupancy query says %d\n", per_cu); }
        (void)hipGetLastError();
        grid = cus;
    }
    if (grid < 0) return;
    (void)in_sizes;
    if (hipMemsetAsync((char*)d_ws + WS_CTL, 0, CTL_BYTES, stream) != hipSuccess) return;
    Args a{};
    for (int i = 0; i < 31; ++i) a.in[i] = (const float*)d_in[i];
    a.out = (float*)d_out; a.ws = (unsigned char*)d_ws;
#if MK_PER_PHASE
    for (int p = 0; p < N_PHASES; ++p) { a.ph_lo = p; a.ph_hi = p + 1; hipLaunchKernelGGL(hymba_fwd, dim3(grid), dim3(NWAVES * 64), LDS_BYTES, stream, a); }
#else
    a.ph_lo = 0; a.ph_hi = N_PHASES;
    hipLaunchKernelGGL(hymba_fwd, dim3(grid), dim3(NWAVES * 64), LDS_BYTES, stream, a);
#endif
}
```

```cpp
#include <hip/hip_runtime.h>
#include <cstdio>
#include <cstdint>

#ifndef PROBE_A
#define PROBE_A -1
#endif
#ifndef PROBE_B
#define PROBE_B -1
#endif
#ifndef PROBE_BLOCK
#define PROBE_BLOCK 0
#endif
#ifndef PROBE_SCALE
#define PROBE_SCALE 4.0f
#endif
constexpr int CW_TS = 20480;
#define TS(id) do { if (PROBE_A >= 0 && (int)blockIdx.x == PROBE_BLOCK && tid == 0 && ((id) == PROBE_A || (id) == PROBE_B)) tsp[id] = __builtin_amdgcn_s_memrealtime(); } while (0)
#ifndef DUP_ATT
#define DUP_ATT 1
#endif
#ifndef DUP_CS
#define DUP_CS 1
#endif
#ifndef DUP_G1
#define DUP_G1 1
#endif
#ifndef DUP_MIX
#define DUP_MIX 1
#endif
#ifndef DUP_E1
#define DUP_E1 1
#endif
#ifndef DUP_P0
#define DUP_P0 1
#endif
#ifndef MK_PER_PHASE
#define MK_PER_PHASE 0
#endif

#define LAS __attribute__((address_space(3)))
#define GAS __attribute__((address_space(1)))
typedef unsigned short bf16_t;
typedef short bf16x8 __attribute__((ext_vector_type(8)));
typedef short s16x4 __attribute__((ext_vector_type(4)));
typedef float f32x4 __attribute__((ext_vector_type(4)));
typedef float f32x2 __attribute__((ext_vector_type(2)));
typedef float f32x16 __attribute__((ext_vector_type(16)));
typedef unsigned u32x4 __attribute__((ext_vector_type(4)));
typedef unsigned u32x2 __attribute__((ext_vector_type(2)));

constexpr int NB = 8, SEQ = 4096, NMETA = 16, DM = 1024, DEPTH = 2;
constexpr int NREAL = NB * SEQ;
constexpr int NTOK = NREAL + NMETA;
constexpr int MROWS = 33024;
constexpr int DUMMY_ROW = NTOK;
constexpr int PJ = 2304;
constexpr int NIN = 2560;
constexpr int DINSRC = 2312;
constexpr int PQ = 512, PK = 1024, PV = 1536, PU = 2048;
constexpr int MX_ATT = 0, MX_SSM = 512, MX_CONV = 768;
constexpr int NCLS = 24;
constexpr float EPS = 1e-6f;
constexpr float LOG2E = 1.4426950408889634f;
constexpr int H1CAP = 40960;

constexpr size_t MiB = 1u << 20;
constexpr size_t WS_CTL = 0, CTL_BYTES = 1 * MiB;
constexpr size_t WS_WIN = 2 * MiB, WS_WOUT = 12 * MiB, WS_W13 = 16 * MiB, WS_W2C = 48 * MiB, WS_WR = 96 * MiB;
constexpr size_t WS_H = 100 * MiB, WS_PROJ = 165 * MiB, WS_MIX = 311 * MiB, WS_H1 = 376 * MiB;
constexpr size_t WS_FLOG = 416 * MiB, WS_SSQ1 = 418 * MiB, WS_SSQ2 = 421 * MiB, WS_SSQA = 424 * MiB, WS_SSQS = 426 * MiB, WS_TINFO = 429 * MiB, WS_LIST = 430 * MiB, WS_S5T = 434 * MiB, WS_END = 440 * MiB;
constexpr int CW_TMO = 0, CW_BAR = 4096, CW_CNT = 16384;

constexpr int RING_BYTES = 131072;
constexpr int LDSCTL_OFF = RING_BYTES;
constexpr int LDS_BYTES = 147456;
constexpr int NWAVES = 8;

#define LDS_WAIT() asm volatile("s_waitcnt lgkmcnt(0)" ::: "memory")
#define VM_WAIT() asm volatile("s_waitcnt vmcnt(0)" ::: "memory")

__device__ __forceinline__ unsigned f2bf(float f) { unsigned u = __float_as_uint(f); return (u + 0x7fffu + ((u >> 16) & 1u)) >> 16; }
__device__ __forceinline__ unsigned pk2(float lo, float hi) { return f2bf(lo) | (f2bf(hi) << 16); }
__device__ __forceinline__ float bflo(unsigned w) { return __uint_as_float(w << 16); }
__device__ __forceinline__ float bfhi(unsigned w) { return __uint_as_float(w & 0xffff0000u); }
__device__ __forceinline__ float bf2f(bf16_t b) { return __uint_as_float(((unsigned)b) << 16); }
__device__ __forceinline__ unsigned cvt_pk_bf16(float lo, float hi) { unsigned r; asm volatile("v_cvt_pk_bf16_f32 %0, %1, %2" : "=v"(r) : "v"(lo), "v"(hi)); return r; }
template <int CTRL> __device__ __forceinline__ float dpp_mov0(float v) { return __builtin_bit_cast(float, __builtin_amdgcn_update_dpp(0, __builtin_bit_cast(int, v), CTRL, 0xF, 0xF, true)); }
__device__ __forceinline__ void swap16(float& a, float& b) { asm volatile("v_nop\n\tv_nop\n\tv_permlane16_swap_b32 %0, %1" : "+v"(a), "+v"(b)); }
__device__ __forceinline__ void swap32(float& a, float& b) { asm volatile("v_nop\n\tv_nop\n\tv_permlane32_swap_b32 %0, %1" : "+v"(a), "+v"(b)); }
__device__ __forceinline__ float xadd16(float v) { float a = v, b = v; swap16(a, b); return a + b; }
__device__ __forceinline__ float xadd32(float v) { float a = v, b = v; swap32(a, b); return a + b; }
__device__ __forceinline__ float row16_sum(float v) {
    v += dpp_mov0<0xB1>(v);
    v += dpp_mov0<0x4E>(v);
    v += dpp_mov0<0x141>(v);
    v += dpp_mov0<0x140>(v);
    return v;
}
template <int CTRL, int ROWMASK> __device__ __forceinline__ float dpp_mov0m(float v) { return __builtin_bit_cast(float, __builtin_amdgcn_update_dpp(0, __builtin_bit_cast(int, v), CTRL, ROWMASK, 0xF, true)); }
__device__ __forceinline__ float xmax32(float v) { float a = v, b = v; swap32(a, b); return fmaxf(a, b); }
__device__ __forceinline__ float wave_incl_scan(float v) {
    v += dpp_mov0<0x111>(v); v += dpp_mov0<0x112>(v); v += dpp_mov0<0x114>(v); v += dpp_mov0<0x118>(v);
    v += dpp_mov0m<0x142, 0xA>(v);
    v += dpp_mov0m<0x143, 0xC>(v);
    return v;
}
__device__ __forceinline__ float half32_sum(float v) { return xadd16(row16_sum(v)); }
__device__ __forceinline__ float wave_sum(float v) { return xadd32(xadd16(row16_sum(v))); }
__device__ __forceinline__ float fast_exp2(float x) { return __builtin_amdgcn_exp2f(x); }
__device__ __forceinline__ float fast_rcp(float x) { return __builtin_amdgcn_rcpf(x); }
__device__ __forceinline__ float sigmoidf_(float x) { return fast_rcp(1.f + fast_exp2(-x * LOG2E)); }
__device__ __forceinline__ float siluf_(float x) { return x * sigmoidf_(x); }
__device__ __forceinline__ int rowof(int b, int t) { return t < NMETA ? NREAL + t : b * SEQ + (t - NMETA); }

namespace pg8 {
constexpr int BM = 256, BK = 64, HALF = 128, HTB = HALF * BK * 2, STAGE_BYTES = 8 * HTB;
__host__ __device__ __forceinline__ int lds_byte(int r, int c) { const int st = (r >> 4) * 2 + (c >> 5), rr = r & 15, cc = c & 31, ob = rr * 64 + cc * 2; return st * 1024 + (ob ^ (((ob >> 9) & 1) << 5)); }
__host__ __device__ __forceinline__ void stage_rc(int b, int& R, int& C) { const int st = b / 1024, sb = b % 1024, swz = sb ^ (((sb >> 9) & 1) << 5); R = (st >> 1) * 16 + swz / 64; C = (st & 1) * 32 + (swz % 64) / 2; }
__host__ __device__ __forceinline__ int perm32(int rho) { const int n = rho >> 4, i = rho & 15; return 8 * (i >> 2) + 4 * n + (i & 3); }

struct Unit { int pm, pn, cls, p0; };

template <class Epi, class Sched, bool ALIGN_EPI, bool GATHER, bool BSPLIT = false>
__device__ __forceinline__ void gemm_phase(LAS unsigned char* lds, const int tid, const int K, const int ldb, const Sched& S, const Epi& E) {
    const int wid = __builtin_amdgcn_readfirstlane(tid >> 6), lane = tid & 63, wr = wid >> 2, wc = wid & 3, fr = lane & 15, fq = lane >> 4;
    const int nt = K / BK;
    unsigned voffA[2], voffB[2]; int RA[2], CA[2];
#pragma unroll
    for (int i = 0; i < 2; ++i) { int R, C; stage_rc(tid * 16 + i * 8192, R, C); const int Rb = (R & ~31) + perm32(R & 31);
        voffA[i] = (unsigned)(R * K + C) * 2u; voffB[i] = (unsigned)(Rb * ldb + C) * 2u; RA[i] = R; CA[i] = C; }
    const size_t kstep = (size_t)(BK * 2);
    const size_t hstepA = (size_t)HALF * K * 2, hstepB = (size_t)HALF * ldb * 2;
    const size_t pstepA = (size_t)64 * K * 2, pstepB = (size_t)64 * ldb * 2;
    const unsigned ldsw = (unsigned)wid * 1024u;
    const int aoff = lds_byte(wr * 64 + fr, fq * 8), boff = lds_byte(wc * 32 + fr, fq * 8);
#define PG8_SA(b, h) (((b) * 2 + (h)) * HTB)
#define PG8_SB(b, h) ((4 + (b) * 2 + (h)) * HTB)
#define PG8_STAGE(bufoff, gbase, voff) do { _Pragma("unroll") for (int _i = 0; _i < 2; ++_i) \
        __builtin_amdgcn_global_load_lds((const unsigned*)((const char*)(gbase) + (voff)[_i]), (LAS unsigned*)(lds + (bufoff) + ldsw + _i * 8192), 16, 0, 0); } while (0)
#define PG8_STAGE1(bufoff, gbase, voff1, step) do { _Pragma("unroll") for (int _i = 0; _i < 2; ++_i) \
        __builtin_amdgcn_global_load_lds((const unsigned*)((const char*)(gbase) + (size_t)_i * (step) + (voff1)), (LAS unsigned*)(lds + (bufoff) + ldsw + _i * 8192), 16, 0, 0); } while (0)
#define PG8_LDA(dst, b, h) do { _Pragma("unroll") for (int m = 0; m < 4; ++m) _Pragma("unroll") for (int k = 0; k < 2; ++k) dst[m][k] = *(const LAS bf16x8*)(lds + PG8_SA(b, h) + aoff + m * 2048 + k * 1024); } while (0)
#define PG8_LDB(dst, b, h) do { _Pragma("unroll") for (int n = 0; n < 2; ++n) _Pragma("unroll") for (int k = 0; k < 2; ++k) dst[n][k] = *(const LAS bf16x8*)(lds + PG8_SB(b, h) + boff + n * 2048 + k * 1024); } while (0)
#define PG8_MMA(ai, bj, At, Bt) do { __builtin_amdgcn_s_setprio(1); _Pragma("unroll") for (int m = 0; m < 4; ++m) _Pragma("unroll") for (int n = 0; n < 2; ++n) _Pragma("unroll") for (int k = 0; k < 2; ++k) \
        acc[ai][bj][m][n] = __builtin_amdgcn_mfma_f32_16x16x32_bf16(Bt[n][k], At[m][k], acc[ai][bj][m][n], 0, 0, 0); __builtin_amdgcn_s_setprio(0); } while (0)
#define PG8_WAIT_V(n) asm volatile("s_waitcnt vmcnt(" #n ")" ::: "memory")
#define PG8_WAIT_L(n) asm volatile("s_waitcnt lgkmcnt(" #n ")" ::: "memory")
#define PG8_BAR __builtin_amdgcn_s_barrier()
#define PG8_SCHED __builtin_amdgcn_sched_barrier(0)
    Unit cur, nxt; int ui = 0;
    if (!S.next(0, cur)) return;
    f32x4 acc[2][2][4][2];
#pragma unroll
    for (int a = 0; a < 2; ++a)
#pragma unroll
        for (int b = 0; b < 2; ++b)
#pragma unroll
            for (int m = 0; m < 4; ++m)
#pragma unroll
                for (int n = 0; n < 2; ++n) acc[a][b][m][n] = (f32x4){0.f, 0.f, 0.f, 0.f};
    bf16x8 At[4][2], B0[2][2], B1[2][2];
    const char* cA = S.abase(cur); const char* cB = S.bbase(cur);
    const char* cB2 = cB; const int ksp = BSPLIT ? nt / 2 : (1 << 30);
    if constexpr (BSPLIT) cB2 = S.bbase2(cur) - (size_t)ksp * kstep;
    unsigned oC[2][2], oN[2][2];
    if constexpr (GATHER) {
#pragma unroll
        for (int h = 0; h < 2; ++h)
#pragma unroll
            for (int i = 0; i < 2; ++i) oC[h][i] = (unsigned)S.rowtok(cur, h * HALF + RA[i]) * (unsigned)(K * 2) + (unsigned)(CA[i] * 2);
    }
    PG8_STAGE1(PG8_SB(0, 0), cB, voffB[0], pstepB); PG8_STAGE1(PG8_SB(0, 1), cB + hstepB, voffB[0], pstepB);
    if constexpr (GATHER) { PG8_STAGE(PG8_SA(0, 0), cA, oC[0]); PG8_STAGE(PG8_SA(0, 1), cA, oC[1]); }
    else { PG8_STAGE1(PG8_SA(0, 0), cA, voffA[0], pstepA); PG8_STAGE1(PG8_SA(0, 1), cA + hstepA, voffA[0], pstepA); }
    if (wr == 1) PG8_BAR;
    PG8_WAIT_V(2); PG8_BAR;
    PG8_STAGE1(PG8_SB(1, 0), cB + kstep, voffB[0], pstepB);
    if constexpr (GATHER) { PG8_STAGE(PG8_SA(1, 0), cA + kstep, oC[0]); } else { PG8_STAGE1(PG8_SA(1, 0), cA + kstep, voffA[0], pstepA); }
    PG8_STAGE1(PG8_SB(1, 1), cB + hstepB + kstep, voffB[0], pstepB);
    PG8_WAIT_V(6); PG8_BAR;
    for (;;) {
        const bool has_next = S.next(ui + 1, nxt);
        const char* nA = has_next ? S.abase(nxt) : cA; const char* nB = has_next ? S.bbase(nxt) : cB;
        const char* nB2 = nB; if constexpr (BSPLIT) nB2 = has_next ? S.bbase2(nxt) - (size_t)ksp * kstep : cB2;
        if constexpr (GATHER) {
#pragma unroll
            for (int h = 0; h < 2; ++h)
#pragma unroll
                for (int i = 0; i < 2; ++i) oN[h][i] = has_next ? (unsigned)S.rowtok(nxt, h * HALF + RA[i]) * (unsigned)(K * 2) + (unsigned)(CA[i] * 2) : oC[h][i];
        }
        for (int t = 0; t < nt; t += 2) {
            const bool last = (t == nt - 2);
            const char* a1 = cA + (size_t)(t + 1) * kstep;
            const char* a2 = last ? nA : cA + (size_t)(t + 2) * kstep; const char* b2 = last ? nB : ((t + 2 < ksp) ? cB : cB2) + (size_t)(t + 2) * kstep;
            const char* a3 = a2 + kstep; const char* b3 = b2 + kstep;
            unsigned s0[2], s1[2];
            if constexpr (GATHER) { s0[0] = last ? oN[0][0] : oC[0][0]; s0[1] = last ? oN[0][1] : oC[0][1]; s1[0] = last ? oN[1][0] : oC[1][0]; s1[1] = last ? oN[1][1] : oC[1][1]; }
            PG8_LDB(B0, 0, 0); PG8_LDB(B1, 0, 1); PG8_SCHED; PG8_LDA(At, 0, 0);
            if constexpr (GATHER) { PG8_STAGE(PG8_SA(1, 1), a1, oC[1]); } else { PG8_STAGE1(PG8_SA(1, 1), a1 + hstepA, voffA[0], pstepA); }
            PG8_WAIT_V(8); PG8_WAIT_L(0); PG8_BAR; PG8_MMA(0, 0, At, B0); PG8_MMA(0, 1, At, B1); PG8_BAR; PG8_SCHED;
            PG8_LDA(At, 0, 1); PG8_STAGE1(PG8_SB(0, 0), b2, voffB[0], pstepB); PG8_STAGE1(PG8_SB(0, 1), b2 + hstepB, voffB[0], pstepB);
            if constexpr (GATHER) { PG8_STAGE(PG8_SA(0, 0), a2, s0); } else { PG8_STAGE1(PG8_SA(0, 0), a2, voffA[0], pstepA); }
            PG8_WAIT_V(8); PG8_WAIT_L(0); PG8_BAR; PG8_MMA(1, 0, At, B0); PG8_MMA(1, 1, At, B1); PG8_BAR; PG8_SCHED;
            PG8_LDB(B0, 1, 0); PG8_LDB(B1, 1, 1); PG8_SCHED; PG8_LDA(At, 1, 0);
            if constexpr (GATHER) { PG8_STAGE(PG8_SA(0, 1), a2, s1); } else { PG8_STAGE1(PG8_SA(0, 1), a2 + hstepA, voffA[0], pstepA); }
            PG8_WAIT_V(8); PG8_WAIT_L(0); PG8_BAR; PG8_MMA(0, 0, At, B0); PG8_MMA(0, 1, At, B1); PG8_BAR; PG8_SCHED;
            PG8_LDA(At, 1, 1); PG8_STAGE1(PG8_SB(1, 0), b3, voffB[0], pstepB); PG8_STAGE1(PG8_SB(1, 1), b3 + hstepB, voffB[0], pstepB);
            if constexpr (GATHER) { PG8_STAGE(PG8_SA(1, 0), a3, s0); } else { PG8_STAGE1(PG8_SA(1, 0), a3, voffA[0], pstepA); }
            PG8_WAIT_V(8); PG8_WAIT_L(0); PG8_BAR; PG8_MMA(1, 0, At, B0); PG8_MMA(1, 1, At, B1); PG8_BAR; PG8_SCHED;
        }
        if constexpr (ALIGN_EPI) { if (wr == 0) PG8_BAR; }
        { int ln_; asm volatile("v_mbcnt_lo_u32_b32 %0, -1, 0\n\tv_mbcnt_hi_u32_b32 %0, -1, %0" : "=v"(ln_)); E(acc, cur, wr, wc, ln_ & 15, ln_ >> 4); }
        if (!has_next) break;
#pragma unroll
        for (int a = 0; a < 2; ++a)
#pragma unroll
            for (int b = 0; b < 2; ++b)
#pragma unroll
                for (int m = 0; m < 4; ++m)
#pragma unroll
                    for (int n = 0; n < 2; ++n) acc[a][b][m][n] = (f32x4){0.f, 0.f, 0.f, 0.f};
        cur = nxt; cA = nA; cB = nB; cB2 = nB2; ++ui;
        if constexpr (GATHER) {
#pragma unroll
            for (int h = 0; h < 2; ++h)
#pragma unroll
                for (int i = 0; i < 2; ++i) oC[h][i] = oN[h][i];
        }
        if constexpr (ALIGN_EPI) { if (wr == 1) PG8_BAR; }
    }
    PG8_WAIT_V(0);
    if constexpr (!ALIGN_EPI) { if (wr == 0) PG8_BAR; }
    PG8_BAR;
#undef PG8_SA
#undef PG8_SB
#undef PG8_STAGE
#undef PG8_STAGE1
#undef PG8_LDA
#undef PG8_LDB
#undef PG8_MMA
#undef PG8_WAIT_V
#undef PG8_WAIT_L
#undef PG8_BAR
#undef PG8_SCHED
}
}
using pg8::Unit;

struct DenseOrder {
    const char* A; const char* Bt; size_t tstepA, tstepB; int nM, nN, nwg, G, c;
    __device__ __forceinline__ void init(const void* A_, const void* Bt_, int M, int N, int K, int ldb, int G_, int c_) {
        A = (const char*)A_; Bt = (const char*)Bt_; tstepA = (size_t)256 * K * 2; tstepB = (size_t)256 * ldb * 2; nM = M / 256; nN = N / 256; nwg = nM * nN; G = G_; c = c_; }
    __device__ __forceinline__ bool next(int i, Unit& u) const {
        const long L = (long)i * G + c; if (L >= nwg) return false;
        int wgid = (int)L; { const int q = nwg / 8, r = nwg % 8, xcd = wgid % 8, off = wgid / 8; wgid = (xcd < r ? xcd * (q + 1) : r * (q + 1) + (xcd - r) * q) + off; }
        const int nig = 8 * nN, gid = wgid / nig, fm = gid * 8, gsz = (nM - fm) < 8 ? (nM - fm) : 8;
        u.pm = fm + ((wgid % nig) % gsz); u.pn = (wgid % nig) / gsz; u.cls = 0; u.p0 = 0; return true;
    }
    __device__ __forceinline__ const char* abase(const Unit& u) const { return A + (size_t)u.pm * tstepA; }
    __device__ __forceinline__ const char* bbase(const Unit& u) const { return Bt + (size_t)u.pn * tstepB; }
    __device__ __forceinline__ const char* bbase2(const Unit& u) const { return bbase(u); }
    __device__ __forceinline__ int rowtok(const Unit&, int) const { return 0; }
};

__device__ __forceinline__ void cls_experts(int cls, int& eA, int& eB) { const int g = cls / 6, p = cls % 6; const int a = (p >= 3) + (p >= 5), b = p < 3 ? p + 1 : (p < 5 ? p - 1 : 3); eA = 4 * g + a; eB = 4 * g + b; }
struct ExpertOrder {
    const LAS int* tb; const LAS int* cn; const int* list; const char* A; const char* W; int G, c, mode, layer;
    __device__ __forceinline__ bool next(int i, Unit& u) const {
        const int nwg = __builtin_amdgcn_readfirstlane(tb[NCLS]) * 4; const long L = (long)i * G + c; if (L >= nwg) return false;
        int wgid = (int)L; { const int q = nwg / 8, r = nwg % 8, xcd = wgid % 8, off = wgid / 8; wgid = (xcd < r ? xcd * (q + 1) : r * (q + 1) + (xcd - r) * q) + off; }
        const int rt = wgid >> 2; int cls = 0;
        for (int k = 1; k < NCLS; ++k) cls += (rt >= tb[k]) ? 1 : 0;
        cls = __builtin_amdgcn_readfirstlane(cls);
        u.pm = rt; u.pn = wgid & 3; u.cls = cls; u.p0 = __builtin_amdgcn_readfirstlane((rt - tb[cls]) * 256); return true;
    }
    __device__ __forceinline__ const char* abase(const Unit& u) const { return mode == 1 ? A : A + (size_t)u.pm * (256 * 512 * 2); }
    __device__ __forceinline__ const char* bbase(const Unit& u) const {
        if (mode == 1) { int eA, eB; cls_experts(u.cls, eA, eB); const int e = (u.pn >> 1) ? eB : eA; return W + ((size_t)(layer * 16 + e) * 512 + (size_t)(u.pn & 1) * 256) * (1024 * 2); }
        int eA, eB; cls_experts(u.cls, eA, eB); return W + ((size_t)(layer * 16 + eA) * 1024 + (size_t)u.pn * 256) * (256 * 2);
    }
    __device__ __forceinline__ const char* bbase2(const Unit& u) const { int eA, eB; cls_experts(u.cls, eA, eB); return W + ((size_t)(layer * 16 + eB) * 1024 + (size_t)u.pn * 256) * (256 * 2); }
    __device__ __forceinline__ int rowtok(const Unit& u, int rr) const { const int pos = u.p0 + rr; return pos < cn[u.cls] ? list[(size_t)u.cls * NTOK + pos] : DUMMY_ROW; }
};

__device__ __forceinline__ float row_rstd16(const float* ssq, int row, int fq, float inv_n) {
    const f32x4 v = *(const f32x4*)(ssq + (size_t)row * 16 + 4 * fq);
    float s = (v.x + v.y) + (v.z + v.w);
    s = xadd32(xadd16(s));
    return rsqrtf(s * inv_n + EPS);
}

struct EpiProj {
    bf16_t* proj; float* flog; const float* ssq1; const float* fb;
    __device__ __forceinline__ void operator()(const f32x4 (&acc)[2][2][4][2], const Unit& u, int wr, int wc, int fr, int fq) const {
#pragma unroll
        for (int ai = 0; ai < 2; ++ai)
#pragma unroll
            for (int m = 0; m < 4; ++m) {
                const int row = u.pm * 256 + ai * 128 + wr * 64 + m * 16 + fr;
                const float rs = row_rstd16(ssq1, row, fq, 1.f / DM);
                if (u.pn < 9) {
#pragma unroll
                    for (int bj = 0; bj < 2; ++bj) { const f32x4 v0 = acc[ai][bj][m][0] * rs, v1 = acc[ai][bj][m][1] * rs; u32x4 w;
                        w.x = cvt_pk_bf16(v0[0], v0[1]); w.y = cvt_pk_bf16(v0[2], v0[3]); w.z = cvt_pk_bf16(v1[0], v1[1]); w.w = cvt_pk_bf16(v1[2], v1[3]);
                        *(u32x4*)(proj + (size_t)row * PJ + u.pn * 256 + bj * 128 + wc * 32 + 8 * fq) = w; }
                } else if (wc == 0 && fq == 0) {
                    f32x4 o0, o1;
#pragma unroll
                    for (int e = 0; e < 4; ++e) { const float f0 = acc[ai][0][m][0][e] * rs + fb[e], f1 = acc[ai][0][m][1][e] * rs + fb[4 + e];
                        o0[e] = -log2f(1.f + exp2f(-f0 * LOG2E)); o1[e] = -log2f(1.f + exp2f(-f1 * LOG2E)); }
                    *(f32x4*)(flog + (size_t)row * 8) = o0; *(f32x4*)(flog + (size_t)row * 8 + 4) = o1;
                }
            }
    }
};
template <bool TOKMAP> struct EpiRes {
    bf16_t* h; float* ssq; const LAS int* cn; const int* list;
    __device__ __forceinline__ void operator()(const f32x4 (&acc)[2][2][4][2], const Unit& u, int wr, int wc, int fr, int fq) const {
#pragma unroll
        for (int ai = 0; ai < 2; ++ai)
#pragma unroll
            for (int m = 0; m < 4; ++m) {
                const int rr = ai * 128 + wr * 64 + m * 16 + fr; int row;
                if constexpr (TOKMAP) { const int pos = u.p0 + rr; row = pos < cn[u.cls] ? list[(size_t)u.cls * NTOK + pos] : DUMMY_ROW; } else row = u.pm * 256 + rr;
                float sq = 0.f;
#pragma unroll
                for (int bj = 0; bj < 2; ++bj) { bf16_t* p = h + (size_t)row * DM + u.pn * 256 + bj * 128 + wc * 32 + 8 * fq; const u32x4 o = *(const u32x4*)p;
                    const f32x4 a0 = acc[ai][bj][m][0], a1 = acc[ai][bj][m][1]; u32x4 w;
                    w.x = cvt_pk_bf16(bflo(o.x) + a0[0], bfhi(o.x) + a0[1]); w.y = cvt_pk_bf16(bflo(o.y) + a0[2], bfhi(o.y) + a0[3]);
                    w.z = cvt_pk_bf16(bflo(o.z) + a1[0], bfhi(o.z) + a1[1]); w.w = cvt_pk_bf16(bflo(o.w) + a1[2], bfhi(o.w) + a1[3]);
                    *(u32x4*)p = w;
                    sq += bflo(w.x) * bflo(w.x) + bfhi(w.x) * bfhi(w.x) + bflo(w.y) * bflo(w.y) + bfhi(w.y) * bfhi(w.y) + bflo(w.z) * bflo(w.z) + bfhi(w.z) * bfhi(w.z) + bflo(w.w) * bflo(w.w) + bfhi(w.w) * bfhi(w.w); }
                sq = xadd32(xadd16(sq));
                if (fq == 0) ssq[(size_t)row * 16 + u.pn * 4 + wc] = sq;
            }
    }
};
struct EpiE1 {
    bf16_t* H1; const float* tinfo; const LAS int* cn; const int* list;
    __device__ __forceinline__ void operator()(const f32x4 (&acc)[2][2][4][2], const Unit& u, int wr, int wc, int fr, int fq) const {
#pragma unroll
        for (int ai = 0; ai < 2; ++ai)
#pragma unroll
            for (int m = 0; m < 4; ++m) {
                const int rr = ai * 128 + wr * 64 + m * 16 + fr; const int pos = u.p0 + rr;
                const int tok = pos < cn[u.cls] ? list[(size_t)u.cls * NTOK + pos] : DUMMY_ROW;
                const f32x4 ti = *(const f32x4*)(tinfo + (size_t)tok * 4);
                const float rs = ti.x, gate = (u.pn >> 1) ? ti.z : ti.y;
                float o[8];
#pragma unroll
                for (int n = 0; n < 2; ++n)
#pragma unroll
                    for (int e = 0; e < 4; ++e) { const float a = acc[ai][0][m][n][e] * rs, b = acc[ai][1][m][n][e] * rs; o[n * 4 + e] = gate * siluf_(a) * b; }
                u32x4 w; w.x = cvt_pk_bf16(o[0], o[1]); w.y = cvt_pk_bf16(o[2], o[3]); w.z = cvt_pk_bf16(o[4], o[5]); w.w = cvt_pk_bf16(o[6], o[7]);
                *(u32x4*)(H1 + (size_t)(u.pm * 256 + rr) * 512 + (u.pn >> 1) * 256 + (u.pn & 1) * 128 + wc * 32 + 8 * fq) = w;
            }
    }
};

__device__ __forceinline__ f32x2 meta_gemm64(LAS unsigned char* lds, const int tid, const bf16_t* A, const bf16_t* Bt, int K, int n0) {
    const int lane = tid & 63, m = lane & 15, q4 = lane >> 4; const int w = __builtin_amdgcn_readfirstlane(tid >> 6);
    const int kr = K >> 3;
    const bf16_t* ap = A + (size_t)m * K + w * kr + 8 * q4; const bf16_t* bp = Bt + (size_t)(n0 + m) * K + w * kr + 8 * q4;
    bf16x8 av[4], bv[4][4];
#pragma unroll
    for (int ks = 0; ks < 4; ++ks) { av[ks] = *(const bf16x8*)(ap + 32 * ks);
#pragma unroll
        for (int j = 0; j < 4; ++j) bv[ks][j] = *(const bf16x8*)(bp + (size_t)16 * j * K + 32 * ks); }
    f32x4 acc[4];
#pragma unroll
    for (int j = 0; j < 4; ++j) acc[j] = (f32x4){0.f, 0.f, 0.f, 0.f};
#pragma unroll
    for (int ks = 0; ks < 4; ++ks)
#pragma unroll
        for (int j = 0; j < 4; ++j) acc[j] = __builtin_amdgcn_mfma_f32_16x16x32_bf16(bv[ks][j], av[ks], acc[j], 0, 0, 0);
    LAS float* part = (LAS float*)lds;
#pragma unroll
    for (int j = 0; j < 4; ++j) *(LAS f32x4*)(part + (w * 16 + m) * 64 + 16 * j + 4 * q4) = acc[j];
    __syncthreads();
    const int mm = tid >> 5, cp = tid & 31; f32x2 r = {0.f, 0.f};
#pragma unroll
    for (int ww = 0; ww < 8; ++ww) r += *(const LAS f32x2*)(part + (ww * 16 + mm) * 64 + 2 * cp);
    __syncthreads();
    return r;
}
__device__ __forceinline__ float row_rstd_all(const float* ssq, int row, float inv_n) {
    float s = 0.f;
#pragma unroll
    for (int q = 0; q < 4; ++q) { const f32x4 v = *(const f32x4*)(ssq + (size_t)row * 16 + 4 * q); s += (v.x + v.y) + (v.z + v.w); }
    return rsqrtf(s * inv_n + EPS);
}

#define XB_TMO      128
#define XB_XCNT(j)  (256  + 64 * (j))
#define XB_XSUB(j)  (1280 + 64 * (j))
#define XB_XGEN(j)  (2304 + 64 * (j))
#define XB_TOP      3328
#define XB_TOPGEN   3392
#define XCD_BAR_WORDS 3456
#define XB_SPIN_CAP (1u << 18)
__device__ __forceinline__ unsigned xb_ld(unsigned* p)              { return __hip_atomic_load(p, __ATOMIC_RELAXED, __HIP_MEMORY_SCOPE_AGENT); }
__device__ __forceinline__ unsigned xb_add(unsigned* p, unsigned v) { return __hip_atomic_fetch_add(p, v, __ATOMIC_RELAXED, __HIP_MEMORY_SCOPE_AGENT); }
__device__ __forceinline__ unsigned xb_xcc_id() { return (unsigned)__builtin_amdgcn_s_getreg((3 << 11) | 20) & 0xFu; }
#define XB_SPIN(cond, bar) do { unsigned _sp = 0; while (cond) { __builtin_amdgcn_s_sleep(1); \
    if ((++_sp & 255u) == 0u) { if (xb_ld(&(bar)[XB_TMO])) break; if (_sp > XB_SPIN_CAP) { atomicAdd(&(bar)[XB_TMO], 1u); break; } } } } while (0)
struct XcdBarrier { unsigned* bar; unsigned x; volatile LAS unsigned* st; };
__device__ __forceinline__ XcdBarrier xcd_barrier_post(unsigned* bar, volatile LAS unsigned* st) {
    XcdBarrier b; b.bar = bar; b.x = xb_xcc_id(); b.st = st;
    if (threadIdx.x == 0) (void)xb_add(&bar[XB_XCNT(b.x)], 1u);
    return b;
}
__device__ __forceinline__ void xcd_barrier_complete(unsigned* bar, unsigned x, unsigned& nloc, unsigned& nx) {
    const unsigned G = gridDim.x * gridDim.y * gridDim.z;
    unsigned sum, cnt, mine, sp = 0u;
    for (;;) {
        sum = 0u; cnt = 0u; mine = 0u;
#pragma unroll
        for (unsigned j = 0; j < 16; ++j) { const unsigned c = xb_ld(&bar[XB_XCNT(j)]); sum += c; cnt += (c > 0u) ? 1u : 0u; mine = (j == x) ? c : mine; }
        if (sum == G) break;
        __builtin_amdgcn_s_sleep(1);
        if ((++sp & 255u) == 0u) { if (xb_ld(&bar[XB_TMO])) break; if (sp > XB_SPIN_CAP) { atomicAdd(&bar[XB_TMO], 1u); break; } }
    }
    nloc = mine > 0u ? mine : 1u; nx = cnt > 0u ? cnt : 1u;
}
__device__ __forceinline__ void xcd_barrier(const XcdBarrier& b, const bool leader_thread) {
    asm volatile("s_waitcnt vmcnt(0)" ::: "memory");
    __syncthreads();
    if (leader_thread) {
        unsigned long long bz_ = 0; asm volatile("" : "+s"(bz_)); unsigned* bar = b.bar + bz_;
        __builtin_amdgcn_s_waitcnt(0);
        unsigned nloc = b.st[0], nx = b.st[1];
        if (nloc == 0u) { xcd_barrier_complete(bar, b.x, nloc, nx); b.st[0] = nloc; b.st[1] = nx; }
        const unsigned old = xb_add(&bar[XB_XSUB(b.x)], 1u);
        const unsigned gen = old / nloc;
        if (old + 1u == (gen + 1u) * nloc) {
            __builtin_amdgcn_fence(__ATOMIC_RELEASE, "agent");
            asm volatile("s_waitcnt vmcnt(0)" ::: "memory");
            const unsigned og = xb_add(&bar[XB_TOP], 1u);
            const unsigned tg = og / nx;
            if (og + 1u == (tg + 1u) * nx) xb_add(&bar[XB_TOPGEN], 1u);
            else XB_SPIN(xb_ld(&bar[XB_TOPGEN]) == tg, bar);
            __builtin_amdgcn_fence(__ATOMIC_ACQUIRE, "agent");
            xb_add(&bar[XB_XGEN(b.x)], 1u);
            asm volatile("s_waitcnt vmcnt(0)" ::: "memory");
        } else {
            XB_SPIN(xb_ld(&bar[XB_XGEN(b.x)]) == gen, bar);
            __builtin_amdgcn_fence(__ATOMIC_ACQUIRE, "agent");
            asm volatile("s_waitcnt vmcnt(0)" ::: "memory");
        }
    }
    __syncthreads();
}

template <class Get>
__device__ __forceinline__ void tr_item(const Get& get, bf16_t* dst, int dpitch, int k0, int n0, LAS float* scr, int lane) {
    float tv[32];
#pragma unroll
    for (int i = 0; i < 32; ++i) tv[i] = get(k0 + 2 * i + (lane >> 5), n0 + (lane & 31));
#pragma unroll
    for (int i = 0; i < 32; ++i) scr[(2 * i + (lane >> 5)) * 33 + (lane & 31)] = tv[i];
    LDS_WAIT(); asm volatile("" ::: "memory");
    const int c = lane & 7;
#pragma unroll
    for (int j = 0; j < 4; ++j) { const int n = (lane >> 3) + 8 * j; const LAS float* s = scr + (8 * c) * 33 + n;
        u32x4 o; o.x = pk2(s[0 * 33], s[1 * 33]); o.y = pk2(s[2 * 33], s[3 * 33]); o.z = pk2(s[4 * 33], s[5 * 33]); o.w = pk2(s[6 * 33], s[7 * 33]);
        *(u32x4*)(dst + (size_t)(n0 + n) * dpitch + k0 + 8 * c) = o; }
    LDS_WAIT(); asm volatile("" ::: "memory");
}
struct GetWin { const float* w; const float* g;
    __device__ __forceinline__ float operator()(int k, int n) const { int src; if (n < 2048) src = n; else if (n < 2304) src = n + 8; else if (n < 2312) src = n - 256; else return 0.f;
        float v = w[(size_t)k * DINSRC + src] * g[k]; if (n >= PQ && n < PK) v *= 0.125f * LOG2E; return v; } };
struct GetWout { const float* w; const float* ga; const float* gs;
    __device__ __forceinline__ float operator()(int k, int n) const { const int src = k < 768 ? k + 256 : k - 768; const float gn = k < 512 ? ga[k] : (k < 768 ? gs[k - 512] : 1.f);
        return w[(size_t)src * DM + n] * gn; } };
struct GetW13 { const float* w1; const float* w3; const float* g;
    __device__ __forceinline__ float operator()(int k, int n) const { const int u = n >> 8, hf = (n >> 7) & 1, j = n & 127; const uintptr_t wp = (uintptr_t)w1 + (uintptr_t)hf * ((uintptr_t)w3 - (uintptr_t)w1); return ((const GAS float*)wp)[(size_t)k * 256 + u * 128 + j] * g[k]; } };
struct GetW2 { const float* w;
    __device__ __forceinline__ float operator()(int k, int n) const { return w[(size_t)k * DM + n]; } };
struct GetWr { const float* rg; const float* re; const float* g; int lo;
    __device__ __forceinline__ float operator()(int k, int n) const { float v = 0.f; if (n < 4) v = rg[(size_t)k * 4 + n]; else if (n < 20) v = re[(size_t)k * 16 + (n - 4)]; v *= g[k];
        if (lo) v = v - __uint_as_float(f2bf(v) << 16); return v; } };

constexpr int AT_SLOT = 16384, AT_CS = 81920, AT_WT = AT_CS + 4608 * 4;
__device__ __forceinline__ int crow(int r, int hi) { return (r & 3) + 8 * (r >> 2) + 4 * hi; }
__device__ __forceinline__ void attn_prefix(LAS unsigned char* lds, const int tid, const float* flog, int b, int h) {
    const int lane = tid & 63; const int w = __builtin_amdgcn_readfirstlane(tid >> 6);
    LAS float* cs = (LAS float*)(lds + AT_CS); LAS float* wt = (LAS float*)(lds + AT_WT);
    float v[9]; float run = 0.f;
#pragma unroll
    for (int i = 0; i < 9; ++i) { const int j = tid * 9 + i; float x = 0.f; if (j < NMETA + SEQ) x = flog[(size_t)rowof(b, j) * 8 + h]; run += x; v[i] = run; }
    const float inc = wave_incl_scan(run);
    if (lane == 63) wt[w] = inc;
    __syncthreads();
    float base = inc - run;
    for (int k = 0; k < w; ++k) base += wt[k];
#pragma unroll
    for (int i = 0; i < 9; ++i) cs[tid * 9 + i] = base + v[i];
    __syncthreads();
}
__device__ __forceinline__ void at_glds16(const void* gsrc, unsigned lds_dst) { unsigned keep;
    asm volatile("s_mov_b32 %0, m0\n\ts_mov_b32 m0, %2\n\ts_nop 0\n\tglobal_load_lds_dwordx4 %1, off\n\ts_mov_b32 m0, %0" : "=&s"(keep) : "v"(gsrc), "s"(lds_dst) : "memory"); }
constexpr float AT_THR = 8.f;
__device__ __forceinline__ void attn_unit(LAS unsigned char* lds, const int tid, const bf16_t* proj, bf16_t* mixed, float* ssqa, int b, int h, int qt) {
    const int lane = tid & 63, r32 = lane & 31, hi = lane >> 5; const int w = __builtin_amdgcn_readfirstlane(tid >> 6);
    const LAS float* cs = (const LAS float*)(lds + AT_CS);
    const int qrel = 32 * w + r32;
    const int qrow = qt >= 0 ? b * SEQ + 256 * qt + qrel : NREAL + (qrel & 15);
    const int qkey = qt >= 0 ? NMETA + 256 * qt + qrel : (qrel & 15);
    const int qkey_w0 = qt >= 0 ? NMETA + 256 * qt + 32 * w : 0;
    const float cq = cs[qkey];
    bf16x8 qr[4];
#pragma unroll
    for (int d0 = 0; d0 < 4; ++d0) qr[d0] = *(const bf16x8*)(proj + (size_t)qrow * PJ + PQ + h * 64 + d0 * 16 + hi * 8);
    const int ntiles = qt >= 0 ? 1 + 4 * (qt + 1) : 1;
    const int wnt = qt >= 0 ? 4 * qt + (w >> 1) + 2 : 1;
    const int vr = 16 * (w & 3) + (lane >> 2);
    const unsigned ldsb = (unsigned)(uintptr_t)lds;
#define AT_DMA(jj) do { int kr_, vr_; if ((jj) == 0) { kr_ = NREAL + (lane < 15 ? lane : 15); vr_ = NREAL + (vr < 15 ? vr : 15); } else { kr_ = b * SEQ + 64 * ((jj) - 1) + lane; vr_ = b * SEQ + 64 * ((jj) - 1) + vr; } \
        const int so_ = AT_SLOTOF(sj, (jj) - jbase) + w * 1024; \
        at_glds16(proj + (size_t)kr_ * PJ + PK + h * 64 + w * 8, (unsigned)__builtin_amdgcn_readfirstlane(ldsb + so_)); \
        at_glds16(proj + (size_t)vr_ * PJ + PV + h * 64 + (w >> 2) * 32 + (lane & 3) * 8, (unsigned)__builtin_amdgcn_readfirstlane(ldsb + so_ + 8192)); } while (0)
#define AT_WAITBAR(n) asm volatile("s_waitcnt vmcnt(" #n ") lgkmcnt(0)\n\ts_barrier" ::: "memory")
    float mref = 0.f, lrun = 0.f; f32x16 o0 = {}, o1 = {};
    const int kfo = hi * 1024 + r32 * 16;
    const int vb = 8192 + ((lane >> 4) & 1) * 32 + (lane & 3) * 8 + (4 * hi + ((lane & 15) >> 2)) * 64;
    const LAS float* csl = cs + 4 * hi;
    bf16x8 kf[8];
#define AT_KLOAD(P0, P1, jjn) do { const int kb_ = (jjn) == 0 ? 0 : NMETA + 64 * ((jjn) - 1); const float cqm = cq - mref; const int so_ = AT_SLOTOF(sj, (jjn) - jbase); \
        _Pragma("unroll") for (int d0 = 0; d0 < 4; ++d0) { kf[2 * d0] = *(const LAS bf16x8*)(lds + so_ + kfo + d0 * 2048); kf[2 * d0 + 1] = *(const LAS bf16x8*)(lds + so_ + kfo + d0 * 2048 + 512); } \
        _Pragma("unroll") for (int g_ = 0; g_ < 4; ++g_) { const f32x4 c0_ = *(const LAS f32x4*)(csl + kb_ + 8 * g_), c1_ = *(const LAS f32x4*)(csl + kb_ + 32 + 8 * g_); \
            _Pragma("unroll") for (int e_ = 0; e_ < 4; ++e_) { P0[4 * g_ + e_] = cqm - c0_[e_]; P1[4 * g_ + e_] = cqm - c1_[e_]; } } \
        __builtin_amdgcn_sched_barrier(0); } while (0)
#define AT_QKM(P0, P1) do { _Pragma("unroll") for (int d0 = 0; d0 < 4; ++d0) { \
            P0 = __builtin_amdgcn_mfma_f32_32x32x16_bf16(kf[2 * d0], qr[d0], P0, 0, 0, 0); P1 = __builtin_amdgcn_mfma_f32_32x32x16_bf16(kf[2 * d0 + 1], qr[d0], P1, 0, 0, 0); } \
        __builtin_amdgcn_sched_barrier(0); } while (0)
#define AT_MX3(a, b, c) __builtin_fmaxf(__builtin_fmaxf((a), (b)), (c))
#define AT_SMPV(P0, P1, N0, N1, jj, pend) do { const int kb_ = (jj) == 0 ? 0 : NMETA + 64 * ((jj) - 1); \
        const LAS unsigned char* Vb_ = lds + AT_SLOTOF(sj, (jj) - jbase) + vb; s16x4 va_[8], vc_[8]; \
        _Pragma("unroll") for (int ks = 0; ks < 4; ++ks) { \
            va_[2 * ks] = __builtin_bit_cast(s16x4, __builtin_amdgcn_ds_read_tr16_b64_v4i16((LAS s16x4*)(Vb_ + ks * 1024))); \
            va_[2 * ks + 1] = __builtin_bit_cast(s16x4, __builtin_amdgcn_ds_read_tr16_b64_v4i16((LAS s16x4*)(Vb_ + ks * 1024 + 512))); } \
        __builtin_amdgcn_sched_barrier(0); \
        if ((jj) == 0 || kb_ + 63 > qkey_w0) { const int lim_ = (jj) == 0 ? (qkey < 15 ? qkey : 15) : qkey; \
            _Pragma("unroll") for (int r = 0; r < 16; ++r) { const int j_ = kb_ + crow(r, hi); if (j_ > lim_) P0[r] = -INFINITY; if (j_ + 32 > lim_) P1[r] = -INFINITY; } } \
        float ra_ = AT_MX3(P0[0], P0[1], P1[0]), rb_ = AT_MX3(P0[2], P0[3], P1[1]); ra_ = AT_MX3(ra_, P1[2], P1[3]); \
        _Pragma("unroll") for (int r = 4; r < 16; r += 4) { ra_ = AT_MX3(ra_, P0[r], P0[r + 1]); rb_ = AT_MX3(rb_, P0[r + 2], P0[r + 3]); ra_ = AT_MX3(ra_, P1[r], P1[r + 1]); rb_ = AT_MX3(rb_, P1[r + 2], P1[r + 3]); } \
        float rm_ = fmaxf(ra_, rb_); \
        rm_ = xmax32(rm_); \
        if ((jj) == 0 || __any(rm_ > AT_THR)) { const float dl_ = (jj) == 0 ? rm_ : fmaxf(rm_, 0.f); mref += dl_; const float f_ = (jj) == 0 ? 1.f : fast_exp2(-dl_); lrun *= f_; \
            _Pragma("unroll") for (int r = 0; r < 16; ++r) { P0[r] -= dl_; P1[r] -= dl_; o0[r] *= f_; o1[r] *= f_; } \
            if (pend) { _Pragma("unroll") for (int r = 0; r < 16; ++r) { N0[r] -= dl_; N1[r] -= dl_; } } } \
        float rs_ = 0.f; \
        _Pragma("unroll") for (int r = 0; r < 16; ++r) { P0[r] = fast_exp2(P0[r]); P1[r] = fast_exp2(P1[r]); rs_ += P0[r] + P1[r]; } \
        lrun += rs_; \
        u32x4 pw_[4]; \
        _Pragma("unroll") for (int i = 0; i < 4; ++i) { pw_[0][i] = cvt_pk_bf16(P0[2 * i], P0[2 * i + 1]); pw_[1][i] = cvt_pk_bf16(P0[8 + 2 * i], P0[8 + 2 * i + 1]); \
            pw_[2][i] = cvt_pk_bf16(P1[2 * i], P1[2 * i + 1]); pw_[3][i] = cvt_pk_bf16(P1[8 + 2 * i], P1[8 + 2 * i + 1]); } \
        __builtin_amdgcn_sched_barrier(0); \
        _Pragma("unroll") for (int ks = 0; ks < 4; ++ks) { \
            vc_[2 * ks] = __builtin_bit_cast(s16x4, __builtin_amdgcn_ds_read_tr16_b64_v4i16((LAS s16x4*)(Vb_ + 4096 + ks * 1024))); \
            vc_[2 * ks + 1] = __builtin_bit_cast(s16x4, __builtin_amdgcn_ds_read_tr16_b64_v4i16((LAS s16x4*)(Vb_ + 4096 + ks * 1024 + 512))); } \
        _Pragma("unroll") for (int ks = 0; ks < 4; ++ks) { \
            const bf16x8 va = {va_[2 * ks][0], va_[2 * ks][1], va_[2 * ks][2], va_[2 * ks][3], va_[2 * ks + 1][0], va_[2 * ks + 1][1], va_[2 * ks + 1][2], va_[2 * ks + 1][3]}; \
            o0 = __builtin_amdgcn_mfma_f32_32x32x16_bf16(va, __builtin_bit_cast(bf16x8, pw_[ks]), o0, 0, 0, 0); } \
        __builtin_amdgcn_sched_barrier(0); \
        _Pragma("unroll") for (int ks = 0; ks < 4; ++ks) { \
            const bf16x8 vbb = {vc_[2 * ks][0], vc_[2 * ks][1], vc_[2 * ks][2], vc_[2 * ks][3], vc_[2 * ks + 1][0], vc_[2 * ks + 1][1], vc_[2 * ks + 1][2], vc_[2 * ks + 1][3]}; \
            o1 = __builtin_amdgcn_mfma_f32_32x32x16_bf16(vbb, __builtin_bit_cast(bf16x8, pw_[ks]), o1, 0, 0, 0); } \
        __builtin_amdgcn_sched_barrier(0); } while (0)
#define AT_STEP(C0, C1, N0, N1, jj) do { \
        const bool dma_ = (jj) + 4 < ntiles; \
        if (dma_) AT_DMA((jj) + 4); \
        const bool pend_ = (jj) + 1 < wnt; \
        if (pend_) AT_QKM(N0, N1); \
        if ((jj) < wnt) AT_SMPV(C0, C1, N0, N1, jj, pend_); \
        if ((jj) + 2 < wnt) AT_KLOAD(C0, C1, (jj) + 2); \
        if (dma_) AT_WAITBAR(2); else AT_WAITBAR(0); } while (0)
    int sj = 0, jbase = 0;
#define AT_SLOTOF(s_, k_) (((s_) + (k_) * AT_SLOT) >= 5 * AT_SLOT ? ((s_) + (k_) * AT_SLOT) - 5 * AT_SLOT : ((s_) + (k_) * AT_SLOT))
    AT_DMA(0);
    if (ntiles > 1) AT_DMA(1);
    if (ntiles > 2) AT_DMA(2);
    if (ntiles > 3) { AT_DMA(3); AT_WAITBAR(2); } else AT_WAITBAR(0);
    f32x16 pa0, pa1, pb0, pb1;
    AT_KLOAD(pa0, pa1, 0); AT_QKM(pa0, pa1);
    if (1 < wnt) AT_KLOAD(pb0, pb1, 1);
#pragma unroll 1
    for (int jj = 0; jj < ntiles; jj += 2) {
        jbase = jj;
        AT_STEP(pa0, pa1, pb0, pb1, jj);
        if (jj + 1 < ntiles) AT_STEP(pb0, pb1, pa0, pa1, jj + 1);
        sj = AT_SLOTOF(sj, 2);
    }
#undef AT_SLOTOF
#undef AT_KLOAD
#undef AT_QKM
#undef AT_MX3
#undef AT_DMA
#undef AT_WAITBAR
#undef AT_SMPV
#undef AT_STEP
    const float ltot = xadd32(lrun);
    const float inv = 1.f / ltot;
    float sq = 0.f;
#pragma unroll
    for (int r = 0; r < 16; ++r) { o0[r] *= inv; o1[r] *= inv; sq += o0[r] * o0[r] + o1[r] * o1[r]; }
    sq = xadd32(sq);
    const bool st = qt >= 0 || qrel < 16;
    if (st) {
        bf16_t* op = mixed + (size_t)qrow * DM + MX_ATT + h * 64;
#pragma unroll
        for (int g = 0; g < 4; ++g) { u32x2 w0, w1; w0.x = cvt_pk_bf16(o0[4 * g], o0[4 * g + 1]); w0.y = cvt_pk_bf16(o0[4 * g + 2], o0[4 * g + 3]); w1.x = cvt_pk_bf16(o1[4 * g], o1[4 * g + 1]); w1.y = cvt_pk_bf16(o1[4 * g + 2], o1[4 * g + 3]);
            *(u32x2*)(op + 8 * g + 4 * hi) = w0; *(u32x2*)(op + 32 + 8 * g + 4 * hi) = w1; }
        if (hi == 0) ssqa[(size_t)qrow * 8 + h] = sq;
    }
    __syncthreads();
}

__device__ __forceinline__ void conv_unit(LAS unsigned char* lds, const int tid, const bf16_t* proj, bf16_t* mixed, const float* cw, const float* cb, const float* lg, const float* lb, int b, int tbase, int nsub, int nvalid) {
    const int lane = tid & 63; const int w = __builtin_amdgcn_readfirstlane(tid >> 6);
    LAS float* ub = (LAS float*)lds;
    const int cp = tid & 127, rg = tid >> 7;
#pragma unroll 1
    for (int sb = 0; sb < nsub; ++sb) {
        const int t0 = tbase + 64 * sb;
        {
            u32x2 av[12], gv[12];
#pragma unroll
            for (int it = 0; it < 12; ++it) { const int idx = tid + 512 * it; const int rr = idx >> 6, cq4 = (idx & 63) * 4; const int t = t0 - 30 + rr; av[it] = (u32x2){0u, 0u}; gv[it] = (u32x2){0u, 0u};
                if (rr < 94 && t >= 0 && t < NMETA + SEQ) { const bf16_t* p = proj + (size_t)rowof(b, t) * PJ + cq4; av[it] = *(const u32x2*)p; gv[it] = *(const u32x2*)(p + 256); } }
#pragma unroll
            for (int it = 0; it < 12; ++it) { const int idx = tid + 512 * it; const int rr = idx >> 6, cq4 = (idx & 63) * 4; f32x4 u;
                u[0] = bflo(av[it].x) * sigmoidf_(bflo(gv[it].x)); u[1] = bfhi(av[it].x) * sigmoidf_(bfhi(gv[it].x)); u[2] = bflo(av[it].y) * sigmoidf_(bflo(gv[it].y)); u[3] = bfhi(av[it].y) * sigmoidf_(bfhi(gv[it].y));
                if (rr < 94) *(LAS f32x4*)(ub + rr * 256 + cq4) = u; }
        }
        f32x2 wv[31];
#pragma unroll
        for (int j = 0; j < 31; ++j) wv[j] = *(const f32x2*)(cw + j * 256 + 2 * cp);
        __syncthreads();
        f32x2 acc[16];
#pragma unroll
        for (int i = 0; i < 16; ++i) acc[i] = (f32x2){0.f, 0.f};
#pragma unroll
        for (int rr = 0; rr < 46; ++rr) { const f32x2 uv = *(const LAS f32x2*)(ub + (16 * rg + rr) * 256 + 2 * cp);
#pragma unroll
            for (int i = 0; i < 16; ++i) if (rr - i >= 0 && rr - i <= 30) acc[i] += wv[rr - i] * uv; }
        __syncthreads();
        { const f32x2 bb = *(const f32x2*)(cb + 2 * cp);
#pragma unroll
        for (int i = 0; i < 16; ++i) *(LAS f32x2*)(ub + (16 * rg + i) * 256 + 2 * cp) = acc[i] + bb; }
        const f32x4 g4 = *(const f32x4*)(lg + 4 * lane), b4 = *(const f32x4*)(lb + 4 * lane);
        __syncthreads();
#pragma unroll
        for (int i = 0; i < 8; ++i) { const int rr = 8 * w + i; const f32x4 y = *(const LAS f32x4*)(ub + rr * 256 + 4 * lane);
            const float mu = wave_sum((y[0] + y[1]) + (y[2] + y[3])) * (1.f / 256.f);
            const f32x4 d = y - mu; const float var = wave_sum((d[0] * d[0] + d[1] * d[1]) + (d[2] * d[2] + d[3] * d[3])) * (1.f / 256.f);
            const float rs = rsqrtf(var + EPS); f32x4 o;
#pragma unroll
            for (int e = 0; e < 4; ++e) o[e] = siluf_(d[e] * rs * g4[e] + b4[e]);
            if (rr < nvalid) { u32x2 wv2; wv2.x = cvt_pk_bf16(o[0], o[1]); wv2.y = cvt_pk_bf16(o[2], o[3]); *(u32x2*)(mixed + (size_t)rowof(b, t0 + rr) * DM + MX_CONV + 4 * lane) = wv2; } }
        __syncthreads();
    }
}

struct S5P { const float *lre, *lim, *ldt, *bre, *bim, *cre, *cim, *dsk, *gw, *gb; };
__device__ __forceinline__ float gelu_tanh(float x) { const float u = 0.7978845608028654f * (x + 0.044715f * x * x * x); const float e = fast_exp2(2.f * LOG2E * u); const float th = 1.f - 2.f * fast_rcp(e + 1.f); return 0.5f * x * (1.f + th); }
constexpr size_t S5T_BYTES = 163840;
constexpr int S5_KT = 0, S5_WS = 8704, S5_WC = 74240, S5_MD = 139776, S5_MC = 142848;
constexpr int S5L_KT = 0, S5L_W = 8704, S5L_EX = 78336, S5L_MD = 82944, S5L_MC = 86016, S5L_CIN = 102656;
__device__ __forceinline__ void s5_tables_block(LAS unsigned char* lds, const int tid, const S5P& P, int g, unsigned char* tbl) {
    typedef float f2 __attribute__((ext_vector_type(2)));
    LAS f2* pw = (LAS f2*)lds;
    LAS f2* Bb = (LAS f2*)(lds + 8704);
    LAS f2* Cc = (LAS f2*)(lds + 16896);
    if (tid < 64) {
        const int p = tid;
        const float dt = expf(P.ldt[g]);
        const float lr = P.lre[g * 64 + p], li = P.lim[g * 64 + p];
        const float mag = expf(lr * dt);
        const double turns = (double)li * (double)dt * 0.15915494309189535; const float fr = (float)(turns - floor(turns));
        const float ar = mag * __builtin_amdgcn_cosf(fr), ai = mag * __builtin_amdgcn_sinf(fr);
        const float nr = ar - 1.f, ni = ai, den = lr * lr + li * li;
        const float fre = (nr * lr + ni * li) / den, fim = (ni * lr - nr * li) / den;
        float xr = 1.f, xi = 0.f;
        for (int t = 0; t <= 16; ++t) { pw[t * 64 + p] = (f2){xr, xi}; const float nxr = xr * ar - xi * ai, nxi = xr * ai + xi * ar; xr = nxr; xi = nxi; }
        const f2 M = pw[16 * 64 + p];
        float* MD = (float*)(tbl + S5_MD); float* MC = (float*)(tbl + S5_MC);
        float mr = M.x, mi = M.y;
        for (int k = 0; k < 6; ++k) { MD[(k * 64 + p) * 2] = mr; MD[(k * 64 + p) * 2 + 1] = mi; const float n1 = mr * mr - mi * mi, n2 = 2.f * mr * mi; mr = n1; mi = n2; }
        xr = 1.f; xi = 0.f;
        for (int c = 0; c < 32; ++c) { MC[(c * 64 + p) * 2] = xr; MC[(c * 64 + p) * 2 + 1] = xi; const float nxr = xr * M.x - xi * M.y, nxi = xr * M.y + xi * M.x; xr = nxr; xi = nxi; }
        for (int h = 0; h < 16; ++h) { const float br = P.bre[(g * 64 + p) * 16 + h], bi = P.bim[(g * 64 + p) * 16 + h]; Bb[p * 16 + h] = (f2){fre * br - fim * bi, fre * bi + fim * br}; }
    }
    for (int e = tid; e < 1024; e += 512) Cc[e] = (f2){P.cre[g * 1024 + e], P.cim[g * 1024 + e]};
    __syncthreads();
    bf16_t* KT = (bf16_t*)(tbl + S5_KT); bf16_t* WSg = (bf16_t*)(tbl + S5_WS); bf16_t* WCg = (bf16_t*)(tbl + S5_WC);
    for (int e = tid; e < 17 * 256; e += 512) {
        const int t1 = e >> 8, h = (e >> 4) & 15, h2 = e & 15; float acc = 0.f;
        if (t1 > 0) { const int tau = t1 - 1;
            for (int p = 0; p < 64; ++p) { const f2 a = pw[tau * 64 + p], bb = Bb[p * 16 + h2], c = Cc[h * 64 + p]; const float zr = a.x * bb.x - a.y * bb.y, zi = a.x * bb.y + a.y * bb.x; acc += c.x * zr - c.y * zi; }
            if (tau == 0 && h == h2) acc += P.dsk[g * 16 + h]; }
        KT[e] = (bf16_t)f2bf(acc);
    }
    for (int e = tid; e < 128 * 256; e += 512) {
        const int r = e >> 8, ri = r >> 6, p = r & 63, q = e & 255, j = q >> 4, h2 = q & 15;
        const f2 a = pw[(15 - j) * 64 + p], bb = Bb[p * 16 + h2]; const float zr = a.x * bb.x - a.y * bb.y, zi = a.x * bb.y + a.y * bb.x;
        WSg[e] = (bf16_t)f2bf(ri ? zi : zr);
    }
    for (int e = tid; e < 256 * 128; e += 512) {
        const int row = e >> 7, i = row >> 4, h = row & 15, q = e & 127; const int blk = q >> 5, sq_ = (q >> 4) & 1, hh = (q >> 3) & 1, j = q & 7;
        const int n = 32 * blk + 16 * sq_ + 8 * (j >> 2) + 4 * hh + (j & 3); const int ri = n >> 6, p = n & 63;
        const f2 a = pw[(i + 1) * 64 + p], c = Cc[h * 64 + p]; const float zr = c.x * a.x - c.y * a.y, zi = c.x * a.y + c.y * a.x;
        WCg[e] = (bf16_t)f2bf(ri ? -zi : zr);
    }
    __syncthreads();
}

__device__ __forceinline__ void s5_unit(unsigned long long* tsp, LAS unsigned char* lds, const int tid, const unsigned char* tbl, const float* gw, const float* gb, const bf16_t* proj, bf16_t* mixed, float* ssqs, int b, int g) {
    typedef float f2 __attribute__((ext_vector_type(2)));
    const int lane = tid & 63, c = lane & 31, hi = lane >> 5; const int w = __builtin_amdgcn_readfirstlane(tid >> 6);
    TS(30);
    for (int q = tid; q < 544; q += 512) *(LAS u32x4*)(lds + S5L_KT + q * 16) = *(const u32x4*)(tbl + S5_KT + q * 16);
#pragma unroll
    for (int it = 0; it < 8; ++it) { const int q = tid + 512 * it; *(LAS u32x4*)(lds + S5L_W + (q >> 5) * 528 + (q & 31) * 16) = *(const u32x4*)(tbl + S5_WS + q * 16); }
    if (tid < 192) *(LAS u32x4*)(lds + S5L_MD + tid * 16) = *(const u32x4*)(tbl + S5_MD + tid * 16);
#pragma unroll
    for (int it = 0; it < 4; ++it) { const int q = tid + 512 * it; *(LAS u32x2*)(lds + S5L_MC + (q >> 6) * 520 + (q & 63) * 8) = *(const u32x2*)(tbl + S5_MC + q * 8); }
    __syncthreads();
    TS(31);
    const bf16_t* ubase = proj + PU + 16 * g + 8 * hi;
    const LAS unsigned char* mdb = lds + S5L_MD + hi * 32;
    const LAS unsigned char* mcb = lds + S5L_MC + c * 520 + hi * 32;
    LAS float* EX = (LAS float*)(lds + S5L_EX) + 4 * hi;
    const LAS unsigned char* wsb = lds + S5L_W + c * 528 + hi * 16;
    const LAS unsigned char* wcb = lds + S5L_W + c * 272 + hi * 16;
    f32x16 sa[4];
#pragma unroll
    for (int k = 0; k < 4; ++k) sa[k] = (f32x16){};
    {
        const int cc = 32 * w + c;
        const GAS bf16_t* up = (const GAS bf16_t*)(ubase + (size_t)rowof(b, 16 * cc) * PJ);
#pragma unroll
        for (int s0 = 0; s0 < 16; s0 += 8) {
            bf16x8 uf[8];
#pragma unroll
            for (int s = 0; s < 8; ++s) { uf[s] = *(const GAS bf16x8*)up; up += PJ; asm volatile("" : "+v"(up)); }
            __builtin_amdgcn_sched_barrier(0);
#pragma unroll
            for (int s = 0; s < 8; ++s) {
#pragma unroll
                for (int blk = 0; blk < 4; ++blk) { const bf16x8 A = *(const LAS bf16x8*)(wsb + blk * (32 * 528) + (s0 + s) * 32); sa[blk] = __builtin_amdgcn_mfma_f32_32x32x16_bf16(A, uf[s], sa[blk], 0, 0, 0); }
                __builtin_amdgcn_sched_barrier(0); }
        }
    }
    TS(32);
    float sr[2][16], si[2][16];
#pragma unroll
    for (int pb = 0; pb < 2; ++pb)
#pragma unroll
        for (int r = 0; r < 16; ++r) { sr[pb][r] = sa[pb][r]; si[pb][r] = sa[2 + pb][r]; }
#pragma unroll
    for (int k = 0; k < 4; ++k) {
        const LAS unsigned char* mdk = mdb + k * 512; asm volatile("" : "+v"(mdk));
#pragma unroll
        for (int pb = 0; pb < 2; ++pb)
#pragma unroll
            for (int r = 0; r < 16; ++r) { const f2 m = *(const LAS f2*)(mdk + (32 * pb + (r & 3) + 8 * (r >> 2)) * 8);
                float yr, yi;
                if (k == 0) { yr = dpp_mov0<0x111>(sr[pb][r]); yi = dpp_mov0<0x111>(si[pb][r]); } else if (k == 1) { yr = dpp_mov0<0x112>(sr[pb][r]); yi = dpp_mov0<0x112>(si[pb][r]); }
                else if (k == 2) { yr = dpp_mov0<0x114>(sr[pb][r]); yi = dpp_mov0<0x114>(si[pb][r]); } else { yr = dpp_mov0<0x118>(sr[pb][r]); yi = dpp_mov0<0x118>(si[pb][r]); }
                sr[pb][r] += m.x * yr - m.y * yi; si[pb][r] += m.x * yi + m.y * yr; asm volatile("" : "+v"(sr[pb][r]), "+v"(si[pb][r]));
                if ((r & 3) == 3) { asm volatile("" ::: "memory"); __builtin_amdgcn_sched_barrier(0); } }
    }
    {
        const LAS unsigned char* mcu = lds + S5L_MC + ((c & 15) + 1) * 520 + hi * 32; asm volatile("" : "+v"(mcu));
#pragma unroll
        for (int pb = 0; pb < 2; ++pb)
#pragma unroll
            for (int r = 0; r < 16; ++r) { const f2 m = *(const LAS f2*)(mcu + (32 * pb + (r & 3) + 8 * (r >> 2)) * 8);
                const float yr = dpp_mov0m<0x142, 0xA>(sr[pb][r]), yi = dpp_mov0m<0x142, 0xA>(si[pb][r]);
                sr[pb][r] += m.x * yr - m.y * yi; si[pb][r] += m.x * yi + m.y * yr; asm volatile("" : "+v"(sr[pb][r]), "+v"(si[pb][r]));
                if ((r & 3) == 3) { asm volatile("" ::: "memory"); __builtin_amdgcn_sched_barrier(0); } }
    }
    TS(33);
    if (c == 31) {
#pragma unroll
        for (int pb = 0; pb < 2; ++pb)
#pragma unroll
            for (int r = 0; r < 16; ++r) { const int p0 = 32 * pb + (r & 3) + 8 * (r >> 2); EX[w * 128 + p0] = sr[pb][r]; EX[w * 128 + 64 + p0] = si[pb][r]; }
    }
    __syncthreads();
    if (w == 0) {
        LAS float* CIN = (LAS float*)(lds + S5L_CIN); const LAS float* EXp = (const LAS float*)(lds + S5L_EX);
        const f2 m = *(const LAS f2*)(lds + S5L_MD + (5 * 64 + lane) * 8); float cr_ = 0.f, ci_ = 0.f;
#pragma unroll
        for (int t = 0; t < 8; ++t) { CIN[t * 128 + lane] = cr_; CIN[t * 128 + 64 + lane] = ci_; const float er = EXp[t * 128 + lane], ei = EXp[t * 128 + 64 + lane];
            const float nr = m.x * cr_ - m.y * ci_ + er, ni = m.x * ci_ + m.y * cr_ + ei; cr_ = nr; ci_ = ni; }
        CIN[8 * 128 + lane] = cr_; CIN[8 * 128 + 64 + lane] = ci_;
    }
#pragma unroll
    for (int it = 0; it < 8; ++it) { const int q = tid + 512 * it; *(LAS u32x4*)(lds + S5L_W + (q >> 4) * 272 + (q & 15) * 16) = *(const u32x4*)(tbl + S5_WC + q * 16); }
    __syncthreads();
    TS(34);
    const int npass = 2;
#pragma unroll 1
    for (int pass = 0; pass < npass; ++pass) {
        if (pass == 1) TS(35);
        const int nprev = pass == 0 ? w : 8;
        const int cc = pass == 0 ? 32 * w + c : 256;
        if (pass == 1) {
#pragma unroll
            for (int pb = 0; pb < 2; ++pb)
#pragma unroll
                for (int r = 0; r < 16; ++r) { sr[pb][r] = 0.f; si[pb][r] = 0.f; }
        }
        {
            const LAS float* cinp = (const LAS float*)(lds + S5L_CIN) + nprev * 128 + 4 * hi; asm volatile("" : "+v"(cinp));
            const LAS unsigned char* mcb2 = mcb; asm volatile("" : "+v"(mcb2));
#pragma unroll
            for (int pb = 0; pb < 2; ++pb)
#pragma unroll
                for (int r = 0; r < 16; ++r) { const f2 m = *(const LAS f2*)(mcb2 + (32 * pb + (r & 3) + 8 * (r >> 2)) * 8);
                    float xr = dpp_mov0<0x138>(sr[pb][r]), xi = dpp_mov0<0x138>(si[pb][r]); if (c == 0) { xr = 0.f; xi = 0.f; }
                    const float cr_ = cinp[32 * pb + (r & 3) + 8 * (r >> 2)], ci_ = cinp[64 + 32 * pb + (r & 3) + 8 * (r >> 2)];
                    sr[pb][r] = xr + m.x * cr_ - m.y * ci_; si[pb][r] = xi + m.x * ci_ + m.y * cr_; asm volatile("" : "+v"(sr[pb][r]), "+v"(si[pb][r]));
                    if ((r & 3) == 3) { asm volatile("" ::: "memory"); __builtin_amdgcn_sched_barrier(0); } }
        }
        bf16x8 xf[4][2];
#pragma unroll
        for (int blk = 0; blk < 4; ++blk)
#pragma unroll
            for (int s = 0; s < 2; ++s) { const float* v = blk < 2 ? &sr[blk][8 * s] : &si[blk - 2][8 * s]; u32x4 t; t.x = cvt_pk_bf16(v[0], v[1]); t.y = cvt_pk_bf16(v[2], v[3]); t.z = cvt_pk_bf16(v[4], v[5]); t.w = cvt_pk_bf16(v[6], v[7]); xf[blk][s] = __builtin_bit_cast(bf16x8, t); }
        const int io = (lane >> 4) & 1, kk = lane & 15;
        bf16x8 Gf0, Gf1;
        { unsigned pkd[4];
    #pragma unroll
          for (int jj = 0; jj < 4; ++jj) { const int j0 = 2 * jj, j1 = 2 * jj + 1; const int h0 = 8 * (j0 >> 2) + 4 * hi + (j0 & 3), h1 = 8 * (j1 >> 2) + 4 * hi + (j1 & 3); pkd[jj] = pk2(gw[h0 * 16 + kk], gw[h1 * 16 + kk]); }
          const u32x4 wv = {pkd[0], pkd[1], pkd[2], pkd[3]}, zz = {0u, 0u, 0u, 0u};
          Gf0 = __builtin_bit_cast(bf16x8, io == 0 ? wv : zz); Gf1 = __builtin_bit_cast(bf16x8, io == 1 ? wv : zz); }
        float gbv[8];
    #pragma unroll
        for (int q = 0; q < 8; ++q) gbv[q] = gb[(q & 3) + 8 * (q >> 2) + 4 * hi];
        const int ktb = S5L_KT + ((lane >> 4) & 1) * 512 + (lane & 15) * 32 + hi * 16;
        const bool stok = pass == 0 ? (cc > 0 || b == 0) : (c == 0);
#pragma unroll
        for (int half = 0; half < 2; ++half) {
            __builtin_amdgcn_sched_barrier(0);
            f32x16 ya[4];
#pragma unroll
            for (int rl = 0; rl < 4; ++rl) ya[rl] = (f32x16){};
            int hi2 = hi; asm volatile("" : "+v"(hi2));
            const GAS bf16_t* up = (const GAS bf16_t*)(proj + PU + 16 * g + 8 * hi2 + (size_t)rowof(b, 16 * cc) * PJ);
#pragma unroll
            for (int s0 = 0; s0 < 8 * half + 8; s0 += 8) {
                bf16x8 uf[8];
#pragma unroll
                for (int s = 0; s < 8; ++s) { uf[s] = *(const GAS bf16x8*)up; up += PJ; asm volatile("" : "+v"(up)); }
                __builtin_amdgcn_sched_barrier(0);
#pragma unroll
                for (int s = 0; s < 8; ++s) {
#pragma unroll
                    for (int rl = 0; rl < 4; ++rl) { const int rb = 4 * half + rl; if (s0 + s <= 2 * rb + 1 && (pass == 0 || rb == w)) { const bf16x8 A = *(const LAS bf16x8*)(lds + ktb + (2 * rb - (s0 + s) + 1) * 512); ya[rl] = __builtin_amdgcn_mfma_f32_32x32x16_bf16(A, uf[s], ya[rl], 0, 0, 0); } }
                    __builtin_amdgcn_sched_barrier(0); }
            }
#pragma unroll
            for (int rl = 0; rl < 4; ++rl) if (pass == 0 || 4 * half + rl == w) {
#pragma unroll
                for (int blk = 0; blk < 4; ++blk)
#pragma unroll
                    for (int s = 0; s < 2; ++s) { const bf16x8 A = *(const LAS bf16x8*)(wcb + (4 * half + rl) * (32 * 272) + (blk * 2 + s) * 32); ya[rl] = __builtin_amdgcn_mfma_f32_32x32x16_bf16(A, xf[blk][s], ya[rl], 0, 0, 0); }
                __builtin_amdgcn_sched_barrier(0);
            }
#pragma unroll
            for (int rl = 0; rl < 4; ++rl) if (pass == 0 || 4 * half + rl == w) {
                const int rb = 4 * half + rl;
                float zg[16];
#pragma unroll
                for (int r = 0; r < 16; ++r) zg[r] = gelu_tanh(ya[rl][r]);
                u32x4 z0, z1; z0.x = cvt_pk_bf16(zg[0], zg[1]); z0.y = cvt_pk_bf16(zg[2], zg[3]); z0.z = cvt_pk_bf16(zg[4], zg[5]); z0.w = cvt_pk_bf16(zg[6], zg[7]);
                z1.x = cvt_pk_bf16(zg[8], zg[9]); z1.y = cvt_pk_bf16(zg[10], zg[11]); z1.z = cvt_pk_bf16(zg[12], zg[13]); z1.w = cvt_pk_bf16(zg[14], zg[15]);
                f32x16 gt = (f32x16){};
                gt = __builtin_amdgcn_mfma_f32_32x32x16_bf16(Gf0, __builtin_bit_cast(bf16x8, z0), gt, 0, 0, 0);
                gt = __builtin_amdgcn_mfma_f32_32x32x16_bf16(Gf1, __builtin_bit_cast(bf16x8, z1), gt, 0, 0, 0);
#pragma unroll
                for (int il = 0; il < 2; ++il) {
                    float o[8]; float sq = 0.f;
#pragma unroll
                    for (int q = 0; q < 8; ++q) { o[q] = zg[8 * il + q] * sigmoidf_(gt[8 * il + q] + gbv[q]); sq += o[q] * o[q]; }
                    sq = xadd32(sq);
                    if (stok) { const int row = rowof(b, 16 * cc + 2 * rb + il); bf16_t* op = mixed + (size_t)row * DM + MX_SSM + 16 * g + 4 * hi;
                        u32x2 w0, w1; w0.x = cvt_pk_bf16(o[0], o[1]); w0.y = cvt_pk_bf16(o[2], o[3]); w1.x = cvt_pk_bf16(o[4], o[5]); w1.y = cvt_pk_bf16(o[6], o[7]);
                        *(u32x2*)op = w0; *(u32x2*)(op + 8) = w1;
                        if (hi == 0) ssqs[(size_t)row * 16 + g] = sq; }
                }
                __builtin_amdgcn_sched_barrier(0);
            }
        }
    }
    TS(36);
    __syncthreads();
}

struct Args { const GAS float* in[31]; GAS float* out; GAS unsigned char* ws; int ph_lo, ph_hi; };
constexpr int N_PHASES = 16;
#define PHASE_IDS() int tid; { int ln_; asm volatile("v_mbcnt_lo_u32_b32 %0, -1, 0\n\tv_mbcnt_hi_u32_b32 %0, -1, %0" : "=v"(ln_)); tid = wave0 * 64 + ln_; } unsigned long long wz_ = 0; asm volatile("" : "+s"(wz_)); unsigned char* ws = ws0 + wz_;        const int lane = tid & 63; const int wave = __builtin_amdgcn_readfirstlane(tid >> 6); (void)lane; (void)wave

__global__ void __launch_bounds__(NWAVES * 64, 2) hymba_fwd(Args args) {
    extern __shared__ __attribute__((aligned(16))) unsigned char lds_raw[];
    LAS unsigned char* lds = (LAS unsigned char*)lds_raw;
    volatile LAS unsigned* MISC = (volatile LAS unsigned*)(lds + LDSCTL_OFF);
    LAS int* TB = (LAS int*)(lds + LDSCTL_OFF + 256);
    LAS int* CN = (LAS int*)(lds + LDSCTL_OFF + 512);
    LAS int* HIST = (LAS int*)(lds + LDSCTL_OFF + 768);
    const int wave0 = __builtin_amdgcn_readfirstlane(threadIdx.x >> 6);
    const int G = gridDim.x; const int bx = blockIdx.x; const int vcu = (G % 8 == 0) ? (bx % 8) * (G / 8) + bx / 8 : bx;
    unsigned char* const ws0 = (unsigned char*)args.ws;
    unsigned* const ctl = (unsigned*)(GAS unsigned*)(ws0 + WS_CTL);
    for (int u = threadIdx.x; u < (LDS_BYTES - LDSCTL_OFF) / 4; u += NWAVES * 64) ((LAS unsigned*)(lds + LDSCTL_OFF))[u] = 0u;
    __syncthreads();
    const int lo = args.ph_lo, hi = args.ph_hi;
    XcdBarrier bar; bar.bar = ctl + CW_BAR; bar.x = 0; bar.st = nullptr;
    if (hi - lo > 1) bar = xcd_barrier_post(ctl + CW_BAR, MISC + 8);
#define IN(k) (lo <= (k) && (k) < hi)
#define SEAM(k) do { if (IN(k) && IN((k) + 1)) { PHASE_IDS(); xcd_barrier(bar, tid == 0); } STAMP((k) + 1); } while (0)
#define WSP(T, off) ((T*)(ws + (off)))
#define INP(k) ((const float*)args.in[k])
#define STAMP(id) do { if (PROBE_A >= 0 && (int)blockIdx.x == PROBE_BLOCK && ((id) == PROBE_A || (id) == PROBE_B)) { PHASE_IDS(); if (tid == 0) ((unsigned long long*)(ctl + CW_TS))[id] = __builtin_amdgcn_s_memrealtime(); } } while (0)
    STAMP(0);

    for (int rep_ = 0; rep_ < DUP_P0; ++rep_) if (IN(0)) {
        PHASE_IDS();
        bf16_t* WinT = WSP(bf16_t, WS_WIN); bf16_t* WoutT = WSP(bf16_t, WS_WOUT); bf16_t* W13T = WSP(bf16_t, WS_W13); bf16_t* W2C = WSP(bf16_t, WS_W2C); bf16_t* WrT = WSP(bf16_t, WS_WR);
        bf16_t* hbuf = WSP(bf16_t, WS_H); float* ssq1 = WSP(float, WS_SSQ1); float* tinfo = WSP(float, WS_TINFO);
#pragma unroll 1
        for (int lg = vcu; lg < 32; lg += G) { const int l = lg >> 4, g = lg & 15;
            const S5P SP{INP(10) + l * 1024, INP(11) + l * 1024, INP(12) + l * 16, INP(13) + (size_t)l * 16384, INP(14) + (size_t)l * 16384, INP(15) + (size_t)l * 16384, INP(16) + (size_t)l * 16384,
                         INP(17) + l * 256, INP(18) + (size_t)l * 4096, INP(19) + l * 256};
            int tidp = tid; asm volatile("" : "+v"(tidp));
            s5_tables_block(lds, tidp, SP, g, WSP(unsigned char, WS_S5T) + (size_t)lg * S5T_BYTES); }
        LAS float* scr = (LAS float*)(lds + wave * 16384);
        const int gw = vcu * NWAVES + wave, NGW = G * NWAVES;
        constexpr int I_WIN = 16 * 80, I_WOUT = 16 * 32, I_W13 = 16 * 16, I_W2 = 4 * 32, I_WR = 16;
        constexpr int T_WIN = 2 * I_WIN, T_WOUT = 2 * I_WOUT, T_W13 = 32 * I_W13, T_W2 = 32 * I_W2, T_WR = 4 * I_WR;
        constexpr int NITEMS = T_WIN + T_WOUT + T_W13 + T_W2 + T_WR;
        const int nskip = G >= 64 ? 32 : 0; const int igw = (vcu - nskip) * NWAVES + wave, INGW = (G - nskip) * NWAVES;
#pragma unroll 1
        for (int it = igw; it < NITEMS && vcu >= nskip; it += INGW) {
            int r = it;
            if (r < T_WIN) { const int l = r / I_WIN, q = r % I_WIN, kb = q / 80, nb = q % 80; GetWin gt{INP(3) + (size_t)l * DM * DINSRC, INP(2) + l * DM};
                tr_item(gt, WinT + (size_t)l * NIN * DM, DM, 64 * kb, 32 * nb, scr, lane); continue; } r -= T_WIN;
            if (r < T_WOUT) { const int l = r / I_WOUT, q = r % I_WOUT, kb = q / 32, nb = q % 32; GetWout gt{INP(21) + (size_t)l * DM * DM, INP(9) + l * 512, INP(20) + l * 256};
                tr_item(gt, WoutT + (size_t)l * DM * DM, DM, 64 * kb, 32 * nb, scr, lane); continue; } r -= T_WOUT;
            if (r < T_W13) { const int le = r / I_W13, q = r % I_W13, kb = q / 16, nb = q % 16; const int l = le / 16; GetW13 gt{INP(27) + (size_t)le * DM * 256, INP(28) + (size_t)le * DM * 256, INP(22) + l * DM};
                tr_item(gt, W13T + (size_t)le * 512 * DM, DM, 64 * kb, 32 * nb, scr, lane); continue; } r -= T_W13;
            if (r < T_W2) { const int le = r / I_W2, q = r % I_W2, kb = q / 32, nb = q % 32; GetW2 gt{INP(29) + (size_t)le * 256 * DM};
                tr_item(gt, W2C + (size_t)le * DM * 256, 256, 64 * kb, 32 * nb, scr, lane); continue; } r -= T_W2;
            { const int lh = r / I_WR, kb = r % I_WR; const int l = lh >> 1, lo_ = lh & 1; GetWr gt{INP(23) + (size_t)l * DM * 4, INP(25) + (size_t)l * DM * 16, INP(22) + l * DM, lo_};
                tr_item(gt, WrT + (size_t)lh * 32 * DM, DM, 64 * kb, 0, scr, lane); }
        }
#pragma unroll 1
        for (int r0 = 2 * gw; r0 < MROWS; r0 += 2 * NGW) {
            f32x4 v[2][4];
#pragma unroll
            for (int q = 0; q < 2; ++q) { const int r = r0 + q;
#pragma unroll
                for (int j = 0; j < 4; ++j) { if (r < NREAL) v[q][j] = *(const f32x4*)(INP(0) + (size_t)r * DM + 4 * lane + 256 * j); else if (r < NTOK) v[q][j] = *(const f32x4*)(INP(1) + (size_t)(r - NREAL) * DM + 4 * lane + 256 * j); else v[q][j] = (f32x4){0.f, 0.f, 0.f, 0.f}; } }
#pragma unroll
            for (int q = 0; q < 2; ++q) { const int r = r0 + q; float s = 0.f;
#pragma unroll
                for (int j = 0; j < 4; ++j) { u32x2 w; w.x = pk2(v[q][j][0], v[q][j][1]); w.y = pk2(v[q][j][2], v[q][j][3]); *(u32x2*)(hbuf + (size_t)r * DM + 4 * lane + 256 * j) = w;
                    s += bflo(w.x) * bflo(w.x) + bfhi(w.x) * bfhi(w.x) + bflo(w.y) * bflo(w.y) + bfhi(w.y) * bfhi(w.y); }
                s = wave_sum(s);
                if (lane < 16) ssq1[(size_t)r * 16 + lane] = lane == 0 ? s : 0.f;
                if (r >= NTOK && lane < 4) tinfo[(size_t)r * 4 + lane] = 0.f; }
        }
    }
    SEAM(0);

#pragma unroll 1
    for (int l = 0; l < DEPTH; ++l) {
        const int P = 1 + 7 * l;
        for (int rep_ = 0; rep_ < DUP_G1; ++rep_) if (IN(P)) {
            PHASE_IDS();
            bf16_t* hbuf = WSP(bf16_t, WS_H); bf16_t* proj = WSP(bf16_t, WS_PROJ); float* flog = WSP(float, WS_FLOG); const float* ssq1 = WSP(float, WS_SSQ1);
            const bf16_t* Win = WSP(bf16_t, WS_WIN) + (size_t)l * NIN * DM; const float* fb = INP(4) + l * 8;
            DenseOrder S; S.init(hbuf, Win, NREAL, NIN, DM, DM, G, bx);
            EpiProj E{proj, flog, ssq1, fb};
            pg8::gemm_phase<EpiProj, DenseOrder, true, false>(lds, tid, DM, DM, S, E);
#pragma unroll 1
            for (int cb = bx; cb < NIN / 64; cb += G) {
                const f32x2 v = meta_gemm64(lds, tid, hbuf + (size_t)NREAL * DM, Win, DM, cb * 64);
                const int mm = tid >> 5, cp = tid & 31, row = NREAL + mm;
                const float rs = row_rstd_all(ssq1, row, 1.f / DM);
                if (cb < 36) *(unsigned*)(proj + (size_t)row * PJ + cb * 64 + 2 * cp) = cvt_pk_bf16(v.x * rs, v.y * rs);
                else if (cb == 36 && cp < 4) { f32x2 o; const float f0 = v.x * rs + fb[2 * cp], f1 = v.y * rs + fb[2 * cp + 1]; o.x = -log2f(1.f + exp2f(-f0 * LOG2E)); o.y = -log2f(1.f + exp2f(-f1 * LOG2E)); *(f32x2*)(flog + (size_t)row * 8 + 2 * cp) = o; }
            }
        }
        SEAM(P);
        for (int rep_ = 0; rep_ < DUP_MIX; ++rep_) if (IN(P + 1)) {
            PHASE_IDS();
            const bf16_t* proj = WSP(bf16_t, WS_PROJ); bf16_t* mixed = WSP(bf16_t, WS_MIX); const float* flog = WSP(float, WS_FLOG); float* ssqa = WSP(float, WS_SSQA); float* ssqs = WSP(float, WS_SSQS);
            for (int repa_ = 0; repa_ < DUP_ATT; ++repa_)
#pragma unroll 1
            for (int vc = vcu; vc < 256; vc += G) {
                int bh = vc >> 2; asm volatile("" : "+s"(bh));
                const int b = bh >> 3, h = bh & 7;
                attn_prefix(lds, tid, flog, b, h);
#pragma unroll 1
                for (int i = 0; i < 4; ++i) { const int s = (vc & 3) * 2 + (i >> 1); int qt = (i & 1) ? 15 - s : s; asm volatile("" : "+s"(qt)); int tid3 = tid; asm volatile("" : "+v"(tid3)); attn_unit(lds, tid3, proj, mixed, ssqa, b, h, qt); }
            }
#pragma unroll 1
            for (int vc = vcu; vc < 8; vc += G) { int hh = vc; asm volatile("" : "+s"(hh)); int tid3 = tid; asm volatile("" : "+v"(tid3)); attn_prefix(lds, tid3, flog, 0, hh); attn_unit(lds, tid3, proj, mixed, ssqa, 0, hh, -1); }
            STAMP(20 + l * 4);
            const float* cw = INP(5) + (size_t)l * 31 * 256; const float* cbp = INP(6) + l * 256; const float* clg = INP(7) + l * 256; const float* clb = INP(8) + l * 256;
            for (int repc_ = 0; repc_ < DUP_CS; ++repc_)
#pragma unroll 1
            for (int vc = vcu; vc < 256; vc += G) {
                int tid2 = tid; asm volatile("" : "+v"(tid2));
                if ((vc & 1) == 0) { const int ci = vc >> 1;
                    conv_unit(lds, tid2, proj, mixed, cw, cbp, clg, clb, ci >> 4, NMETA + 256 * (ci & 15), 4, 64);
                } else {
                    if (vc == 1) conv_unit(lds, tid2, proj, mixed, cw, cbp, clg, clb, 0, 0, 1, 16);
                    int ug = vc >> 1; asm volatile("" : "+s"(ug));
                    s5_unit((unsigned long long*)(ctl + CW_TS), lds, tid2, WSP(unsigned char, WS_S5T) + (size_t)(l * 16 + (ug & 15)) * S5T_BYTES, INP(18) + (size_t)l * 4096 + (ug & 15) * 256, INP(19) + l * 256 + (ug & 15) * 16, proj, mixed, ssqs, ug >> 4, ug & 15);
                }
            }
        }
        if (IN(P + 1)) STAMP(21 + l * 4);
        SEAM(P + 1);
        if (IN(P + 2)) {
            PHASE_IDS();
            bf16_t* mixed = WSP(bf16_t, WS_MIX); const float* ssqa = WSP(float, WS_SSQA); const float* ssqs = WSP(float, WS_SSQS);
            const int gw = vcu * NWAVES + wave, NGW = G * NWAVES;
#pragma unroll 1
            for (int r = gw; r < NTOK; r += NGW) {
                float sa = lane < 8 ? ssqa[(size_t)r * 8 + lane] : 0.f, ss = lane < 16 ? ssqs[(size_t)r * 16 + lane] : 0.f;
                sa = wave_sum(sa); ss = wave_sum(ss);
                const float ra = rsqrtf(sa * (1.f / 512.f) + EPS), rsm = rsqrtf(ss * (1.f / 256.f) + EPS);
                bf16_t* p = mixed + (size_t)r * DM;
                u32x4 a = *(u32x4*)(p + 8 * lane);
                a.x = cvt_pk_bf16(bflo(a.x) * ra, bfhi(a.x) * ra); a.y = cvt_pk_bf16(bflo(a.y) * ra, bfhi(a.y) * ra); a.z = cvt_pk_bf16(bflo(a.z) * ra, bfhi(a.z) * ra); a.w = cvt_pk_bf16(bflo(a.w) * ra, bfhi(a.w) * ra);
                *(u32x4*)(p + 8 * lane) = a;
                u32x2 s2 = *(u32x2*)(p + MX_SSM + 4 * lane);
                s2.x = cvt_pk_bf16(bflo(s2.x) * rsm, bfhi(s2.x) * rsm); s2.y = cvt_pk_bf16(bflo(s2.y) * rsm, bfhi(s2.y) * rsm);
                *(u32x2*)(p + MX_SSM + 4 * lane) = s2;
            }
        }
        SEAM(P + 2);
        if (IN(P + 3)) {
            PHASE_IDS();
            bf16_t* hbuf = WSP(bf16_t, WS_H); const bf16_t* mixed = WSP(bf16_t, WS_MIX); float* ssq2 = WSP(float, WS_SSQ2); const bf16_t* Wo = WSP(bf16_t, WS_WOUT) + (size_t)l * DM * DM;
            DenseOrder S; S.init(mixed, Wo, NREAL, DM, DM, DM, G, bx);
            EpiRes<false> E{hbuf, ssq2, CN, nullptr};
            pg8::gemm_phase<EpiRes<false>, DenseOrder, true, false>(lds, tid, DM, DM, S, E);
            STAMP(40 + 2 * l);
#pragma unroll 1
            for (int cb = bx; cb < DM / 64; cb += G) {
                const f32x2 v = meta_gemm64(lds, tid, mixed + (size_t)NREAL * DM, Wo, DM, cb * 64);
                const int mm = tid >> 5, cp = tid & 31, row = NREAL + mm;
                unsigned* p = (unsigned*)(hbuf + (size_t)row * DM + cb * 64 + 2 * cp); const unsigned o = *p;
                const unsigned wv = cvt_pk_bf16(bflo(o) + v.x, bfhi(o) + v.y); *p = wv;
                const float sq = half32_sum(bflo(wv) * bflo(wv) + bfhi(wv) * bfhi(wv));
                if (cp == 0) ssq2[(size_t)row * 16 + cb] = sq;
            }
        }
        if (IN(P + 3)) STAMP(41 + 2 * l);
        SEAM(P + 3);
        if (IN(P + 4)) {
            PHASE_IDS();
            const bf16_t* hbuf = WSP(bf16_t, WS_H); const float* ssq2 = WSP(float, WS_SSQ2); float* tinfo = WSP(float, WS_TINFO); int* list = WSP(int, WS_LIST);
            unsigned* gcnt = ctl + CW_CNT + l * 32;
            const bf16_t* Whi = WSP(bf16_t, WS_WR) + (size_t)(2 * l) * 32 * DM; const bf16_t* Wlo = Whi + (size_t)32 * DM;
            LAS float* scr = (LAS float*)(lds + wave * 4352);
#pragma unroll 1
            for (int base = 0; base < 1025; base += G * 4) {
                const int grp = base + bx * 4 + wave;
                const bool active = wave < 4 && grp < 1025;
                int cls = 0, posl = 0, tok = 0; bool valid = false; float rstd = 0.f, gA = 0.f, gB = 0.f;
                if (active) {
                    const int r32 = lane & 31, hh = lane >> 5; const int rowA = grp * 32 + r32 < NTOK ? grp * 32 + r32 : DUMMY_ROW;
                    f32x16 acc = {};
                    const bf16_t* ap = hbuf + (size_t)rowA * DM + 8 * hh; const bf16_t* bh_ = Whi + (size_t)r32 * DM + 8 * hh; const bf16_t* bl_ = Wlo + (size_t)r32 * DM + 8 * hh;
#pragma unroll 8
                    for (int k0 = 0; k0 < DM; k0 += 16) { const bf16x8 a = *(const bf16x8*)(ap + k0), b0 = *(const bf16x8*)(bh_ + k0), b1 = *(const bf16x8*)(bl_ + k0);
                        acc = __builtin_amdgcn_mfma_f32_32x32x16_bf16(a, b0, acc, 0, 0, 0); acc = __builtin_amdgcn_mfma_f32_32x32x16_bf16(a, b1, acc, 0, 0, 0); }
#pragma unroll
                    for (int r = 0; r < 16; ++r) scr[crow(r, hh) * 33 + r32] = acc[r];
                    LDS_WAIT(); asm volatile("" ::: "memory");
                    tok = grp * 32 + r32; valid = hh == 0 && tok < NTOK;
                    if (valid) {
                        float s = 0.f;
#pragma unroll
                        for (int q = 0; q < 4; ++q) { const f32x4 v = *(const f32x4*)(ssq2 + (size_t)tok * 16 + 4 * q); s += (v.x + v.y) + (v.z + v.w); }
                        rstd = rsqrtf(s * (1.f / DM) + EPS);
                        float lg[4]; const float* bg = INP(24) + l * 4; const float* be = INP(26) + l * 16;
#pragma unroll
                        for (int i = 0; i < 4; ++i) lg[i] = scr[r32 * 33 + i] * rstd + bg[i];
                        int gs = 0; float mx = lg[0];
#pragma unroll
                        for (int i = 1; i < 4; ++i) if (lg[i] > mx) { mx = lg[i]; gs = i; }
                        float se = 0.f;
#pragma unroll
                        for (int i = 0; i < 4; ++i) se += expf(lg[i] - mx);
                        const float pg = 1.f / se;
                        float le[4];
#pragma unroll
                        for (int i = 0; i < 4; ++i) le[i] = scr[r32 * 33 + 4 + 4 * gs + i] * rstd + be[4 * gs + i];
                        int i1 = 0; float v1 = le[0];
#pragma unroll
                        for (int i = 1; i < 4; ++i) if (le[i] > v1) { v1 = le[i]; i1 = i; }
                        int i2 = -1; float v2 = -INFINITY;
#pragma unroll
                        for (int i = 0; i < 4; ++i) if (i != i1 && le[i] > v2) { v2 = le[i]; i2 = i; }
                        const float w1 = pg / (1.f + expf(v2 - v1)), w2 = pg - w1;
                        const int a = i1 < i2 ? i1 : i2, bb = i1 < i2 ? i2 : i1;
                        gA = i1 < i2 ? w1 : w2; gB = i1 < i2 ? w2 : w1;
                        cls = gs * 6 + (a == 0 ? bb - 1 : (a == 1 ? bb + 1 : 5));
                        posl = __hip_atomic_fetch_add(&HIST[cls], 1, __ATOMIC_RELAXED, __HIP_MEMORY_SCOPE_WORKGROUP);
                    }
                }
                __syncthreads();
                if (tid < NCLS) { const int n = HIST[tid]; HIST[32 + tid] = n ? (int)__hip_atomic_fetch_add(gcnt + tid, (unsigned)n, __ATOMIC_RELAXED, __HIP_MEMORY_SCOPE_AGENT) : 0; }
                __syncthreads();
                if (valid) { const int pos = HIST[32 + cls] + posl; list[(size_t)cls * NTOK + pos] = tok; *(f32x4*)(tinfo + (size_t)tok * 4) = (f32x4){rstd, gA, gB, 0.f}; }
                __syncthreads();
                if (tid < NCLS) HIST[tid] = 0;
                __syncthreads();
            }
        }
        SEAM(P + 4);
        if (IN(P + 5) || IN(P + 6)) {
            unsigned* gcnt = ctl + CW_CNT + l * 32;
            PHASE_IDS();
            if (tid == 0) { int run = 0; for (int c = 0; c < NCLS; ++c) { const int n = (int)__hip_atomic_load(gcnt + c, __ATOMIC_RELAXED, __HIP_MEMORY_SCOPE_AGENT); CN[c] = n; TB[c] = run; run += (n + 255) >> 8; } TB[NCLS] = run; }
            __syncthreads();
        }
        for (int rep_ = 0; rep_ < DUP_E1; ++rep_) if (IN(P + 5)) {
            PHASE_IDS();
            const int* list = WSP(int, WS_LIST);
            ExpertOrder S{TB, CN, list, (const char*)WSP(bf16_t, WS_H), (const char*)WSP(bf16_t, WS_W13), G, bx, 1, l};
            EpiE1 E{WSP(bf16_t, WS_H1), WSP(float, WS_TINFO), CN, list};
            pg8::gemm_phase<EpiE1, ExpertOrder, true, true>(lds, tid, DM, DM, S, E);
        }
        SEAM(P + 5);
        if (IN(P + 6)) {
            PHASE_IDS();
            const int* list = WSP(int, WS_LIST);
            ExpertOrder S{TB, CN, list, (const char*)WSP(bf16_t, WS_H1), (const char*)WSP(bf16_t, WS_W2C), G, bx, 2, l};
            EpiRes<true> E{WSP(bf16_t, WS_H), WSP(float, WS_SSQ1), CN, list};
            pg8::gemm_phase<EpiRes<true>, ExpertOrder, true, false, true>(lds, tid, 512, 256, S, E);
        }
        SEAM(P + 6);
    }
    if (IN(15)) {
        PHASE_IDS();
        const bf16_t* hbuf = WSP(bf16_t, WS_H); const float* ssq1 = WSP(float, WS_SSQ1);
        const int gw = vcu * NWAVES + wave, NGW = G * NWAVES; const float* gF = INP(30);
        f32x4 gv[4];
#pragma unroll
        for (int j = 0; j < 4; ++j) gv[j] = *(const f32x4*)(gF + 4 * lane + 256 * j);
#pragma unroll 1
        for (int r = gw; r < NREAL; r += NGW) {
            float s = lane < 16 ? ssq1[(size_t)r * 16 + lane] : 0.f; s = wave_sum(s);
            const float rs = rsqrtf(s * (1.f / DM) + EPS);
#pragma unroll
            for (int j = 0; j < 4; ++j) { const u32x2 w = *(const u32x2*)(hbuf + (size_t)r * DM + 4 * lane + 256 * j);
                f32x4 o; o[0] = bflo(w.x) * rs * gv[j][0]; o[1] = bfhi(w.x) * rs * gv[j][1]; o[2] = bflo(w.y) * rs * gv[j][2]; o[3] = bfhi(w.y) * rs * gv[j][3];
                if (PROBE_A >= 0 && r == 0 && lane == 0 && j == 0) { const unsigned long long ta = __hip_atomic_load((unsigned long long*)(ctl + CW_TS) + (PROBE_A < 0 ? 0 : PROBE_A), __ATOMIC_RELAXED, __HIP_MEMORY_SCOPE_AGENT), tb = __hip_atomic_load((unsigned long long*)(ctl + CW_TS) + (PROBE_B < 0 ? 0 : PROBE_B), __ATOMIC_RELAXED, __HIP_MEMORY_SCOPE_AGENT); o[0] += (float)(long long)(tb - ta) * (0.01f / PROBE_SCALE); }
                *(f32x4*)(((float*)args.out) + (size_t)r * DM + 4 * lane + 256 * j) = o; }
        }
    }
#undef IN
#undef SEAM
#undef WSP
}

extern "C" void kernel_launch(void* const* d_in, const int* in_sizes, int n_in, void* d_out, int out_size, void* d_ws, size_t ws_size, hipStream_t stream) {
    static int grid = 0;
    if (grid == 0) {
        if (n_in != 31 || out_size != NREAL * DM || ws_size < WS_END) { fprintf(stderr, "kernel_launch: unexpected shapes (n_in %d, out %d, ws %zu)\n", n_in, out_size, ws_size); grid = -1; return; }
        int dev = 0, cus = 0, per_cu = 0;
        if (hipGetDevice(&dev) != hipSuccess || hipDeviceGetAttribute(&cus, hipDeviceAttributeMultiprocessorCount, dev) != hipSuccess) { grid = -1; return; }
        if (hipFuncSetAttribute((const void*)hymba_fwd, hipFuncAttributeMaxDynamicSharedMemorySize, LDS_BYTES) != hipSuccess) { fprintf(stderr, "kernel_launch: hipFuncSetAttribute failed\n"); grid = -1; return; }
        if (hipOccupancyMaxActiveBlocksPerMultiprocessor(&per_cu, (const void*)hymba_fwd, NWAVES * 64, LDS_BYTES) != hipSuccess || per_cu < 1) { fprintf(stderr, "kernel_launch: occupancy query says %d\n", per_cu); }
        (void)hipGetLastError();
        grid = cus;
    }
    if (grid < 0) return;
    (void)in_sizes;
    if (hipMemsetAsync((char*)d_ws + WS_CTL, 0, CTL_BYTES, stream) != hipSuccess) return;
    Args a{};
    for (int i = 0; i < 31; ++i) a.in[i] = (const GAS float*)d_in[i];
    a.out = (GAS float*)d_out; a.ws = (GAS unsigned char*)d_ws;
#if MK_PER_PHASE
    for (int p = 0; p < N_PHASES; ++p) { a.ph_lo = p; a.ph_hi = p + 1; hipLaunchKernelGGL(hymba_fwd, dim3(grid), dim3(NWAVES * 64), LDS_BYTES, stream, a); }
#else
    a.ph_lo = 0; a.ph_hi = N_PHASES;
    hipLaunchKernelGGL(hymba_fwd, dim3(grid), dim3(NWAVES * 64), LDS_BYTES, stream, a);
#endif
}
```

```cpp
#include <hip/hip_runtime.h>
#include <cstdio>
#include <cstdint>

#ifndef PROBE_A
#define PROBE_A -1
#endif
#ifndef PROBE_B
#define PROBE_B -1
#endif
#ifndef PROBE_BLOCK
#define PROBE_BLOCK 0
#endif
#ifndef PROBE_SCALE
#define PROBE_SCALE 4.0f
#endif
constexpr int CW_TS = 20480;
#define TS(id) do { if (PROBE_A >= 0 && (int)blockIdx.x == PROBE_BLOCK && tid == 0 && ((id) == PROBE_A || (id) == PROBE_B)) tsp[id] = __builtin_amdgcn_s_memrealtime(); } while (0)
#ifndef DUP_ATT
#define DUP_ATT 1
#endif
#ifndef DUP_CS
#define DUP_CS 1
#endif
#ifndef DUP_G1
#define DUP_G1 1
#endif
#ifndef DUP_MIX
#define DUP_MIX 1
#endif
#ifndef DUP_E1
#define DUP_E1 1
#endif
#ifndef DUP_P0
#define DUP_P0 1
#endif
#ifndef MK_PER_PHASE
#define MK_PER_PHASE 0
#endif

#define LAS __attribute__((address_space(3)))
#define GAS __attribute__((address_space(1)))
typedef unsigned short bf16_t;
typedef short bf16x8 __attribute__((ext_vector_type(8)));
typedef short s16x4 __attribute__((ext_vector_type(4)));
typedef float f32x4 __attribute__((ext_vector_type(4)));
typedef float f32x2 __attribute__((ext_vector_type(2)));
typedef float f32x16 __attribute__((ext_vector_type(16)));
typedef unsigned u32x4 __attribute__((ext_vector_type(4)));
typedef unsigned u32x2 __attribute__((ext_vector_type(2)));

constexpr int NB = 8, SEQ = 4096, NMETA = 16, DM = 1024, DEPTH = 2;
constexpr int NREAL = NB * SEQ;
constexpr int NTOK = NREAL + NMETA;
constexpr int MROWS = 33024;
constexpr int DUMMY_ROW = NTOK;
constexpr int PJ = 2304;
constexpr int NIN = 2560;
constexpr int DINSRC = 2312;
constexpr int PQ = 512, PK = 1024, PV = 1536, PU = 2048;
constexpr int MX_ATT = 0, MX_SSM = 512, MX_CONV = 768;
constexpr int NCLS = 24;
constexpr float EPS = 1e-6f;
constexpr float LOG2E = 1.4426950408889634f;
constexpr int H1CAP = 40960;

constexpr size_t MiB = 1u << 20;
constexpr size_t WS_CTL = 0, CTL_BYTES = 1 * MiB;
constexpr size_t WS_WIN = 2 * MiB, WS_WOUT = 12 * MiB, WS_W13 = 16 * MiB, WS_W2C = 48 * MiB, WS_WR = 96 * MiB;
constexpr size_t WS_H = 100 * MiB, WS_PROJ = 165 * MiB, WS_MIX = 311 * MiB, WS_H1 = 376 * MiB;
constexpr size_t WS_FLOG = 416 * MiB, WS_SSQ1 = 418 * MiB, WS_SSQ2 = 421 * MiB, WS_SSQA = 424 * MiB, WS_SSQS = 426 * MiB, WS_TINFO = 429 * MiB, WS_LIST = 430 * MiB, WS_S5T = 434 * MiB, WS_END = 440 * MiB;
constexpr int CW_TMO = 0, CW_BAR = 4096, CW_CNT = 16384;

constexpr int RING_BYTES = 131072;
constexpr int LDSCTL_OFF = RING_BYTES;
constexpr int LDS_BYTES = 147456;
constexpr int NWAVES = 8;

#define LDS_WAIT() asm volatile("s_waitcnt lgkmcnt(0)" ::: "memory")
#define VM_WAIT() asm volatile("s_waitcnt vmcnt(0)" ::: "memory")

__device__ __forceinline__ unsigned f2bf(float f) { unsigned u = __float_as_uint(f); return (u + 0x7fffu + ((u >> 16) & 1u)) >> 16; }
__device__ __forceinline__ unsigned pk2(float lo, float hi) { return f2bf(lo) | (f2bf(hi) << 16); }
__device__ __forceinline__ float bflo(unsigned w) { return __uint_as_float(w << 16); }
__device__ __forceinline__ float bfhi(unsigned w) { return __uint_as_float(w & 0xffff0000u); }
__device__ __forceinline__ float bf2f(bf16_t b) { return __uint_as_float(((unsigned)b) << 16); }
__device__ __forceinline__ unsigned cvt_pk_bf16(float lo, float hi) { unsigned r; asm volatile("v_cvt_pk_bf16_f32 %0, %1, %2" : "=v"(r) : "v"(lo), "v"(hi)); return r; }
template <int CTRL> __device__ __forceinline__ float dpp_mov0(float v) { return __builtin_bit_cast(float, __builtin_amdgcn_update_dpp(0, __builtin_bit_cast(int, v), CTRL, 0xF, 0xF, true)); }
__device__ __forceinline__ void swap16(float& a, float& b) { asm volatile("v_nop\n\tv_nop\n\tv_permlane16_swap_b32 %0, %1" : "+v"(a), "+v"(b)); }
__device__ __forceinline__ void swap32(float& a, float& b) { asm volatile("v_nop\n\tv_nop\n\tv_permlane32_swap_b32 %0, %1" : "+v"(a), "+v"(b)); }
__device__ __forceinline__ float xadd16(float v) { float a = v, b = v; swap16(a, b); return a + b; }
__device__ __forceinline__ float xadd32(float v) { float a = v, b = v; swap32(a, b); return a + b; }
__device__ __forceinline__ float row16_sum(float v) {
    v += dpp_mov0<0xB1>(v);
    v += dpp_mov0<0x4E>(v);
    v += dpp_mov0<0x141>(v);
    v += dpp_mov0<0x140>(v);
    return v;
}
template <int CTRL, int ROWMASK> __device__ __forceinline__ float dpp_mov0m(float v) { return __builtin_bit_cast(float, __builtin_amdgcn_update_dpp(0, __builtin_bit_cast(int, v), CTRL, ROWMASK, 0xF, true)); }
__device__ __forceinline__ float xmax32(float v) { float a = v, b = v; swap32(a, b); return fmaxf(a, b); }
__device__ __forceinline__ float wave_incl_scan(float v) {
    v += dpp_mov0<0x111>(v); v += dpp_mov0<0x112>(v); v += dpp_mov0<0x114>(v); v += dpp_mov0<0x118>(v);
    v += dpp_mov0m<0x142, 0xA>(v);
    v += dpp_mov0m<0x143, 0xC>(v);
    return v;
}
__device__ __forceinline__ float half32_sum(float v) { return xadd16(row16_sum(v)); }
__device__ __forceinline__ float wave_sum(float v) { return xadd32(xadd16(row16_sum(v))); }
__device__ __forceinline__ float fast_exp2(float x) { return __builtin_amdgcn_exp2f(x); }
__device__ __forceinline__ float fast_rcp(float x) { return __builtin_amdgcn_rcpf(x); }
__device__ __forceinline__ float sigmoidf_(float x) { return fast_rcp(1.f + fast_exp2(-x * LOG2E)); }
__device__ __forceinline__ float siluf_(float x) { return x * sigmoidf_(x); }
__device__ __forceinline__ int rowof(int b, int t) { return t < NMETA ? NREAL + t : b * SEQ + (t - NMETA); }

namespace pg8 {
constexpr int BM = 256, BK = 64, HALF = 128, HTB = HALF * BK * 2, STAGE_BYTES = 8 * HTB;
__host__ __device__ __forceinline__ int lds_byte(int r, int c) { const int st = (r >> 4) * 2 + (c >> 5), rr = r & 15, cc = c & 31, ob = rr * 64 + cc * 2; return st * 1024 + (ob ^ (((ob >> 9) & 1) << 5)); }
__host__ __device__ __forceinline__ void stage_rc(int b, int& R, int& C) { const int st = b / 1024, sb = b % 1024, swz = sb ^ (((sb >> 9) & 1) << 5); R = (st >> 1) * 16 + swz / 64; C = (st & 1) * 32 + (swz % 64) / 2; }
__host__ __device__ __forceinline__ int perm32(int rho) { const int n = rho >> 4, i = rho & 15; return 8 * (i >> 2) + 4 * n + (i & 3); }

struct Unit { int pm, pn, cls, p0; };

struct NoHook { static constexpr bool ON = false; __device__ __forceinline__ void load(const Unit&, int, int, int, float (&)[8], float (&)[8]) const {} };
template <class Epi, class Sched, bool ALIGN_EPI, bool GATHER, bool BSPLIT = false, class Hook = NoHook>
__device__ __forceinline__ void gemm_phase(LAS unsigned char* lds, const int tid, const int K, const int ldb, const Sched& S, const Epi& E, const Hook& H = Hook()) {
    const int wid = __builtin_amdgcn_readfirstlane(tid >> 6), lane = tid & 63, wr = wid >> 2, wc = wid & 3, fr = lane & 15, fq = lane >> 4;
    const int nt = K / BK;
    unsigned voffA[2], voffB[2]; int RA[2], CA[2];
#pragma unroll
    for (int i = 0; i < 2; ++i) { int R, C; stage_rc(tid * 16 + i * 8192, R, C); const int Rb = (R & ~31) + perm32(R & 31);
        voffA[i] = (unsigned)(R * K + C) * 2u; voffB[i] = (unsigned)(Rb * ldb + C) * 2u; RA[i] = R; CA[i] = C; }
    const size_t kstep = (size_t)(BK * 2);
    const size_t hstepA = (size_t)HALF * K * 2, hstepB = (size_t)HALF * ldb * 2;
    const size_t pstepA = (size_t)64 * K * 2, pstepB = (size_t)64 * ldb * 2;
    const unsigned ldsw = (unsigned)wid * 1024u;
    const int aoff = lds_byte(wr * 64 + fr, fq * 8), boff = lds_byte(wc * 32 + fr, fq * 8);
#define PG8_SA(b, h) (((b) * 2 + (h)) * HTB)
#define PG8_SB(b, h) ((4 + (b) * 2 + (h)) * HTB)
#define PG8_STAGE(bufoff, gbase, voff) do { _Pragma("unroll") for (int _i = 0; _i < 2; ++_i) \
        __builtin_amdgcn_global_load_lds((const unsigned*)((const char*)(gbase) + (voff)[_i]), (LAS unsigned*)(lds + (bufoff) + ldsw + _i * 8192), 16, 0, 0); } while (0)
#define PG8_STAGE1(bufoff, gbase, voff1, step) do { _Pragma("unroll") for (int _i = 0; _i < 2; ++_i) \
        __builtin_amdgcn_global_load_lds((const unsigned*)((const char*)(gbase) + (size_t)_i * (step) + (voff1)), (LAS unsigned*)(lds + (bufoff) + ldsw + _i * 8192), 16, 0, 0); } while (0)
#define PG8_LDA(dst, b, h) do { _Pragma("unroll") for (int m = 0; m < 4; ++m) _Pragma("unroll") for (int k = 0; k < 2; ++k) dst[m][k] = *(const LAS bf16x8*)(lds + PG8_SA(b, h) + aoff + m * 2048 + k * 1024); } while (0)
#define PG8_LDB(dst, b, h) do { _Pragma("unroll") for (int n = 0; n < 2; ++n) _Pragma("unroll") for (int k = 0; k < 2; ++k) dst[n][k] = *(const LAS bf16x8*)(lds + PG8_SB(b, h) + boff + n * 2048 + k * 1024); } while (0)
#define PG8_MMA(ai, bj, At, Bt) do { __builtin_amdgcn_s_setprio(1); _Pragma("unroll") for (int m = 0; m < 4; ++m) _Pragma("unroll") for (int n = 0; n < 2; ++n) _Pragma("unroll") for (int k = 0; k < 2; ++k) \
        acc[ai][bj][m][n] = __builtin_amdgcn_mfma_f32_16x16x32_bf16(Bt[n][k], At[m][k], acc[ai][bj][m][n], 0, 0, 0); __builtin_amdgcn_s_setprio(0); } while (0)
#define PG8_WAIT_V(n) asm volatile("s_waitcnt vmcnt(" #n ")" ::: "memory")
#define PG8_WAIT_L(n) asm volatile("s_waitcnt lgkmcnt(" #n ")" ::: "memory")
#define PG8_BAR __builtin_amdgcn_s_barrier()
#define PG8_SCHED __builtin_amdgcn_sched_barrier(0)
    Unit cur, nxt; int ui = 0;
    if (!S.next(0, cur)) return;
    f32x4 acc[2][2][4][2];
#pragma unroll
    for (int a = 0; a < 2; ++a)
#pragma unroll
        for (int b = 0; b < 2; ++b)
#pragma unroll
            for (int m = 0; m < 4; ++m)
#pragma unroll
                for (int n = 0; n < 2; ++n) acc[a][b][m][n] = (f32x4){0.f, 0.f, 0.f, 0.f};
    bf16x8 At[4][2], B0[2][2], B1[2][2];
    const char* cA = S.abase(cur); const char* cB = S.bbase(cur);
    const char* cB2 = cB; const int ksp = BSPLIT ? nt / 2 : (1 << 30);
    if constexpr (BSPLIT) cB2 = S.bbase2(cur) - (size_t)ksp * kstep;
    unsigned oC[2][2], oN[2][2];
    if constexpr (GATHER) {
#pragma unroll
        for (int h = 0; h < 2; ++h)
#pragma unroll
            for (int i = 0; i < 2; ++i) oC[h][i] = (unsigned)S.rowtok(cur, h * HALF + RA[i]) * (unsigned)(K * 2) + (unsigned)(CA[i] * 2);
    }
    PG8_STAGE1(PG8_SB(0, 0), cB, voffB[0], pstepB); PG8_STAGE1(PG8_SB(0, 1), cB + hstepB, voffB[0], pstepB);
    if constexpr (GATHER) { PG8_STAGE(PG8_SA(0, 0), cA, oC[0]); PG8_STAGE(PG8_SA(0, 1), cA, oC[1]); }
    else { PG8_STAGE1(PG8_SA(0, 0), cA, voffA[0], pstepA); PG8_STAGE1(PG8_SA(0, 1), cA + hstepA, voffA[0], pstepA); }
    if (wr == 1) PG8_BAR;
    PG8_WAIT_V(2); PG8_BAR;
    PG8_STAGE1(PG8_SB(1, 0), cB + kstep, voffB[0], pstepB);
    if constexpr (GATHER) { PG8_STAGE(PG8_SA(1, 0), cA + kstep, oC[0]); } else { PG8_STAGE1(PG8_SA(1, 0), cA + kstep, voffA[0], pstepA); }
    PG8_STAGE1(PG8_SB(1, 1), cB + hstepB + kstep, voffB[0], pstepB);
    PG8_WAIT_V(6); PG8_BAR;
    for (;;) {
        const bool has_next = S.next(ui + 1, nxt);
        float hf1[8], hf2[8];
        if constexpr (Hook::ON) { int ln_; asm volatile("v_mbcnt_lo_u32_b32 %0, -1, 0\n\tv_mbcnt_hi_u32_b32 %0, -1, %0" : "=v"(ln_)); H.load(cur, wr, ln_ & 15, ln_ >> 4, hf1, hf2); }
        const char* nA = has_next ? S.abase(nxt) : cA; const char* nB = has_next ? S.bbase(nxt) : cB;
        const char* nB2 = nB; if constexpr (BSPLIT) nB2 = has_next ? S.bbase2(nxt) - (size_t)ksp * kstep : cB2;
        if constexpr (GATHER) {
#pragma unroll
            for (int h = 0; h < 2; ++h)
#pragma unroll
                for (int i = 0; i < 2; ++i) oN[h][i] = has_next ? (unsigned)S.rowtok(nxt, h * HALF + RA[i]) * (unsigned)(K * 2) + (unsigned)(CA[i] * 2) : oC[h][i];
        }
        for (int t = 0; t < nt; t += 2) {
            if constexpr (Hook::ON) { if (t == 8 || t == 12) {
#pragma unroll
                for (int a = 0; a < 2; ++a)
#pragma unroll
                    for (int m = 0; m < 4; ++m) { const float f = t == 8 ? hf1[a * 4 + m] : hf2[a * 4 + m];
#pragma unroll
                        for (int b = 0; b < 2; ++b)
#pragma unroll
                            for (int n = 0; n < 2; ++n) acc[a][b][m][n] *= f; } } }
            const bool last = (t == nt - 2);
            const char* a1 = cA + (size_t)(t + 1) * kstep;
            const char* a2 = last ? nA : cA + (size_t)(t + 2) * kstep; const char* b2 = last ? nB : ((t + 2 < ksp) ? cB : cB2) + (size_t)(t + 2) * kstep;
            const char* a3 = a2 + kstep; const char* b3 = b2 + kstep;
            unsigned s0[2], s1[2];
            if constexpr (GATHER) { s0[0] = last ? oN[0][0] : oC[0][0]; s0[1] = last ? oN[0][1] : oC[0][1]; s1[0] = last ? oN[1][0] : oC[1][0]; s1[1] = last ? oN[1][1] : oC[1][1]; }
            PG8_LDB(B0, 0, 0); PG8_LDB(B1, 0, 1); PG8_SCHED; PG8_LDA(At, 0, 0);
            if constexpr (GATHER) { PG8_STAGE(PG8_SA(1, 1), a1, oC[1]); } else { PG8_STAGE1(PG8_SA(1, 1), a1 + hstepA, voffA[0], pstepA); }
            PG8_WAIT_V(8); PG8_WAIT_L(0); PG8_BAR; PG8_MMA(0, 0, At, B0); PG8_MMA(0, 1, At, B1); PG8_BAR; PG8_SCHED;
            PG8_LDA(At, 0, 1); PG8_STAGE1(PG8_SB(0, 0), b2, voffB[0], pstepB); PG8_STAGE1(PG8_SB(0, 1), b2 + hstepB, voffB[0], pstepB);
            if constexpr (GATHER) { PG8_STAGE(PG8_SA(0, 0), a2, s0); } else { PG8_STAGE1(PG8_SA(0, 0), a2, voffA[0], pstepA); }
            PG8_WAIT_V(8); PG8_WAIT_L(0); PG8_BAR; PG8_MMA(1, 0, At, B0); PG8_MMA(1, 1, At, B1); PG8_BAR; PG8_SCHED;
            PG8_LDB(B0, 1, 0); PG8_LDB(B1, 1, 1); PG8_SCHED; PG8_LDA(At, 1, 0);
            if constexpr (GATHER) { PG8_STAGE(PG8_SA(0, 1), a2, s1); } else { PG8_STAGE1(PG8_SA(0, 1), a2 + hstepA, voffA[0], pstepA); }
            PG8_WAIT_V(8); PG8_WAIT_L(0); PG8_BAR; PG8_MMA(0, 0, At, B0); PG8_MMA(0, 1, At, B1); PG8_BAR; PG8_SCHED;
            PG8_LDA(At, 1, 1); PG8_STAGE1(PG8_SB(1, 0), b3, voffB[0], pstepB); PG8_STAGE1(PG8_SB(1, 1), b3 + hstepB, voffB[0], pstepB);
            if constexpr (GATHER) { PG8_STAGE(PG8_SA(1, 0), a3, s0); } else { PG8_STAGE1(PG8_SA(1, 0), a3, voffA[0], pstepA); }
            PG8_WAIT_V(8); PG8_WAIT_L(0); PG8_BAR; PG8_MMA(1, 0, At, B0); PG8_MMA(1, 1, At, B1); PG8_BAR; PG8_SCHED;
        }
        if constexpr (ALIGN_EPI) { if (wr == 0) PG8_BAR; }
        { int ln_; asm volatile("v_mbcnt_lo_u32_b32 %0, -1, 0\n\tv_mbcnt_hi_u32_b32 %0, -1, %0" : "=v"(ln_)); E(acc, cur, wr, wc, ln_ & 15, ln_ >> 4); }
        if (!has_next) break;
#pragma unroll
        for (int a = 0; a < 2; ++a)
#pragma unroll
            for (int b = 0; b < 2; ++b)
#pragma unroll
                for (int m = 0; m < 4; ++m)
#pragma unroll
                    for (int n = 0; n < 2; ++n) acc[a][b][m][n] = (f32x4){0.f, 0.f, 0.f, 0.f};
        cur = nxt; cA = nA; cB = nB; cB2 = nB2; ++ui;
        if constexpr (GATHER) {
#pragma unroll
            for (int h = 0; h < 2; ++h)
#pragma unroll
                for (int i = 0; i < 2; ++i) oC[h][i] = oN[h][i];
        }
        if constexpr (ALIGN_EPI) { if (wr == 1) PG8_BAR; }
    }
    PG8_WAIT_V(0);
    if constexpr (!ALIGN_EPI) { if (wr == 0) PG8_BAR; }
    PG8_BAR;
#undef PG8_SA
#undef PG8_SB
#undef PG8_STAGE
#undef PG8_STAGE1
#undef PG8_LDA
#undef PG8_LDB
#undef PG8_MMA
#undef PG8_WAIT_V
#undef PG8_WAIT_L
#undef PG8_BAR
#undef PG8_SCHED
}
}
using pg8::Unit;

struct DenseOrder {
    const char* A; const char* Bt; size_t tstepA, tstepB; int nM, nN, nwg, G, c;
    __device__ __forceinline__ void init(const void* A_, const void* Bt_, int M, int N, int K, int ldb, int G_, int c_) {
        A = (const char*)A_; Bt = (const char*)Bt_; tstepA = (size_t)256 * K * 2; tstepB = (size_t)256 * ldb * 2; nM = M / 256; nN = N / 256; nwg = nM * nN; G = G_; c = c_; }
    __device__ __forceinline__ bool next(int i, Unit& u) const {
        const long L = (long)i * G + c; if (L >= nwg) return false;
        int wgid = (int)L; { const int q = nwg / 8, r = nwg % 8, xcd = wgid % 8, off = wgid / 8; wgid = (xcd < r ? xcd * (q + 1) : r * (q + 1) + (xcd - r) * q) + off; }
        const int nig = 8 * nN, gid = wgid / nig, fm = gid * 8, gsz = (nM - fm) < 8 ? (nM - fm) : 8;
        u.pm = fm + ((wgid % nig) % gsz); u.pn = (wgid % nig) / gsz; u.cls = 0; u.p0 = 0; return true;
    }
    __device__ __forceinline__ const char* abase(const Unit& u) const { return A + (size_t)u.pm * tstepA; }
    __device__ __forceinline__ const char* bbase(const Unit& u) const { return Bt + (size_t)u.pn * tstepB; }
    __device__ __forceinline__ const char* bbase2(const Unit& u) const { return bbase(u); }
    __device__ __forceinline__ int rowtok(const Unit&, int) const { return 0; }
};

__device__ __forceinline__ void cls_experts(int cls, int& eA, int& eB) { const int g = cls / 6, p = cls % 6; const int a = (p >= 3) + (p >= 5), b = p < 3 ? p + 1 : (p < 5 ? p - 1 : 3); eA = 4 * g + a; eB = 4 * g + b; }
struct ExpertOrder {
    const LAS int* tb; const LAS int* cn; const int* list; const char* A; const char* W; int G, c, mode, layer;
    __device__ __forceinline__ bool next(int i, Unit& u) const {
        const int nwg = __builtin_amdgcn_readfirstlane(tb[NCLS]) * 4; const long L = (long)i * G + c; if (L >= nwg) return false;
        int wgid = (int)L; { const int q = nwg / 8, r = nwg % 8, xcd = wgid % 8, off = wgid / 8; wgid = (xcd < r ? xcd * (q + 1) : r * (q + 1) + (xcd - r) * q) + off; }
        const int rt = wgid >> 2; int cls = 0;
        for (int k = 1; k < NCLS; ++k) cls += (rt >= tb[k]) ? 1 : 0;
        cls = __builtin_amdgcn_readfirstlane(cls);
        u.pm = rt; u.pn = wgid & 3; u.cls = cls; u.p0 = __builtin_amdgcn_readfirstlane((rt - tb[cls]) * 256); return true;
    }
    __device__ __forceinline__ const char* abase(const Unit& u) const { return mode == 1 ? A : A + (size_t)u.pm * (256 * 512 * 2); }
    __device__ __forceinline__ const char* bbase(const Unit& u) const {
        if (mode == 1) { int eA, eB; cls_experts(u.cls, eA, eB); const int e = (u.pn >> 1) ? eB : eA; return W + ((size_t)(layer * 16 + e) * 512 + (size_t)(u.pn & 1) * 256) * (1024 * 2); }
        int eA, eB; cls_experts(u.cls, eA, eB); return W + ((size_t)(layer * 16 + eA) * 1024 + (size_t)u.pn * 256) * (256 * 2);
    }
    __device__ __forceinline__ const char* bbase2(const Unit& u) const { int eA, eB; cls_experts(u.cls, eA, eB); return W + ((size_t)(layer * 16 + eB) * 1024 + (size_t)u.pn * 256) * (256 * 2); }
    __device__ __forceinline__ int rowtok(const Unit& u, int rr) const { const int pos = u.p0 + rr; return pos < cn[u.cls] ? list[(size_t)u.cls * NTOK + pos] : DUMMY_ROW; }
};

__device__ __forceinline__ float row_rstd16(const float* ssq, int row, int fq, float inv_n) {
    const f32x4 v = *(const f32x4*)(ssq + (size_t)row * 16 + 4 * fq);
    float s = (v.x + v.y) + (v.z + v.w);
    s = xadd32(xadd16(s));
    return rsqrtf(s * inv_n + EPS);
}

struct HookNorm { static constexpr bool ON = true; const float* ssqa; const float* ssqs;
    __device__ __forceinline__ void load(const Unit& u, int wr, int fr, int fq, float (&f1)[8], float (&f2)[8]) const {
#pragma unroll
        for (int ai = 0; ai < 2; ++ai)
#pragma unroll
            for (int m = 0; m < 4; ++m) { const int row = u.pm * 256 + ai * 128 + wr * 64 + m * 16 + fr;
                const f32x2 a = *(const f32x2*)(ssqa + (size_t)row * 8 + 2 * fq); const f32x4 b = *(const f32x4*)(ssqs + (size_t)row * 16 + 4 * fq);
                const float sa = xadd32(xadd16(a.x + a.y)), ss = xadd32(xadd16((b.x + b.y) + (b.z + b.w)));
                const float ra = rsqrtf(sa * (1.f / 512.f) + EPS), vs = ss * (1.f / 256.f) + EPS;
                f1[ai * 4 + m] = ra * sqrtf(vs); f2[ai * 4 + m] = rsqrtf(vs); }
    }
};
struct EpiProj {
    bf16_t* proj; float* flog; const float* ssq1; const float* fb;
    __device__ __forceinline__ void operator()(const f32x4 (&acc)[2][2][4][2], const Unit& u, int wr, int wc, int fr, int fq) const {
#pragma unroll
        for (int ai = 0; ai < 2; ++ai)
#pragma unroll
            for (int m = 0; m < 4; ++m) {
                const int row = u.pm * 256 + ai * 128 + wr * 64 + m * 16 + fr;
                const float rs = row_rstd16(ssq1, row, fq, 1.f / DM);
                if (u.pn < 9) {
#pragma unroll
                    for (int bj = 0; bj < 2; ++bj) { const f32x4 v0 = acc[ai][bj][m][0] * rs, v1 = acc[ai][bj][m][1] * rs; u32x4 w;
                        w.x = cvt_pk_bf16(v0[0], v0[1]); w.y = cvt_pk_bf16(v0[2], v0[3]); w.z = cvt_pk_bf16(v1[0], v1[1]); w.w = cvt_pk_bf16(v1[2], v1[3]);
                        *(u32x4*)(proj + (size_t)row * PJ + u.pn * 256 + bj * 128 + wc * 32 + 8 * fq) = w; }
                } else if (wc == 0 && fq == 0) {
                    f32x4 o0, o1;
#pragma unroll
                    for (int e = 0; e < 4; ++e) { const float f0 = acc[ai][0][m][0][e] * rs + fb[e], f1 = acc[ai][0][m][1][e] * rs + fb[4 + e];
                        o0[e] = -log2f(1.f + exp2f(-f0 * LOG2E)); o1[e] = -log2f(1.f + exp2f(-f1 * LOG2E)); }
                    *(f32x4*)(flog + (size_t)row * 8) = o0; *(f32x4*)(flog + (size_t)row * 8 + 4) = o1;
                }
            }
    }
};
template <bool TOKMAP> struct EpiRes {
    bf16_t* h; float* ssq; const LAS int* cn; const int* list;
    __device__ __forceinline__ void operator()(const f32x4 (&acc)[2][2][4][2], const Unit& u, int wr, int wc, int fr, int fq) const {
#pragma unroll
        for (int ai = 0; ai < 2; ++ai)
#pragma unroll
            for (int m = 0; m < 4; ++m) {
                const int rr = ai * 128 + wr * 64 + m * 16 + fr; int row;
                if constexpr (TOKMAP) { const int pos = u.p0 + rr; row = pos < cn[u.cls] ? list[(size_t)u.cls * NTOK + pos] : DUMMY_ROW; } else row = u.pm * 256 + rr;
                float sq = 0.f;
#pragma unroll
                for (int bj = 0; bj < 2; ++bj) { bf16_t* p = h + (size_t)row * DM + u.pn * 256 + bj * 128 + wc * 32 + 8 * fq; const u32x4 o = *(const u32x4*)p;
                    const f32x4 a0 = acc[ai][bj][m][0], a1 = acc[ai][bj][m][1]; u32x4 w;
                    w.x = cvt_pk_bf16(bflo(o.x) + a0[0], bfhi(o.x) + a0[1]); w.y = cvt_pk_bf16(bflo(o.y) + a0[2], bfhi(o.y) + a0[3]);
                    w.z = cvt_pk_bf16(bflo(o.z) + a1[0], bfhi(o.z) + a1[1]); w.w = cvt_pk_bf16(bflo(o.w) + a1[2], bfhi(o.w) + a1[3]);
                    *(u32x4*)p = w;
                    sq += bflo(w.x) * bflo(w.x) + bfhi(w.x) * bfhi(w.x) + bflo(w.y) * bflo(w.y) + bfhi(w.y) * bfhi(w.y) + bflo(w.z) * bflo(w.z) + bfhi(w.z) * bfhi(w.z) + bflo(w.w) * bflo(w.w) + bfhi(w.w) * bfhi(w.w); }
                sq = xadd32(xadd16(sq));
                if (fq == 0) ssq[(size_t)row * 16 + u.pn * 4 + wc] = sq;
            }
    }
};
struct EpiE1 {
    bf16_t* H1; const float* tinfo; const LAS int* cn; const int* list;
    __device__ __forceinline__ void operator()(const f32x4 (&acc)[2][2][4][2], const Unit& u, int wr, int wc, int fr, int fq) const {
#pragma unroll
        for (int ai = 0; ai < 2; ++ai)
#pragma unroll
            for (int m = 0; m < 4; ++m) {
                const int rr = ai * 128 + wr * 64 + m * 16 + fr; const int pos = u.p0 + rr;
                const int tok = pos < cn[u.cls] ? list[(size_t)u.cls * NTOK + pos] : DUMMY_ROW;
                const f32x4 ti = *(const f32x4*)(tinfo + (size_t)tok * 4);
                const float rs = ti.x, gate = (u.pn >> 1) ? ti.z : ti.y;
                float o[8];
#pragma unroll
                for (int n = 0; n < 2; ++n)
#pragma unroll
                    for (int e = 0; e < 4; ++e) { const float a = acc[ai][0][m][n][e] * rs, b = acc[ai][1][m][n][e] * rs; o[n * 4 + e] = gate * siluf_(a) * b; }
                u32x4 w; w.x = cvt_pk_bf16(o[0], o[1]); w.y = cvt_pk_bf16(o[2], o[3]); w.z = cvt_pk_bf16(o[4], o[5]); w.w = cvt_pk_bf16(o[6], o[7]);
                *(u32x4*)(H1 + (size_t)(u.pm * 256 + rr) * 512 + (u.pn >> 1) * 256 + (u.pn & 1) * 128 + wc * 32 + 8 * fq) = w;
            }
    }
};

template <bool SEGNORM>
__device__ __forceinline__ f32x2 meta_gemm64(LAS unsigned char* lds, const int tid, const bf16_t* A, const bf16_t* Bt, int K, int n0, const float* ssqa, const float* ssqs) {
    const int lane = tid & 63, m = lane & 15, q4 = lane >> 4; const int w = __builtin_amdgcn_readfirstlane(tid >> 6);
    const int kr = K >> 3;
    const bf16_t* ap = A + (size_t)m * K + w * kr + 8 * q4; const bf16_t* bp = Bt + (size_t)(n0 + m) * K + w * kr + 8 * q4;
    bf16x8 av[4], bv[4][4];
#pragma unroll
    for (int ks = 0; ks < 4; ++ks) { av[ks] = *(const bf16x8*)(ap + 32 * ks);
#pragma unroll
        for (int j = 0; j < 4; ++j) bv[ks][j] = *(const bf16x8*)(bp + (size_t)16 * j * K + 32 * ks); }
    f32x4 acc[4];
#pragma unroll
    for (int j = 0; j < 4; ++j) acc[j] = (f32x4){0.f, 0.f, 0.f, 0.f};
#pragma unroll
    for (int ks = 0; ks < 4; ++ks)
#pragma unroll
        for (int j = 0; j < 4; ++j) acc[j] = __builtin_amdgcn_mfma_f32_16x16x32_bf16(bv[ks][j], av[ks], acc[j], 0, 0, 0);
    if constexpr (SEGNORM) {
        const int row = NREAL + m; float sc = 1.f;
        if (w < 4) { float sa = 0.f;
#pragma unroll
            for (int q = 0; q < 8; ++q) sa += ssqa[(size_t)row * 8 + q]; sc = rsqrtf(sa * (1.f / 512.f) + EPS); }
        else if (w < 6) { float ss = 0.f;
#pragma unroll
            for (int q = 0; q < 16; ++q) ss += ssqs[(size_t)row * 16 + q]; sc = rsqrtf(ss * (1.f / 256.f) + EPS); }
#pragma unroll
        for (int j = 0; j < 4; ++j) acc[j] *= sc;
    }
    LAS float* part = (LAS float*)lds;
#pragma unroll
    for (int j = 0; j < 4; ++j) *(LAS f32x4*)(part + (w * 16 + m) * 64 + 16 * j + 4 * q4) = acc[j];
    __syncthreads();
    const int mm = tid >> 5, cp = tid & 31; f32x2 r = {0.f, 0.f};
#pragma unroll
    for (int ww = 0; ww < 8; ++ww) r += *(const LAS f32x2*)(part + (ww * 16 + mm) * 64 + 2 * cp);
    __syncthreads();
    return r;
}
__device__ __forceinline__ float row_rstd_all(const float* ssq, int row, float inv_n) {
    float s = 0.f;
#pragma unroll
    for (int q = 0; q < 4; ++q) { const f32x4 v = *(const f32x4*)(ssq + (size_t)row * 16 + 4 * q); s += (v.x + v.y) + (v.z + v.w); }
    return rsqrtf(s * inv_n + EPS);
}

#define XB_TMO      128
#define XB_XCNT(j)  (256  + 64 * (j))
#define XB_XSUB(j)  (1280 + 64 * (j))
#define XB_XGEN(j)  (2304 + 64 * (j))
#define XB_TOP      3328
#define XB_TOPGEN   3392
#define XCD_BAR_WORDS 3456
#define XB_SPIN_CAP (1u << 18)
__device__ __forceinline__ unsigned xb_ld(unsigned* p)              { return __hip_atomic_load(p, __ATOMIC_RELAXED, __HIP_MEMORY_SCOPE_AGENT); }
__device__ __forceinline__ unsigned xb_add(unsigned* p, unsigned v) { return __hip_atomic_fetch_add(p, v, __ATOMIC_RELAXED, __HIP_MEMORY_SCOPE_AGENT); }
__device__ __forceinline__ unsigned xb_xcc_id() { return (unsigned)__builtin_amdgcn_s_getreg((3 << 11) | 20) & 0xFu; }
#define XB_SPIN(cond, bar) do { unsigned _sp = 0; while (cond) { __builtin_amdgcn_s_sleep(1); \
    if ((++_sp & 255u) == 0u) { if (xb_ld(&(bar)[XB_TMO])) break; if (_sp > XB_SPIN_CAP) { atomicAdd(&(bar)[XB_TMO], 1u); break; } } } } while (0)
struct XcdBarrier { unsigned* bar; unsigned x; volatile LAS unsigned* st; };
__device__ __forceinline__ XcdBarrier xcd_barrier_post(unsigned* bar, volatile LAS unsigned* st) {
    XcdBarrier b; b.bar = bar; b.x = xb_xcc_id(); b.st = st;
    if (threadIdx.x == 0) (void)xb_add(&bar[XB_XCNT(b.x)], 1u);
    return b;
}
__device__ __forceinline__ void xcd_barrier_complete(unsigned* bar, unsigned x, unsigned& nloc, unsigned& nx) {
    const unsigned G = gridDim.x * gridDim.y * gridDim.z;
    unsigned sum, cnt, mine, sp = 0u;
    for (;;) {
        sum = 0u; cnt = 0u; mine = 0u;
#pragma unroll
        for (unsigned j = 0; j < 16; ++j) { const unsigned c = xb_ld(&bar[XB_XCNT(j)]); sum += c; cnt += (c > 0u) ? 1u : 0u; mine = (j == x) ? c : mine; }
        if (sum == G) break;
        __builtin_amdgcn_s_sleep(1);
        if ((++sp & 255u) == 0u) { if (xb_ld(&bar[XB_TMO])) break; if (sp > XB_SPIN_CAP) { atomicAdd(&bar[XB_TMO], 1u); break; } }
    }
    nloc = mine > 0u ? mine : 1u; nx = cnt > 0u ? cnt : 1u;
}
__device__ __forceinline__ void xcd_barrier(const XcdBarrier& b, const bool leader_thread) {
    asm volatile("s_waitcnt vmcnt(0)" ::: "memory");
    __syncthreads();
    if (leader_thread) {
        unsigned long long bz_ = 0; asm volatile("" : "+s"(bz_)); unsigned* bar = b.bar + bz_;
        __builtin_amdgcn_s_waitcnt(0);
        unsigned nloc = b.st[0], nx = b.st[1];
        if (nloc == 0u) { xcd_barrier_complete(bar, b.x, nloc, nx); b.st[0] = nloc; b.st[1] = nx; }
        const unsigned old = xb_add(&bar[XB_XSUB(b.x)], 1u);
        const unsigned gen = old / nloc;
        if (old + 1u == (gen + 1u) * nloc) {
            __builtin_amdgcn_fence(__ATOMIC_RELEASE, "agent");
            asm volatile("s_waitcnt vmcnt(0)" ::: "memory");
            const unsigned og = xb_add(&bar[XB_TOP], 1u);
            const unsigned tg = og / nx;
            if (og + 1u == (tg + 1u) * nx) xb_add(&bar[XB_TOPGEN], 1u);
            else XB_SPIN(xb_ld(&bar[XB_TOPGEN]) == tg, bar);
            __builtin_amdgcn_fence(__ATOMIC_ACQUIRE, "agent");
            xb_add(&bar[XB_XGEN(b.x)], 1u);
            asm volatile("s_waitcnt vmcnt(0)" ::: "memory");
        } else {
            XB_SPIN(xb_ld(&bar[XB_XGEN(b.x)]) == gen, bar);
            __builtin_amdgcn_fence(__ATOMIC_ACQUIRE, "agent");
            asm volatile("s_waitcnt vmcnt(0)" ::: "memory");
        }
    }
    __syncthreads();
}

template <class Get>
__device__ __forceinline__ void tr_item(const Get& get, bf16_t* dst, int dpitch, int k0, int n0, LAS float* scr, int lane) {
    float tv[32];
#pragma unroll
    for (int i = 0; i < 32; ++i) tv[i] = get(k0 + 2 * i + (lane >> 5), n0 + (lane & 31));
#pragma unroll
    for (int i = 0; i < 32; ++i) scr[(2 * i + (lane >> 5)) * 33 + (lane & 31)] = tv[i];
    LDS_WAIT(); asm volatile("" ::: "memory");
    const int c = lane & 7;
#pragma unroll
    for (int j = 0; j < 4; ++j) { const int n = (lane >> 3) + 8 * j; const LAS float* s = scr + (8 * c) * 33 + n;
        u32x4 o; o.x = pk2(s[0 * 33], s[1 * 33]); o.y = pk2(s[2 * 33], s[3 * 33]); o.z = pk2(s[4 * 33], s[5 * 33]); o.w = pk2(s[6 * 33], s[7 * 33]);
        *(u32x4*)(dst + (size_t)(n0 + n) * dpitch + k0 + 8 * c) = o; }
    LDS_WAIT(); asm volatile("" ::: "memory");
}
struct GetWin { const float* w; const float* g;
    __device__ __forceinline__ float operator()(int k, int n) const { int src; if (n < 2048) src = n; else if (n < 2304) src = n + 8; else if (n < 2312) src = n - 256; else return 0.f;
        float v = w[(size_t)k * DINSRC + src] * g[k]; if (n >= PQ && n < PK) v *= 0.125f * LOG2E; return v; } };
struct GetWout { const float* w; const float* ga; const float* gs;
    __device__ __forceinline__ float operator()(int k, int n) const { const int src = k < 768 ? k + 256 : k - 768; const float gn = k < 512 ? ga[k] : (k < 768 ? gs[k - 512] : 1.f);
        return w[(size_t)src * DM + n] * gn; } };
struct GetW13 { const float* w1; const float* w3; const float* g;
    __device__ __forceinline__ float operator()(int k, int n) const { const int u = n >> 8, hf = (n >> 7) & 1, j = n & 127; const uintptr_t wp = (uintptr_t)w1 + (uintptr_t)hf * ((uintptr_t)w3 - (uintptr_t)w1); return ((const GAS float*)wp)[(size_t)k * 256 + u * 128 + j] * g[k]; } };
struct GetW2 { const float* w;
    __device__ __forceinline__ float operator()(int k, int n) const { return w[(size_t)k * DM + n]; } };
struct GetWr { const float* rg; const float* re; const float* g; int lo;
    __device__ __forceinline__ float operator()(int k, int n) const { float v = 0.f; if (n < 4) v = rg[(size_t)k * 4 + n]; else if (n < 20) v = re[(size_t)k * 16 + (n - 4)]; v *= g[k];
        if (lo) v = v - __uint_as_float(f2bf(v) << 16); return v; } };

constexpr int AT_SLOT = 16384, AT_CS = 81920, AT_WT = AT_CS + 4608 * 4;
__device__ __forceinline__ int crow(int r, int hi) { return (r & 3) + 8 * (r >> 2) + 4 * hi; }
__device__ __forceinline__ void attn_prefix(LAS unsigned char* lds, const int tid, const float* flog, int b, int h) {
    const int lane = tid & 63; const int w = __builtin_amdgcn_readfirstlane(tid >> 6);
    LAS float* cs = (LAS float*)(lds + AT_CS); LAS float* wt = (LAS float*)(lds + AT_WT);
    float v[9]; float run = 0.f;
#pragma unroll
    for (int i = 0; i < 9; ++i) { const int j = tid * 9 + i; float x = 0.f; if (j < NMETA + SEQ) x = flog[(size_t)rowof(b, j) * 8 + h]; run += x; v[i] = run; }
    const float inc = wave_incl_scan(run);
    if (lane == 63) wt[w] = inc;
    __syncthreads();
    float base = inc - run;
    for (int k = 0; k < w; ++k) base += wt[k];
#pragma unroll
    for (int i = 0; i < 9; ++i) cs[tid * 9 + i] = base + v[i];
    __syncthreads();
}
__device__ __forceinline__ void at_glds16(const void* gsrc, unsigned lds_dst) { unsigned keep;
    asm volatile("s_mov_b32 %0, m0\n\ts_mov_b32 m0, %2\n\ts_nop 0\n\tglobal_load_lds_dwordx4 %1, off\n\ts_mov_b32 m0, %0" : "=&s"(keep) : "v"(gsrc), "s"(lds_dst) : "memory"); }
constexpr float AT_THR = 8.f;
__device__ __forceinline__ void attn_unit(LAS unsigned char* lds, const int tid, const bf16_t* proj, bf16_t* mixed, float* ssqa, int b, int h, int qt) {
    const int lane = tid & 63, r32 = lane & 31, hi = lane >> 5; const int w = __builtin_amdgcn_readfirstlane(tid >> 6);
    const LAS float* cs = (const LAS float*)(lds + AT_CS);
    const int qrel = 32 * w + r32;
    const int qrow = qt >= 0 ? b * SEQ + 256 * qt + qrel : NREAL + (qrel & 15);
    const int qkey = qt >= 0 ? NMETA + 256 * qt + qrel : (qrel & 15);
    const int qkey_w0 = qt >= 0 ? NMETA + 256 * qt + 32 * w : 0;
    const float cq = cs[qkey];
    bf16x8 qr[4];
#pragma unroll
    for (int d0 = 0; d0 < 4; ++d0) qr[d0] = *(const bf16x8*)(proj + (size_t)qrow * PJ + PQ + h * 64 + d0 * 16 + hi * 8);
    const int ntiles = qt >= 0 ? 1 + 4 * (qt + 1) : 1;
    const int wnt = qt >= 0 ? 4 * qt + (w >> 1) + 2 : 1;
    const int vr = 16 * (w & 3) + (lane >> 2);
    const unsigned ldsb = (unsigned)(uintptr_t)lds;
#define AT_DMA(jj) do { int kr_, vr_; if ((jj) == 0) { kr_ = NREAL + (lane < 15 ? lane : 15); vr_ = NREAL + (vr < 15 ? vr : 15); } else { kr_ = b * SEQ + 64 * ((jj) - 1) + lane; vr_ = b * SEQ + 64 * ((jj) - 1) + vr; } \
        const int so_ = AT_SLOTOF(sj, (jj) - jbase) + w * 1024; \
        at_glds16(proj + (size_t)kr_ * PJ + PK + h * 64 + w * 8, (unsigned)__builtin_amdgcn_readfirstlane(ldsb + so_)); \
        at_glds16(proj + (size_t)vr_ * PJ + PV + h * 64 + (w >> 2) * 32 + (lane & 3) * 8, (unsigned)__builtin_amdgcn_readfirstlane(ldsb + so_ + 8192)); } while (0)
#define AT_WAITBAR(n) asm volatile("s_waitcnt vmcnt(" #n ") lgkmcnt(0)\n\ts_barrier" ::: "memory")
    float mref = 0.f, lrun = 0.f; f32x16 o0 = {}, o1 = {};
    const int kfo = hi * 1024 + r32 * 16;
    const int vb = 8192 + ((lane >> 4) & 1) * 32 + (lane & 3) * 8 + (4 * hi + ((lane & 15) >> 2)) * 64;
    const LAS float* csl = cs + 4 * hi;
    bf16x8 kf[8];
#define AT_KLOAD(P0, P1, jjn) do { const int kb_ = (jjn) == 0 ? 0 : NMETA + 64 * ((jjn) - 1); const float cqm = cq - mref; const int so_ = AT_SLOTOF(sj, (jjn) - jbase); \
        _Pragma("unroll") for (int d0 = 0; d0 < 4; ++d0) { kf[2 * d0] = *(const LAS bf16x8*)(lds + so_ + kfo + d0 * 2048); kf[2 * d0 + 1] = *(const LAS bf16x8*)(lds + so_ + kfo + d0 * 2048 + 512); } \
        _Pragma("unroll") for (int g_ = 0; g_ < 4; ++g_) { const f32x4 c0_ = *(const LAS f32x4*)(csl + kb_ + 8 * g_), c1_ = *(const LAS f32x4*)(csl + kb_ + 32 + 8 * g_); \
            _Pragma("unroll") for (int e_ = 0; e_ < 4; ++e_) { P0[4 * g_ + e_] = cqm - c0_[e_]; P1[4 * g_ + e_] = cqm - c1_[e_]; } } \
        __builtin_amdgcn_sched_barrier(0); } while (0)
#define AT_QKM(P0, P1) do { _Pragma("unroll") for (int d0 = 0; d0 < 4; ++d0) { \
            P0 = __builtin_amdgcn_mfma_f32_32x32x16_bf16(kf[2 * d0], qr[d0], P0, 0, 0, 0); P1 = __builtin_amdgcn_mfma_f32_32x32x16_bf16(kf[2 * d0 + 1], qr[d0], P1, 0, 0, 0); } \
        __builtin_amdgcn_sched_barrier(0); } while (0)
#define AT_MX3(a, b, c) __builtin_fmaxf(__builtin_fmaxf((a), (b)), (c))
#define AT_SMPV(P0, P1, N0, N1, jj, pend) do { const int kb_ = (jj) == 0 ? 0 : NMETA + 64 * ((jj) - 1); \
        const LAS unsigned char* Vb_ = lds + AT_SLOTOF(sj, (jj) - jbase) + vb; s16x4 va_[8], vc_[8]; \
        _Pragma("unroll") for (int ks = 0; ks < 4; ++ks) { \
            va_[2 * ks] = __builtin_bit_cast(s16x4, __builtin_amdgcn_ds_read_tr16_b64_v4i16((LAS s16x4*)(Vb_ + ks * 1024))); \
            va_[2 * ks + 1] = __builtin_bit_cast(s16x4, __builtin_amdgcn_ds_read_tr16_b64_v4i16((LAS s16x4*)(Vb_ + ks * 1024 + 512))); } \
        __builtin_amdgcn_sched_barrier(0); \
        if ((jj) == 0 || kb_ + 63 > qkey_w0) { const int lim_ = (jj) == 0 ? (qkey < 15 ? qkey : 15) : qkey; \
            _Pragma("unroll") for (int r = 0; r < 16; ++r) { const int j_ = kb_ + crow(r, hi); if (j_ > lim_) P0[r] = -INFINITY; if (j_ + 32 > lim_) P1[r] = -INFINITY; } } \
        float ra_ = AT_MX3(P0[0], P0[1], P1[0]), rb_ = AT_MX3(P0[2], P0[3], P1[1]); ra_ = AT_MX3(ra_, P1[2], P1[3]); \
        _Pragma("unroll") for (int r = 4; r < 16; r += 4) { ra_ = AT_MX3(ra_, P0[r], P0[r + 1]); rb_ = AT_MX3(rb_, P0[r + 2], P0[r + 3]); ra_ = AT_MX3(ra_, P1[r], P1[r + 1]); rb_ = AT_MX3(rb_, P1[r + 2], P1[r + 3]); } \
        float rm_ = fmaxf(ra_, rb_); \
        rm_ = xmax32(rm_); \
        if ((jj) == 0 || __any(rm_ > AT_THR)) { const float dl_ = (jj) == 0 ? rm_ : fmaxf(rm_, 0.f); mref += dl_; const float f_ = (jj) == 0 ? 1.f : fast_exp2(-dl_); lrun *= f_; \
            _Pragma("unroll") for (int r = 0; r < 16; ++r) { P0[r] -= dl_; P1[r] -= dl_; o0[r] *= f_; o1[r] *= f_; } \
            if (pend) { _Pragma("unroll") for (int r = 0; r < 16; ++r) { N0[r] -= dl_; N1[r] -= dl_; } } } \
        float rs_ = 0.f; \
        _Pragma("unroll") for (int r = 0; r < 16; ++r) { P0[r] = fast_exp2(P0[r]); P1[r] = fast_exp2(P1[r]); rs_ += P0[r] + P1[r]; } \
        lrun += rs_; \
        u32x4 pw_[4]; \
        _Pragma("unroll") for (int i = 0; i < 4; ++i) { pw_[0][i] = cvt_pk_bf16(P0[2 * i], P0[2 * i + 1]); pw_[1][i] = cvt_pk_bf16(P0[8 + 2 * i], P0[8 + 2 * i + 1]); \
            pw_[2][i] = cvt_pk_bf16(P1[2 * i], P1[2 * i + 1]); pw_[3][i] = cvt_pk_bf16(P1[8 + 2 * i], P1[8 + 2 * i + 1]); } \
        __builtin_amdgcn_sched_barrier(0); \
        _Pragma("unroll") for (int ks = 0; ks < 4; ++ks) { \
            vc_[2 * ks] = __builtin_bit_cast(s16x4, __builtin_amdgcn_ds_read_tr16_b64_v4i16((LAS s16x4*)(Vb_ + 4096 + ks * 1024))); \
            vc_[2 * ks + 1] = __builtin_bit_cast(s16x4, __builtin_amdgcn_ds_read_tr16_b64_v4i16((LAS s16x4*)(Vb_ + 4096 + ks * 1024 + 512))); } \
        _Pragma("unroll") for (int ks = 0; ks < 4; ++ks) { \
            const bf16x8 va = {va_[2 * ks][0], va_[2 * ks][1], va_[2 * ks][2], va_[2 * ks][3], va_[2 * ks + 1][0], va_[2 * ks + 1][1], va_[2 * ks + 1][2], va_[2 * ks + 1][3]}; \
            o0 = __builtin_amdgcn_mfma_f32_32x32x16_bf16(va, __builtin_bit_cast(bf16x8, pw_[ks]), o0, 0, 0, 0); } \
        __builtin_amdgcn_sched_barrier(0); \
        _Pragma("unroll") for (int ks = 0; ks < 4; ++ks) { \
            const bf16x8 vbb = {vc_[2 * ks][0], vc_[2 * ks][1], vc_[2 * ks][2], vc_[2 * ks][3], vc_[2 * ks + 1][0], vc_[2 * ks + 1][1], vc_[2 * ks + 1][2], vc_[2 * ks + 1][3]}; \
            o1 = __builtin_amdgcn_mfma_f32_32x32x16_bf16(vbb, __builtin_bit_cast(bf16x8, pw_[ks]), o1, 0, 0, 0); } \
        __builtin_amdgcn_sched_barrier(0); } while (0)
#define AT_STEP(C0, C1, N0, N1, jj) do { \
        const bool dma_ = (jj) + 4 < ntiles; \
        if (dma_) AT_DMA((jj) + 4); \
        const bool pend_ = (jj) + 1 < wnt; \
        if (pend_) AT_QKM(N0, N1); \
        if ((jj) < wnt) AT_SMPV(C0, C1, N0, N1, jj, pend_); \
        if ((jj) + 2 < wnt) AT_KLOAD(C0, C1, (jj) + 2); \
        if (dma_) AT_WAITBAR(2); else AT_WAITBAR(0); } while (0)
    int sj = 0, jbase = 0;
#define AT_SLOTOF(s_, k_) (((s_) + (k_) * AT_SLOT) >= 5 * AT_SLOT ? ((s_) + (k_) * AT_SLOT) - 5 * AT_SLOT : ((s_) + (k_) * AT_SLOT))
    AT_DMA(0);
    if (ntiles > 1) AT_DMA(1);
    if (ntiles > 2) AT_DMA(2);
    if (ntiles > 3) { AT_DMA(3); AT_WAITBAR(2); } else AT_WAITBAR(0);
    f32x16 pa0, pa1, pb0, pb1;
    AT_KLOAD(pa0, pa1, 0); AT_QKM(pa0, pa1);
    if (1 < wnt) AT_KLOAD(pb0, pb1, 1);
#pragma unroll 1
    for (int jj = 0; jj < ntiles; jj += 2) {
        jbase = jj;
        AT_STEP(pa0, pa1, pb0, pb1, jj);
        if (jj + 1 < ntiles) AT_STEP(pb0, pb1, pa0, pa1, jj + 1);
        sj = AT_SLOTOF(sj, 2);
    }
#undef AT_SLOTOF
#undef AT_KLOAD
#undef AT_QKM
#undef AT_MX3
#undef AT_DMA
#undef AT_WAITBAR
#undef AT_SMPV
#undef AT_STEP
    const float ltot = xadd32(lrun);
    const float inv = 1.f / ltot;
    float sq = 0.f;
#pragma unroll
    for (int r = 0; r < 16; ++r) { o0[r] *= inv; o1[r] *= inv; sq += o0[r] * o0[r] + o1[r] * o1[r]; }
    sq = xadd32(sq);
    const bool st = qt >= 0 || qrel < 16;
    if (st) {
        bf16_t* op = mixed + (size_t)qrow * DM + MX_ATT + h * 64;
#pragma unroll
        for (int g = 0; g < 4; ++g) { u32x2 w0, w1; w0.x = cvt_pk_bf16(o0[4 * g], o0[4 * g + 1]); w0.y = cvt_pk_bf16(o0[4 * g + 2], o0[4 * g + 3]); w1.x = cvt_pk_bf16(o1[4 * g], o1[4 * g + 1]); w1.y = cvt_pk_bf16(o1[4 * g + 2], o1[4 * g + 3]);
            *(u32x2*)(op + 8 * g + 4 * hi) = w0; *(u32x2*)(op + 32 + 8 * g + 4 * hi) = w1; }
        if (hi == 0) ssqa[(size_t)qrow * 8 + h] = sq;
    }
    __syncthreads();
}

__device__ __forceinline__ void conv_unit(LAS unsigned char* lds, const int tid, const bf16_t* proj, bf16_t* mixed, const float* cw, const float* cb, const float* lg, const float* lb, int b, int tbase, int nsub, int nvalid) {
    const int lane = tid & 63; const int w = __builtin_amdgcn_readfirstlane(tid >> 6);
    LAS float* ub = (LAS float*)lds;
    const int cp = tid & 127, rg = tid >> 7;
#pragma unroll 1
    for (int sb = 0; sb < nsub; ++sb) {
        const int t0 = tbase + 64 * sb;
        {
            u32x2 av[12], gv[12];
#pragma unroll
            for (int it = 0; it < 12; ++it) { const int idx = tid + 512 * it; const int rr = idx >> 6, cq4 = (idx & 63) * 4; const int t = t0 - 30 + rr; av[it] = (u32x2){0u, 0u}; gv[it] = (u32x2){0u, 0u};
                if (rr < 94 && t >= 0 && t < NMETA + SEQ) { const bf16_t* p = proj + (size_t)rowof(b, t) * PJ + cq4; av[it] = *(const u32x2*)p; gv[it] = *(const u32x2*)(p + 256); } }
#pragma unroll
            for (int it = 0; it < 12; ++it) { const int idx = tid + 512 * it; const int rr = idx >> 6, cq4 = (idx & 63) * 4; f32x4 u;
                u[0] = bflo(av[it].x) * sigmoidf_(bflo(gv[it].x)); u[1] = bfhi(av[it].x) * sigmoidf_(bfhi(gv[it].x)); u[2] = bflo(av[it].y) * sigmoidf_(bflo(gv[it].y)); u[3] = bfhi(av[it].y) * sigmoidf_(bfhi(gv[it].y));
                if (rr < 94) *(LAS f32x4*)(ub + rr * 256 + cq4) = u; }
        }
        f32x2 wv[31];
#pragma unroll
        for (int j = 0; j < 31; ++j) wv[j] = *(const f32x2*)(cw + j * 256 + 2 * cp);
        __syncthreads();
        f32x2 acc[16];
#pragma unroll
        for (int i = 0; i < 16; ++i) acc[i] = (f32x2){0.f, 0.f};
#pragma unroll
        for (int rr = 0; rr < 46; ++rr) { const f32x2 uv = *(const LAS f32x2*)(ub + (16 * rg + rr) * 256 + 2 * cp);
#pragma unroll
            for (int i = 0; i < 16; ++i) if (rr - i >= 0 && rr - i <= 30) acc[i] += wv[rr - i] * uv; }
        __syncthreads();
        { const f32x2 bb = *(const f32x2*)(cb + 2 * cp);
#pragma unroll
        for (int i = 0; i < 16; ++i) *(LAS f32x2*)(ub + (16 * rg + i) * 256 + 2 * cp) = acc[i] + bb; }
        const f32x4 g4 = *(const f32x4*)(lg + 4 * lane), b4 = *(const f32x4*)(lb + 4 * lane);
        __syncthreads();
#pragma unroll
        for (int i = 0; i < 8; ++i) { const int rr = 8 * w + i; const f32x4 y = *(const LAS f32x4*)(ub + rr * 256 + 4 * lane);
            const float mu = wave_sum((y[0] + y[1]) + (y[2] + y[3])) * (1.f / 256.f);
            const f32x4 d = y - mu; const float var = wave_sum((d[0] * d[0] + d[1] * d[1]) + (d[2] * d[2] + d[3] * d[3])) * (1.f / 256.f);
            const float rs = rsqrtf(var + EPS); f32x4 o;
#pragma unroll
            for (int e = 0; e < 4; ++e) o[e] = siluf_(d[e] * rs * g4[e] + b4[e]);
            if (rr < nvalid) { u32x2 wv2; wv2.x = cvt_pk_bf16(o[0], o[1]); wv2.y = cvt_pk_bf16(o[2], o[3]); *(u32x2*)(mixed + (size_t)rowof(b, t0 + rr) * DM + MX_CONV + 4 * lane) = wv2; } }
        __syncthreads();
    }
}

struct S5P { const float *lre, *lim, *ldt, *bre, *bim, *cre, *cim, *dsk, *gw, *gb; };
__device__ __forceinline__ float gelu_tanh(float x) { const float u = 0.7978845608028654f * (x + 0.044715f * x * x * x); const float e = fast_exp2(2.f * LOG2E * u); const float th = 1.f - 2.f * fast_rcp(e + 1.f); return 0.5f * x * (1.f + th); }
constexpr size_t S5T_BYTES = 163840;
constexpr int S5_KT = 0, S5_WS = 8704, S5_WC = 74240, S5_MD = 139776, S5_MC = 142848;
constexpr int S5L_KT = 0, S5L_W = 8704, S5L_EX = 78336, S5L_MD = 82944, S5L_MC = 86016, S5L_CIN = 102656;
__device__ __forceinline__ void s5_tables_block(LAS unsigned char* lds, const int tid, const S5P& P, int g, unsigned char* tbl) {
    typedef float f2 __attribute__((ext_vector_type(2)));
    LAS f2* pw = (LAS f2*)lds;
    LAS f2* Bb = (LAS f2*)(lds + 8704);
    LAS f2* Cc = (LAS f2*)(lds + 16896);
    if (tid < 64) {
        const int p = tid;
        const float dt = expf(P.ldt[g]);
        const float lr = P.lre[g * 64 + p], li = P.lim[g * 64 + p];
        const float mag = expf(lr * dt);
        const double turns = (double)li * (double)dt * 0.15915494309189535; const float fr = (float)(turns - floor(turns));
        const float ar = mag * __builtin_amdgcn_cosf(fr), ai = mag * __builtin_amdgcn_sinf(fr);
        const float nr = ar - 1.f, ni = ai, den = lr * lr + li * li;
        const float fre = (nr * lr + ni * li) / den, fim = (ni * lr - nr * li) / den;
        float xr = 1.f, xi = 0.f;
        for (int t = 0; t <= 16; ++t) { pw[t * 64 + p] = (f2){xr, xi}; const float nxr = xr * ar - xi * ai, nxi = xr * ai + xi * ar; xr = nxr; xi = nxi; }
        const f2 M = pw[16 * 64 + p];
        float* MD = (float*)(tbl + S5_MD); float* MC = (float*)(tbl + S5_MC);
        float mr = M.x, mi = M.y;
        for (int k = 0; k < 6; ++k) { MD[(k * 64 + p) * 2] = mr; MD[(k * 64 + p) * 2 + 1] = mi; const float n1 = mr * mr - mi * mi, n2 = 2.f * mr * mi; mr = n1; mi = n2; }
        xr = 1.f; xi = 0.f;
        for (int c = 0; c < 32; ++c) { MC[(c * 64 + p) * 2] = xr; MC[(c * 64 + p) * 2 + 1] = xi; const float nxr = xr * M.x - xi * M.y, nxi = xr * M.y + xi * M.x; xr = nxr; xi = nxi; }
        for (int h = 0; h < 16; ++h) { const float br = P.bre[(g * 64 + p) * 16 + h], bi = P.bim[(g * 64 + p) * 16 + h]; Bb[p * 16 + h] = (f2){fre * br - fim * bi, fre * bi + fim * br}; }
    }
    for (int e = tid; e < 1024; e += 512) Cc[e] = (f2){P.cre[g * 1024 + e], P.cim[g * 1024 + e]};
    __syncthreads();
    bf16_t* KT = (bf16_t*)(tbl + S5_KT); bf16_t* WSg = (bf16_t*)(tbl + S5_WS); bf16_t* WCg = (bf16_t*)(tbl + S5_WC);
    for (int e = tid; e < 17 * 256; e += 512) {
        const int t1 = e >> 8, h = (e >> 4) & 15, h2 = e & 15; float acc = 0.f;
        if (t1 > 0) { const int tau = t1 - 1;
            for (int p = 0; p < 64; ++p) { const f2 a = pw[tau * 64 + p], bb = Bb[p * 16 + h2], c = Cc[h * 64 + p]; const float zr = a.x * bb.x - a.y * bb.y, zi = a.x * bb.y + a.y * bb.x; acc += c.x * zr - c.y * zi; }
            if (tau == 0 && h == h2) acc += P.dsk[g * 16 + h]; }
        KT[e] = (bf16_t)f2bf(acc);
    }
    for (int e = tid; e < 128 * 256; e += 512) {
        const int r = e >> 8, ri = r >> 6, p = r & 63, q = e & 255, j = q >> 4, h2 = q & 15;
        const f2 a = pw[(15 - j) * 64 + p], bb = Bb[p * 16 + h2]; const float zr = a.x * bb.x - a.y * bb.y, zi = a.x * bb.y + a.y * bb.x;
        WSg[e] = (bf16_t)f2bf(ri ? zi : zr);
    }
    for (int e = tid; e < 256 * 128; e += 512) {
        const int row = e >> 7, i = row >> 4, h = row & 15, q = e & 127; const int blk = q >> 5, sq_ = (q >> 4) & 1, hh = (q >> 3) & 1, j = q & 7;
        const int n = 32 * blk + 16 * sq_ + 8 * (j >> 2) + 4 * hh + (j & 3); const int ri = n >> 6, p = n & 63;
        const f2 a = pw[(i + 1) * 64 + p], c = Cc[h * 64 + p]; const float zr = c.x * a.x - c.y * a.y, zi = c.x * a.y + c.y * a.x;
        WCg[e] = (bf16_t)f2bf(ri ? -zi : zr);
    }
    __syncthreads();
}

__device__ __forceinline__ void s5_unit(unsigned long long* tsp, LAS unsigned char* lds, const int tid, const unsigned char* tbl, const float* gw, const float* gb, const bf16_t* proj, bf16_t* mixed, float* ssqs, int b, int g) {
    typedef float f2 __attribute__((ext_vector_type(2)));
    const int lane = tid & 63, c = lane & 31, hi = lane >> 5; const int w = __builtin_amdgcn_readfirstlane(tid >> 6);
    TS(30);
    for (int q = tid; q < 544; q += 512) *(LAS u32x4*)(lds + S5L_KT + q * 16) = *(const u32x4*)(tbl + S5_KT + q * 16);
#pragma unroll
    for (int it = 0; it < 8; ++it) { const int q = tid + 512 * it; *(LAS u32x4*)(lds + S5L_W + (q >> 5) * 528 + (q & 31) * 16) = *(const u32x4*)(tbl + S5_WS + q * 16); }
    if (tid < 192) *(LAS u32x4*)(lds + S5L_MD + tid * 16) = *(const u32x4*)(tbl + S5_MD + tid * 16);
#pragma unroll
    for (int it = 0; it < 4; ++it) { const int q = tid + 512 * it; *(LAS u32x2*)(lds + S5L_MC + (q >> 6) * 520 + (q & 63) * 8) = *(const u32x2*)(tbl + S5_MC + q * 8); }
    __syncthreads();
    TS(31);
    const bf16_t* ubase = proj + PU + 16 * g + 8 * hi;
    const LAS unsigned char* mdb = lds + S5L_MD + hi * 32;
    const LAS unsigned char* mcb = lds + S5L_MC + c * 520 + hi * 32;
    LAS float* EX = (LAS float*)(lds + S5L_EX) + 4 * hi;
    const LAS unsigned char* wsb = lds + S5L_W + c * 528 + hi * 16;
    const LAS unsigned char* wcb = lds + S5L_W + c * 272 + hi * 16;
    f32x16 sa[4];
#pragma unroll
    for (int k = 0; k < 4; ++k) sa[k] = (f32x16){};
    {
        const int cc = 32 * w + c;
        const GAS bf16_t* up = (const GAS bf16_t*)(ubase + (size_t)rowof(b, 16 * cc) * PJ);
#pragma unroll
        for (int s0 = 0; s0 < 16; s0 += 8) {
            bf16x8 uf[8];
#pragma unroll
            for (int s = 0; s < 8; ++s) { uf[s] = *(const GAS bf16x8*)up; up += PJ; asm volatile("" : "+v"(up)); }
            __builtin_amdgcn_sched_barrier(0);
#pragma unroll
            for (int s = 0; s < 8; ++s) {
#pragma unroll
                for (int blk = 0; blk < 4; ++blk) { const bf16x8 A = *(const LAS bf16x8*)(wsb + blk * (32 * 528) + (s0 + s) * 32); sa[blk] = __builtin_amdgcn_mfma_f32_32x32x16_bf16(A, uf[s], sa[blk], 0, 0, 0); }
                __builtin_amdgcn_sched_barrier(0); }
        }
    }
    TS(32);
    float sr[2][16], si[2][16];
#pragma unroll
    for (int pb = 0; pb < 2; ++pb)
#pragma unroll
        for (int r = 0; r < 16; ++r) { sr[pb][r] = sa[pb][r]; si[pb][r] = sa[2 + pb][r]; }
#pragma unroll
    for (int k = 0; k < 4; ++k) {
        const LAS unsigned char* mdk = mdb + k * 512; asm volatile("" : "+v"(mdk));
#pragma unroll
        for (int pb = 0; pb < 2; ++pb)
#pragma unroll
            for (int r = 0; r < 16; ++r) { const f2 m = *(const LAS f2*)(mdk + (32 * pb + (r & 3) + 8 * (r >> 2)) * 8);
                float yr, yi;
                if (k == 0) { yr = dpp_mov0<0x111>(sr[pb][r]); yi = dpp_mov0<0x111>(si[pb][r]); } else if (k == 1) { yr = dpp_mov0<0x112>(sr[pb][r]); yi = dpp_mov0<0x112>(si[pb][r]); }
                else if (k == 2) { yr = dpp_mov0<0x114>(sr[pb][r]); yi = dpp_mov0<0x114>(si[pb][r]); } else { yr = dpp_mov0<0x118>(sr[pb][r]); yi = dpp_mov0<0x118>(si[pb][r]); }
                sr[pb][r] += m.x * yr - m.y * yi; si[pb][r] += m.x * yi + m.y * yr; asm volatile("" : "+v"(sr[pb][r]), "+v"(si[pb][r]));
                if ((r & 3) == 3) { asm volatile("" ::: "memory"); __builtin_amdgcn_sched_barrier(0); } }
    }
    {
        const LAS unsigned char* mcu = lds + S5L_MC + ((c & 15) + 1) * 520 + hi * 32; asm volatile("" : "+v"(mcu));
#pragma unroll
        for (int pb = 0; pb < 2; ++pb)
#pragma unroll
            for (int r = 0; r < 16; ++r) { const f2 m = *(const LAS f2*)(mcu + (32 * pb + (r & 3) + 8 * (r >> 2)) * 8);
                const float yr = dpp_mov0m<0x142, 0xA>(sr[pb][r]), yi = dpp_mov0m<0x142, 0xA>(si[pb][r]);
                sr[pb][r] += m.x * yr - m.y * yi; si[pb][r] += m.x * yi + m.y * yr; asm volatile("" : "+v"(sr[pb][r]), "+v"(si[pb][r]));
                if ((r & 3) == 3) { asm volatile("" ::: "memory"); __builtin_amdgcn_sched_barrier(0); } }
    }
    TS(33);
    if (c == 31) {
#pragma unroll
        for (int pb = 0; pb < 2; ++pb)
#pragma unroll
            for (int r = 0; r < 16; ++r) { const int p0 = 32 * pb + (r & 3) + 8 * (r >> 2); EX[w * 128 + p0] = sr[pb][r]; EX[w * 128 + 64 + p0] = si[pb][r]; }
    }
    __syncthreads();
    if (w == 0) {
        LAS float* CIN = (LAS float*)(lds + S5L_CIN); const LAS float* EXp = (const LAS float*)(lds + S5L_EX);
        const f2 m = *(const LAS f2*)(lds + S5L_MD + (5 * 64 + lane) * 8); float cr_ = 0.f, ci_ = 0.f;
#pragma unroll
        for (int t = 0; t < 8; ++t) { CIN[t * 128 + lane] = cr_; CIN[t * 128 + 64 + lane] = ci_; const float er = EXp[t * 128 + lane], ei = EXp[t * 128 + 64 + lane];
            const float nr = m.x * cr_ - m.y * ci_ + er, ni = m.x * ci_ + m.y * cr_ + ei; cr_ = nr; ci_ = ni; }
        CIN[8 * 128 + lane] = cr_; CIN[8 * 128 + 64 + lane] = ci_;
    }
#pragma unroll
    for (int it = 0; it < 8; ++it) { const int q = tid + 512 * it; *(LAS u32x4*)(lds + S5L_W + (q >> 4) * 272 + (q & 15) * 16) = *(const u32x4*)(tbl + S5_WC + q * 16); }
    __syncthreads();
    TS(34);
    const int npass = 2;
#pragma unroll 1
    for (int pass = 0; pass < npass; ++pass) {
        if (pass == 1) TS(35);
        const int nprev = pass == 0 ? w : 8;
        const int cc = pass == 0 ? 32 * w + c : 256;
        if (pass == 1) {
#pragma unroll
            for (int pb = 0; pb < 2; ++pb)
#pragma unroll
                for (int r = 0; r < 16; ++r) { sr[pb][r] = 0.f; si[pb][r] = 0.f; }
        }
        {
            const LAS float* cinp = (const LAS float*)(lds + S5L_CIN) + nprev * 128 + 4 * hi; asm volatile("" : "+v"(cinp));
            const LAS unsigned char* mcb2 = mcb; asm volatile("" : "+v"(mcb2));
#pragma unroll
            for (int pb = 0; pb < 2; ++pb)
#pragma unroll
                for (int r = 0; r < 16; ++r) { const f2 m = *(const LAS f2*)(mcb2 + (32 * pb + (r & 3) + 8 * (r >> 2)) * 8);
                    float xr = dpp_mov0<0x138>(sr[pb][r]), xi = dpp_mov0<0x138>(si[pb][r]); if (c == 0) { xr = 0.f; xi = 0.f; }
                    const float cr_ = cinp[32 * pb + (r & 3) + 8 * (r >> 2)], ci_ = cinp[64 + 32 * pb + (r & 3) + 8 * (r >> 2)];
                    sr[pb][r] = xr + m.x * cr_ - m.y * ci_; si[pb][r] = xi + m.x * ci_ + m.y * cr_; asm volatile("" : "+v"(sr[pb][r]), "+v"(si[pb][r]));
                    if ((r & 3) == 3) { asm volatile("" ::: "memory"); __builtin_amdgcn_sched_barrier(0); } }
        }
        bf16x8 xf[4][2];
#pragma unroll
        for (int blk = 0; blk < 4; ++blk)
#pragma unroll
            for (int s = 0; s < 2; ++s) { const float* v = blk < 2 ? &sr[blk][8 * s] : &si[blk - 2][8 * s]; u32x4 t; t.x = cvt_pk_bf16(v[0], v[1]); t.y = cvt_pk_bf16(v[2], v[3]); t.z = cvt_pk_bf16(v[4], v[5]); t.w = cvt_pk_bf16(v[6], v[7]); xf[blk][s] = __builtin_bit_cast(bf16x8, t); }
        const int io = (lane >> 4) & 1, kk = lane & 15;
        bf16x8 Gf0, Gf1;
        { unsigned pkd[4];
    #pragma unroll
          for (int jj = 0; jj < 4; ++jj) { const int j0 = 2 * jj, j1 = 2 * jj + 1; const int h0 = 8 * (j0 >> 2) + 4 * hi + (j0 & 3), h1 = 8 * (j1 >> 2) + 4 * hi + (j1 & 3); pkd[jj] = pk2(gw[h0 * 16 + kk], gw[h1 * 16 + kk]); }
          const u32x4 wv = {pkd[0], pkd[1], pkd[2], pkd[3]}, zz = {0u, 0u, 0u, 0u};
          Gf0 = __builtin_bit_cast(bf16x8, io == 0 ? wv : zz); Gf1 = __builtin_bit_cast(bf16x8, io == 1 ? wv : zz); }
        float gbv[8];
    #pragma unroll
        for (int q = 0; q < 8; ++q) gbv[q] = gb[(q & 3) + 8 * (q >> 2) + 4 * hi];
        const int ktb = S5L_KT + ((lane >> 4) & 1) * 512 + (lane & 15) * 32 + hi * 16;
        const bool stok = pass == 0 ? (cc > 0 || b == 0) : (c == 0);
#pragma unroll
        for (int half = 0; half < 2; ++half) {
            __builtin_amdgcn_sched_barrier(0);
            f32x16 ya[4];
#pragma unroll
            for (int rl = 0; rl < 4; ++rl) ya[rl] = (f32x16){};
            int hi2 = hi; asm volatile("" : "+v"(hi2));
            const GAS bf16_t* up = (const GAS bf16_t*)(proj + PU + 16 * g + 8 * hi2 + (size_t)rowof(b, 16 * cc) * PJ);
#pragma unroll
            for (int s0 = 0; s0 < 8 * half + 8; s0 += 8) {
                bf16x8 uf[8];
#pragma unroll
                for (int s = 0; s < 8; ++s) { uf[s] = *(const GAS bf16x8*)up; up += PJ; asm volatile("" : "+v"(up)); }
                __builtin_amdgcn_sched_barrier(0);
#pragma unroll
                for (int s = 0; s < 8; ++s) {
#pragma unroll
                    for (int rl = 0; rl < 4; ++rl) { const int rb = 4 * half + rl; if (s0 + s <= 2 * rb + 1 && (pass == 0 || rb == w)) { const bf16x8 A = *(const LAS bf16x8*)(lds + ktb + (2 * rb - (s0 + s) + 1) * 512); ya[rl] = __builtin_amdgcn_mfma_f32_32x32x16_bf16(A, uf[s], ya[rl], 0, 0, 0); } }
                    __builtin_amdgcn_sched_barrier(0); }
            }
#pragma unroll
            for (int rl = 0; rl < 4; ++rl) if (pass == 0 || 4 * half + rl == w) {
#pragma unroll
                for (int blk = 0; blk < 4; ++blk)
#pragma unroll
                    for (int s = 0; s < 2; ++s) { const bf16x8 A = *(const LAS bf16x8*)(wcb + (4 * half + rl) * (32 * 272) + (blk * 2 + s) * 32); ya[rl] = __builtin_amdgcn_mfma_f32_32x32x16_bf16(A, xf[blk][s], ya[rl], 0, 0, 0); }
                __builtin_amdgcn_sched_barrier(0);
            }
#pragma unroll
            for (int rl = 0; rl < 4; ++rl) if (pass == 0 || 4 * half + rl == w) {
                const int rb = 4 * half + rl;
                float zg[16];
#pragma unroll
                for (int r = 0; r < 16; ++r) zg[r] = gelu_tanh(ya[rl][r]);
                u32x4 z0, z1; z0.x = cvt_pk_bf16(zg[0], zg[1]); z0.y = cvt_pk_bf16(zg[2], zg[3]); z0.z = cvt_pk_bf16(zg[4], zg[5]); z0.w = cvt_pk_bf16(zg[6], zg[7]);
                z1.x = cvt_pk_bf16(zg[8], zg[9]); z1.y = cvt_pk_bf16(zg[10], zg[11]); z1.z = cvt_pk_bf16(zg[12], zg[13]); z1.w = cvt_pk_bf16(zg[14], zg[15]);
                f32x16 gt = (f32x16){};
                gt = __builtin_amdgcn_mfma_f32_32x32x16_bf16(Gf0, __builtin_bit_cast(bf16x8, z0), gt, 0, 0, 0);
                gt = __builtin_amdgcn_mfma_f32_32x32x16_bf16(Gf1, __builtin_bit_cast(bf16x8, z1), gt, 0, 0, 0);
#pragma unroll
                for (int il = 0; il < 2; ++il) {
                    float o[8]; float sq = 0.f;
#pragma unroll
                    for (int q = 0; q < 8; ++q) { o[q] = zg[8 * il + q] * sigmoidf_(gt[8 * il + q] + gbv[q]); sq += o[q] * o[q]; }
                    sq = xadd32(sq);
                    if (stok) { const int row = rowof(b, 16 * cc + 2 * rb + il); bf16_t* op = mixed + (size_t)row * DM + MX_SSM + 16 * g + 4 * hi;
                        u32x2 w0, w1; w0.x = cvt_pk_bf16(o[0], o[1]); w0.y = cvt_pk_bf16(o[2], o[3]); w1.x = cvt_pk_bf16(o[4], o[5]); w1.y = cvt_pk_bf16(o[6], o[7]);
                        *(u32x2*)op = w0; *(u32x2*)(op + 8) = w1;
                        if (hi == 0) ssqs[(size_t)row * 16 + g] = sq; }
                }
                __builtin_amdgcn_sched_barrier(0);
            }
        }
    }
    TS(36);
    __syncthreads();
}

struct Args { const GAS float* in[31]; GAS float* out; GAS unsigned char* ws; int ph_lo, ph_hi; };
constexpr int N_PHASES = 16;
#define PHASE_IDS() int tid; { int ln_; asm volatile("v_mbcnt_lo_u32_b32 %0, -1, 0\n\tv_mbcnt_hi_u32_b32 %0, -1, %0" : "=v"(ln_)); tid = wave0 * 64 + ln_; } unsigned long long wz_ = 0; asm volatile("" : "+s"(wz_)); unsigned char* ws = ws0 + wz_;        const int lane = tid & 63; const int wave = __builtin_amdgcn_readfirstlane(tid >> 6); (void)lane; (void)wave

__global__ void __launch_bounds__(NWAVES * 64, 2) hymba_fwd(Args args) {
    extern __shared__ __attribute__((aligned(16))) unsigned char lds_raw[];
    LAS unsigned char* lds = (LAS unsigned char*)lds_raw;
    volatile LAS unsigned* MISC = (volatile LAS unsigned*)(lds + LDSCTL_OFF);
    LAS int* TB = (LAS int*)(lds + LDSCTL_OFF + 256);
    LAS int* CN = (LAS int*)(lds + LDSCTL_OFF + 512);
    LAS int* HIST = (LAS int*)(lds + LDSCTL_OFF + 768);
    const int wave0 = __builtin_amdgcn_readfirstlane(threadIdx.x >> 6);
    const int G = gridDim.x; const int bx = blockIdx.x; const int vcu = (G % 8 == 0) ? (bx % 8) * (G / 8) + bx / 8 : bx;
    unsigned char* const ws0 = (unsigned char*)args.ws;
    unsigned* const ctl = (unsigned*)(GAS unsigned*)(ws0 + WS_CTL);
    for (int u = threadIdx.x; u < (LDS_BYTES - LDSCTL_OFF) / 4; u += NWAVES * 64) ((LAS unsigned*)(lds + LDSCTL_OFF))[u] = 0u;
    __syncthreads();
    const int lo = args.ph_lo, hi = args.ph_hi;
    XcdBarrier bar; bar.bar = ctl + CW_BAR; bar.x = 0; bar.st = nullptr;
    if (hi - lo > 1) bar = xcd_barrier_post(ctl + CW_BAR, MISC + 8);
#define IN(k) (lo <= (k) && (k) < hi)
#define SEAM(k) do { if (IN(k) && IN((k) + 1)) { PHASE_IDS(); xcd_barrier(bar, tid == 0); } STAMP((k) + 1); } while (0)
#define WSP(T, off) ((T*)(ws + (off)))
#define INP(k) ((const float*)args.in[k])
#define STAMP(id) do { if (PROBE_A >= 0 && (int)blockIdx.x == PROBE_BLOCK && ((id) == PROBE_A || (id) == PROBE_B)) { PHASE_IDS(); if (tid == 0) ((unsigned long long*)(ctl + CW_TS))[id] = __builtin_amdgcn_s_memrealtime(); } } while (0)
    STAMP(0);

    for (int rep_ = 0; rep_ < DUP_P0; ++rep_) if (IN(0)) {
        PHASE_IDS();
        bf16_t* WinT = WSP(bf16_t, WS_WIN); bf16_t* WoutT = WSP(bf16_t, WS_WOUT); bf16_t* W13T = WSP(bf16_t, WS_W13); bf16_t* W2C = WSP(bf16_t, WS_W2C); bf16_t* WrT = WSP(bf16_t, WS_WR);
        bf16_t* hbuf = WSP(bf16_t, WS_H); float* ssq1 = WSP(float, WS_SSQ1); float* tinfo = WSP(float, WS_TINFO);
#pragma unroll 1
        for (int lg = vcu; lg < 32; lg += G) { const int l = lg >> 4, g = lg & 15;
            const S5P SP{INP(10) + l * 1024, INP(11) + l * 1024, INP(12) + l * 16, INP(13) + (size_t)l * 16384, INP(14) + (size_t)l * 16384, INP(15) + (size_t)l * 16384, INP(16) + (size_t)l * 16384,
                         INP(17) + l * 256, INP(18) + (size_t)l * 4096, INP(19) + l * 256};
            int tidp = tid; asm volatile("" : "+v"(tidp));
            s5_tables_block(lds, tidp, SP, g, WSP(unsigned char, WS_S5T) + (size_t)lg * S5T_BYTES); }
        LAS float* scr = (LAS float*)(lds + wave * 16384);
        const int gw = vcu * NWAVES + wave, NGW = G * NWAVES;
        constexpr int I_WIN = 16 * 80, I_WOUT = 16 * 32, I_W13 = 16 * 16, I_W2 = 4 * 32, I_WR = 16;
        constexpr int T_WIN = 2 * I_WIN, T_WOUT = 2 * I_WOUT, T_W13 = 32 * I_W13, T_W2 = 32 * I_W2, T_WR = 4 * I_WR;
        constexpr int NITEMS = T_WIN + T_WOUT + T_W13 + T_W2 + T_WR;
        const int nskip = G >= 64 ? 32 : 0; const int igw = (vcu - nskip) * NWAVES + wave, INGW = (G - nskip) * NWAVES;
#pragma unroll 1
        for (int it = igw; it < NITEMS && vcu >= nskip; it += INGW) {
            int r = it;
            if (r < T_WIN) { const int l = r / I_WIN, q = r % I_WIN, kb = q / 80, nb = q % 80; GetWin gt{INP(3) + (size_t)l * DM * DINSRC, INP(2) + l * DM};
                tr_item(gt, WinT + (size_t)l * NIN * DM, DM, 64 * kb, 32 * nb, scr, lane); continue; } r -= T_WIN;
            if (r < T_WOUT) { const int l = r / I_WOUT, q = r % I_WOUT, kb = q / 32, nb = q % 32; GetWout gt{INP(21) + (size_t)l * DM * DM, INP(9) + l * 512, INP(20) + l * 256};
                tr_item(gt, WoutT + (size_t)l * DM * DM, DM, 64 * kb, 32 * nb, scr, lane); continue; } r -= T_WOUT;
            if (r < T_W13) { const int le = r / I_W13, q = r % I_W13, kb = q / 16, nb = q % 16; const int l = le / 16; GetW13 gt{INP(27) + (size_t)le * DM * 256, INP(28) + (size_t)le * DM * 256, INP(22) + l * DM};
                tr_item(gt, W13T + (size_t)le * 512 * DM, DM, 64 * kb, 32 * nb, scr, lane); continue; } r -= T_W13;
            if (r < T_W2) { const int le = r / I_W2, q = r % I_W2, kb = q / 32, nb = q % 32; GetW2 gt{INP(29) + (size_t)le * 256 * DM};
                tr_item(gt, W2C + (size_t)le * DM * 256, 256, 64 * kb, 32 * nb, scr, lane); continue; } r -= T_W2;
            { const int lh = r / I_WR, kb = r % I_WR; const int l = lh >> 1, lo_ = lh & 1; GetWr gt{INP(23) + (size_t)l * DM * 4, INP(25) + (size_t)l * DM * 16, INP(22) + l * DM, lo_};
                tr_item(gt, WrT + (size_t)lh * 32 * DM, DM, 64 * kb, 0, scr, lane); }
        }
#pragma unroll 1
        for (int r0 = 2 * gw; r0 < MROWS; r0 += 2 * NGW) {
            f32x4 v[2][4];
#pragma unroll
            for (int q = 0; q < 2; ++q) { const int r = r0 + q;
#pragma unroll
                for (int j = 0; j < 4; ++j) { if (r < NREAL) v[q][j] = *(const f32x4*)(INP(0) + (size_t)r * DM + 4 * lane + 256 * j); else if (r < NTOK) v[q][j] = *(const f32x4*)(INP(1) + (size_t)(r - NREAL) * DM + 4 * lane + 256 * j); else v[q][j] = (f32x4){0.f, 0.f, 0.f, 0.f}; } }
#pragma unroll
            for (int q = 0; q < 2; ++q) { const int r = r0 + q; float s = 0.f;
#pragma unroll
                for (int j = 0; j < 4; ++j) { u32x2 w; w.x = pk2(v[q][j][0], v[q][j][1]); w.y = pk2(v[q][j][2], v[q][j][3]); *(u32x2*)(hbuf + (size_t)r * DM + 4 * lane + 256 * j) = w;
                    s += bflo(w.x) * bflo(w.x) + bfhi(w.x) * bfhi(w.x) + bflo(w.y) * bflo(w.y) + bfhi(w.y) * bfhi(w.y); }
                s = wave_sum(s);
                if (lane < 16) ssq1[(size_t)r * 16 + lane] = lane == 0 ? s : 0.f;
                if (r >= NTOK && lane < 4) tinfo[(size_t)r * 4 + lane] = 0.f; }
        }
    }
    SEAM(0);

#pragma unroll 1
    for (int l = 0; l < DEPTH; ++l) {
        const int P = 1 + 7 * l;
        for (int rep_ = 0; rep_ < DUP_G1; ++rep_) if (IN(P)) {
            PHASE_IDS();
            bf16_t* hbuf = WSP(bf16_t, WS_H); bf16_t* proj = WSP(bf16_t, WS_PROJ); float* flog = WSP(float, WS_FLOG); const float* ssq1 = WSP(float, WS_SSQ1);
            const bf16_t* Win = WSP(bf16_t, WS_WIN) + (size_t)l * NIN * DM; const float* fb = INP(4) + l * 8;
            DenseOrder S; S.init(hbuf, Win, NREAL, NIN, DM, DM, G, bx);
            EpiProj E{proj, flog, ssq1, fb};
            pg8::gemm_phase<EpiProj, DenseOrder, true, false>(lds, tid, DM, DM, S, E);
#pragma unroll 1
            for (int cb = bx; cb < NIN / 64; cb += G) {
                const f32x2 v = meta_gemm64<false>(lds, tid, hbuf + (size_t)NREAL * DM, Win, DM, cb * 64, nullptr, nullptr);
                const int mm = tid >> 5, cp = tid & 31, row = NREAL + mm;
                const float rs = row_rstd_all(ssq1, row, 1.f / DM);
                if (cb < 36) *(unsigned*)(proj + (size_t)row * PJ + cb * 64 + 2 * cp) = cvt_pk_bf16(v.x * rs, v.y * rs);
                else if (cb == 36 && cp < 4) { f32x2 o; const float f0 = v.x * rs + fb[2 * cp], f1 = v.y * rs + fb[2 * cp + 1]; o.x = -log2f(1.f + exp2f(-f0 * LOG2E)); o.y = -log2f(1.f + exp2f(-f1 * LOG2E)); *(f32x2*)(flog + (size_t)row * 8 + 2 * cp) = o; }
            }
        }
        SEAM(P);
        for (int rep_ = 0; rep_ < DUP_MIX; ++rep_) if (IN(P + 1)) {
            PHASE_IDS();
            const bf16_t* proj = WSP(bf16_t, WS_PROJ); bf16_t* mixed = WSP(bf16_t, WS_MIX); const float* flog = WSP(float, WS_FLOG); float* ssqa = WSP(float, WS_SSQA); float* ssqs = WSP(float, WS_SSQS);
            for (int repa_ = 0; repa_ < DUP_ATT; ++repa_)
#pragma unroll 1
            for (int vc = vcu; vc < 256; vc += G) {
                int bh = vc >> 2; asm volatile("" : "+s"(bh));
                const int b = bh >> 3, h = bh & 7;
                attn_prefix(lds, tid, flog, b, h);
#pragma unroll 1
                for (int i = 0; i < 4; ++i) { const int s = (vc & 3) * 2 + (i >> 1); int qt = (i & 1) ? 15 - s : s; asm volatile("" : "+s"(qt)); int tid3 = tid; asm volatile("" : "+v"(tid3)); attn_unit(lds, tid3, proj, mixed, ssqa, b, h, qt); }
            }
#pragma unroll 1
            for (int vc = vcu; vc < 8; vc += G) { int hh = vc; asm volatile("" : "+s"(hh)); int tid3 = tid; asm volatile("" : "+v"(tid3)); attn_prefix(lds, tid3, flog, 0, hh); attn_unit(lds, tid3, proj, mixed, ssqa, 0, hh, -1); }
            STAMP(20 + l * 4);
            const float* cw = INP(5) + (size_t)l * 31 * 256; const float* cbp = INP(6) + l * 256; const float* clg = INP(7) + l * 256; const float* clb = INP(8) + l * 256;
            for (int repc_ = 0; repc_ < DUP_CS; ++repc_)
#pragma unroll 1
            for (int vc = vcu; vc < 256; vc += G) {
                int tid2 = tid; asm volatile("" : "+v"(tid2));
                if ((vc & 1) == 0) { const int ci = vc >> 1;
                    conv_unit(lds, tid2, proj, mixed, cw, cbp, clg, clb, ci >> 4, NMETA + 256 * (ci & 15), 4, 64);
                } else {
                    if (vc == 1) conv_unit(lds, tid2, proj, mixed, cw, cbp, clg, clb, 0, 0, 1, 16);
                    int ug = vc >> 1; asm volatile("" : "+s"(ug));
                    s5_unit((unsigned long long*)(ctl + CW_TS), lds, tid2, WSP(unsigned char, WS_S5T) + (size_t)(l * 16 + (ug & 15)) * S5T_BYTES, INP(18) + (size_t)l * 4096 + (ug & 15) * 256, INP(19) + l * 256 + (ug & 15) * 16, proj, mixed, ssqs, ug >> 4, ug & 15);
                }
            }
        }
        if (IN(P + 1)) STAMP(21 + l * 4);
        SEAM(P + 1);
        if (IN(P + 3)) {
            PHASE_IDS();
            bf16_t* hbuf = WSP(bf16_t, WS_H); const bf16_t* mixed = WSP(bf16_t, WS_MIX); float* ssq2 = WSP(float, WS_SSQ2); const bf16_t* Wo = WSP(bf16_t, WS_WOUT) + (size_t)l * DM * DM;
            DenseOrder S; S.init(mixed, Wo, NREAL, DM, DM, DM, G, bx);
            EpiRes<false> E{hbuf, ssq2, CN, nullptr};
            HookNorm HK{WSP(float, WS_SSQA), WSP(float, WS_SSQS)};
            pg8::gemm_phase<EpiRes<false>, DenseOrder, true, false, false, HookNorm>(lds, tid, DM, DM, S, E, HK);
            STAMP(40 + 2 * l);
#pragma unroll 1
            for (int cb = bx; cb < DM / 64; cb += G) {
                const f32x2 v = meta_gemm64<true>(lds, tid, mixed + (size_t)NREAL * DM, Wo, DM, cb * 64, WSP(float, WS_SSQA), WSP(float, WS_SSQS));
                const int mm = tid >> 5, cp = tid & 31, row = NREAL + mm;
                unsigned* p = (unsigned*)(hbuf + (size_t)row * DM + cb * 64 + 2 * cp); const unsigned o = *p;
                const unsigned wv = cvt_pk_bf16(bflo(o) + v.x, bfhi(o) + v.y); *p = wv;
                const float sq = half32_sum(bflo(wv) * bflo(wv) + bfhi(wv) * bfhi(wv));
                if (cp == 0) ssq2[(size_t)row * 16 + cb] = sq;
            }
        }
        if (IN(P + 3)) STAMP(41 + 2 * l);
        SEAM(P + 3);
        if (IN(P + 4)) {
            PHASE_IDS();
            const bf16_t* hbuf = WSP(bf16_t, WS_H); const float* ssq2 = WSP(float, WS_SSQ2); float* tinfo = WSP(float, WS_TINFO); int* list = WSP(int, WS_LIST);
            unsigned* gcnt = ctl + CW_CNT + l * 32;
            const bf16_t* Whi = WSP(bf16_t, WS_WR) + (size_t)(2 * l) * 32 * DM; const bf16_t* Wlo = Whi + (size_t)32 * DM;
            LAS float* scr = (LAS float*)(lds + wave * 4352);
#pragma unroll 1
            for (int base = 0; base < 1025; base += G * 4) {
                const int grp = base + bx * 4 + wave;
                const bool active = wave < 4 && grp < 1025;
                int cls = 0, posl = 0, tok = 0; bool valid = false; float rstd = 0.f, gA = 0.f, gB = 0.f;
                if (active) {
                    const int r32 = lane & 31, hh = lane >> 5; const int rowA = grp * 32 + r32 < NTOK ? grp * 32 + r32 : DUMMY_ROW;
                    f32x16 acc = {};
                    const bf16_t* ap = hbuf + (size_t)rowA * DM + 8 * hh; const bf16_t* bh_ = Whi + (size_t)r32 * DM + 8 * hh; const bf16_t* bl_ = Wlo + (size_t)r32 * DM + 8 * hh;
#pragma unroll 8
                    for (int k0 = 0; k0 < DM; k0 += 16) { const bf16x8 a = *(const bf16x8*)(ap + k0), b0 = *(const bf16x8*)(bh_ + k0), b1 = *(const bf16x8*)(bl_ + k0);
                        acc = __builtin_amdgcn_mfma_f32_32x32x16_bf16(a, b0, acc, 0, 0, 0); acc = __builtin_amdgcn_mfma_f32_32x32x16_bf16(a, b1, acc, 0, 0, 0); }
#pragma unroll
                    for (int r = 0; r < 16; ++r) scr[crow(r, hh) * 33 + r32] = acc[r];
                    LDS_WAIT(); asm volatile("" ::: "memory");
                    tok = grp * 32 + r32; valid = hh == 0 && tok < NTOK;
                    if (valid) {
                        float s = 0.f;
#pragma unroll
                        for (int q = 0; q < 4; ++q) { const f32x4 v = *(const f32x4*)(ssq2 + (size_t)tok * 16 + 4 * q); s += (v.x + v.y) + (v.z + v.w); }
                        rstd = rsqrtf(s * (1.f / DM) + EPS);
                        float lg[4]; const float* bg = INP(24) + l * 4; const float* be = INP(26) + l * 16;
#pragma unroll
                        for (int i = 0; i < 4; ++i) lg[i] = scr[r32 * 33 + i] * rstd + bg[i];
                        int gs = 0; float mx = lg[0];
#pragma unroll
                        for (int i = 1; i < 4; ++i) if (lg[i] > mx) { mx = lg[i]; gs = i; }
                        float se = 0.f;
#pragma unroll
                        for (int i = 0; i < 4; ++i) se += expf(lg[i] - mx);
                        const float pg = 1.f / se;
                        float le[4];
#pragma unroll
                        for (int i = 0; i < 4; ++i) le[i] = scr[r32 * 33 + 4 + 4 * gs + i] * rstd + be[4 * gs + i];
                        int i1 = 0; float v1 = le[0];
#pragma unroll
                        for (int i = 1; i < 4; ++i) if (le[i] > v1) { v1 = le[i]; i1 = i; }
                        int i2 = -1; float v2 = -INFINITY;
#pragma unroll
                        for (int i = 0; i < 4; ++i) if (i != i1 && le[i] > v2) { v2 = le[i]; i2 = i; }
                        const float w1 = pg / (1.f + expf(v2 - v1)), w2 = pg - w1;
                        const int a = i1 < i2 ? i1 : i2, bb = i1 < i2 ? i2 : i1;
                        gA = i1 < i2 ? w1 : w2; gB = i1 < i2 ? w2 : w1;
                        cls = gs * 6 + (a == 0 ? bb - 1 : (a == 1 ? bb + 1 : 5));
                        posl = __hip_atomic_fetch_add(&HIST[cls], 1, __ATOMIC_RELAXED, __HIP_MEMORY_SCOPE_WORKGROUP);
                    }
                }
                __syncthreads();
                if (tid < NCLS) { const int n = HIST[tid]; HIST[32 + tid] = n ? (int)__hip_atomic_fetch_add(gcnt + tid, (unsigned)n, __ATOMIC_RELAXED, __HIP_MEMORY_SCOPE_AGENT) : 0; }
                __syncthreads();
                if (valid) { const int pos = HIST[32 + cls] + posl; list[(size_t)cls * NTOK + pos] = tok; *(f32x4*)(tinfo + (size_t)tok * 4) = (f32x4){rstd, gA, gB, 0.f}; }
                __syncthreads();
                if (tid < NCLS) HIST[tid] = 0;
                __syncthreads();
            }
        }
        SEAM(P + 4);
        if (IN(P + 5) || IN(P + 6)) {
            unsigned* gcnt = ctl + CW_CNT + l * 32;
            PHASE_IDS();
            if (tid == 0) { int run = 0; for (int c = 0; c < NCLS; ++c) { const int n = (int)__hip_atomic_load(gcnt + c, __ATOMIC_RELAXED, __HIP_MEMORY_SCOPE_AGENT); CN[c] = n; TB[c] = run; run += (n + 255) >> 8; } TB[NCLS] = run; }
            __syncthreads();
        }
        for (int rep_ = 0; rep_ < DUP_E1; ++rep_) if (IN(P + 5)) {
            PHASE_IDS();
            const int* list = WSP(int, WS_LIST);
            ExpertOrder S{TB, CN, list, (const char*)WSP(bf16_t, WS_H), (const char*)WSP(bf16_t, WS_W13), G, bx, 1, l};
            EpiE1 E{WSP(bf16_t, WS_H1), WSP(float, WS_TINFO), CN, list};
            pg8::gemm_phase<EpiE1, ExpertOrder, true, true>(lds, tid, DM, DM, S, E);
        }
        SEAM(P + 5);
        if (IN(P + 6)) {
            PHASE_IDS();
            const int* list = WSP(int, WS_LIST);
            ExpertOrder S{TB, CN, list, (const char*)WSP(bf16_t, WS_H1), (const char*)WSP(bf16_t, WS_W2C), G, bx, 2, l};
            EpiRes<true> E{WSP(bf16_t, WS_H), WSP(float, WS_SSQ1), CN, list};
            pg8::gemm_phase<EpiRes<true>, ExpertOrder, true, false, true>(lds, tid, 512, 256, S, E);
        }
        SEAM(P + 6);
    }
    if (IN(15)) {
        PHASE_IDS();
        const bf16_t* hbuf = WSP(bf16_t, WS_H); const float* ssq1 = WSP(float, WS_SSQ1);
        const int gw = vcu * NWAVES + wave, NGW = G * NWAVES; const float* gF = INP(30);
        f32x4 gv[4];
#pragma unroll
        for (int j = 0; j < 4; ++j) gv[j] = *(const f32x4*)(gF + 4 * lane + 256 * j);
#pragma unroll 1
        for (int r = gw; r < NREAL; r += NGW) {
            float s = lane < 16 ? ssq1[(size_t)r * 16 + lane] : 0.f; s = wave_sum(s);
            const float rs = rsqrtf(s * (1.f / DM) + EPS);
#pragma unroll
            for (int j = 0; j < 4; ++j) { const u32x2 w = *(const u32x2*)(hbuf + (size_t)r * DM + 4 * lane + 256 * j);
                f32x4 o; o[0] = bflo(w.x) * rs * gv[j][0]; o[1] = bfhi(w.x) * rs * gv[j][1]; o[2] = bflo(w.y) * rs * gv[j][2]; o[3] = bfhi(w.y) * rs * gv[j][3];
                if (PROBE_A >= 0 && r == 0 && lane == 0 && j == 0) { const unsigned long long ta = __hip_atomic_load((unsigned long long*)(ctl + CW_TS) + (PROBE_A < 0 ? 0 : PROBE_A), __ATOMIC_RELAXED, __HIP_MEMORY_SCOPE_AGENT), tb = __hip_atomic_load((unsigned long long*)(ctl + CW_TS) + (PROBE_B < 0 ? 0 : PROBE_B), __ATOMIC_RELAXED, __HIP_MEMORY_SCOPE_AGENT); o[0] += (float)(long long)(tb - ta) * (0.01f / PROBE_SCALE); }
                *(f32x4*)(((float*)args.out) + (size_t)r * DM + 4 * lane + 256 * j) = o; }
        }
    }
#undef IN
#undef SEAM
#undef WSP
}

extern "C" void kernel_launch(void* const* d_in, const int* in_sizes, int n_in, void* d_out, int out_size, void* d_ws, size_t ws_size, hipStream_t stream) {
    static int grid = 0;
    if (grid == 0) {
        if (n_in != 31 || out_size != NREAL * DM || ws_size < WS_END) { fprintf(stderr, "kernel_launch: unexpected shapes (n_in %d, out %d, ws %zu)\n", n_in, out_size, ws_size); grid = -1; return; }
        int dev = 0, cus = 0, per_cu = 0;
        if (hipGetDevice(&dev) != hipSuccess || hipDeviceGetAttribute(&cus, hipDeviceAttributeMultiprocessorCount, dev) != hipSuccess) { grid = -1; return; }
        if (hipFuncSetAttribute((const void*)hymba_fwd, hipFuncAttributeMaxDynamicSharedMemorySize, LDS_BYTES) != hipSuccess) { fprintf(stderr, "kernel_launch: hipFuncSetAttribute failed\n"); grid = -1; return; }
        if (hipOccupancyMaxActiveBlocksPerMultiprocessor(&per_cu, (const void*)hymba_fwd, NWAVES * 64, LDS_BYTES) != hipSuccess || per_cu < 1) { fprintf(stderr, "kernel_launch: occupancy query says %d\n", per_cu); }
        (void)hipGetLastError();
        grid = cus;
    }
    if (grid < 0) return;
    (void)in_sizes;
    if (hipMemsetAsync((char*)d_ws + WS_CTL, 0, CTL_BYTES, stream) != hipSuccess) return;
    Args a{};
    for (int i = 0; i < 31; ++i) a.in[i] = (const GAS float*)d_in[i];
    a.out = (GAS float*)d_out; a.ws = (GAS unsigned char*)d_ws;
#if MK_PER_PHASE
    for (int p = 0; p < N_PHASES; ++p) { a.ph_lo = p; a.ph_hi = p + 1; hipLaunchKernelGGL(hymba_fwd, dim3(grid), dim3(NWAVES * 64), LDS_BYTES, stream, a); }
#else
    a.ph_lo = 0; a.ph_hi = N_PHASES;
    hipLaunchKernelGGL(hymba_fwd, dim3(grid), dim3(NWAVES * 64), LDS_BYTES, stream, a);
#endif
}
```

```cpp
#include <hip/hip_runtime.h>
#include <cstdio>
#include <cstdint>

#ifndef PROBE_A
#define PROBE_A -1
#endif
#ifndef PROBE_B
#define PROBE_B -1
#endif
#ifndef PROBE_BLOCK
#define PROBE_BLOCK 0
#endif
#ifndef PROBE_SCALE
#define PROBE_SCALE 4.0f
#endif
constexpr int CW_TS = 20480;
#define TS(id) do { if (PROBE_A >= 0 && (int)blockIdx.x == PROBE_BLOCK && tid == 0 && ((id) == PROBE_A || (id) == PROBE_B)) tsp[id] = __builtin_amdgcn_s_memrealtime(); } while (0)
#ifndef DUP_ATT
#define DUP_ATT 1
#endif
#ifndef DUP_CS
#define DUP_CS 1
#endif
#ifndef DUP_G1
#define DUP_G1 1
#endif
#ifndef DUP_MIX
#define DUP_MIX 1
#endif
#ifndef DUP_E1
#define DUP_E1 1
#endif
#ifndef DUP_P0
#define DUP_P0 1
#endif
#ifndef MK_PER_PHASE
#define MK_PER_PHASE 0
#endif

#define LAS __attribute__((address_space(3)))
#define GAS __attribute__((address_space(1)))
typedef unsigned short bf16_t;
typedef short bf16x8 __attribute__((ext_vector_type(8)));
typedef short s16x4 __attribute__((ext_vector_type(4)));
typedef float f32x4 __attribute__((ext_vector_type(4)));
typedef float f32x2 __attribute__((ext_vector_type(2)));
typedef float f32x16 __attribute__((ext_vector_type(16)));
typedef unsigned u32x4 __attribute__((ext_vector_type(4)));
typedef unsigned u32x2 __attribute__((ext_vector_type(2)));

constexpr int NB = 8, SEQ = 4096, NMETA = 16, DM = 1024, DEPTH = 2;
constexpr int NREAL = NB * SEQ;
constexpr int NTOK = NREAL + NMETA;
constexpr int MROWS = 33024;
constexpr int DUMMY_ROW = NTOK;
constexpr int PJ = 2304;
constexpr int NIN = 2560;
constexpr int DINSRC = 2312;
constexpr int PQ = 512, PK = 1024, PV = 1536, PU = 2048;
constexpr int MX_ATT = 0, MX_SSM = 512, MX_CONV = 768;
constexpr int NCLS = 24;
constexpr float EPS = 1e-6f;
constexpr float LOG2E = 1.4426950408889634f;
constexpr int H1CAP = 40960;

constexpr size_t MiB = 1u << 20;
constexpr size_t WS_CTL = 0, CTL_BYTES = 1 * MiB;
constexpr size_t WS_WIN = 2 * MiB, WS_WOUT = 12 * MiB, WS_W13 = 16 * MiB, WS_W2C = 48 * MiB, WS_WR = 96 * MiB;
constexpr size_t WS_H = 100 * MiB, WS_PROJ = 165 * MiB, WS_MIX = 311 * MiB, WS_H1 = 376 * MiB;
constexpr size_t WS_FLOG = 416 * MiB, WS_SSQ1 = 418 * MiB, WS_SSQ2 = 421 * MiB, WS_SSQA = 424 * MiB, WS_SSQS = 426 * MiB, WS_TINFO = 429 * MiB, WS_LIST = 430 * MiB, WS_S5T = 434 * MiB, WS_END = 440 * MiB;
constexpr int CW_TMO = 0, CW_BAR = 4096, CW_CNT = 16384;

constexpr int RING_BYTES = 131072;
constexpr int LDSCTL_OFF = RING_BYTES;
constexpr int LDS_BYTES = 147456;
constexpr int NWAVES = 8;

#define LDS_WAIT() asm volatile("s_waitcnt lgkmcnt(0)" ::: "memory")
#define VM_WAIT() asm volatile("s_waitcnt vmcnt(0)" ::: "memory")

__device__ __forceinline__ unsigned f2bf(float f) { unsigned u = __float_as_uint(f); return (u + 0x7fffu + ((u >> 16) & 1u)) >> 16; }
__device__ __forceinline__ unsigned pk2(float lo, float hi) { return f2bf(lo) | (f2bf(hi) << 16); }
__device__ __forceinline__ float bflo(unsigned w) { return __uint_as_float(w << 16); }
__device__ __forceinline__ float bfhi(unsigned w) { return __uint_as_float(w & 0xffff0000u); }
__device__ __forceinline__ float bf2f(bf16_t b) { return __uint_as_float(((unsigned)b) << 16); }
__device__ __forceinline__ unsigned cvt_pk_bf16(float lo, float hi) { unsigned r; asm volatile("v_cvt_pk_bf16_f32 %0, %1, %2" : "=v"(r) : "v"(lo), "v"(hi)); return r; }
template <int CTRL> __device__ __forceinline__ float dpp_mov0(float v) { return __builtin_bit_cast(float, __builtin_amdgcn_update_dpp(0, __builtin_bit_cast(int, v), CTRL, 0xF, 0xF, true)); }
__device__ __forceinline__ void swap16(float& a, float& b) { asm volatile("v_nop\n\tv_nop\n\tv_permlane16_swap_b32 %0, %1" : "+v"(a), "+v"(b)); }
__device__ __forceinline__ void swap32(float& a, float& b) { asm volatile("v_nop\n\tv_nop\n\tv_permlane32_swap_b32 %0, %1" : "+v"(a), "+v"(b)); }
__device__ __forceinline__ float xadd16(float v) { float a = v, b = v; swap16(a, b); return a + b; }
__device__ __forceinline__ float xadd32(float v) { float a = v, b = v; swap32(a, b); return a + b; }
__device__ __forceinline__ float row16_sum(float v) {
    v += dpp_mov0<0xB1>(v);
    v += dpp_mov0<0x4E>(v);
    v += dpp_mov0<0x141>(v);
    v += dpp_mov0<0x140>(v);
    return v;
}
template <int CTRL, int ROWMASK> __device__ __forceinline__ float dpp_mov0m(float v) { return __builtin_bit_cast(float, __builtin_amdgcn_update_dpp(0, __builtin_bit_cast(int, v), CTRL, ROWMASK, 0xF, true)); }
__device__ __forceinline__ float xmax32(float v) { float a = v, b = v; swap32(a, b); return fmaxf(a, b); }
__device__ __forceinline__ float wave_incl_scan(float v) {
    v += dpp_mov0<0x111>(v); v += dpp_mov0<0x112>(v); v += dpp_mov0<0x114>(v); v += dpp_mov0<0x118>(v);
    v += dpp_mov0m<0x142, 0xA>(v);
    v += dpp_mov0m<0x143, 0xC>(v);
    return v;
}
__device__ __forceinline__ float half32_sum(float v) { return xadd16(row16_sum(v)); }
__device__ __forceinline__ float wave_sum(float v) { return xadd32(xadd16(row16_sum(v))); }
__device__ __forceinline__ float fast_exp2(float x) { return __builtin_amdgcn_exp2f(x); }
__device__ __forceinline__ float fast_rcp(float x) { return __builtin_amdgcn_rcpf(x); }
__device__ __forceinline__ float sigmoidf_(float x) { return fast_rcp(1.f + fast_exp2(-x * LOG2E)); }
__device__ __forceinline__ float siluf_(float x) { return x * sigmoidf_(x); }
__device__ __forceinline__ int rowof(int b, int t) { return t < NMETA ? NREAL + t : b * SEQ + (t - NMETA); }

namespace pg8 {
constexpr int BM = 256, BK = 64, HALF = 128, HTB = HALF * BK * 2, STAGE_BYTES = 8 * HTB;
__host__ __device__ __forceinline__ int lds_byte(int r, int c) { const int st = (r >> 4) * 2 + (c >> 5), rr = r & 15, cc = c & 31, ob = rr * 64 + cc * 2; return st * 1024 + (ob ^ (((ob >> 9) & 1) << 5)); }
__host__ __device__ __forceinline__ void stage_rc(int b, int& R, int& C) { const int st = b / 1024, sb = b % 1024, swz = sb ^ (((sb >> 9) & 1) << 5); R = (st >> 1) * 16 + swz / 64; C = (st & 1) * 32 + (swz % 64) / 2; }
__host__ __device__ __forceinline__ int perm32(int rho) { const int n = rho >> 4, i = rho & 15; return 8 * (i >> 2) + 4 * n + (i & 3); }

struct Unit { int pm, pn, cls, p0; };

struct NoHook { static constexpr bool ON = false; __device__ __forceinline__ void load(const Unit&, int, int, int, float (&)[8], float (&)[8]) const {} };
template <class Epi, class Sched, bool ALIGN_EPI, bool GATHER, bool BSPLIT = false, class Hook = NoHook>
__device__ __forceinline__ void gemm_phase(LAS unsigned char* lds, const int tid, const int K, const int ldb, const Sched& S, const Epi& E, const Hook& H = Hook()) {
    const int wid = __builtin_amdgcn_readfirstlane(tid >> 6), lane = tid & 63, wr = wid >> 2, wc = wid & 3, fr = lane & 15, fq = lane >> 4;
    const int nt = K / BK;
    unsigned voffA[2], voffB[2]; int RA[2], CA[2];
#pragma unroll
    for (int i = 0; i < 2; ++i) { int R, C; stage_rc(tid * 16 + i * 8192, R, C); const int Rb = (R & ~31) + perm32(R & 31);
        voffA[i] = (unsigned)(R * K + C) * 2u; voffB[i] = (unsigned)(Rb * ldb + C) * 2u; RA[i] = R; CA[i] = C; }
    const size_t kstep = (size_t)(BK * 2);
    const size_t hstepA = (size_t)HALF * K * 2, hstepB = (size_t)HALF * ldb * 2;
    const size_t pstepA = (size_t)64 * K * 2, pstepB = (size_t)64 * ldb * 2;
    const unsigned ldsw = (unsigned)wid * 1024u;
    const int aoff = lds_byte(wr * 64 + fr, fq * 8), boff = lds_byte(wc * 32 + fr, fq * 8);
#define PG8_SA(b, h) (((b) * 2 + (h)) * HTB)
#define PG8_SB(b, h) ((4 + (b) * 2 + (h)) * HTB)
#define PG8_STAGE(bufoff, gbase, voff) do { _Pragma("unroll") for (int _i = 0; _i < 2; ++_i) \
        __builtin_amdgcn_global_load_lds((const unsigned*)((const char*)(gbase) + (voff)[_i]), (LAS unsigned*)(lds + (bufoff) + ldsw + _i * 8192), 16, 0, 0); } while (0)
#define PG8_STAGE1(bufoff, gbase, voff1, step) do { _Pragma("unroll") for (int _i = 0; _i < 2; ++_i) \
        __builtin_amdgcn_global_load_lds((const unsigned*)((const char*)(gbase) + (size_t)_i * (step) + (voff1)), (LAS unsigned*)(lds + (bufoff) + ldsw + _i * 8192), 16, 0, 0); } while (0)
#define PG8_LDA(dst, b, h) do { _Pragma("unroll") for (int m = 0; m < 4; ++m) _Pragma("unroll") for (int k = 0; k < 2; ++k) dst[m][k] = *(const LAS bf16x8*)(lds + PG8_SA(b, h) + aoff + m * 2048 + k * 1024); } while (0)
#define PG8_LDB(dst, b, h) do { _Pragma("unroll") for (int n = 0; n < 2; ++n) _Pragma("unroll") for (int k = 0; k < 2; ++k) dst[n][k] = *(const LAS bf16x8*)(lds + PG8_SB(b, h) + boff + n * 2048 + k * 1024); } while (0)
#define PG8_MMA(ai, bj, At, Bt) do { __builtin_amdgcn_s_setprio(1); _Pragma("unroll") for (int m = 0; m < 4; ++m) _Pragma("unroll") for (int n = 0; n < 2; ++n) _Pragma("unroll") for (int k = 0; k < 2; ++k) \
        acc[ai][bj][m][n] = __builtin_amdgcn_mfma_f32_16x16x32_bf16(Bt[n][k], At[m][k], acc[ai][bj][m][n], 0, 0, 0); __builtin_amdgcn_s_setprio(0); } while (0)
#define PG8_WAIT_V(n) asm volatile("s_waitcnt vmcnt(" #n ")" ::: "memory")
#define PG8_WAIT_L(n) asm volatile("s_waitcnt lgkmcnt(" #n ")" ::: "memory")
#define PG8_BAR __builtin_amdgcn_s_barrier()
#define PG8_SCHED __builtin_amdgcn_sched_barrier(0)
    Unit cur, nxt; int ui = 0;
    if (!S.next(0, cur)) return;
    f32x4 acc[2][2][4][2];
#pragma unroll
    for (int a = 0; a < 2; ++a)
#pragma unroll
        for (int b = 0; b < 2; ++b)
#pragma unroll
            for (int m = 0; m < 4; ++m)
#pragma unroll
                for (int n = 0; n < 2; ++n) acc[a][b][m][n] = (f32x4){0.f, 0.f, 0.f, 0.f};
    bf16x8 At[4][2], B0[2][2], B1[2][2];
    const char* cA = S.abase(cur); const char* cB = S.bbase(cur);
    const char* cB2 = cB; const int ksp = BSPLIT ? nt / 2 : (1 << 30);
    if constexpr (BSPLIT) cB2 = S.bbase2(cur) - (size_t)ksp * kstep;
    unsigned oC[2][2], oN[2][2];
    if constexpr (GATHER) {
#pragma unroll
        for (int h = 0; h < 2; ++h)
#pragma unroll
            for (int i = 0; i < 2; ++i) oC[h][i] = (unsigned)S.rowtok(cur, h * HALF + RA[i]) * (unsigned)(K * 2) + (unsigned)(CA[i] * 2);
    }
    PG8_STAGE1(PG8_SB(0, 0), cB, voffB[0], pstepB); PG8_STAGE1(PG8_SB(0, 1), cB + hstepB, voffB[0], pstepB);
    if constexpr (GATHER) { PG8_STAGE(PG8_SA(0, 0), cA, oC[0]); PG8_STAGE(PG8_SA(0, 1), cA, oC[1]); }
    else { PG8_STAGE1(PG8_SA(0, 0), cA, voffA[0], pstepA); PG8_STAGE1(PG8_SA(0, 1), cA + hstepA, voffA[0], pstepA); }
    if (wr == 1) PG8_BAR;
    PG8_WAIT_V(2); PG8_BAR;
    PG8_STAGE1(PG8_SB(1, 0), cB + kstep, voffB[0], pstepB);
    if constexpr (GATHER) { PG8_STAGE(PG8_SA(1, 0), cA + kstep, oC[0]); } else { PG8_STAGE1(PG8_SA(1, 0), cA + kstep, voffA[0], pstepA); }
    PG8_STAGE1(PG8_SB(1, 1), cB + hstepB + kstep, voffB[0], pstepB);
    PG8_WAIT_V(6); PG8_BAR;
    for (;;) {
        const bool has_next = S.next(ui + 1, nxt);
        float hf1[8], hf2[8];
        if constexpr (Hook::ON) { int ln_; asm volatile("v_mbcnt_lo_u32_b32 %0, -1, 0\n\tv_mbcnt_hi_u32_b32 %0, -1, %0" : "=v"(ln_)); H.load(cur, wr, ln_ & 15, ln_ >> 4, hf1, hf2); }
        const char* nA = has_next ? S.abase(nxt) : cA; const char* nB = has_next ? S.bbase(nxt) : cB;
        const char* nB2 = nB; if constexpr (BSPLIT) nB2 = has_next ? S.bbase2(nxt) - (size_t)ksp * kstep : cB2;
        if constexpr (GATHER) {
#pragma unroll
            for (int h = 0; h < 2; ++h)
#pragma unroll
                for (int i = 0; i < 2; ++i) oN[h][i] = has_next ? (unsigned)S.rowtok(nxt, h * HALF + RA[i]) * (unsigned)(K * 2) + (unsigned)(CA[i] * 2) : oC[h][i];
        }
        for (int t = 0; t < nt; t += 2) {
            if constexpr (Hook::ON) { if (t == 8 || t == 12) {
#pragma unroll
                for (int a = 0; a < 2; ++a)
#pragma unroll
                    for (int m = 0; m < 4; ++m) { const float f = t == 8 ? hf1[a * 4 + m] : hf2[a * 4 + m];
#pragma unroll
                        for (int b = 0; b < 2; ++b)
#pragma unroll
                            for (int n = 0; n < 2; ++n) acc[a][b][m][n] *= f; } } }
            const bool last = (t == nt - 2);
            const char* a1 = cA + (size_t)(t + 1) * kstep;
            const char* a2 = last ? nA : cA + (size_t)(t + 2) * kstep; const char* b2 = last ? nB : ((t + 2 < ksp) ? cB : cB2) + (size_t)(t + 2) * kstep;
            const char* a3 = a2 + kstep; const char* b3 = b2 + kstep;
            unsigned s0[2], s1[2];
            if constexpr (GATHER) { s0[0] = last ? oN[0][0] : oC[0][0]; s0[1] = last ? oN[0][1] : oC[0][1]; s1[0] = last ? oN[1][0] : oC[1][0]; s1[1] = last ? oN[1][1] : oC[1][1]; }
            PG8_LDB(B0, 0, 0); PG8_LDB(B1, 0, 1); PG8_SCHED; PG8_LDA(At, 0, 0);
            if constexpr (GATHER) { PG8_STAGE(PG8_SA(1, 1), a1, oC[1]); } else { PG8_STAGE1(PG8_SA(1, 1), a1 + hstepA, voffA[0], pstepA); }
            PG8_WAIT_V(8); PG8_WAIT_L(0); PG8_BAR; PG8_MMA(0, 0, At, B0); PG8_MMA(0, 1, At, B1); PG8_BAR; PG8_SCHED;
            PG8_LDA(At, 0, 1); PG8_STAGE1(PG8_SB(0, 0), b2, voffB[0], pstepB); PG8_STAGE1(PG8_SB(0, 1), b2 + hstepB, voffB[0], pstepB);
            if constexpr (GATHER) { PG8_STAGE(PG8_SA(0, 0), a2, s0); } else { PG8_STAGE1(PG8_SA(0, 0), a2, voffA[0], pstepA); }
            PG8_WAIT_V(8); PG8_WAIT_L(0); PG8_BAR; PG8_MMA(1, 0, At, B0); PG8_MMA(1, 1, At, B1); PG8_BAR; PG8_SCHED;
            PG8_LDB(B0, 1, 0); PG8_LDB(B1, 1, 1); PG8_SCHED; PG8_LDA(At, 1, 0);
            if constexpr (GATHER) { PG8_STAGE(PG8_SA(0, 1), a2, s1); } else { PG8_STAGE1(PG8_SA(0, 1), a2 + hstepA, voffA[0], pstepA); }
            PG8_WAIT_V(8); PG8_WAIT_L(0); PG8_BAR; PG8_MMA(0, 0, At, B0); PG8_MMA(0, 1, At, B1); PG8_BAR; PG8_SCHED;
            PG8_LDA(At, 1, 1); PG8_STAGE1(PG8_SB(1, 0), b3, voffB[0], pstepB); PG8_STAGE1(PG8_SB(1, 1), b3 + hstepB, voffB[0], pstepB);
            if constexpr (GATHER) { PG8_STAGE(PG8_SA(1, 0), a3, s0); } else { PG8_STAGE1(PG8_SA(1, 0), a3, voffA[0], pstepA); }
            PG8_WAIT_V(8); PG8_WAIT_L(0); PG8_BAR; PG8_MMA(1, 0, At, B0); PG8_MMA(1, 1, At, B1); PG8_BAR; PG8_SCHED;
        }
        if constexpr (ALIGN_EPI) { if (wr == 0) PG8_BAR; }
        { int ln_; asm volatile("v_mbcnt_lo_u32_b32 %0, -1, 0\n\tv_mbcnt_hi_u32_b32 %0, -1, %0" : "=v"(ln_)); E(acc, cur, wr, wc, ln_ & 15, ln_ >> 4); }
        if (!has_next) break;
#pragma unroll
        for (int a = 0; a < 2; ++a)
#pragma unroll
            for (int b = 0; b < 2; ++b)
#pragma unroll
                for (int m = 0; m < 4; ++m)
#pragma unroll
                    for (int n = 0; n < 2; ++n) acc[a][b][m][n] = (f32x4){0.f, 0.f, 0.f, 0.f};
        cur = nxt; cA = nA; cB = nB; cB2 = nB2; ++ui;
        if constexpr (GATHER) {
#pragma unroll
            for (int h = 0; h < 2; ++h)
#pragma unroll
                for (int i = 0; i < 2; ++i) oC[h][i] = oN[h][i];
        }
        if constexpr (ALIGN_EPI) { if (wr == 1) PG8_BAR; }
    }
    PG8_WAIT_V(0);
    if constexpr (!ALIGN_EPI) { if (wr == 0) PG8_BAR; }
    PG8_BAR;
#undef PG8_SA
#undef PG8_SB
#undef PG8_STAGE
#undef PG8_STAGE1
#undef PG8_LDA
#undef PG8_LDB
#undef PG8_MMA
#undef PG8_WAIT_V
#undef PG8_WAIT_L
#undef PG8_BAR
#undef PG8_SCHED
}
}
using pg8::Unit;

struct DenseOrder {
    const char* A; const char* Bt; size_t tstepA, tstepB; int nM, nN, nwg, G, c;
    __device__ __forceinline__ void init(const void* A_, const void* Bt_, int M, int N, int K, int ldb, int G_, int c_) {
        A = (const char*)A_; Bt = (const char*)Bt_; tstepA = (size_t)256 * K * 2; tstepB = (size_t)256 * ldb * 2; nM = M / 256; nN = N / 256; nwg = nM * nN; G = G_; c = c_; }
    __device__ __forceinline__ bool next(int i, Unit& u) const {
        const long L = (long)i * G + c; if (L >= nwg) return false;
        int wgid = (int)L; { const int q = nwg / 8, r = nwg % 8, xcd = wgid % 8, off = wgid / 8; wgid = (xcd < r ? xcd * (q + 1) : r * (q + 1) + (xcd - r) * q) + off; }
        const int nig = 8 * nN, gid = wgid / nig, fm = gid * 8, gsz = (nM - fm) < 8 ? (nM - fm) : 8;
        u.pm = fm + ((wgid % nig) % gsz); u.pn = (wgid % nig) / gsz; u.cls = 0; u.p0 = 0; return true;
    }
    __device__ __forceinline__ const char* abase(const Unit& u) const { return A + (size_t)u.pm * tstepA; }
    __device__ __forceinline__ const char* bbase(const Unit& u) const { return Bt + (size_t)u.pn * tstepB; }
    __device__ __forceinline__ const char* bbase2(const Unit& u) const { return bbase(u); }
    __device__ __forceinline__ int rowtok(const Unit&, int) const { return 0; }
};

__device__ __forceinline__ void cls_experts(int cls, int& eA, int& eB) { const int g = cls / 6, p = cls % 6; const int a = (p >= 3) + (p >= 5), b = p < 3 ? p + 1 : (p < 5 ? p - 1 : 3); eA = 4 * g + a; eB = 4 * g + b; }
struct ExpertOrder {
    const LAS int* tb; const LAS int* cn; const int* list; const char* A; const char* W; int G, c, mode, layer;
    __device__ __forceinline__ bool next(int i, Unit& u) const {
        const int nwg = __builtin_amdgcn_readfirstlane(tb[NCLS]) * 4; const long L = (long)i * G + c; if (L >= nwg) return false;
        int wgid = (int)L; { const int q = nwg / 8, r = nwg % 8, xcd = wgid % 8, off = wgid / 8; wgid = (xcd < r ? xcd * (q + 1) : r * (q + 1) + (xcd - r) * q) + off; }
        const int rt = wgid >> 2; int cls = 0;
        for (int k = 1; k < NCLS; ++k) cls += (rt >= tb[k]) ? 1 : 0;
        cls = __builtin_amdgcn_readfirstlane(cls);
        u.pm = rt; u.pn = wgid & 3; u.cls = cls; u.p0 = __builtin_amdgcn_readfirstlane((rt - tb[cls]) * 256); return true;
    }
    __device__ __forceinline__ const char* abase(const Unit& u) const { return mode == 1 ? A : A + (size_t)u.pm * (256 * 512 * 2); }
    __device__ __forceinline__ const char* bbase(const Unit& u) const {
        if (mode == 1) { int eA, eB; cls_experts(u.cls, eA, eB); const int e = (u.pn >> 1) ? eB : eA; return W + ((size_t)(layer * 16 + e) * 512 + (size_t)(u.pn & 1) * 256) * (1024 * 2); }
        int eA, eB; cls_experts(u.cls, eA, eB); return W + ((size_t)(layer * 16 + eA) * 1024 + (size_t)u.pn * 256) * (256 * 2);
    }
    __device__ __forceinline__ const char* bbase2(const Unit& u) const { int eA, eB; cls_experts(u.cls, eA, eB); return W + ((size_t)(layer * 16 + eB) * 1024 + (size_t)u.pn * 256) * (256 * 2); }
    __device__ __forceinline__ int rowtok(const Unit& u, int rr) const { const int pos = u.p0 + rr; return pos < cn[u.cls] ? list[(size_t)u.cls * NTOK + pos] : DUMMY_ROW; }
};

__device__ __forceinline__ float row_rstd16(const float* ssq, int row, int fq, float inv_n) {
    const f32x4 v = *(const f32x4*)(ssq + (size_t)row * 16 + 4 * fq);
    float s = (v.x + v.y) + (v.z + v.w);
    s = xadd32(xadd16(s));
    return rsqrtf(s * inv_n + EPS);
}

struct HookNorm { static constexpr bool ON = true; const float* ssqa; const float* ssqs;
    __device__ __forceinline__ void load(const Unit& u, int wr, int fr, int fq, float (&f1)[8], float (&f2)[8]) const {
#pragma unroll
        for (int ai = 0; ai < 2; ++ai)
#pragma unroll
            for (int m = 0; m < 4; ++m) { const int row = u.pm * 256 + ai * 128 + wr * 64 + m * 16 + fr;
                const f32x2 a = *(const f32x2*)(ssqa + (size_t)row * 8 + 2 * fq); const f32x4 b = *(const f32x4*)(ssqs + (size_t)row * 16 + 4 * fq);
                const float sa = xadd32(xadd16(a.x + a.y)), ss = xadd32(xadd16((b.x + b.y) + (b.z + b.w)));
                const float ra = rsqrtf(sa * (1.f / 512.f) + EPS), vs = ss * (1.f / 256.f) + EPS;
                f1[ai * 4 + m] = ra * sqrtf(vs); f2[ai * 4 + m] = rsqrtf(vs); }
    }
};
struct EpiProj {
    bf16_t* proj; float* flog; const float* ssq1; const float* fb;
    __device__ __forceinline__ void operator()(const f32x4 (&acc)[2][2][4][2], const Unit& u, int wr, int wc, int fr, int fq) const {
#pragma unroll
        for (int ai = 0; ai < 2; ++ai)
#pragma unroll
            for (int m = 0; m < 4; ++m) {
                const int row = u.pm * 256 + ai * 128 + wr * 64 + m * 16 + fr;
                const float rs = row_rstd16(ssq1, row, fq, 1.f / DM);
                if (u.pn < 9) {
#pragma unroll
                    for (int bj = 0; bj < 2; ++bj) { const f32x4 v0 = acc[ai][bj][m][0] * rs, v1 = acc[ai][bj][m][1] * rs; u32x4 w;
                        w.x = cvt_pk_bf16(v0[0], v0[1]); w.y = cvt_pk_bf16(v0[2], v0[3]); w.z = cvt_pk_bf16(v1[0], v1[1]); w.w = cvt_pk_bf16(v1[2], v1[3]);
                        *(u32x4*)(proj + (size_t)row * PJ + u.pn * 256 + bj * 128 + wc * 32 + 8 * fq) = w; }
                } else if (wc == 0 && fq == 0) {
                    f32x4 o0, o1;
#pragma unroll
                    for (int e = 0; e < 4; ++e) { const float f0 = acc[ai][0][m][0][e] * rs + fb[e], f1 = acc[ai][0][m][1][e] * rs + fb[4 + e];
                        o0[e] = -log2f(1.f + exp2f(-f0 * LOG2E)); o1[e] = -log2f(1.f + exp2f(-f1 * LOG2E)); }
                    *(f32x4*)(flog + (size_t)row * 8) = o0; *(f32x4*)(flog + (size_t)row * 8 + 4) = o1;
                }
            }
    }
};
template <bool TOKMAP> struct EpiRes {
    bf16_t* h; float* ssq; const LAS int* cn; const int* list;
    __device__ __forceinline__ void operator()(const f32x4 (&acc)[2][2][4][2], const Unit& u, int wr, int wc, int fr, int fq) const {
#pragma unroll
        for (int ai = 0; ai < 2; ++ai)
#pragma unroll
            for (int m = 0; m < 4; ++m) {
                const int rr = ai * 128 + wr * 64 + m * 16 + fr; int row;
                if constexpr (TOKMAP) { const int pos = u.p0 + rr; row = pos < cn[u.cls] ? list[(size_t)u.cls * NTOK + pos] : DUMMY_ROW; } else row = u.pm * 256 + rr;
                float sq = 0.f;
#pragma unroll
                for (int bj = 0; bj < 2; ++bj) { bf16_t* p = h + (size_t)row * DM + u.pn * 256 + bj * 128 + wc * 32 + 8 * fq; const u32x4 o = *(const u32x4*)p;
                    const f32x4 a0 = acc[ai][bj][m][0], a1 = acc[ai][bj][m][1]; u32x4 w;
                    w.x = cvt_pk_bf16(bflo(o.x) + a0[0], bfhi(o.x) + a0[1]); w.y = cvt_pk_bf16(bflo(o.y) + a0[2], bfhi(o.y) + a0[3]);
                    w.z = cvt_pk_bf16(bflo(o.z) + a1[0], bfhi(o.z) + a1[1]); w.w = cvt_pk_bf16(bflo(o.w) + a1[2], bfhi(o.w) + a1[3]);
                    *(u32x4*)p = w;
                    sq += bflo(w.x) * bflo(w.x) + bfhi(w.x) * bfhi(w.x) + bflo(w.y) * bflo(w.y) + bfhi(w.y) * bfhi(w.y) + bflo(w.z) * bflo(w.z) + bfhi(w.z) * bfhi(w.z) + bflo(w.w) * bflo(w.w) + bfhi(w.w) * bfhi(w.w); }
                sq = xadd32(xadd16(sq));
                if (fq == 0) ssq[(size_t)row * 16 + u.pn * 4 + wc] = sq;
            }
    }
};
struct EpiE1 {
    bf16_t* H1; const float* tinfo; const LAS int* cn; const int* list;
    __device__ __forceinline__ void operator()(const f32x4 (&acc)[2][2][4][2], const Unit& u, int wr, int wc, int fr, int fq) const {
#pragma unroll
        for (int ai = 0; ai < 2; ++ai)
#pragma unroll
            for (int m = 0; m < 4; ++m) {
                const int rr = ai * 128 + wr * 64 + m * 16 + fr; const int pos = u.p0 + rr;
                const int tok = pos < cn[u.cls] ? list[(size_t)u.cls * NTOK + pos] : DUMMY_ROW;
                const f32x4 ti = *(const f32x4*)(tinfo + (size_t)tok * 4);
                const float rs = ti.x, gate = (u.pn >> 1) ? ti.z : ti.y;
                float o[8];
#pragma unroll
                for (int n = 0; n < 2; ++n)
#pragma unroll
                    for (int e = 0; e < 4; ++e) { const float a = acc[ai][0][m][n][e] * rs, b = acc[ai][1][m][n][e] * rs; o[n * 4 + e] = gate * siluf_(a) * b; }
                u32x4 w; w.x = cvt_pk_bf16(o[0], o[1]); w.y = cvt_pk_bf16(o[2], o[3]); w.z = cvt_pk_bf16(o[4], o[5]); w.w = cvt_pk_bf16(o[6], o[7]);
                *(u32x4*)(H1 + (size_t)(u.pm * 256 + rr) * 512 + (u.pn >> 1) * 256 + (u.pn & 1) * 128 + wc * 32 + 8 * fq) = w;
            }
    }
};

template <bool SEGNORM>
__device__ __forceinline__ f32x2 meta_gemm64(LAS unsigned char* lds, const int tid, const bf16_t* A, const bf16_t* Bt, int K, int n0, const float* ssqa, const float* ssqs) {
    const int lane = tid & 63, m = lane & 15, q4 = lane >> 4; const int w = __builtin_amdgcn_readfirstlane(tid >> 6);
    const int kr = K >> 3;
    const bf16_t* ap = A + (size_t)m * K + w * kr + 8 * q4; const bf16_t* bp = Bt + (size_t)(n0 + m) * K + w * kr + 8 * q4;
    bf16x8 av[4], bv[4][4];
#pragma unroll
    for (int ks = 0; ks < 4; ++ks) { av[ks] = *(const bf16x8*)(ap + 32 * ks);
#pragma unroll
        for (int j = 0; j < 4; ++j) bv[ks][j] = *(const bf16x8*)(bp + (size_t)16 * j * K + 32 * ks); }
    f32x4 acc[4];
#pragma unroll
    for (int j = 0; j < 4; ++j) acc[j] = (f32x4){0.f, 0.f, 0.f, 0.f};
#pragma unroll
    for (int ks = 0; ks < 4; ++ks)
#pragma unroll
        for (int j = 0; j < 4; ++j) acc[j] = __builtin_amdgcn_mfma_f32_16x16x32_bf16(bv[ks][j], av[ks], acc[j], 0, 0, 0);
    if constexpr (SEGNORM) {
        const int row = NREAL + m; float sc = 1.f;
        if (w < 4) { float sa = 0.f;
#pragma unroll
            for (int q = 0; q < 8; ++q) sa += ssqa[(size_t)row * 8 + q]; sc = rsqrtf(sa * (1.f / 512.f) + EPS); }
        else if (w < 6) { float ss = 0.f;
#pragma unroll
            for (int q = 0; q < 16; ++q) ss += ssqs[(size_t)row * 16 + q]; sc = rsqrtf(ss * (1.f / 256.f) + EPS); }
#pragma unroll
        for (int j = 0; j < 4; ++j) acc[j] *= sc;
    }
    LAS float* part = (LAS float*)lds;
#pragma unroll
    for (int j = 0; j < 4; ++j) *(LAS f32x4*)(part + (w * 16 + m) * 64 + 16 * j + 4 * q4) = acc[j];
    __syncthreads();
    const int mm = tid >> 5, cp = tid & 31; f32x2 r = {0.f, 0.f};
#pragma unroll
    for (int ww = 0; ww < 8; ++ww) r += *(const LAS f32x2*)(part + (ww * 16 + mm) * 64 + 2 * cp);
    __syncthreads();
    return r;
}
__device__ __forceinline__ float row_rstd_all(const float* ssq, int row, float inv_n) {
    float s = 0.f;
#pragma unroll
    for (int q = 0; q < 4; ++q) { const f32x4 v = *(const f32x4*)(ssq + (size_t)row * 16 + 4 * q); s += (v.x + v.y) + (v.z + v.w); }
    return rsqrtf(s * inv_n + EPS);
}

#define XB_TMO      128
#define XB_XCNT(j)  (256  + 64 * (j))
#define XB_XSUB(j)  (1280 + 64 * (j))
#define XB_XGEN(j)  (2304 + 64 * (j))
#define XB_TOP      3328
#define XB_TOPGEN   3392
#define XCD_BAR_WORDS 3456
#define XB_SPIN_CAP (1u << 18)
__device__ __forceinline__ unsigned xb_ld(unsigned* p)              { return __hip_atomic_load(p, __ATOMIC_RELAXED, __HIP_MEMORY_SCOPE_AGENT); }
__device__ __forceinline__ unsigned xb_add(unsigned* p, unsigned v) { return __hip_atomic_fetch_add(p, v, __ATOMIC_RELAXED, __HIP_MEMORY_SCOPE_AGENT); }
__device__ __forceinline__ unsigned xb_xcc_id() { return (unsigned)__builtin_amdgcn_s_getreg((3 << 11) | 20) & 0xFu; }
#define XB_SPIN(cond, bar) do { unsigned _sp = 0; while (cond) { __builtin_amdgcn_s_sleep(1); \
    if ((++_sp & 255u) == 0u) { if (xb_ld(&(bar)[XB_TMO])) break; if (_sp > XB_SPIN_CAP) { atomicAdd(&(bar)[XB_TMO], 1u); break; } } } } while (0)
struct XcdBarrier { unsigned* bar; unsigned x; volatile LAS unsigned* st; };
__device__ __forceinline__ XcdBarrier xcd_barrier_post(unsigned* bar, volatile LAS unsigned* st) {
    XcdBarrier b; b.bar = bar; b.x = xb_xcc_id(); b.st = st;
    if (threadIdx.x == 0) (void)xb_add(&bar[XB_XCNT(b.x)], 1u);
    return b;
}
__device__ __forceinline__ void xcd_barrier_complete(unsigned* bar, unsigned x, unsigned& nloc, unsigned& nx) {
    const unsigned G = gridDim.x * gridDim.y * gridDim.z;
    unsigned sum, cnt, mine, sp = 0u;
    for (;;) {
        sum = 0u; cnt = 0u; mine = 0u;
#pragma unroll
        for (unsigned j = 0; j < 16; ++j) { const unsigned c = xb_ld(&bar[XB_XCNT(j)]); sum += c; cnt += (c > 0u) ? 1u : 0u; mine = (j == x) ? c : mine; }
        if (sum == G) break;
        __builtin_amdgcn_s_sleep(1);
        if ((++sp & 255u) == 0u) { if (xb_ld(&bar[XB_TMO])) break; if (sp > XB_SPIN_CAP) { atomicAdd(&bar[XB_TMO], 1u); break; } }
    }
    nloc = mine > 0u ? mine : 1u; nx = cnt > 0u ? cnt : 1u;
}
__device__ __forceinline__ void xcd_barrier(const XcdBarrier& b, const bool leader_thread) {
    asm volatile("s_waitcnt vmcnt(0)" ::: "memory");
    __syncthreads();
    if (leader_thread) {
        unsigned long long bz_ = 0; asm volatile("" : "+s"(bz_)); unsigned* bar = b.bar + bz_;
        __builtin_amdgcn_s_waitcnt(0);
        unsigned nloc = b.st[0], nx = b.st[1];
        if (nloc == 0u) { xcd_barrier_complete(bar, b.x, nloc, nx); b.st[0] = nloc; b.st[1] = nx; }
        const unsigned old = xb_add(&bar[XB_XSUB(b.x)], 1u);
        const unsigned gen = old / nloc;
        if (old + 1u == (gen + 1u) * nloc) {
            __builtin_amdgcn_fence(__ATOMIC_RELEASE, "agent");
            asm volatile("s_waitcnt vmcnt(0)" ::: "memory");
            const unsigned og = xb_add(&bar[XB_TOP], 1u);
            const unsigned tg = og / nx;
            if (og + 1u == (tg + 1u) * nx) xb_add(&bar[XB_TOPGEN], 1u);
            else XB_SPIN(xb_ld(&bar[XB_TOPGEN]) == tg, bar);
            __builtin_amdgcn_fence(__ATOMIC_ACQUIRE, "agent");
            xb_add(&bar[XB_XGEN(b.x)], 1u);
            asm volatile("s_waitcnt vmcnt(0)" ::: "memory");
        } else {
            XB_SPIN(xb_ld(&bar[XB_XGEN(b.x)]) == gen, bar);
            __builtin_amdgcn_fence(__ATOMIC_ACQUIRE, "agent");
            asm volatile("s_waitcnt vmcnt(0)" ::: "memory");
        }
    }
    __syncthreads();
}

template <class Get>
__device__ __forceinline__ void tr_item(const Get& get, bf16_t* dst, int dpitch, int k0, int n0, LAS float* scr, int lane) {
    float tv[32];
#pragma unroll
    for (int i = 0; i < 32; ++i) tv[i] = get(k0 + 2 * i + (lane >> 5), n0 + (lane & 31));
#pragma unroll
    for (int i = 0; i < 32; ++i) scr[(2 * i + (lane >> 5)) * 33 + (lane & 31)] = tv[i];
    LDS_WAIT(); asm volatile("" ::: "memory");
    const int c = lane & 7;
#pragma unroll
    for (int j = 0; j < 4; ++j) { const int n = (lane >> 3) + 8 * j; const LAS float* s = scr + (8 * c) * 33 + n;
        u32x4 o; o.x = pk2(s[0 * 33], s[1 * 33]); o.y = pk2(s[2 * 33], s[3 * 33]); o.z = pk2(s[4 * 33], s[5 * 33]); o.w = pk2(s[6 * 33], s[7 * 33]);
        *(u32x4*)(dst + (size_t)(n0 + n) * dpitch + k0 + 8 * c) = o; }
    LDS_WAIT(); asm volatile("" ::: "memory");
}
struct GetWin { const float* w; const float* g;
    __device__ __forceinline__ float operator()(int k, int n) const { int src; if (n < 2048) src = n; else if (n < 2304) src = n + 8; else if (n < 2312) src = n - 256; else return 0.f;
        float v = w[(size_t)k * DINSRC + src] * g[k]; if (n >= PQ && n < PK) v *= 0.125f * LOG2E; return v; } };
struct GetWout { const float* w; const float* ga; const float* gs;
    __device__ __forceinline__ float operator()(int k, int n) const { const int src = k < 768 ? k + 256 : k - 768; const float gn = k < 512 ? ga[k] : (k < 768 ? gs[k - 512] : 1.f);
        return w[(size_t)src * DM + n] * gn; } };
struct GetW13 { const float* w1; const float* w3; const float* g;
    __device__ __forceinline__ float operator()(int k, int n) const { const int u = n >> 8, hf = (n >> 7) & 1, j = n & 127; const uintptr_t wp = (uintptr_t)w1 + (uintptr_t)hf * ((uintptr_t)w3 - (uintptr_t)w1); return ((const GAS float*)wp)[(size_t)k * 256 + u * 128 + j] * g[k]; } };
struct GetW2 { const float* w;
    __device__ __forceinline__ float operator()(int k, int n) const { return w[(size_t)k * DM + n]; } };
struct GetWr { const float* rg; const float* re; const float* g; int lo;
    __device__ __forceinline__ float operator()(int k, int n) const { float v = 0.f; if (n < 4) v = rg[(size_t)k * 4 + n]; else if (n < 20) v = re[(size_t)k * 16 + (n - 4)]; v *= g[k];
        if (lo) v = v - __uint_as_float(f2bf(v) << 16); return v; } };

constexpr int AT_SLOT = 16384, AT_CS = 81920, AT_WT = AT_CS + 4608 * 4;
__device__ __forceinline__ int crow(int r, int hi) { return (r & 3) + 8 * (r >> 2) + 4 * hi; }
__device__ __forceinline__ void attn_prefix(LAS unsigned char* lds, const int tid, const float* flog, int b, int h) {
    const int lane = tid & 63; const int w = __builtin_amdgcn_readfirstlane(tid >> 6);
    LAS float* cs = (LAS float*)(lds + AT_CS); LAS float* wt = (LAS float*)(lds + AT_WT);
    float v[9]; float run = 0.f;
#pragma unroll
    for (int i = 0; i < 9; ++i) { const int j = tid * 9 + i; float x = 0.f; if (j < NMETA + SEQ) x = flog[(size_t)rowof(b, j) * 8 + h]; run += x; v[i] = run; }
    const float inc = wave_incl_scan(run);
    if (lane == 63) wt[w] = inc;
    __syncthreads();
    float base = inc - run;
    for (int k = 0; k < w; ++k) base += wt[k];
#pragma unroll
    for (int i = 0; i < 9; ++i) cs[tid * 9 + i] = base + v[i];
    __syncthreads();
}
__device__ __forceinline__ void at_glds16(const void* gsrc, unsigned lds_dst) { unsigned keep;
    asm volatile("s_mov_b32 %0, m0\n\ts_mov_b32 m0, %2\n\ts_nop 0\n\tglobal_load_lds_dwordx4 %1, off\n\ts_mov_b32 m0, %0" : "=&s"(keep) : "v"(gsrc), "s"(lds_dst) : "memory"); }
constexpr float AT_THR = 8.f;
__device__ __forceinline__ void attn_unit(LAS unsigned char* lds, const int tid, const bf16_t* proj, bf16_t* mixed, float* ssqa, int b, int h, int qt) {
    const int lane = tid & 63, r32 = lane & 31, hi = lane >> 5; const int w = __builtin_amdgcn_readfirstlane(tid >> 6);
    const LAS float* cs = (const LAS float*)(lds + AT_CS);
    const int qrel = 32 * w + r32;
    const int qrow = qt >= 0 ? b * SEQ + 256 * qt + qrel : NREAL + (qrel & 15);
    const int qkey = qt >= 0 ? NMETA + 256 * qt + qrel : (qrel & 15);
    const int qkey_w0 = qt >= 0 ? NMETA + 256 * qt + 32 * w : 0;
    const float cq = cs[qkey];
    bf16x8 qr[4];
#pragma unroll
    for (int d0 = 0; d0 < 4; ++d0) qr[d0] = *(const bf16x8*)(proj + (size_t)qrow * PJ + PQ + h * 64 + d0 * 16 + hi * 8);
    const int ntiles = qt >= 0 ? 1 + 4 * (qt + 1) : 1;
    const int wnt = qt >= 0 ? 4 * qt + (w >> 1) + 2 : 1;
    const int vr = 16 * (w & 3) + (lane >> 2);
    const unsigned ldsb = (unsigned)(uintptr_t)lds;
#define AT_DMA(jj) do { int kr_, vr_; if ((jj) == 0) { kr_ = NREAL + (lane < 15 ? lane : 15); vr_ = NREAL + (vr < 15 ? vr : 15); } else { kr_ = b * SEQ + 64 * ((jj) - 1) + lane; vr_ = b * SEQ + 64 * ((jj) - 1) + vr; } \
        const int so_ = AT_SLOTOF(sj, (jj) - jbase) + w * 1024; \
        at_glds16(proj + (size_t)kr_ * PJ + PK + h * 64 + w * 8, (unsigned)__builtin_amdgcn_readfirstlane(ldsb + so_)); \
        at_glds16(proj + (size_t)vr_ * PJ + PV + h * 64 + (w >> 2) * 32 + (lane & 3) * 8, (unsigned)__builtin_amdgcn_readfirstlane(ldsb + so_ + 8192)); } while (0)
#define AT_WAITBAR(n) asm volatile("s_waitcnt vmcnt(" #n ") lgkmcnt(0)\n\ts_barrier" ::: "memory")
    float mref = 0.f, lrun = 0.f; f32x16 o0 = {}, o1 = {};
    const int kfo = hi * 1024 + r32 * 16;
    const int vb = 8192 + ((lane >> 4) & 1) * 32 + (lane & 3) * 8 + (4 * hi + ((lane & 15) >> 2)) * 64;
    const LAS float* csl = cs + 4 * hi;
    bf16x8 kf[8];
#define AT_KLOAD(P0, P1, jjn) do { const int kb_ = (jjn) == 0 ? 0 : NMETA + 64 * ((jjn) - 1); const float cqm = cq - mref; const int so_ = AT_SLOTOF(sj, (jjn) - jbase); \
        _Pragma("unroll") for (int d0 = 0; d0 < 4; ++d0) { kf[2 * d0] = *(const LAS bf16x8*)(lds + so_ + kfo + d0 * 2048); kf[2 * d0 + 1] = *(const LAS bf16x8*)(lds + so_ + kfo + d0 * 2048 + 512); } \
        _Pragma("unroll") for (int g_ = 0; g_ < 4; ++g_) { const f32x4 c0_ = *(const LAS f32x4*)(csl + kb_ + 8 * g_), c1_ = *(const LAS f32x4*)(csl + kb_ + 32 + 8 * g_); \
            _Pragma("unroll") for (int e_ = 0; e_ < 4; ++e_) { P0[4 * g_ + e_] = cqm - c0_[e_]; P1[4 * g_ + e_] = cqm - c1_[e_]; } } \
        __builtin_amdgcn_sched_barrier(0); } while (0)
#define AT_QKM(P0, P1) do { _Pragma("unroll") for (int d0 = 0; d0 < 4; ++d0) { \
            P0 = __builtin_amdgcn_mfma_f32_32x32x16_bf16(kf[2 * d0], qr[d0], P0, 0, 0, 0); P1 = __builtin_amdgcn_mfma_f32_32x32x16_bf16(kf[2 * d0 + 1], qr[d0], P1, 0, 0, 0); } \
        __builtin_amdgcn_sched_barrier(0); } while (0)
#define AT_MX3(a, b, c) __builtin_fmaxf(__builtin_fmaxf((a), (b)), (c))
#define AT_SMPV(P0, P1, N0, N1, jj, pend) do { const int kb_ = (jj) == 0 ? 0 : NMETA + 64 * ((jj) - 1); \
        const LAS unsigned char* Vb_ = lds + AT_SLOTOF(sj, (jj) - jbase) + vb; s16x4 va_[8], vc_[8]; \
        _Pragma("unroll") for (int ks = 0; ks < 4; ++ks) { \
            va_[2 * ks] = __builtin_bit_cast(s16x4, __builtin_amdgcn_ds_read_tr16_b64_v4i16((LAS s16x4*)(Vb_ + ks * 1024))); \
            va_[2 * ks + 1] = __builtin_bit_cast(s16x4, __builtin_amdgcn_ds_read_tr16_b64_v4i16((LAS s16x4*)(Vb_ + ks * 1024 + 512))); } \
        __builtin_amdgcn_sched_barrier(0); \
        if ((jj) == 0 || kb_ + 63 > qkey_w0) { const int lim_ = (jj) == 0 ? (qkey < 15 ? qkey : 15) : qkey; \
            _Pragma("unroll") for (int r = 0; r < 16; ++r) { const int j_ = kb_ + crow(r, hi); if (j_ > lim_) P0[r] = -INFINITY; if (j_ + 32 > lim_) P1[r] = -INFINITY; } } \
        float ra_ = AT_MX3(P0[0], P0[1], P1[0]), rb_ = AT_MX3(P0[2], P0[3], P1[1]); ra_ = AT_MX3(ra_, P1[2], P1[3]); \
        _Pragma("unroll") for (int r = 4; r < 16; r += 4) { ra_ = AT_MX3(ra_, P0[r], P0[r + 1]); rb_ = AT_MX3(rb_, P0[r + 2], P0[r + 3]); ra_ = AT_MX3(ra_, P1[r], P1[r + 1]); rb_ = AT_MX3(rb_, P1[r + 2], P1[r + 3]); } \
        float rm_ = fmaxf(ra_, rb_); \
        rm_ = xmax32(rm_); \
        if ((jj) == 0 || __any(rm_ > AT_THR)) { const float dl_ = (jj) == 0 ? rm_ : fmaxf(rm_, 0.f); mref += dl_; const float f_ = (jj) == 0 ? 1.f : fast_exp2(-dl_); lrun *= f_; \
            _Pragma("unroll") for (int r = 0; r < 16; ++r) { P0[r] -= dl_; P1[r] -= dl_; o0[r] *= f_; o1[r] *= f_; } \
            if (pend) { _Pragma("unroll") for (int r = 0; r < 16; ++r) { N0[r] -= dl_; N1[r] -= dl_; } } } \
        float rs_ = 0.f; \
        _Pragma("unroll") for (int r = 0; r < 16; ++r) { P0[r] = fast_exp2(P0[r]); P1[r] = fast_exp2(P1[r]); rs_ += P0[r] + P1[r]; } \
        lrun += rs_; \
        u32x4 pw_[4]; \
        _Pragma("unroll") for (int i = 0; i < 4; ++i) { pw_[0][i] = cvt_pk_bf16(P0[2 * i], P0[2 * i + 1]); pw_[1][i] = cvt_pk_bf16(P0[8 + 2 * i], P0[8 + 2 * i + 1]); \
            pw_[2][i] = cvt_pk_bf16(P1[2 * i], P1[2 * i + 1]); pw_[3][i] = cvt_pk_bf16(P1[8 + 2 * i], P1[8 + 2 * i + 1]); } \
        __builtin_amdgcn_sched_barrier(0); \
        _Pragma("unroll") for (int ks = 0; ks < 4; ++ks) { \
            vc_[2 * ks] = __builtin_bit_cast(s16x4, __builtin_amdgcn_ds_read_tr16_b64_v4i16((LAS s16x4*)(Vb_ + 4096 + ks * 1024))); \
            vc_[2 * ks + 1] = __builtin_bit_cast(s16x4, __builtin_amdgcn_ds_read_tr16_b64_v4i16((LAS s16x4*)(Vb_ + 4096 + ks * 1024 + 512))); } \
        _Pragma("unroll") for (int ks = 0; ks < 4; ++ks) { \
            const bf16x8 va = {va_[2 * ks][0], va_[2 * ks][1], va_[2 * ks][2], va_[2 * ks][3], va_[2 * ks + 1][0], va_[2 * ks + 1][1], va_[2 * ks + 1][2], va_[2 * ks + 1][3]}; \
            o0 = __builtin_amdgcn_mfma_f32_32x32x16_bf16(va, __builtin_bit_cast(bf16x8, pw_[ks]), o0, 0, 0, 0); } \
        __builtin_amdgcn_sched_barrier(0); \
        _Pragma("unroll") for (int ks = 0; ks < 4; ++ks) { \
            const bf16x8 vbb = {vc_[2 * ks][0], vc_[2 * ks][1], vc_[2 * ks][2], vc_[2 * ks][3], vc_[2 * ks + 1][0], vc_[2 * ks + 1][1], vc_[2 * ks + 1][2], vc_[2 * ks + 1][3]}; \
            o1 = __builtin_amdgcn_mfma_f32_32x32x16_bf16(vbb, __builtin_bit_cast(bf16x8, pw_[ks]), o1, 0, 0, 0); } \
        __builtin_amdgcn_sched_barrier(0); } while (0)
#define AT_STEP(C0, C1, N0, N1, jj) do { \
        const bool dma_ = (jj) + 4 < ntiles; \
        if (dma_) AT_DMA((jj) + 4); \
        const bool pend_ = (jj) + 1 < wnt; \
        if (pend_) AT_QKM(N0, N1); \
        if ((jj) < wnt) AT_SMPV(C0, C1, N0, N1, jj, pend_); \
        if ((jj) + 2 < wnt) AT_KLOAD(C0, C1, (jj) + 2); \
        if (dma_) AT_WAITBAR(2); else AT_WAITBAR(0); } while (0)
    int sj = 0, jbase = 0;
#define AT_SLOTOF(s_, k_) (((s_) + (k_) * AT_SLOT) >= 5 * AT_SLOT ? ((s_) + (k_) * AT_SLOT) - 5 * AT_SLOT : ((s_) + (k_) * AT_SLOT))
    AT_DMA(0);
    if (ntiles > 1) AT_DMA(1);
    if (ntiles > 2) AT_DMA(2);
    if (ntiles > 3) { AT_DMA(3); AT_WAITBAR(2); } else AT_WAITBAR(0);
    f32x16 pa0, pa1, pb0, pb1;
    AT_KLOAD(pa0, pa1, 0); AT_QKM(pa0, pa1);
    if (1 < wnt) AT_KLOAD(pb0, pb1, 1);
#pragma unroll 1
    for (int jj = 0; jj < ntiles; jj += 2) {
        jbase = jj;
        AT_STEP(pa0, pa1, pb0, pb1, jj);
        if (jj + 1 < ntiles) AT_STEP(pb0, pb1, pa0, pa1, jj + 1);
        sj = AT_SLOTOF(sj, 2);
    }
#undef AT_SLOTOF
#undef AT_KLOAD
#undef AT_QKM
#undef AT_MX3
#undef AT_DMA
#undef AT_WAITBAR
#undef AT_SMPV
#undef AT_STEP
    const float ltot = xadd32(lrun);
    const float inv = 1.f / ltot;
    float sq = 0.f;
#pragma unroll
    for (int r = 0; r < 16; ++r) { o0[r] *= inv; o1[r] *= inv; sq += o0[r] * o0[r] + o1[r] * o1[r]; }
    sq = xadd32(sq);
    const bool st = qt >= 0 || qrel < 16;
    if (st) {
        bf16_t* op = mixed + (size_t)qrow * DM + MX_ATT + h * 64;
#pragma unroll
        for (int g = 0; g < 4; ++g) { u32x2 w0, w1; w0.x = cvt_pk_bf16(o0[4 * g], o0[4 * g + 1]); w0.y = cvt_pk_bf16(o0[4 * g + 2], o0[4 * g + 3]); w1.x = cvt_pk_bf16(o1[4 * g], o1[4 * g + 1]); w1.y = cvt_pk_bf16(o1[4 * g + 2], o1[4 * g + 3]);
            *(u32x2*)(op + 8 * g + 4 * hi) = w0; *(u32x2*)(op + 32 + 8 * g + 4 * hi) = w1; }
        if (hi == 0) ssqa[(size_t)qrow * 8 + h] = sq;
    }
    __syncthreads();
}

__device__ __forceinline__ void conv_unit(LAS unsigned char* lds, const int tid, const bf16_t* proj, bf16_t* mixed, const float* cw, const float* cb, const float* lg, const float* lb, int b, int tbase, int nsub, int nvalid) {
    const int lane = tid & 63; const int w = __builtin_amdgcn_readfirstlane(tid >> 6);
    LAS float* ub = (LAS float*)lds;
    const int cp = tid & 127, rg = tid >> 7;
#pragma unroll 1
    for (int sb = 0; sb < nsub; ++sb) {
        const int t0 = tbase + 64 * sb;
        {
            u32x2 av[12], gv[12];
#pragma unroll
            for (int it = 0; it < 12; ++it) { const int idx = tid + 512 * it; const int rr = idx >> 6, cq4 = (idx & 63) * 4; const int t = t0 - 30 + rr; av[it] = (u32x2){0u, 0u}; gv[it] = (u32x2){0u, 0u};
                if (rr < 94 && t >= 0 && t < NMETA + SEQ) { const bf16_t* p = proj + (size_t)rowof(b, t) * PJ + cq4; av[it] = *(const u32x2*)p; gv[it] = *(const u32x2*)(p + 256); } }
#pragma unroll
            for (int it = 0; it < 12; ++it) { const int idx = tid + 512 * it; const int rr = idx >> 6, cq4 = (idx & 63) * 4; f32x4 u;
                u[0] = bflo(av[it].x) * sigmoidf_(bflo(gv[it].x)); u[1] = bfhi(av[it].x) * sigmoidf_(bfhi(gv[it].x)); u[2] = bflo(av[it].y) * sigmoidf_(bflo(gv[it].y)); u[3] = bfhi(av[it].y) * sigmoidf_(bfhi(gv[it].y));
                if (rr < 94) *(LAS f32x4*)(ub + rr * 256 + cq4) = u; }
        }
        f32x2 wv[31];
#pragma unroll
        for (int j = 0; j < 31; ++j) wv[j] = *(const f32x2*)(cw + j * 256 + 2 * cp);
        __syncthreads();
        f32x2 acc[16];
#pragma unroll
        for (int i = 0; i < 16; ++i) acc[i] = (f32x2){0.f, 0.f};
#pragma unroll
        for (int rr = 0; rr < 46; ++rr) { const f32x2 uv = *(const LAS f32x2*)(ub + (16 * rg + rr) * 256 + 2 * cp);
#pragma unroll
            for (int i = 0; i < 16; ++i) if (rr - i >= 0 && rr - i <= 30) acc[i] += wv[rr - i] * uv; }
        __syncthreads();
        { const f32x2 bb = *(const f32x2*)(cb + 2 * cp);
#pragma unroll
        for (int i = 0; i < 16; ++i) *(LAS f32x2*)(ub + (16 * rg + i) * 256 + 2 * cp) = acc[i] + bb; }
        const f32x4 g4 = *(const f32x4*)(lg + 4 * lane), b4 = *(const f32x4*)(lb + 4 * lane);
        __syncthreads();
#pragma unroll
        for (int i = 0; i < 8; ++i) { const int rr = 8 * w + i; const f32x4 y = *(const LAS f32x4*)(ub + rr * 256 + 4 * lane);
            const float mu = wave_sum((y[0] + y[1]) + (y[2] + y[3])) * (1.f / 256.f);
            const f32x4 d = y - mu; const float var = wave_sum((d[0] * d[0] + d[1] * d[1]) + (d[2] * d[2] + d[3] * d[3])) * (1.f / 256.f);
            const float rs = rsqrtf(var + EPS); f32x4 o;
#pragma unroll
            for (int e = 0; e < 4; ++e) o[e] = siluf_(d[e] * rs * g4[e] + b4[e]);
            if (rr < nvalid) { u32x2 wv2; wv2.x = cvt_pk_bf16(o[0], o[1]); wv2.y = cvt_pk_bf16(o[2], o[3]); *(u32x2*)(mixed + (size_t)rowof(b, t0 + rr) * DM + MX_CONV + 4 * lane) = wv2; } }
        __syncthreads();
    }
}

struct S5P { const float *lre, *lim, *ldt, *bre, *bim, *cre, *cim, *dsk, *gw, *gb; };
__device__ __forceinline__ float gelu_tanh(float x) { const float u = 0.7978845608028654f * (x + 0.044715f * x * x * x); const float e = fast_exp2(2.f * LOG2E * u); const float th = 1.f - 2.f * fast_rcp(e + 1.f); return 0.5f * x * (1.f + th); }
constexpr size_t S5T_BYTES = 163840;
constexpr int S5_KT = 0, S5_WS = 8704, S5_WC = 74240, S5_MD = 139776, S5_MC = 142848;
constexpr int S5L_KT = 0, S5L_W = 8704, S5L_EX = 78336, S5L_MD = 82944, S5L_MC = 86016, S5L_CIN = 102656;
__device__ __forceinline__ void s5_tables_block(LAS unsigned char* lds, const int tid, const S5P& P, int g, unsigned char* tbl) {
    typedef float f2 __attribute__((ext_vector_type(2)));
    LAS f2* pw = (LAS f2*)lds;
    LAS f2* Bb = (LAS f2*)(lds + 8704);
    LAS f2* Cc = (LAS f2*)(lds + 16896);
    if (tid < 64) {
        const int p = tid;
        const float dt = expf(P.ldt[g]);
        const float lr = P.lre[g * 64 + p], li = P.lim[g * 64 + p];
        const float mag = expf(lr * dt);
        const double turns = (double)li * (double)dt * 0.15915494309189535; const float fr = (float)(turns - floor(turns));
        const float ar = mag * __builtin_amdgcn_cosf(fr), ai = mag * __builtin_amdgcn_sinf(fr);
        const float nr = ar - 1.f, ni = ai, den = lr * lr + li * li;
        const float fre = (nr * lr + ni * li) / den, fim = (ni * lr - nr * li) / den;
        float xr = 1.f, xi = 0.f;
        for (int t = 0; t <= 16; ++t) { pw[t * 64 + p] = (f2){xr, xi}; const float nxr = xr * ar - xi * ai, nxi = xr * ai + xi * ar; xr = nxr; xi = nxi; }
        const f2 M = pw[16 * 64 + p];
        float* MD = (float*)(tbl + S5_MD); float* MC = (float*)(tbl + S5_MC);
        float mr = M.x, mi = M.y;
        for (int k = 0; k < 6; ++k) { MD[(k * 64 + p) * 2] = mr; MD[(k * 64 + p) * 2 + 1] = mi; const float n1 = mr * mr - mi * mi, n2 = 2.f * mr * mi; mr = n1; mi = n2; }
        xr = 1.f; xi = 0.f;
        for (int c = 0; c < 32; ++c) { MC[(c * 64 + p) * 2] = xr; MC[(c * 64 + p) * 2 + 1] = xi; const float nxr = xr * M.x - xi * M.y, nxi = xr * M.y + xi * M.x; xr = nxr; xi = nxi; }
        for (int h = 0; h < 16; ++h) { const float br = P.bre[(g * 64 + p) * 16 + h], bi = P.bim[(g * 64 + p) * 16 + h]; Bb[p * 16 + h] = (f2){fre * br - fim * bi, fre * bi + fim * br}; }
    }
    for (int e = tid; e < 1024; e += 512) Cc[e] = (f2){P.cre[g * 1024 + e], P.cim[g * 1024 + e]};
    __syncthreads();
    bf16_t* KT = (bf16_t*)(tbl + S5_KT); bf16_t* WSg = (bf16_t*)(tbl + S5_WS); bf16_t* WCg = (bf16_t*)(tbl + S5_WC);
    for (int e = tid; e < 17 * 256; e += 512) {
        const int t1 = e >> 8, h = (e >> 4) & 15, h2 = e & 15; float acc = 0.f;
        if (t1 > 0) { const int tau = t1 - 1;
            for (int p = 0; p < 64; ++p) { const f2 a = pw[tau * 64 + p], bb = Bb[p * 16 + h2], c = Cc[h * 64 + p]; const float zr = a.x * bb.x - a.y * bb.y, zi = a.x * bb.y + a.y * bb.x; acc += c.x * zr - c.y * zi; }
            if (tau == 0 && h == h2) acc += P.dsk[g * 16 + h]; }
        KT[e] = (bf16_t)f2bf(acc);
    }
    for (int e = tid; e < 128 * 256; e += 512) {
        const int r = e >> 8, ri = r >> 6, p = r & 63, q = e & 255, j = q >> 4, h2 = q & 15;
        const f2 a = pw[(15 - j) * 64 + p], bb = Bb[p * 16 + h2]; const float zr = a.x * bb.x - a.y * bb.y, zi = a.x * bb.y + a.y * bb.x;
        WSg[e] = (bf16_t)f2bf(ri ? zi : zr);
    }
    for (int e = tid; e < 256 * 128; e += 512) {
        const int row = e >> 7, i = row >> 4, h = row & 15, q = e & 127; const int blk = q >> 5, sq_ = (q >> 4) & 1, hh = (q >> 3) & 1, j = q & 7;
        const int n = 32 * blk + 16 * sq_ + 8 * (j >> 2) + 4 * hh + (j & 3); const int ri = n >> 6, p = n & 63;
        const f2 a = pw[(i + 1) * 64 + p], c = Cc[h * 64 + p]; const float zr = c.x * a.x - c.y * a.y, zi = c.x * a.y + c.y * a.x;
        WCg[e] = (bf16_t)f2bf(ri ? -zi : zr);
    }
    __syncthreads();
}

__device__ __forceinline__ void s5_unit(unsigned long long* tsp, LAS unsigned char* lds, const int tid, const unsigned char* tbl, const float* gw, const float* gb, const bf16_t* proj, bf16_t* mixed, float* ssqs, int b, int g) {
    typedef float f2 __attribute__((ext_vector_type(2)));
    const int lane = tid & 63, c = lane & 31, hi = lane >> 5; const int w = __builtin_amdgcn_readfirstlane(tid >> 6);
    TS(30);
    for (int q = tid; q < 544; q += 512) *(LAS u32x4*)(lds + S5L_KT + q * 16) = *(const u32x4*)(tbl + S5_KT + q * 16);
#pragma unroll
    for (int it = 0; it < 8; ++it) { const int q = tid + 512 * it; *(LAS u32x4*)(lds + S5L_W + (q >> 5) * 528 + (q & 31) * 16) = *(const u32x4*)(tbl + S5_WS + q * 16); }
    if (tid < 192) *(LAS u32x4*)(lds + S5L_MD + tid * 16) = *(const u32x4*)(tbl + S5_MD + tid * 16);
#pragma unroll
    for (int it = 0; it < 4; ++it) { const int q = tid + 512 * it; *(LAS u32x2*)(lds + S5L_MC + (q >> 6) * 520 + (q & 63) * 8) = *(const u32x2*)(tbl + S5_MC + q * 8); }
    __syncthreads();
    TS(31);
    const bf16_t* ubase = proj + PU + 16 * g + 8 * hi;
    const LAS unsigned char* mdb = lds + S5L_MD + hi * 32;
    const LAS unsigned char* mcb = lds + S5L_MC + c * 520 + hi * 32;
    LAS float* EX = (LAS float*)(lds + S5L_EX) + 4 * hi;
    const LAS unsigned char* wsb = lds + S5L_W + c * 528 + hi * 16;
    const LAS unsigned char* wcb = lds + S5L_W + c * 272 + hi * 16;
    f32x16 sa[4];
#pragma unroll
    for (int k = 0; k < 4; ++k) sa[k] = (f32x16){};
    {
        const int cc = 32 * w + c;
        const GAS bf16_t* up = (const GAS bf16_t*)(ubase + (size_t)rowof(b, 16 * cc) * PJ);
#pragma unroll
        for (int s0 = 0; s0 < 16; s0 += 8) {
            bf16x8 uf[8];
#pragma unroll
            for (int s = 0; s < 8; ++s) { uf[s] = *(const GAS bf16x8*)up; up += PJ; asm volatile("" : "+v"(up)); }
            __builtin_amdgcn_sched_barrier(0);
#pragma unroll
            for (int s = 0; s < 8; ++s) {
#pragma unroll
                for (int blk = 0; blk < 4; ++blk) { const bf16x8 A = *(const LAS bf16x8*)(wsb + blk * (32 * 528) + (s0 + s) * 32); sa[blk] = __builtin_amdgcn_mfma_f32_32x32x16_bf16(A, uf[s], sa[blk], 0, 0, 0); }
                __builtin_amdgcn_sched_barrier(0); }
        }
    }
    TS(32);
    float sr[2][16], si[2][16];
#pragma unroll
    for (int pb = 0; pb < 2; ++pb)
#pragma unroll
        for (int r = 0; r < 16; ++r) { sr[pb][r] = sa[pb][r]; si[pb][r] = sa[2 + pb][r]; }
#pragma unroll
    for (int k = 0; k < 4; ++k) {
        const LAS unsigned char* mdk = mdb + k * 512; asm volatile("" : "+v"(mdk));
#pragma unroll
        for (int pb = 0; pb < 2; ++pb)
#pragma unroll
            for (int r = 0; r < 16; ++r) { const f2 m = *(const LAS f2*)(mdk + (32 * pb + (r & 3) + 8 * (r >> 2)) * 8);
                float yr, yi;
                if (k == 0) { yr = dpp_mov0<0x111>(sr[pb][r]); yi = dpp_mov0<0x111>(si[pb][r]); } else if (k == 1) { yr = dpp_mov0<0x112>(sr[pb][r]); yi = dpp_mov0<0x112>(si[pb][r]); }
                else if (k == 2) { yr = dpp_mov0<0x114>(sr[pb][r]); yi = dpp_mov0<0x114>(si[pb][r]); } else { yr = dpp_mov0<0x118>(sr[pb][r]); yi = dpp_mov0<0x118>(si[pb][r]); }
                sr[pb][r] += m.x * yr - m.y * yi; si[pb][r] += m.x * yi + m.y * yr; asm volatile("" : "+v"(sr[pb][r]), "+v"(si[pb][r]));
                if ((r & 3) == 3) { asm volatile("" ::: "memory"); __builtin_amdgcn_sched_barrier(0); } }
    }
    {
        const LAS unsigned char* mcu = lds + S5L_MC + ((c & 15) + 1) * 520 + hi * 32; asm volatile("" : "+v"(mcu));
#pragma unroll
        for (int pb = 0; pb < 2; ++pb)
#pragma unroll
            for (int r = 0; r < 16; ++r) { const f2 m = *(const LAS f2*)(mcu + (32 * pb + (r & 3) + 8 * (r >> 2)) * 8);
                const float yr = dpp_mov0m<0x142, 0xA>(sr[pb][r]), yi = dpp_mov0m<0x142, 0xA>(si[pb][r]);
                sr[pb][r] += m.x * yr - m.y * yi; si[pb][r] += m.x * yi + m.y * yr; asm volatile("" : "+v"(sr[pb][r]), "+v"(si[pb][r]));
                if ((r & 3) == 3) { asm volatile("" ::: "memory"); __builtin_amdgcn_sched_barrier(0); } }
    }
    TS(33);
    if (c == 31) {
#pragma unroll
        for (int pb = 0; pb < 2; ++pb)
#pragma unroll
            for (int r = 0; r < 16; ++r) { const int p0 = 32 * pb + (r & 3) + 8 * (r >> 2); EX[w * 128 + p0] = sr[pb][r]; EX[w * 128 + 64 + p0] = si[pb][r]; }
    }
    __syncthreads();
    if (w == 0) {
        LAS float* CIN = (LAS float*)(lds + S5L_CIN); const LAS float* EXp = (const LAS float*)(lds + S5L_EX);
        const f2 m = *(const LAS f2*)(lds + S5L_MD + (5 * 64 + lane) * 8); float cr_ = 0.f, ci_ = 0.f;
#pragma unroll
        for (int t = 0; t < 8; ++t) { CIN[t * 128 + lane] = cr_; CIN[t * 128 + 64 + lane] = ci_; const float er = EXp[t * 128 + lane], ei = EXp[t * 128 + 64 + lane];
            const float nr = m.x * cr_ - m.y * ci_ + er, ni = m.x * ci_ + m.y * cr_ + ei; cr_ = nr; ci_ = ni; }
        CIN[8 * 128 + lane] = cr_; CIN[8 * 128 + 64 + lane] = ci_;
    }
#pragma unroll
    for (int it = 0; it < 8; ++it) { const int q = tid + 512 * it; *(LAS u32x4*)(lds + S5L_W + (q >> 4) * 272 + (q & 15) * 16) = *(const u32x4*)(tbl + S5_WC + q * 16); }
    __syncthreads();
    TS(34);
    const int npass = 2;
#pragma unroll 1
    for (int pass = 0; pass < npass; ++pass) {
        if (pass == 1) TS(35);
        const int nprev = pass == 0 ? w : 8;
        const int cc = pass == 0 ? 32 * w + c : 256;
        if (pass == 1) {
#pragma unroll
            for (int pb = 0; pb < 2; ++pb)
#pragma unroll
                for (int r = 0; r < 16; ++r) { sr[pb][r] = 0.f; si[pb][r] = 0.f; }
        }
        {
            const LAS float* cinp = (const LAS float*)(lds + S5L_CIN) + nprev * 128 + 4 * hi; asm volatile("" : "+v"(cinp));
            const LAS unsigned char* mcb2 = mcb; asm volatile("" : "+v"(mcb2));
#pragma unroll
            for (int pb = 0; pb < 2; ++pb)
#pragma unroll
                for (int r = 0; r < 16; ++r) { const f2 m = *(const LAS f2*)(mcb2 + (32 * pb + (r & 3) + 8 * (r >> 2)) * 8);
                    float xr = dpp_mov0<0x138>(sr[pb][r]), xi = dpp_mov0<0x138>(si[pb][r]); if (c == 0) { xr = 0.f; xi = 0.f; }
                    const float cr_ = cinp[32 * pb + (r & 3) + 8 * (r >> 2)], ci_ = cinp[64 + 32 * pb + (r & 3) + 8 * (r >> 2)];
                    sr[pb][r] = xr + m.x * cr_ - m.y * ci_; si[pb][r] = xi + m.x * ci_ + m.y * cr_; asm volatile("" : "+v"(sr[pb][r]), "+v"(si[pb][r]));
                    if ((r & 3) == 3) { asm volatile("" ::: "memory"); __builtin_amdgcn_sched_barrier(0); } }
        }
        bf16x8 xf[4][2];
#pragma unroll
        for (int blk = 0; blk < 4; ++blk)
#pragma unroll
            for (int s = 0; s < 2; ++s) { const float* v = blk < 2 ? &sr[blk][8 * s] : &si[blk - 2][8 * s]; u32x4 t; t.x = cvt_pk_bf16(v[0], v[1]); t.y = cvt_pk_bf16(v[2], v[3]); t.z = cvt_pk_bf16(v[4], v[5]); t.w = cvt_pk_bf16(v[6], v[7]); xf[blk][s] = __builtin_bit_cast(bf16x8, t); }
        const int io = (lane >> 4) & 1, kk = lane & 15;
        bf16x8 Gf0, Gf1;
        { unsigned pkd[4];
    #pragma unroll
          for (int jj = 0; jj < 4; ++jj) { const int j0 = 2 * jj, j1 = 2 * jj + 1; const int h0 = 8 * (j0 >> 2) + 4 * hi + (j0 & 3), h1 = 8 * (j1 >> 2) + 4 * hi + (j1 & 3); pkd[jj] = pk2(gw[h0 * 16 + kk], gw[h1 * 16 + kk]); }
          const u32x4 wv = {pkd[0], pkd[1], pkd[2], pkd[3]}, zz = {0u, 0u, 0u, 0u};
          Gf0 = __builtin_bit_cast(bf16x8, io == 0 ? wv : zz); Gf1 = __builtin_bit_cast(bf16x8, io == 1 ? wv : zz); }
        float gbv[8];
    #pragma unroll
        for (int q = 0; q < 8; ++q) gbv[q] = gb[(q & 3) + 8 * (q >> 2) + 4 * hi];
        const int ktb = S5L_KT + ((lane >> 4) & 1) * 512 + (lane & 15) * 32 + hi * 16;
        const bool stok = pass == 0 ? (cc > 0 || b == 0) : (c == 0);
#pragma unroll
        for (int half = 0; half < 2; ++half) {
            __builtin_amdgcn_sched_barrier(0);
            f32x16 ya[4];
#pragma unroll
            for (int rl = 0; rl < 4; ++rl) ya[rl] = (f32x16){};
            int hi2 = hi; asm volatile("" : "+v"(hi2));
            const GAS bf16_t* up = (const GAS bf16_t*)(proj + PU + 16 * g + 8 * hi2 + (size_t)rowof(b, 16 * cc) * PJ);
#pragma unroll
            for (int s0 = 0; s0 < 8 * half + 8; s0 += 8) {
                bf16x8 uf[8];
#pragma unroll
                for (int s = 0; s < 8; ++s) { uf[s] = *(const GAS bf16x8*)up; up += PJ; asm volatile("" : "+v"(up)); }
                __builtin_amdgcn_sched_barrier(0);
#pragma unroll
                for (int s = 0; s < 8; ++s) {
#pragma unroll
                    for (int rl = 0; rl < 4; ++rl) { const int rb = 4 * half + rl; if (s0 + s <= 2 * rb + 1 && (pass == 0 || rb == w)) { const bf16x8 A = *(const LAS bf16x8*)(lds + ktb + (2 * rb - (s0 + s) + 1) * 512); ya[rl] = __builtin_amdgcn_mfma_f32_32x32x16_bf16(A, uf[s], ya[rl], 0, 0, 0); } }
                    __builtin_amdgcn_sched_barrier(0); }
            }
#pragma unroll
            for (int rl = 0; rl < 4; ++rl) if (pass == 0 || 4 * half + rl == w) {
#pragma unroll
                for (int blk = 0; blk < 4; ++blk)
#pragma unroll
                    for (int s = 0; s < 2; ++s) { const bf16x8 A = *(const LAS bf16x8*)(wcb + (4 * half + rl) * (32 * 272) + (blk * 2 + s) * 32); ya[rl] = __builtin_amdgcn_mfma_f32_32x32x16_bf16(A, xf[blk][s], ya[rl], 0, 0, 0); }
                __builtin_amdgcn_sched_barrier(0);
            }
#pragma unroll
            for (int rl = 0; rl < 4; ++rl) if (pass == 0 || 4 * half + rl == w) {
                const int rb = 4 * half + rl;
                float zg[16];
#pragma unroll
                for (int r = 0; r < 16; ++r) zg[r] = gelu_tanh(ya[rl][r]);
                u32x4 z0, z1; z0.x = cvt_pk_bf16(zg[0], zg[1]); z0.y = cvt_pk_bf16(zg[2], zg[3]); z0.z = cvt_pk_bf16(zg[4], zg[5]); z0.w = cvt_pk_bf16(zg[6], zg[7]);
                z1.x = cvt_pk_bf16(zg[8], zg[9]); z1.y = cvt_pk_bf16(zg[10], zg[11]); z1.z = cvt_pk_bf16(zg[12], zg[13]); z1.w = cvt_pk_bf16(zg[14], zg[15]);
                f32x16 gt = (f32x16){};
                gt = __builtin_amdgcn_mfma_f32_32x32x16_bf16(Gf0, __builtin_bit_cast(bf16x8, z0), gt, 0, 0, 0);
                gt = __builtin_amdgcn_mfma_f32_32x32x16_bf16(Gf1, __builtin_bit_cast(bf16x8, z1), gt, 0, 0, 0);
#pragma unroll
                for (int il = 0; il < 2; ++il) {
                    float o[8]; float sq = 0.f;
#pragma unroll
                    for (int q = 0; q < 8; ++q) { o[q] = zg[8 * il + q] * sigmoidf_(gt[8 * il + q] + gbv[q]); sq += o[q] * o[q]; }
                    sq = xadd32(sq);
                    if (stok) { const int row = rowof(b, 16 * cc + 2 * rb + il); bf16_t* op = mixed + (size_t)row * DM + MX_SSM + 16 * g + 4 * hi;
                        u32x2 w0, w1; w0.x = cvt_pk_bf16(o[0], o[1]); w0.y = cvt_pk_bf16(o[2], o[3]); w1.x = cvt_pk_bf16(o[4], o[5]); w1.y = cvt_pk_bf16(o[6], o[7]);
                        *(u32x2*)op = w0; *(u32x2*)(op + 8) = w1;
                        if (hi == 0) ssqs[(size_t)row * 16 + g] = sq; }
                }
                __builtin_amdgcn_sched_barrier(0);
            }
        }
    }
    TS(36);
    __syncthreads();
}

template <int NG>
__device__ __forceinline__ void router_partial(LAS float* part, const bf16_t* hbuf, const bf16_t* Whi, const bf16_t* Wlo, int row0, bool meta, int g0, int wave, int lane) {
    const int r32 = lane & 31, hh = lane >> 5;
    f32x16 acc[NG];
#pragma unroll
    for (int g = 0; g < NG; ++g) acc[g] = (f32x16){};
    const bf16_t* bh_ = Whi + (size_t)r32 * DM + wave * 128 + 8 * hh; const bf16_t* bl_ = Wlo + (size_t)r32 * DM + wave * 128 + 8 * hh;
#pragma unroll
    for (int half = 0; half < 2; ++half) {
        bf16x8 av[NG][4], bhv[4], blv[4];
#pragma unroll
        for (int ks = 0; ks < 4; ++ks) { bhv[ks] = *(const bf16x8*)(bh_ + 64 * half + 16 * ks); blv[ks] = *(const bf16x8*)(bl_ + 64 * half + 16 * ks); }
#pragma unroll
        for (int g = 0; g < NG; ++g) { const int row = meta ? (r32 < NMETA ? NREAL + r32 : DUMMY_ROW) : row0 + 32 * g + r32;
            const bf16_t* ap = hbuf + (size_t)row * DM + wave * 128 + 64 * half + 8 * hh;
#pragma unroll
            for (int ks = 0; ks < 4; ++ks) av[g][ks] = *(const bf16x8*)(ap + 16 * ks); }
#pragma unroll
        for (int g = 0; g < NG; ++g)
#pragma unroll
            for (int ks = 0; ks < 4; ++ks) { acc[g] = __builtin_amdgcn_mfma_f32_32x32x16_bf16(av[g][ks], bhv[ks], acc[g], 0, 0, 0); acc[g] = __builtin_amdgcn_mfma_f32_32x32x16_bf16(av[g][ks], blv[ks], acc[g], 0, 0, 0); }
        __builtin_amdgcn_sched_barrier(0);
    }
    if (r32 < 20) {
#pragma unroll
        for (int g = 0; g < NG; ++g)
#pragma unroll
            for (int r = 0; r < 16; ++r) part[((wave * 5 + g0 + g) * 32 + crow(r, hh)) * 20 + r32] = acc[g][r];
    }
}

struct Args { const GAS float* in[31]; GAS float* out; GAS unsigned char* ws; int ph_lo, ph_hi; };
constexpr int N_PHASES = 16;
#define PHASE_IDS() int tid; { int ln_; asm volatile("v_mbcnt_lo_u32_b32 %0, -1, 0\n\tv_mbcnt_hi_u32_b32 %0, -1, %0" : "=v"(ln_)); tid = wave0 * 64 + ln_; } unsigned long long wz_ = 0; asm volatile("" : "+s"(wz_)); unsigned char* ws = ws0 + wz_;        const int lane = tid & 63; const int wave = __builtin_amdgcn_readfirstlane(tid >> 6); (void)lane; (void)wave

__global__ void __launch_bounds__(NWAVES * 64, 2) hymba_fwd(Args args) {
    extern __shared__ __attribute__((aligned(16))) unsigned char lds_raw[];
    LAS unsigned char* lds = (LAS unsigned char*)lds_raw;
    volatile LAS unsigned* MISC = (volatile LAS unsigned*)(lds + LDSCTL_OFF);
    LAS int* TB = (LAS int*)(lds + LDSCTL_OFF + 256);
    LAS int* CN = (LAS int*)(lds + LDSCTL_OFF + 512);
    LAS int* HIST = (LAS int*)(lds + LDSCTL_OFF + 768);
    const int wave0 = __builtin_amdgcn_readfirstlane(threadIdx.x >> 6);
    const int G = gridDim.x; const int bx = blockIdx.x; const int vcu = (G % 8 == 0) ? (bx % 8) * (G / 8) + bx / 8 : bx;
    unsigned char* const ws0 = (unsigned char*)args.ws;
    unsigned* const ctl = (unsigned*)(GAS unsigned*)(ws0 + WS_CTL);
    for (int u = threadIdx.x; u < (LDS_BYTES - LDSCTL_OFF) / 4; u += NWAVES * 64) ((LAS unsigned*)(lds + LDSCTL_OFF))[u] = 0u;
    __syncthreads();
    const int lo = args.ph_lo, hi = args.ph_hi;
    XcdBarrier bar; bar.bar = ctl + CW_BAR; bar.x = 0; bar.st = nullptr;
    if (hi - lo > 1) bar = xcd_barrier_post(ctl + CW_BAR, MISC + 8);
#define IN(k) (lo <= (k) && (k) < hi)
#define SEAM(k) do { if (IN(k) && IN((k) + 1)) { PHASE_IDS(); xcd_barrier(bar, tid == 0); } STAMP((k) + 1); } while (0)
#define WSP(T, off) ((T*)(ws + (off)))
#define INP(k) ((const float*)args.in[k])
#define STAMP(id) do { if (PROBE_A >= 0 && (int)blockIdx.x == PROBE_BLOCK && ((id) == PROBE_A || (id) == PROBE_B)) { PHASE_IDS(); if (tid == 0) ((unsigned long long*)(ctl + CW_TS))[id] = __builtin_amdgcn_s_memrealtime(); } } while (0)
    STAMP(0);

    for (int rep_ = 0; rep_ < DUP_P0; ++rep_) if (IN(0)) {
        PHASE_IDS();
        bf16_t* WinT = WSP(bf16_t, WS_WIN); bf16_t* WoutT = WSP(bf16_t, WS_WOUT); bf16_t* W13T = WSP(bf16_t, WS_W13); bf16_t* W2C = WSP(bf16_t, WS_W2C); bf16_t* WrT = WSP(bf16_t, WS_WR);
        bf16_t* hbuf = WSP(bf16_t, WS_H); float* ssq1 = WSP(float, WS_SSQ1); float* tinfo = WSP(float, WS_TINFO);
#pragma unroll 1
        for (int lg = vcu; lg < 32; lg += G) { const int l = lg >> 4, g = lg & 15;
            const S5P SP{INP(10) + l * 1024, INP(11) + l * 1024, INP(12) + l * 16, INP(13) + (size_t)l * 16384, INP(14) + (size_t)l * 16384, INP(15) + (size_t)l * 16384, INP(16) + (size_t)l * 16384,
                         INP(17) + l * 256, INP(18) + (size_t)l * 4096, INP(19) + l * 256};
            int tidp = tid; asm volatile("" : "+v"(tidp));
            s5_tables_block(lds, tidp, SP, g, WSP(unsigned char, WS_S5T) + (size_t)lg * S5T_BYTES); }
        LAS float* scr = (LAS float*)(lds + wave * 16384);
        const int gw = vcu * NWAVES + wave, NGW = G * NWAVES;
        constexpr int I_WIN = 16 * 80, I_WOUT = 16 * 32, I_W13 = 16 * 16, I_W2 = 4 * 32, I_WR = 16;
        constexpr int T_WIN = 2 * I_WIN, T_WOUT = 2 * I_WOUT, T_W13 = 32 * I_W13, T_W2 = 32 * I_W2, T_WR = 4 * I_WR;
        constexpr int NITEMS = T_WIN + T_WOUT + T_W13 + T_W2 + T_WR;
        const int nskip = G >= 64 ? 32 : 0; const int igw = (vcu - nskip) * NWAVES + wave, INGW = (G - nskip) * NWAVES;
#pragma unroll 1
        for (int it = igw; it < NITEMS && vcu >= nskip; it += INGW) {
            int r = it;
            if (r < T_WIN) { const int l = r / I_WIN, q = r % I_WIN, kb = q / 80, nb = q % 80; GetWin gt{INP(3) + (size_t)l * DM * DINSRC, INP(2) + l * DM};
                tr_item(gt, WinT + (size_t)l * NIN * DM, DM, 64 * kb, 32 * nb, scr, lane); continue; } r -= T_WIN;
            if (r < T_WOUT) { const int l = r / I_WOUT, q = r % I_WOUT, kb = q / 32, nb = q % 32; GetWout gt{INP(21) + (size_t)l * DM * DM, INP(9) + l * 512, INP(20) + l * 256};
                tr_item(gt, WoutT + (size_t)l * DM * DM, DM, 64 * kb, 32 * nb, scr, lane); continue; } r -= T_WOUT;
            if (r < T_W13) { const int le = r / I_W13, q = r % I_W13, kb = q / 16, nb = q % 16; const int l = le / 16; GetW13 gt{INP(27) + (size_t)le * DM * 256, INP(28) + (size_t)le * DM * 256, INP(22) + l * DM};
                tr_item(gt, W13T + (size_t)le * 512 * DM, DM, 64 * kb, 32 * nb, scr, lane); continue; } r -= T_W13;
            if (r < T_W2) { const int le = r / I_W2, q = r % I_W2, kb = q / 32, nb = q % 32; GetW2 gt{INP(29) + (size_t)le * 256 * DM};
                tr_item(gt, W2C + (size_t)le * DM * 256, 256, 64 * kb, 32 * nb, scr, lane); continue; } r -= T_W2;
            { const int lh = r / I_WR, kb = r % I_WR; const int l = lh >> 1, lo_ = lh & 1; GetWr gt{INP(23) + (size_t)l * DM * 4, INP(25) + (size_t)l * DM * 16, INP(22) + l * DM, lo_};
                tr_item(gt, WrT + (size_t)lh * 32 * DM, DM, 64 * kb, 0, scr, lane); }
        }
#pragma unroll 1
        for (int r0 = 2 * gw; r0 < MROWS; r0 += 2 * NGW) {
            f32x4 v[2][4];
#pragma unroll
            for (int q = 0; q < 2; ++q) { const int r = r0 + q;
#pragma unroll
                for (int j = 0; j < 4; ++j) { if (r < NREAL) v[q][j] = *(const f32x4*)(INP(0) + (size_t)r * DM + 4 * lane + 256 * j); else if (r < NTOK) v[q][j] = *(const f32x4*)(INP(1) + (size_t)(r - NREAL) * DM + 4 * lane + 256 * j); else v[q][j] = (f32x4){0.f, 0.f, 0.f, 0.f}; } }
#pragma unroll
            for (int q = 0; q < 2; ++q) { const int r = r0 + q; float s = 0.f;
#pragma unroll
                for (int j = 0; j < 4; ++j) { u32x2 w; w.x = pk2(v[q][j][0], v[q][j][1]); w.y = pk2(v[q][j][2], v[q][j][3]); *(u32x2*)(hbuf + (size_t)r * DM + 4 * lane + 256 * j) = w;
                    s += bflo(w.x) * bflo(w.x) + bfhi(w.x) * bfhi(w.x) + bflo(w.y) * bflo(w.y) + bfhi(w.y) * bfhi(w.y); }
                s = wave_sum(s);
                if (lane < 16) ssq1[(size_t)r * 16 + lane] = lane == 0 ? s : 0.f;
                if (r >= NTOK && lane < 4) tinfo[(size_t)r * 4 + lane] = 0.f; }
        }
    }
    SEAM(0);

#pragma unroll 1
    for (int l = 0; l < DEPTH; ++l) {
        const int P = 1 + 7 * l;
        for (int rep_ = 0; rep_ < DUP_G1; ++rep_) if (IN(P)) {
            PHASE_IDS();
            bf16_t* hbuf = WSP(bf16_t, WS_H); bf16_t* proj = WSP(bf16_t, WS_PROJ); float* flog = WSP(float, WS_FLOG); const float* ssq1 = WSP(float, WS_SSQ1);
            const bf16_t* Win = WSP(bf16_t, WS_WIN) + (size_t)l * NIN * DM; const float* fb = INP(4) + l * 8;
            DenseOrder S; S.init(hbuf, Win, NREAL, NIN, DM, DM, G, bx);
            EpiProj E{proj, flog, ssq1, fb};
            pg8::gemm_phase<EpiProj, DenseOrder, true, false>(lds, tid, DM, DM, S, E);
#pragma unroll 1
            for (int cb = bx; cb < NIN / 64; cb += G) {
                const f32x2 v = meta_gemm64<false>(lds, tid, hbuf + (size_t)NREAL * DM, Win, DM, cb * 64, nullptr, nullptr);
                const int mm = tid >> 5, cp = tid & 31, row = NREAL + mm;
                const float rs = row_rstd_all(ssq1, row, 1.f / DM);
                if (cb < 36) *(unsigned*)(proj + (size_t)row * PJ + cb * 64 + 2 * cp) = cvt_pk_bf16(v.x * rs, v.y * rs);
                else if (cb == 36 && cp < 4) { f32x2 o; const float f0 = v.x * rs + fb[2 * cp], f1 = v.y * rs + fb[2 * cp + 1]; o.x = -log2f(1.f + exp2f(-f0 * LOG2E)); o.y = -log2f(1.f + exp2f(-f1 * LOG2E)); *(f32x2*)(flog + (size_t)row * 8 + 2 * cp) = o; }
            }
        }
        SEAM(P);
        for (int rep_ = 0; rep_ < DUP_MIX; ++rep_) if (IN(P + 1)) {
            PHASE_IDS();
            const bf16_t* proj = WSP(bf16_t, WS_PROJ); bf16_t* mixed = WSP(bf16_t, WS_MIX); const float* flog = WSP(float, WS_FLOG); float* ssqa = WSP(float, WS_SSQA); float* ssqs = WSP(float, WS_SSQS);
            for (int repa_ = 0; repa_ < DUP_ATT; ++repa_)
#pragma unroll 1
            for (int vc = vcu; vc < 256; vc += G) {
                int bh = vc >> 2; asm volatile("" : "+s"(bh));
                const int b = bh >> 3, h = bh & 7;
                attn_prefix(lds, tid, flog, b, h);
#pragma unroll 1
                for (int i = 0; i < 4; ++i) { const int s = (vc & 3) * 2 + (i >> 1); int qt = (i & 1) ? 15 - s : s; asm volatile("" : "+s"(qt)); int tid3 = tid; asm volatile("" : "+v"(tid3)); attn_unit(lds, tid3, proj, mixed, ssqa, b, h, qt); }
            }
#pragma unroll 1
            for (int vc = vcu; vc < 8; vc += G) { int hh = vc; asm volatile("" : "+s"(hh)); int tid3 = tid; asm volatile("" : "+v"(tid3)); attn_prefix(lds, tid3, flog, 0, hh); attn_unit(lds, tid3, proj, mixed, ssqa, 0, hh, -1); }
            STAMP(20 + l * 4);
            const float* cw = INP(5) + (size_t)l * 31 * 256; const float* cbp = INP(6) + l * 256; const float* clg = INP(7) + l * 256; const float* clb = INP(8) + l * 256;
            for (int repc_ = 0; repc_ < DUP_CS; ++repc_)
#pragma unroll 1
            for (int vc = vcu; vc < 256; vc += G) {
                int tid2 = tid; asm volatile("" : "+v"(tid2));
                if ((vc & 1) == 0) { const int ci = vc >> 1;
                    conv_unit(lds, tid2, proj, mixed, cw, cbp, clg, clb, ci >> 4, NMETA + 256 * (ci & 15), 4, 64);
                } else {
                    if (vc == 1) conv_unit(lds, tid2, proj, mixed, cw, cbp, clg, clb, 0, 0, 1, 16);
                    int ug = vc >> 1; asm volatile("" : "+s"(ug));
                    s5_unit((unsigned long long*)(ctl + CW_TS), lds, tid2, WSP(unsigned char, WS_S5T) + (size_t)(l * 16 + (ug & 15)) * S5T_BYTES, INP(18) + (size_t)l * 4096 + (ug & 15) * 256, INP(19) + l * 256 + (ug & 15) * 16, proj, mixed, ssqs, ug >> 4, ug & 15);
                }
            }
        }
        if (IN(P + 1)) STAMP(21 + l * 4);
        SEAM(P + 1);
        if (IN(P + 3)) {
            PHASE_IDS();
            bf16_t* hbuf = WSP(bf16_t, WS_H); const bf16_t* mixed = WSP(bf16_t, WS_MIX); float* ssq2 = WSP(float, WS_SSQ2); const bf16_t* Wo = WSP(bf16_t, WS_WOUT) + (size_t)l * DM * DM;
            DenseOrder S; S.init(mixed, Wo, NREAL, DM, DM, DM, G, bx);
            EpiRes<false> E{hbuf, ssq2, CN, nullptr};
            HookNorm HK{WSP(float, WS_SSQA), WSP(float, WS_SSQS)};
            pg8::gemm_phase<EpiRes<false>, DenseOrder, true, false, false, HookNorm>(lds, tid, DM, DM, S, E, HK);
            STAMP(40 + 2 * l);
#pragma unroll 1
            for (int cb = bx; cb < DM / 64; cb += G) {
                const f32x2 v = meta_gemm64<true>(lds, tid, mixed + (size_t)NREAL * DM, Wo, DM, cb * 64, WSP(float, WS_SSQA), WSP(float, WS_SSQS));
                const int mm = tid >> 5, cp = tid & 31, row = NREAL + mm;
                unsigned* p = (unsigned*)(hbuf + (size_t)row * DM + cb * 64 + 2 * cp); const unsigned o = *p;
                const unsigned wv = cvt_pk_bf16(bflo(o) + v.x, bfhi(o) + v.y); *p = wv;
                const float sq = half32_sum(bflo(wv) * bflo(wv) + bfhi(wv) * bfhi(wv));
                if (cp == 0) ssq2[(size_t)row * 16 + cb] = sq;
            }
        }
        if (IN(P + 3)) STAMP(41 + 2 * l);
        SEAM(P + 3);
        if (IN(P + 4)) {
            PHASE_IDS();
            const bf16_t* hbuf = WSP(bf16_t, WS_H); const float* ssq2 = WSP(float, WS_SSQ2); float* tinfo = WSP(float, WS_TINFO); int* list = WSP(int, WS_LIST);
            unsigned* gcnt = ctl + CW_CNT + l * 32;
            const bf16_t* Whi = WSP(bf16_t, WS_WR) + (size_t)(2 * l) * 32 * DM; const bf16_t* Wlo = Whi + (size_t)32 * DM;
            LAS float* part = (LAS float*)lds;
            LAS float* fin = (LAS float*)(lds + 106496);
            const float* bg = INP(24) + l * 4; const float* be = INP(26) + l * 16;
#pragma unroll 1
            for (int rb = bx; rb < 256; rb += G) {
                const int ng = rb == 255 ? 5 : 4;
                router_partial<4>(part, hbuf, Whi, Wlo, rb * 128, false, 0, wave, lane);
                if (ng == 5) router_partial<1>(part, hbuf, Whi, Wlo, 0, true, 4, wave, lane);
                __syncthreads();
                for (int e = tid; e < ng * 32 * 20; e += 512) { const int g = e / 640, q = e % 640; float sum = 0.f;
#pragma unroll
                    for (int ww = 0; ww < 8; ++ww) sum += part[(ww * 5 + g) * 640 + q];
                    fin[g * 640 + q] = sum; }
                __syncthreads();
                int cls = 0, posl = 0, tok = 0; bool valid = false; float rstd = 0.f, gA = 0.f, gB = 0.f;
                if (tid < ng * 32) {
                    tok = tid < 128 ? rb * 128 + tid : NREAL + (tid - 128); valid = tid < 128 || tid < 128 + NMETA;
                    if (valid) {
                        float s_ = 0.f;
#pragma unroll
                        for (int q = 0; q < 4; ++q) { const f32x4 v = *(const f32x4*)(ssq2 + (size_t)tok * 16 + 4 * q); s_ += (v.x + v.y) + (v.z + v.w); }
                        rstd = rsqrtf(s_ * (1.f / DM) + EPS);
                        const LAS float* lgp = fin + tid * 20;
                        float lg[4];
#pragma unroll
                        for (int i = 0; i < 4; ++i) lg[i] = lgp[i] * rstd + bg[i];
                        int gs = 0; float mx = lg[0];
#pragma unroll
                        for (int i = 1; i < 4; ++i) if (lg[i] > mx) { mx = lg[i]; gs = i; }
                        float se = 0.f;
#pragma unroll
                        for (int i = 0; i < 4; ++i) se += expf(lg[i] - mx);
                        const float pg = 1.f / se;
                        float le[4];
#pragma unroll
                        for (int i = 0; i < 4; ++i) le[i] = lgp[4 + 4 * gs + i] * rstd + be[4 * gs + i];
                        int i1 = 0; float v1 = le[0];
#pragma unroll
                        for (int i = 1; i < 4; ++i) if (le[i] > v1) { v1 = le[i]; i1 = i; }
                        int i2 = -1; float v2 = -INFINITY;
#pragma unroll
                        for (int i = 0; i < 4; ++i) if (i != i1 && le[i] > v2) { v2 = le[i]; i2 = i; }
                        const float w1 = pg / (1.f + expf(v2 - v1)), w2 = pg - w1;
                        const int a_ = i1 < i2 ? i1 : i2, bb = i1 < i2 ? i2 : i1;
                        gA = i1 < i2 ? w1 : w2; gB = i1 < i2 ? w2 : w1;
                        cls = gs * 6 + (a_ == 0 ? bb - 1 : (a_ == 1 ? bb + 1 : 5));
                        posl = __hip_atomic_fetch_add(&HIST[cls], 1, __ATOMIC_RELAXED, __HIP_MEMORY_SCOPE_WORKGROUP);
                    }
                }
                __syncthreads();
                if (tid < NCLS) { const int n = HIST[tid]; HIST[32 + tid] = n ? (int)__hip_atomic_fetch_add(gcnt + tid, (unsigned)n, __ATOMIC_RELAXED, __HIP_MEMORY_SCOPE_AGENT) : 0; }
                __syncthreads();
                if (valid) { const int pos = HIST[32 + cls] + posl; list[(size_t)cls * NTOK + pos] = tok; *(f32x4*)(tinfo + (size_t)tok * 4) = (f32x4){rstd, gA, gB, 0.f}; }
                __syncthreads();
                if (tid < NCLS) HIST[tid] = 0;
                __syncthreads();
            }
        }
        SEAM(P + 4);
        if (IN(P + 5) || IN(P + 6)) {
            unsigned* gcnt = ctl + CW_CNT + l * 32;
            PHASE_IDS();
            if (tid == 0) { int run = 0; for (int c = 0; c < NCLS; ++c) { const int n = (int)__hip_atomic_load(gcnt + c, __ATOMIC_RELAXED, __HIP_MEMORY_SCOPE_AGENT); CN[c] = n; TB[c] = run; run += (n + 255) >> 8; } TB[NCLS] = run; }
            __syncthreads();
        }
        for (int rep_ = 0; rep_ < DUP_E1; ++rep_) if (IN(P + 5)) {
            PHASE_IDS();
            const int* list = WSP(int, WS_LIST);
            ExpertOrder S{TB, CN, list, (const char*)WSP(bf16_t, WS_H), (const char*)WSP(bf16_t, WS_W13), G, bx, 1, l};
            EpiE1 E{WSP(bf16_t, WS_H1), WSP(float, WS_TINFO), CN, list};
            pg8::gemm_phase<EpiE1, ExpertOrder, true, true>(lds, tid, DM, DM, S, E);
        }
        SEAM(P + 5);
        if (IN(P + 6)) {
            PHASE_IDS();
            const int* list = WSP(int, WS_LIST);
            ExpertOrder S{TB, CN, list, (const char*)WSP(bf16_t, WS_H1), (const char*)WSP(bf16_t, WS_W2C), G, bx, 2, l};
            EpiRes<true> E{WSP(bf16_t, WS_H), WSP(float, WS_SSQ1), CN, list};
            pg8::gemm_phase<EpiRes<true>, ExpertOrder, true, false, true>(lds, tid, 512, 256, S, E);
        }
        SEAM(P + 6);
    }
    if (IN(15)) {
        PHASE_IDS();
        const bf16_t* hbuf = WSP(bf16_t, WS_H); const float* ssq1 = WSP(float, WS_SSQ1);
        const int gw = vcu * NWAVES + wave, NGW = G * NWAVES; const float* gF = INP(30);
        f32x4 gv[4];
#pragma unroll
        for (int j = 0; j < 4; ++j) gv[j] = *(const f32x4*)(gF + 4 * lane + 256 * j);
#pragma unroll 1
        for (int r = gw; r < NREAL; r += NGW) {
            float s = lane < 16 ? ssq1[(size_t)r * 16 + lane] : 0.f; s = wave_sum(s);
            const float rs = rsqrtf(s * (1.f / DM) + EPS);
#pragma unroll
            for (int j = 0; j < 4; ++j) { const u32x2 w = *(const u32x2*)(hbuf + (size_t)r * DM + 4 * lane + 256 * j);
                f32x4 o; o[0] = bflo(w.x) * rs * gv[j][0]; o[1] = bfhi(w.x) * rs * gv[j][1]; o[2] = bflo(w.y) * rs * gv[j][2]; o[3] = bfhi(w.y) * rs * gv[j][3];
                if (PROBE_A >= 0 && r == 0 && lane == 0 && j == 0) { const unsigned long long ta = __hip_atomic_load((unsigned long long*)(ctl + CW_TS) + (PROBE_A < 0 ? 0 : PROBE_A), __ATOMIC_RELAXED, __HIP_MEMORY_SCOPE_AGENT), tb = __hip_atomic_load((unsigned long long*)(ctl + CW_TS) + (PROBE_B < 0 ? 0 : PROBE_B), __ATOMIC_RELAXED, __HIP_MEMORY_SCOPE_AGENT); o[0] += (float)(long long)(tb - ta) * (0.01f / PROBE_SCALE); }
                *(f32x4*)(((float*)args.out) + (size_t)r * DM + 4 * lane + 256 * j) = o; }
        }
    }
#undef IN
#undef SEAM
#undef WSP
}

extern "C" void kernel_launch(void* const* d_in, const int* in_sizes, int n_in, void* d_out, int out_size, void* d_ws, size_t ws_size, hipStream_t stream) {
    static int grid = 0;
    if (grid == 0) {
        if (n_in != 31 || out_size != NREAL * DM || ws_size < WS_END) { fprintf(stderr, "kernel_launch: unexpected shapes (n_in %d, out %d, ws %zu)\n", n_in, out_size, ws_size); grid = -1; return; }
        int dev = 0, cus = 0, per_cu = 0;
        if (hipGetDevice(&dev) != hipSuccess || hipDeviceGetAttribute(&cus, hipDeviceAttributeMultiprocessorCount, dev) != hipSuccess) { grid = -1; return; }
        if (hipFuncSetAttribute((const void*)hymba_fwd, hipFuncAttributeMaxDynamicSharedMemorySize, LDS_BYTES) != hipSuccess) { fprintf(stderr, "kernel_launch: hipFuncSetAttribute failed\n"); grid = -1; return; }
        if (hipOccupancyMaxActiveBlocksPerMultiprocessor(&per_cu, (const void*)hymba_fwd, NWAVES * 64, LDS_BYTES) != hipSuccess || per_cu < 1) { fprintf(stderr, "kernel_launch: occupancy query says %d\n", per_cu); }
        (void)hipGetLastError();
        grid = cus;
    }
    if (grid < 0) return;
    (void)in_sizes;
    if (hipMemsetAsync((char*)d_ws + WS_CTL, 0, CTL_BYTES, stream) != hipSuccess) return;
    Args a{};
    for (int i = 0; i < 31; ++i) a.in[i] = (const GAS float*)d_in[i];
    a.out = (GAS float*)d_out; a.ws = (GAS unsigned char*)d_ws;
#if MK_PER_PHASE
    for (int p = 0; p < N_PHASES; ++p) { a.ph_lo = p; a.ph_hi = p + 1; hipLaunchKernelGGL(hymba_fwd, dim3(grid), dim3(NWAVES * 64), LDS_BYTES, stream, a); }
#else
    a.ph_lo = 0; a.ph_hi = N_PHASES;
    hipLaunchKernelGGL(hymba_fwd, dim3(grid), dim3(NWAVES * 64), LDS_BYTES, stream, a);
#endif
}
```

```cpp
#include <hip/hip_runtime.h>
#include <cstdio>
#include <cstdint>

#ifndef PROBE_A
#define PROBE_A -1
#endif
#ifndef PROBE_B
#define PROBE_B -1
#endif
#ifndef PROBE_BLOCK
#define PROBE_BLOCK 0
#endif
#ifndef PROBE_SCALE
#define PROBE_SCALE 4.0f
#endif
constexpr int CW_TS = 20480;
#define TS(id) do { if (PROBE_A >= 0 && (int)blockIdx.x == PROBE_BLOCK && tid == 0 && ((id) == PROBE_A || (id) == PROBE_B)) tsp[id] = __builtin_amdgcn_s_memrealtime(); } while (0)
#ifndef DUP_ATT
#define DUP_ATT 1
#endif
#ifndef DUP_CS
#define DUP_CS 1
#endif
#ifndef DUP_G1
#define DUP_G1 1
#endif
#ifndef DUP_MIX
#define DUP_MIX 1
#endif
#ifndef DUP_E1
#define DUP_E1 1
#endif
#ifndef DUP_P0
#define DUP_P0 1
#endif
#ifndef MK_PER_PHASE
#define MK_PER_PHASE 0
#endif

#define LAS __attribute__((address_space(3)))
#define GAS __attribute__((address_space(1)))
typedef unsigned short bf16_t;
typedef short bf16x8 __attribute__((ext_vector_type(8)));
typedef short s16x4 __attribute__((ext_vector_type(4)));
typedef float f32x4 __attribute__((ext_vector_type(4)));
typedef float f32x2 __attribute__((ext_vector_type(2)));
typedef float f32x16 __attribute__((ext_vector_type(16)));
typedef unsigned u32x4 __attribute__((ext_vector_type(4)));
typedef unsigned u32x2 __attribute__((ext_vector_type(2)));

constexpr int NB = 8, SEQ = 4096, NMETA = 16, DM = 1024, DEPTH = 2;
constexpr int NREAL = NB * SEQ;
constexpr int NTOK = NREAL + NMETA;
constexpr int MROWS = 33024;
constexpr int DUMMY_ROW = NTOK;
constexpr int PJ = 2304;
constexpr int NIN = 2560;
constexpr int DINSRC = 2312;
constexpr int PQ = 512, PK = 1024, PV = 1536, PU = 2048;
constexpr int MX_ATT = 0, MX_SSM = 512, MX_CONV = 768;
constexpr int NCLS = 24;
constexpr float EPS = 1e-6f;
constexpr float LOG2E = 1.4426950408889634f;
constexpr int H1CAP = 40960;

constexpr size_t MiB = 1u << 20;
constexpr size_t WS_CTL = 0, CTL_BYTES = 1 * MiB;
constexpr size_t WS_WIN = 2 * MiB, WS_WOUT = 12 * MiB, WS_W13 = 16 * MiB, WS_W2C = 48 * MiB, WS_WR = 96 * MiB;
constexpr size_t WS_H = 100 * MiB, WS_PROJ = 165 * MiB, WS_MIX = 311 * MiB, WS_H1 = 376 * MiB;
constexpr size_t WS_FLOG = 416 * MiB, WS_SSQ1 = 418 * MiB, WS_SSQ2 = 421 * MiB, WS_SSQA = 424 * MiB, WS_SSQS = 426 * MiB, WS_TINFO = 429 * MiB, WS_LIST = 430 * MiB, WS_S5T = 434 * MiB, WS_END = 440 * MiB;
constexpr int CW_TMO = 0, CW_BAR = 4096, CW_CNT = 16384;

constexpr int RING_BYTES = 151552;
constexpr int LDSCTL_OFF = RING_BYTES;
constexpr int LDS_BYTES = 155648;
constexpr int NWAVES = 8;

#define LDS_WAIT() asm volatile("s_waitcnt lgkmcnt(0)" ::: "memory")
#define VM_WAIT() asm volatile("s_waitcnt vmcnt(0)" ::: "memory")

__device__ __forceinline__ unsigned f2bf(float f) { unsigned u = __float_as_uint(f); return (u + 0x7fffu + ((u >> 16) & 1u)) >> 16; }
__device__ __forceinline__ unsigned pk2(float lo, float hi) { return f2bf(lo) | (f2bf(hi) << 16); }
__device__ __forceinline__ float bflo(unsigned w) { return __uint_as_float(w << 16); }
__device__ __forceinline__ float bfhi(unsigned w) { return __uint_as_float(w & 0xffff0000u); }
__device__ __forceinline__ float bf2f(bf16_t b) { return __uint_as_float(((unsigned)b) << 16); }
__device__ __forceinline__ unsigned cvt_pk_bf16(float lo, float hi) { unsigned r; asm volatile("v_cvt_pk_bf16_f32 %0, %1, %2" : "=v"(r) : "v"(lo), "v"(hi)); return r; }
template <int CTRL> __device__ __forceinline__ float dpp_mov0(float v) { return __builtin_bit_cast(float, __builtin_amdgcn_update_dpp(0, __builtin_bit_cast(int, v), CTRL, 0xF, 0xF, true)); }
__device__ __forceinline__ void swap16(float& a, float& b) { asm volatile("v_nop\n\tv_nop\n\tv_permlane16_swap_b32 %0, %1" : "+v"(a), "+v"(b)); }
__device__ __forceinline__ void swap32(float& a, float& b) { asm volatile("v_nop\n\tv_nop\n\tv_permlane32_swap_b32 %0, %1" : "+v"(a), "+v"(b)); }
__device__ __forceinline__ float xadd16(float v) { float a = v, b = v; swap16(a, b); return a + b; }
__device__ __forceinline__ float xadd32(float v) { float a = v, b = v; swap32(a, b); return a + b; }
__device__ __forceinline__ float row16_sum(float v) {
    v += dpp_mov0<0xB1>(v);
    v += dpp_mov0<0x4E>(v);
    v += dpp_mov0<0x141>(v);
    v += dpp_mov0<0x140>(v);
    return v;
}
template <int CTRL, int ROWMASK> __device__ __forceinline__ float dpp_mov0m(float v) { return __builtin_bit_cast(float, __builtin_amdgcn_update_dpp(0, __builtin_bit_cast(int, v), CTRL, ROWMASK, 0xF, true)); }
__device__ __forceinline__ float xmax32(float v) { float a = v, b = v; swap32(a, b); return fmaxf(a, b); }
__device__ __forceinline__ float wave_incl_scan(float v) {
    v += dpp_mov0<0x111>(v); v += dpp_mov0<0x112>(v); v += dpp_mov0<0x114>(v); v += dpp_mov0<0x118>(v);
    v += dpp_mov0m<0x142, 0xA>(v);
    v += dpp_mov0m<0x143, 0xC>(v);
    return v;
}
__device__ __forceinline__ float half32_sum(float v) { return xadd16(row16_sum(v)); }
__device__ __forceinline__ float wave_sum(float v) { return xadd32(xadd16(row16_sum(v))); }
__device__ __forceinline__ float fast_exp2(float x) { return __builtin_amdgcn_exp2f(x); }
__device__ __forceinline__ float fast_rcp(float x) { return __builtin_amdgcn_rcpf(x); }
__device__ __forceinline__ float sigmoidf_(float x) { return fast_rcp(1.f + fast_exp2(-x * LOG2E)); }
__device__ __forceinline__ float siluf_(float x) { return x * sigmoidf_(x); }
__device__ __forceinline__ int rowof(int b, int t) { return t < NMETA ? NREAL + t : b * SEQ + (t - NMETA); }

namespace pg8 {
constexpr int BM = 256, BK = 64, HALF = 128, HTB = HALF * BK * 2, STAGE_BYTES = 8 * HTB;
__host__ __device__ __forceinline__ int lds_byte(int r, int c) { const int st = (r >> 4) * 2 + (c >> 5), rr = r & 15, cc = c & 31, ob = rr * 64 + cc * 2; return st * 1024 + (ob ^ (((ob >> 9) & 1) << 5)); }
__host__ __device__ __forceinline__ void stage_rc(int b, int& R, int& C) { const int st = b / 1024, sb = b % 1024, swz = sb ^ (((sb >> 9) & 1) << 5); R = (st >> 1) * 16 + swz / 64; C = (st & 1) * 32 + (swz % 64) / 2; }
__host__ __device__ __forceinline__ int perm32(int rho) { const int n = rho >> 4, i = rho & 15; return 8 * (i >> 2) + 4 * n + (i & 3); }

struct Unit { int pm, pn, cls, p0; };

struct NoHook { static constexpr bool ON = false; __device__ __forceinline__ void load(const Unit&, int, int, int, float (&)[8], float (&)[8]) const {} };
template <class Epi, class Sched, bool ALIGN_EPI, bool GATHER, bool BSPLIT = false, class Hook = NoHook>
__device__ __forceinline__ void gemm_phase(LAS unsigned char* lds, const int tid, const int K, const int ldb, const Sched& S, const Epi& E, const Hook& H = Hook()) {
    const int wid = __builtin_amdgcn_readfirstlane(tid >> 6), lane = tid & 63, wr = wid >> 2, wc = wid & 3, fr = lane & 15, fq = lane >> 4;
    const int nt = K / BK;
    unsigned voffA[2], voffB[2]; int RA[2], CA[2];
#pragma unroll
    for (int i = 0; i < 2; ++i) { int R, C; stage_rc(tid * 16 + i * 8192, R, C); const int Rb = (R & ~31) + perm32(R & 31);
        voffA[i] = (unsigned)(R * K + C) * 2u; voffB[i] = (unsigned)(Rb * ldb + C) * 2u; RA[i] = R; CA[i] = C; }
    const size_t kstep = (size_t)(BK * 2);
    const size_t hstepA = (size_t)HALF * K * 2, hstepB = (size_t)HALF * ldb * 2;
    const size_t pstepA = (size_t)64 * K * 2, pstepB = (size_t)64 * ldb * 2;
    const unsigned ldsw = (unsigned)wid * 1024u;
    const int aoff = lds_byte(wr * 64 + fr, fq * 8), boff = lds_byte(wc * 32 + fr, fq * 8);
#define PG8_SA(b, h) (((b) * 2 + (h)) * HTB)
#define PG8_SB(b, h) ((4 + (b) * 2 + (h)) * HTB)
#define PG8_STAGE(bufoff, gbase, voff) do { _Pragma("unroll") for (int _i = 0; _i < 2; ++_i) \
        __builtin_amdgcn_global_load_lds((const unsigned*)((const char*)(gbase) + (voff)[_i]), (LAS unsigned*)(lds + (bufoff) + ldsw + _i * 8192), 16, 0, 0); } while (0)
#define PG8_STAGE1(bufoff, gbase, voff1, step) do { _Pragma("unroll") for (int _i = 0; _i < 2; ++_i) \
        __builtin_amdgcn_global_load_lds((const unsigned*)((const char*)(gbase) + (size_t)_i * (step) + (voff1)), (LAS unsigned*)(lds + (bufoff) + ldsw + _i * 8192), 16, 0, 0); } while (0)
#define PG8_LDA(dst, b, h) do { _Pragma("unroll") for (int m = 0; m < 4; ++m) _Pragma("unroll") for (int k = 0; k < 2; ++k) dst[m][k] = *(const LAS bf16x8*)(lds + PG8_SA(b, h) + aoff + m * 2048 + k * 1024); } while (0)
#define PG8_LDB(dst, b, h) do { _Pragma("unroll") for (int n = 0; n < 2; ++n) _Pragma("unroll") for (int k = 0; k < 2; ++k) dst[n][k] = *(const LAS bf16x8*)(lds + PG8_SB(b, h) + boff + n * 2048 + k * 1024); } while (0)
#define PG8_MMA(ai, bj, At, Bt) do { __builtin_amdgcn_s_setprio(1); _Pragma("unroll") for (int m = 0; m < 4; ++m) _Pragma("unroll") for (int n = 0; n < 2; ++n) _Pragma("unroll") for (int k = 0; k < 2; ++k) \
        acc[ai][bj][m][n] = __builtin_amdgcn_mfma_f32_16x16x32_bf16(Bt[n][k], At[m][k], acc[ai][bj][m][n], 0, 0, 0); __builtin_amdgcn_s_setprio(0); } while (0)
#define PG8_WAIT_V(n) asm volatile("s_waitcnt vmcnt(" #n ")" ::: "memory")
#define PG8_WAIT_L(n) asm volatile("s_waitcnt lgkmcnt(" #n ")" ::: "memory")
#define PG8_BAR __builtin_amdgcn_s_barrier()
#define PG8_SCHED __builtin_amdgcn_sched_barrier(0)
    Unit cur, nxt; int ui = 0;
    if (!S.next(0, cur)) return;
    f32x4 acc[2][2][4][2];
#pragma unroll
    for (int a = 0; a < 2; ++a)
#pragma unroll
        for (int b = 0; b < 2; ++b)
#pragma unroll
            for (int m = 0; m < 4; ++m)
#pragma unroll
                for (int n = 0; n < 2; ++n) acc[a][b][m][n] = (f32x4){0.f, 0.f, 0.f, 0.f};
    bf16x8 At[4][2], B0[2][2], B1[2][2];
    const char* cA = S.abase(cur); const char* cB = S.bbase(cur);
    const char* cB2 = cB; const int ksp = BSPLIT ? nt / 2 : (1 << 30);
    if constexpr (BSPLIT) cB2 = S.bbase2(cur) - (size_t)ksp * kstep;
    unsigned oC[2][2], oN[2][2];
    if constexpr (GATHER) {
#pragma unroll
        for (int h = 0; h < 2; ++h)
#pragma unroll
            for (int i = 0; i < 2; ++i) oC[h][i] = (unsigned)S.rowtok(cur, h * HALF + RA[i]) * (unsigned)(K * 2) + (unsigned)(CA[i] * 2);
    }
    PG8_STAGE1(PG8_SB(0, 0), cB, voffB[0], pstepB); PG8_STAGE1(PG8_SB(0, 1), cB + hstepB, voffB[0], pstepB);
    if constexpr (GATHER) { PG8_STAGE(PG8_SA(0, 0), cA, oC[0]); PG8_STAGE(PG8_SA(0, 1), cA, oC[1]); }
    else { PG8_STAGE1(PG8_SA(0, 0), cA, voffA[0], pstepA); PG8_STAGE1(PG8_SA(0, 1), cA + hstepA, voffA[0], pstepA); }
    if (wr == 1) PG8_BAR;
    PG8_WAIT_V(2); PG8_BAR;
    PG8_STAGE1(PG8_SB(1, 0), cB + kstep, voffB[0], pstepB);
    if constexpr (GATHER) { PG8_STAGE(PG8_SA(1, 0), cA + kstep, oC[0]); } else { PG8_STAGE1(PG8_SA(1, 0), cA + kstep, voffA[0], pstepA); }
    PG8_STAGE1(PG8_SB(1, 1), cB + hstepB + kstep, voffB[0], pstepB);
    PG8_WAIT_V(6); PG8_BAR;
    for (;;) {
        const bool has_next = S.next(ui + 1, nxt);
        float hf1[8], hf2[8];
        if constexpr (Hook::ON) { int ln_; asm volatile("v_mbcnt_lo_u32_b32 %0, -1, 0\n\tv_mbcnt_hi_u32_b32 %0, -1, %0" : "=v"(ln_)); H.load(cur, wr, ln_ & 15, ln_ >> 4, hf1, hf2); }
        const char* nA = has_next ? S.abase(nxt) : cA; const char* nB = has_next ? S.bbase(nxt) : cB;
        const char* nB2 = nB; if constexpr (BSPLIT) nB2 = has_next ? S.bbase2(nxt) - (size_t)ksp * kstep : cB2;
        if constexpr (GATHER) {
#pragma unroll
            for (int h = 0; h < 2; ++h)
#pragma unroll
                for (int i = 0; i < 2; ++i) oN[h][i] = has_next ? (unsigned)S.rowtok(nxt, h * HALF + RA[i]) * (unsigned)(K * 2) + (unsigned)(CA[i] * 2) : oC[h][i];
        }
        for (int t = 0; t < nt; t += 2) {
            if constexpr (Hook::ON) { if (t == 8 || t == 12) {
#pragma unroll
                for (int a = 0; a < 2; ++a)
#pragma unroll
                    for (int m = 0; m < 4; ++m) { const float f = t == 8 ? hf1[a * 4 + m] : hf2[a * 4 + m];
#pragma unroll
                        for (int b = 0; b < 2; ++b)
#pragma unroll
                            for (int n = 0; n < 2; ++n) acc[a][b][m][n] *= f; } } }
            const bool last = (t == nt - 2);
            const char* a1 = cA + (size_t)(t + 1) * kstep;
            const char* a2 = last ? nA : cA + (size_t)(t + 2) * kstep; const char* b2 = last ? nB : ((t + 2 < ksp) ? cB : cB2) + (size_t)(t + 2) * kstep;
            const char* a3 = a2 + kstep; const char* b3 = b2 + kstep;
            unsigned s0[2], s1[2];
            if constexpr (GATHER) { s0[0] = last ? oN[0][0] : oC[0][0]; s0[1] = last ? oN[0][1] : oC[0][1]; s1[0] = last ? oN[1][0] : oC[1][0]; s1[1] = last ? oN[1][1] : oC[1][1]; }
            PG8_LDB(B0, 0, 0); PG8_LDB(B1, 0, 1); PG8_SCHED; PG8_LDA(At, 0, 0);
            if constexpr (GATHER) { PG8_STAGE(PG8_SA(1, 1), a1, oC[1]); } else { PG8_STAGE1(PG8_SA(1, 1), a1 + hstepA, voffA[0], pstepA); }
            PG8_WAIT_V(8); PG8_WAIT_L(0); PG8_BAR; PG8_MMA(0, 0, At, B0); PG8_MMA(0, 1, At, B1); PG8_BAR; PG8_SCHED;
            PG8_LDA(At, 0, 1); PG8_STAGE1(PG8_SB(0, 0), b2, voffB[0], pstepB); PG8_STAGE1(PG8_SB(0, 1), b2 + hstepB, voffB[0], pstepB);
            if constexpr (GATHER) { PG8_STAGE(PG8_SA(0, 0), a2, s0); } else { PG8_STAGE1(PG8_SA(0, 0), a2, voffA[0], pstepA); }
            PG8_WAIT_V(8); PG8_WAIT_L(0); PG8_BAR; PG8_MMA(1, 0, At, B0); PG8_MMA(1, 1, At, B1); PG8_BAR; PG8_SCHED;
            PG8_LDB(B0, 1, 0); PG8_LDB(B1, 1, 1); PG8_SCHED; PG8_LDA(At, 1, 0);
            if constexpr (GATHER) { PG8_STAGE(PG8_SA(0, 1), a2, s1); } else { PG8_STAGE1(PG8_SA(0, 1), a2 + hstepA, voffA[0], pstepA); }
            PG8_WAIT_V(8); PG8_WAIT_L(0); PG8_BAR; PG8_MMA(0, 0, At, B0); PG8_MMA(0, 1, At, B1); PG8_BAR; PG8_SCHED;
            PG8_LDA(At, 1, 1); PG8_STAGE1(PG8_SB(1, 0), b3, voffB[0], pstepB); PG8_STAGE1(PG8_SB(1, 1), b3 + hstepB, voffB[0], pstepB);
            if constexpr (GATHER) { PG8_STAGE(PG8_SA(1, 0), a3, s0); } else { PG8_STAGE1(PG8_SA(1, 0), a3, voffA[0], pstepA); }
            PG8_WAIT_V(8); PG8_WAIT_L(0); PG8_BAR; PG8_MMA(1, 0, At, B0); PG8_MMA(1, 1, At, B1); PG8_BAR; PG8_SCHED;
        }
        if constexpr (ALIGN_EPI) { if (wr == 0) PG8_BAR; }
        { int ln_; asm volatile("v_mbcnt_lo_u32_b32 %0, -1, 0\n\tv_mbcnt_hi_u32_b32 %0, -1, %0" : "=v"(ln_)); E(acc, cur, wr, wc, ln_ & 15, ln_ >> 4); }
        if (!has_next) break;
#pragma unroll
        for (int a = 0; a < 2; ++a)
#pragma unroll
            for (int b = 0; b < 2; ++b)
#pragma unroll
                for (int m = 0; m < 4; ++m)
#pragma unroll
                    for (int n = 0; n < 2; ++n) acc[a][b][m][n] = (f32x4){0.f, 0.f, 0.f, 0.f};
        cur = nxt; cA = nA; cB = nB; cB2 = nB2; ++ui;
        if constexpr (GATHER) {
#pragma unroll
            for (int h = 0; h < 2; ++h)
#pragma unroll
                for (int i = 0; i < 2; ++i) oC[h][i] = oN[h][i];
        }
        if constexpr (ALIGN_EPI) { if (wr == 1) PG8_BAR; }
    }
    PG8_WAIT_V(0);
    if constexpr (!ALIGN_EPI) { if (wr == 0) PG8_BAR; }
    PG8_BAR;
#undef PG8_SA
#undef PG8_SB
#undef PG8_STAGE
#undef PG8_STAGE1
#undef PG8_LDA
#undef PG8_LDB
#undef PG8_MMA
#undef PG8_WAIT_V
#undef PG8_WAIT_L
#undef PG8_BAR
#undef PG8_SCHED
}
}
using pg8::Unit;

struct DenseOrder {
    const char* A; const char* Bt; size_t tstepA, tstepB; int nM, nN, nwg, G, c;
    __device__ __forceinline__ void init(const void* A_, const void* Bt_, int M, int N, int K, int ldb, int G_, int c_) {
        A = (const char*)A_; Bt = (const char*)Bt_; tstepA = (size_t)256 * K * 2; tstepB = (size_t)256 * ldb * 2; nM = M / 256; nN = N / 256; nwg = nM * nN; G = G_; c = c_; }
    __device__ __forceinline__ bool next(int i, Unit& u) const {
        const long L = (long)i * G + c; if (L >= nwg) return false;
        int wgid = (int)L; { const int q = nwg / 8, r = nwg % 8, xcd = wgid % 8, off = wgid / 8; wgid = (xcd < r ? xcd * (q + 1) : r * (q + 1) + (xcd - r) * q) + off; }
        const int nig = 8 * nN, gid = wgid / nig, fm = gid * 8, gsz = (nM - fm) < 8 ? (nM - fm) : 8;
        u.pm = fm + ((wgid % nig) % gsz); u.pn = (wgid % nig) / gsz; u.cls = 0; u.p0 = 0; return true;
    }
    __device__ __forceinline__ const char* abase(const Unit& u) const { return A + (size_t)u.pm * tstepA; }
    __device__ __forceinline__ const char* bbase(const Unit& u) const { return Bt + (size_t)u.pn * tstepB; }
    __device__ __forceinline__ const char* bbase2(const Unit& u) const { return bbase(u); }
    __device__ __forceinline__ int rowtok(const Unit&, int) const { return 0; }
};

__device__ __forceinline__ void cls_experts(int cls, int& eA, int& eB) { const int g = cls / 6, p = cls % 6; const int a = (p >= 3) + (p >= 5), b = p < 3 ? p + 1 : (p < 5 ? p - 1 : 3); eA = 4 * g + a; eB = 4 * g + b; }
struct ExpertOrder {
    const LAS int* tb; const LAS int* cn; const int* list; const char* A; const char* W; int G, c, mode, layer;
    __device__ __forceinline__ bool next(int i, Unit& u) const {
        const int nwg = __builtin_amdgcn_readfirstlane(tb[NCLS]) * 4; const long L = (long)i * G + c; if (L >= nwg) return false;
        int wgid = (int)L; { const int q = nwg / 8, r = nwg % 8, xcd = wgid % 8, off = wgid / 8; wgid = (xcd < r ? xcd * (q + 1) : r * (q + 1) + (xcd - r) * q) + off; }
        const int rt = wgid >> 2; int cls = 0;
        for (int k = 1; k < NCLS; ++k) cls += (rt >= tb[k]) ? 1 : 0;
        cls = __builtin_amdgcn_readfirstlane(cls);
        u.pm = rt; u.pn = wgid & 3; u.cls = cls; u.p0 = __builtin_amdgcn_readfirstlane((rt - tb[cls]) * 256); return true;
    }
    __device__ __forceinline__ const char* abase(const Unit& u) const { return mode == 1 ? A : A + (size_t)u.pm * (256 * 512 * 2); }
    __device__ __forceinline__ const char* bbase(const Unit& u) const {
        if (mode == 1) { int eA, eB; cls_experts(u.cls, eA, eB); const int e = (u.pn >> 1) ? eB : eA; return W + ((size_t)(layer * 16 + e) * 512 + (size_t)(u.pn & 1) * 256) * (1024 * 2); }
        int eA, eB; cls_experts(u.cls, eA, eB); return W + ((size_t)(layer * 16 + eA) * 1024 + (size_t)u.pn * 256) * (256 * 2);
    }
    __device__ __forceinline__ const char* bbase2(const Unit& u) const { int eA, eB; cls_experts(u.cls, eA, eB); return W + ((size_t)(layer * 16 + eB) * 1024 + (size_t)u.pn * 256) * (256 * 2); }
    __device__ __forceinline__ int rowtok(const Unit& u, int rr) const { const int pos = u.p0 + rr; return pos < cn[u.cls] ? list[(size_t)u.cls * NTOK + pos] : DUMMY_ROW; }
};

__device__ __forceinline__ float row_rstd16(const float* ssq, int row, int fq, float inv_n) {
    const f32x4 v = *(const f32x4*)(ssq + (size_t)row * 16 + 4 * fq);
    float s = (v.x + v.y) + (v.z + v.w);
    s = xadd32(xadd16(s));
    return rsqrtf(s * inv_n + EPS);
}

struct HookNorm { static constexpr bool ON = true; const float* ssqa; const float* ssqs;
    __device__ __forceinline__ void load(const Unit& u, int wr, int fr, int fq, float (&f1)[8], float (&f2)[8]) const {
#pragma unroll
        for (int ai = 0; ai < 2; ++ai)
#pragma unroll
            for (int m = 0; m < 4; ++m) { const int row = u.pm * 256 + ai * 128 + wr * 64 + m * 16 + fr;
                const f32x2 a = *(const f32x2*)(ssqa + (size_t)row * 8 + 2 * fq); const f32x4 b = *(const f32x4*)(ssqs + (size_t)row * 16 + 4 * fq);
                const float sa = xadd32(xadd16(a.x + a.y)), ss = xadd32(xadd16((b.x + b.y) + (b.z + b.w)));
                const float ra = rsqrtf(sa * (1.f / 512.f) + EPS), vs = ss * (1.f / 256.f) + EPS;
                f1[ai * 4 + m] = ra * sqrtf(vs); f2[ai * 4 + m] = rsqrtf(vs); }
    }
};
struct EpiProj {
    bf16_t* proj; float* flog; const float* ssq1; const float* fb;
    __device__ __forceinline__ void operator()(const f32x4 (&acc)[2][2][4][2], const Unit& u, int wr, int wc, int fr, int fq) const {
#pragma unroll
        for (int ai = 0; ai < 2; ++ai)
#pragma unroll
            for (int m = 0; m < 4; ++m) {
                const int row = u.pm * 256 + ai * 128 + wr * 64 + m * 16 + fr;
                const float rs = row_rstd16(ssq1, row, fq, 1.f / DM);
                if (u.pn < 9) {
#pragma unroll
                    for (int bj = 0; bj < 2; ++bj) { const f32x4 v0 = acc[ai][bj][m][0] * rs, v1 = acc[ai][bj][m][1] * rs; u32x4 w;
                        w.x = cvt_pk_bf16(v0[0], v0[1]); w.y = cvt_pk_bf16(v0[2], v0[3]); w.z = cvt_pk_bf16(v1[0], v1[1]); w.w = cvt_pk_bf16(v1[2], v1[3]);
                        *(u32x4*)(proj + (size_t)row * PJ + u.pn * 256 + bj * 128 + wc * 32 + 8 * fq) = w; }
                } else if (wc == 0 && fq == 0) {
                    f32x4 o0, o1;
#pragma unroll
                    for (int e = 0; e < 4; ++e) { const float f0 = acc[ai][0][m][0][e] * rs + fb[e], f1 = acc[ai][0][m][1][e] * rs + fb[4 + e];
                        o0[e] = -log2f(1.f + exp2f(-f0 * LOG2E)); o1[e] = -log2f(1.f + exp2f(-f1 * LOG2E)); }
                    *(f32x4*)(flog + (size_t)row * 8) = o0; *(f32x4*)(flog + (size_t)row * 8 + 4) = o1;
                }
            }
    }
};
template <bool TOKMAP> struct EpiRes {
    bf16_t* h; float* ssq; const LAS int* cn; const int* list;
    __device__ __forceinline__ void operator()(const f32x4 (&acc)[2][2][4][2], const Unit& u, int wr, int wc, int fr, int fq) const {
#pragma unroll
        for (int ai = 0; ai < 2; ++ai)
#pragma unroll
            for (int m = 0; m < 4; ++m) {
                const int rr = ai * 128 + wr * 64 + m * 16 + fr; int row;
                if constexpr (TOKMAP) { const int pos = u.p0 + rr; row = pos < cn[u.cls] ? list[(size_t)u.cls * NTOK + pos] : DUMMY_ROW; } else row = u.pm * 256 + rr;
                float sq = 0.f;
#pragma unroll
                for (int bj = 0; bj < 2; ++bj) { bf16_t* p = h + (size_t)row * DM + u.pn * 256 + bj * 128 + wc * 32 + 8 * fq; const u32x4 o = *(const u32x4*)p;
                    const f32x4 a0 = acc[ai][bj][m][0], a1 = acc[ai][bj][m][1]; u32x4 w;
                    w.x = cvt_pk_bf16(bflo(o.x) + a0[0], bfhi(o.x) + a0[1]); w.y = cvt_pk_bf16(bflo(o.y) + a0[2], bfhi(o.y) + a0[3]);
                    w.z = cvt_pk_bf16(bflo(o.z) + a1[0], bfhi(o.z) + a1[1]); w.w = cvt_pk_bf16(bflo(o.w) + a1[2], bfhi(o.w) + a1[3]);
                    *(u32x4*)p = w;
                    sq += bflo(w.x) * bflo(w.x) + bfhi(w.x) * bfhi(w.x) + bflo(w.y) * bflo(w.y) + bfhi(w.y) * bfhi(w.y) + bflo(w.z) * bflo(w.z) + bfhi(w.z) * bfhi(w.z) + bflo(w.w) * bflo(w.w) + bfhi(w.w) * bfhi(w.w); }
                sq = xadd32(xadd16(sq));
                if (fq == 0) ssq[(size_t)row * 16 + u.pn * 4 + wc] = sq;
            }
    }
};
struct EpiE1 {
    bf16_t* H1; const float* tinfo; const LAS int* cn; const int* list;
    __device__ __forceinline__ void operator()(const f32x4 (&acc)[2][2][4][2], const Unit& u, int wr, int wc, int fr, int fq) const {
#pragma unroll
        for (int ai = 0; ai < 2; ++ai)
#pragma unroll
            for (int m = 0; m < 4; ++m) {
                const int rr = ai * 128 + wr * 64 + m * 16 + fr; const int pos = u.p0 + rr;
                const int tok = pos < cn[u.cls] ? list[(size_t)u.cls * NTOK + pos] : DUMMY_ROW;
                const f32x4 ti = *(const f32x4*)(tinfo + (size_t)tok * 4);
                const float rs = ti.x, gate = (u.pn >> 1) ? ti.z : ti.y;
                float o[8];
#pragma unroll
                for (int n = 0; n < 2; ++n)
#pragma unroll
                    for (int e = 0; e < 4; ++e) { const float a = acc[ai][0][m][n][e] * rs, b = acc[ai][1][m][n][e] * rs; o[n * 4 + e] = gate * siluf_(a) * b; }
                u32x4 w; w.x = cvt_pk_bf16(o[0], o[1]); w.y = cvt_pk_bf16(o[2], o[3]); w.z = cvt_pk_bf16(o[4], o[5]); w.w = cvt_pk_bf16(o[6], o[7]);
                *(u32x4*)(H1 + (size_t)(u.pm * 256 + rr) * 512 + (u.pn >> 1) * 256 + (u.pn & 1) * 128 + wc * 32 + 8 * fq) = w;
            }
    }
};

template <bool SEGNORM>
__device__ __forceinline__ f32x2 meta_gemm64(LAS unsigned char* lds, const int tid, const bf16_t* A, const bf16_t* Bt, int K, int n0, const float* ssqa, const float* ssqs) {
    const int lane = tid & 63, m = lane & 15, q4 = lane >> 4; const int w = __builtin_amdgcn_readfirstlane(tid >> 6);
    const int kr = K >> 3;
    const bf16_t* ap = A + (size_t)m * K + w * kr + 8 * q4; const bf16_t* bp = Bt + (size_t)(n0 + m) * K + w * kr + 8 * q4;
    bf16x8 av[4], bv[4][4];
#pragma unroll
    for (int ks = 0; ks < 4; ++ks) { av[ks] = *(const bf16x8*)(ap + 32 * ks);
#pragma unroll
        for (int j = 0; j < 4; ++j) bv[ks][j] = *(const bf16x8*)(bp + (size_t)16 * j * K + 32 * ks); }
    f32x4 acc[4];
#pragma unroll
    for (int j = 0; j < 4; ++j) acc[j] = (f32x4){0.f, 0.f, 0.f, 0.f};
#pragma unroll
    for (int ks = 0; ks < 4; ++ks)
#pragma unroll
        for (int j = 0; j < 4; ++j) acc[j] = __builtin_amdgcn_mfma_f32_16x16x32_bf16(bv[ks][j], av[ks], acc[j], 0, 0, 0);
    if constexpr (SEGNORM) {
        const int row = NREAL + m; float sc = 1.f;
        if (w < 4) { float sa = 0.f;
#pragma unroll
            for (int q = 0; q < 8; ++q) sa += ssqa[(size_t)row * 8 + q]; sc = rsqrtf(sa * (1.f / 512.f) + EPS); }
        else if (w < 6) { float ss = 0.f;
#pragma unroll
            for (int q = 0; q < 16; ++q) ss += ssqs[(size_t)row * 16 + q]; sc = rsqrtf(ss * (1.f / 256.f) + EPS); }
#pragma unroll
        for (int j = 0; j < 4; ++j) acc[j] *= sc;
    }
    LAS float* part = (LAS float*)lds;
#pragma unroll
    for (int j = 0; j < 4; ++j) *(LAS f32x4*)(part + (w * 16 + m) * 64 + 16 * j + 4 * q4) = acc[j];
    __syncthreads();
    const int mm = tid >> 5, cp = tid & 31; f32x2 r = {0.f, 0.f};
#pragma unroll
    for (int ww = 0; ww < 8; ++ww) r += *(const LAS f32x2*)(part + (ww * 16 + mm) * 64 + 2 * cp);
    __syncthreads();
    return r;
}
__device__ __forceinline__ float row_rstd_all(const float* ssq, int row, float inv_n) {
    float s = 0.f;
#pragma unroll
    for (int q = 0; q < 4; ++q) { const f32x4 v = *(const f32x4*)(ssq + (size_t)row * 16 + 4 * q); s += (v.x + v.y) + (v.z + v.w); }
    return rsqrtf(s * inv_n + EPS);
}

#define XB_TMO      128
#define XB_XCNT(j)  (256  + 64 * (j))
#define XB_XSUB(j)  (1280 + 64 * (j))
#define XB_XGEN(j)  (2304 + 64 * (j))
#define XB_TOP      3328
#define XB_TOPGEN   3392
#define XCD_BAR_WORDS 3456
#define XB_SPIN_CAP (1u << 18)
__device__ __forceinline__ unsigned xb_ld(unsigned* p)              { return __hip_atomic_load(p, __ATOMIC_RELAXED, __HIP_MEMORY_SCOPE_AGENT); }
__device__ __forceinline__ unsigned xb_add(unsigned* p, unsigned v) { return __hip_atomic_fetch_add(p, v, __ATOMIC_RELAXED, __HIP_MEMORY_SCOPE_AGENT); }
__device__ __forceinline__ unsigned xb_xcc_id() { return (unsigned)__builtin_amdgcn_s_getreg((3 << 11) | 20) & 0xFu; }
#define XB_SPIN(cond, bar) do { unsigned _sp = 0; while (cond) { __builtin_amdgcn_s_sleep(1); \
    if ((++_sp & 255u) == 0u) { if (xb_ld(&(bar)[XB_TMO])) break; if (_sp > XB_SPIN_CAP) { atomicAdd(&(bar)[XB_TMO], 1u); break; } } } } while (0)
struct XcdBarrier { unsigned* bar; unsigned x; volatile LAS unsigned* st; };
__device__ __forceinline__ XcdBarrier xcd_barrier_post(unsigned* bar, volatile LAS unsigned* st) {
    XcdBarrier b; b.bar = bar; b.x = xb_xcc_id(); b.st = st;
    if (threadIdx.x == 0) (void)xb_add(&bar[XB_XCNT(b.x)], 1u);
    return b;
}
__device__ __forceinline__ void xcd_barrier_complete(unsigned* bar, unsigned x, unsigned& nloc, unsigned& nx) {
    const unsigned G = gridDim.x * gridDim.y * gridDim.z;
    unsigned sum, cnt, mine, sp = 0u;
    for (;;) {
        sum = 0u; cnt = 0u; mine = 0u;
#pragma unroll
        for (unsigned j = 0; j < 16; ++j) { const unsigned c = xb_ld(&bar[XB_XCNT(j)]); sum += c; cnt += (c > 0u) ? 1u : 0u; mine = (j == x) ? c : mine; }
        if (sum == G) break;
        __builtin_amdgcn_s_sleep(1);
        if ((++sp & 255u) == 0u) { if (xb_ld(&bar[XB_TMO])) break; if (sp > XB_SPIN_CAP) { atomicAdd(&bar[XB_TMO], 1u); break; } }
    }
    nloc = mine > 0u ? mine : 1u; nx = cnt > 0u ? cnt : 1u;
}
__device__ __forceinline__ void xcd_barrier(const XcdBarrier& b, const bool leader_thread) {
    asm volatile("s_waitcnt vmcnt(0)" ::: "memory");
    __syncthreads();
    if (leader_thread) {
        unsigned long long bz_ = 0; asm volatile("" : "+s"(bz_)); unsigned* bar = b.bar + bz_;
        __builtin_amdgcn_s_waitcnt(0);
        unsigned nloc = b.st[0], nx = b.st[1];
        if (nloc == 0u) { xcd_barrier_complete(bar, b.x, nloc, nx); b.st[0] = nloc; b.st[1] = nx; }
        const unsigned old = xb_add(&bar[XB_XSUB(b.x)], 1u);
        const unsigned gen = old / nloc;
        if (old + 1u == (gen + 1u) * nloc) {
            __builtin_amdgcn_fence(__ATOMIC_RELEASE, "agent");
            asm volatile("s_waitcnt vmcnt(0)" ::: "memory");
            const unsigned og = xb_add(&bar[XB_TOP], 1u);
            const unsigned tg = og / nx;
            if (og + 1u == (tg + 1u) * nx) xb_add(&bar[XB_TOPGEN], 1u);
            else XB_SPIN(xb_ld(&bar[XB_TOPGEN]) == tg, bar);
            __builtin_amdgcn_fence(__ATOMIC_ACQUIRE, "agent");
            xb_add(&bar[XB_XGEN(b.x)], 1u);
            asm volatile("s_waitcnt vmcnt(0)" ::: "memory");
        } else {
            XB_SPIN(xb_ld(&bar[XB_XGEN(b.x)]) == gen, bar);
            __builtin_amdgcn_fence(__ATOMIC_ACQUIRE, "agent");
            asm volatile("s_waitcnt vmcnt(0)" ::: "memory");
        }
    }
    __syncthreads();
}

template <class Get>
__device__ __forceinline__ void tr_item(const Get& get, bf16_t* dst, int dpitch, int k0, int n0, LAS float* scr, int lane) {
    float tv[32];
#pragma unroll
    for (int i = 0; i < 32; ++i) tv[i] = get(k0 + 2 * i + (lane >> 5), n0 + (lane & 31));
#pragma unroll
    for (int i = 0; i < 32; ++i) scr[(2 * i + (lane >> 5)) * 33 + (lane & 31)] = tv[i];
    LDS_WAIT(); asm volatile("" ::: "memory");
    const int c = lane & 7;
#pragma unroll
    for (int j = 0; j < 4; ++j) { const int n = (lane >> 3) + 8 * j; const LAS float* s = scr + (8 * c) * 33 + n;
        u32x4 o; o.x = pk2(s[0 * 33], s[1 * 33]); o.y = pk2(s[2 * 33], s[3 * 33]); o.z = pk2(s[4 * 33], s[5 * 33]); o.w = pk2(s[6 * 33], s[7 * 33]);
        *(u32x4*)(dst + (size_t)(n0 + n) * dpitch + k0 + 8 * c) = o; }
    LDS_WAIT(); asm volatile("" ::: "memory");
}
struct GetWin { const float* w; const float* g;
    __device__ __forceinline__ float operator()(int k, int n) const { int src; if (n < 2048) src = n; else if (n < 2304) src = n + 8; else if (n < 2312) src = n - 256; else return 0.f;
        float v = w[(size_t)k * DINSRC + src] * g[k]; if (n >= PQ && n < PK) v *= 0.125f * LOG2E; return v; } };
struct GetWout { const float* w; const float* ga; const float* gs;
    __device__ __forceinline__ float operator()(int k, int n) const { const int src = k < 768 ? k + 256 : k - 768; const float gn = k < 512 ? ga[k] : (k < 768 ? gs[k - 512] : 1.f);
        return w[(size_t)src * DM + n] * gn; } };
struct GetW13 { const float* w1; const float* w3; const float* g;
    __device__ __forceinline__ float operator()(int k, int n) const { const int u = n >> 8, hf = (n >> 7) & 1, j = n & 127; const uintptr_t wp = (uintptr_t)w1 + (uintptr_t)hf * ((uintptr_t)w3 - (uintptr_t)w1); return ((const GAS float*)wp)[(size_t)k * 256 + u * 128 + j] * g[k]; } };
struct GetW2 { const float* w;
    __device__ __forceinline__ float operator()(int k, int n) const { return w[(size_t)k * DM + n]; } };
struct GetWr { const float* rg; const float* re; const float* g; int lo;
    __device__ __forceinline__ float operator()(int k, int n) const { float v = 0.f; if (n < 4) v = rg[(size_t)k * 4 + n]; else if (n < 20) v = re[(size_t)k * 16 + (n - 4)]; v *= g[k];
        if (lo) v = v - __uint_as_float(f2bf(v) << 16); return v; } };

constexpr int AT_SLOT = 16384, AT_KX = 81920, AT_KXZ = 4144, AT_WT = AT_KX + 4160 * 16;
__device__ __forceinline__ int crow(int r, int hi) { return (r & 3) + 8 * (r >> 2) + 4 * hi; }
__device__ __forceinline__ void attn_prefix(LAS unsigned char* lds, const int tid, const float* flog, int b, int h) {
    const int lane = tid & 63; const int w = __builtin_amdgcn_readfirstlane(tid >> 6);
    LAS u32x4* kx = (LAS u32x4*)(lds + AT_KX); LAS float* wt = (LAS float*)(lds + AT_WT);
    float v[9]; float run = 0.f;
#pragma unroll
    for (int i = 0; i < 9; ++i) { const int j = tid * 9 + i; float x = 0.f; if (j < NMETA + SEQ) x = flog[(size_t)rowof(b, j) * 8 + h]; run += x; v[i] = run; }
    const float inc = wave_incl_scan(run);
    if (lane == 63) wt[w] = inc;
    __syncthreads();
    float base = inc - run;
    for (int k = 0; k < w; ++k) base += wt[k];
#pragma unroll
    for (int i = 0; i < 9; ++i) { const int j = tid * 9 + i; if (j < 4160) { const float t = -(base + v[i]);
        const unsigned hi_ = f2bf(t); const float r1 = t - __uint_as_float(hi_ << 16); const unsigned mi_ = f2bf(r1); const float r2 = r1 - __uint_as_float(mi_ << 16); const unsigned lo_ = f2bf(r2);
        u32x4 e; e.x = hi_ | (mi_ << 16); e.y = lo_ | (0x3F80u << 16); e.z = 0x3F803F80u; e.w = 0u;
        if (j >= NMETA + SEQ) e = (u32x4){0u, 0u, 0u, 0u};
        kx[j] = e; } }
    __syncthreads();
}
__device__ __forceinline__ void at_glds16(const void* gsrc, unsigned lds_dst) { unsigned keep;
    asm volatile("s_mov_b32 %0, m0\n\ts_mov_b32 m0, %2\n\ts_nop 0\n\tglobal_load_lds_dwordx4 %1, off\n\ts_mov_b32 m0, %0" : "=&s"(keep) : "v"(gsrc), "s"(lds_dst) : "memory"); }
constexpr float AT_THR = 8.f;
__device__ __forceinline__ void attn_unit(LAS unsigned char* lds, const int tid, const bf16_t* proj, bf16_t* mixed, float* ssqa, int b, int h, int qt) {
    const int lane = tid & 63, r32 = lane & 31, hi = lane >> 5; const int w = __builtin_amdgcn_readfirstlane(tid >> 6);
    const LAS u32x4* kxt = (const LAS u32x4*)(lds + AT_KX);
    const int qrel = 32 * w + r32;
    const int qrow = qt >= 0 ? b * SEQ + 256 * qt + qrel : NREAL + (qrel & 15);
    const int qkey = qt >= 0 ? NMETA + 256 * qt + qrel : (qrel & 15);
    const int qkey_w0 = qt >= 0 ? NMETA + 256 * qt + 32 * w : 0;
    float cq; { const u32x4 e = kxt[qkey]; cq = -(__uint_as_float(e.x << 16) + __uint_as_float(e.x & 0xffff0000u) + __uint_as_float(e.y << 16)); }
    bf16x8 qr[4];
#pragma unroll
    for (int d0 = 0; d0 < 4; ++d0) qr[d0] = *(const bf16x8*)(proj + (size_t)qrow * PJ + PQ + h * 64 + d0 * 16 + hi * 8);
    const int ntiles = qt >= 0 ? 1 + 4 * (qt + 1) : 1;
    const int wnt = qt >= 0 ? 4 * qt + (w >> 1) + 2 : 1;
    const int vr = 16 * (w & 3) + (lane >> 2);
    const unsigned ldsb = (unsigned)(uintptr_t)lds;
#define AT_DMA(jj) do { int kr_, vr_; if ((jj) == 0) { kr_ = NREAL + (lane < 15 ? lane : 15); vr_ = NREAL + (vr < 15 ? vr : 15); } else { kr_ = b * SEQ + 64 * ((jj) - 1) + lane; vr_ = b * SEQ + 64 * ((jj) - 1) + vr; } \
        const int so_ = AT_SLOTOF(sj, (jj) - jbase) + w * 1024; \
        at_glds16(proj + (size_t)kr_ * PJ + PK + h * 64 + w * 8, (unsigned)__builtin_amdgcn_readfirstlane(ldsb + so_)); \
        at_glds16(proj + (size_t)vr_ * PJ + PV + h * 64 + (w >> 2) * 32 + (lane & 3) * 8, (unsigned)__builtin_amdgcn_readfirstlane(ldsb + so_ + 8192)); } while (0)
#define AT_WAITBAR(n) asm volatile("s_waitcnt vmcnt(" #n ") lgkmcnt(0)\n\ts_barrier" ::: "memory")
    float mref = 0.f, lrun = 0.f; f32x16 o0 = {}, o1 = {};
    const bf16x8 onesf = __builtin_bit_cast(bf16x8, (u32x4){0x3F803F80u, 0x3F803F80u, 0x3F803F80u, 0x3F803F80u});
    u32x4 qx;
#define AT_QX() do { const float u_ = cq - mref; const unsigned h_ = f2bf(u_); const float r1_ = u_ - __uint_as_float(h_ << 16); const unsigned m_ = f2bf(r1_); const unsigned l_ = f2bf(r1_ - __uint_as_float(m_ << 16)); \
        qx = hi ? (u32x4){0u, 0u, 0u, 0u} : (u32x4){0x3F803F80u, 0x3F80u | (h_ << 16), m_ | (l_ << 16), 0u}; } while (0)
    AT_QX();
    const int kfo = hi * 1024 + r32 * 16;
    const int vb = 8192 + ((lane >> 4) & 1) * 32 + (lane & 3) * 8 + (4 * hi + ((lane & 15) >> 2)) * 64;
    const int kxo = hi ? AT_KXZ * 16 : r32 * 16;
    bf16x8 kf[8], kxf[2];
#define AT_KLOAD(P0, P1, jjn) do { const int kb_ = (jjn) == 0 ? 0 : NMETA + 64 * ((jjn) - 1); const int so_ = AT_SLOTOF(sj, (jjn) - jbase); \
        _Pragma("unroll") for (int d0 = 0; d0 < 4; ++d0) { kf[2 * d0] = *(const LAS bf16x8*)(lds + so_ + kfo + d0 * 2048); kf[2 * d0 + 1] = *(const LAS bf16x8*)(lds + so_ + kfo + d0 * 2048 + 512); } \
        kxf[0] = *(const LAS bf16x8*)(lds + AT_KX + (hi ? 0 : kb_ * 16) + kxo); kxf[1] = *(const LAS bf16x8*)(lds + AT_KX + (hi ? 0 : (kb_ + 32) * 16) + kxo); \
        __builtin_amdgcn_sched_barrier(0); } while (0)
#define AT_QKM(P0, P1) do { const f32x16 z_ = {}; const bf16x8 qb_ = __builtin_bit_cast(bf16x8, qx); \
        P0 = __builtin_amdgcn_mfma_f32_32x32x16_bf16(kxf[0], qb_, z_, 0, 0, 0); P1 = __builtin_amdgcn_mfma_f32_32x32x16_bf16(kxf[1], qb_, z_, 0, 0, 0); \
        _Pragma("unroll") for (int d0 = 0; d0 < 4; ++d0) { \
            P0 = __builtin_amdgcn_mfma_f32_32x32x16_bf16(kf[2 * d0], qr[d0], P0, 0, 0, 0); P1 = __builtin_amdgcn_mfma_f32_32x32x16_bf16(kf[2 * d0 + 1], qr[d0], P1, 0, 0, 0); } \
        __builtin_amdgcn_sched_barrier(0); } while (0)
#define AT_MX3(a, b, c) __builtin_fmaxf(__builtin_fmaxf((a), (b)), (c))
#define AT_SMPV(P0, P1, N0, N1, jj, pend) do { const int kb_ = (jj) == 0 ? 0 : NMETA + 64 * ((jj) - 1); \
        const LAS unsigned char* Vb_ = lds + AT_SLOTOF(sj, (jj) - jbase) + vb; s16x4 va_[8], vc_[8]; \
        _Pragma("unroll") for (int ks = 0; ks < 4; ++ks) { \
            va_[2 * ks] = __builtin_bit_cast(s16x4, __builtin_amdgcn_ds_read_tr16_b64_v4i16((LAS s16x4*)(Vb_ + ks * 1024))); \
            va_[2 * ks + 1] = __builtin_bit_cast(s16x4, __builtin_amdgcn_ds_read_tr16_b64_v4i16((LAS s16x4*)(Vb_ + ks * 1024 + 512))); } \
        __builtin_amdgcn_sched_barrier(0); \
        if ((jj) == 0 || kb_ + 63 > qkey_w0) { const int lim_ = (jj) == 0 ? (qkey < 15 ? qkey : 15) : qkey; \
            _Pragma("unroll") for (int r = 0; r < 16; ++r) { const int j_ = kb_ + crow(r, hi); if (j_ > lim_) P0[r] = -INFINITY; if (j_ + 32 > lim_) P1[r] = -INFINITY; } } \
        float ra_ = AT_MX3(P0[0], P0[1], P1[0]), rb_ = AT_MX3(P0[2], P0[3], P1[1]); ra_ = AT_MX3(ra_, P1[2], P1[3]); \
        _Pragma("unroll") for (int r = 4; r < 16; r += 4) { ra_ = AT_MX3(ra_, P0[r], P0[r + 1]); rb_ = AT_MX3(rb_, P0[r + 2], P0[r + 3]); ra_ = AT_MX3(ra_, P1[r], P1[r + 1]); rb_ = AT_MX3(rb_, P1[r + 2], P1[r + 3]); } \
        float rm_ = fmaxf(ra_, rb_); \
        rm_ = xmax32(rm_); \
        if ((jj) == 0 || __any(rm_ > AT_THR)) { const float dl_ = (jj) == 0 ? rm_ : fmaxf(rm_, 0.f); mref += dl_; const float f_ = (jj) == 0 ? 1.f : fast_exp2(-dl_); AT_QX(); \
            _Pragma("unroll") for (int r = 0; r < 16; ++r) { P0[r] -= dl_; P1[r] -= dl_; o0[r] *= f_; o1[r] *= f_; } lrun *= f_; \
            if (pend) { _Pragma("unroll") for (int r = 0; r < 16; ++r) { N0[r] -= dl_; N1[r] -= dl_; } } } \
        float rs_ = 0.f; \
        _Pragma("unroll") for (int r = 0; r < 16; ++r) { P0[r] = fast_exp2(P0[r]); P1[r] = fast_exp2(P1[r]); rs_ += P0[r] + P1[r]; } \
        lrun += rs_; \
        u32x4 pw_[4]; \
        _Pragma("unroll") for (int i = 0; i < 4; ++i) { pw_[0][i] = cvt_pk_bf16(P0[2 * i], P0[2 * i + 1]); pw_[1][i] = cvt_pk_bf16(P0[8 + 2 * i], P0[8 + 2 * i + 1]); \
            pw_[2][i] = cvt_pk_bf16(P1[2 * i], P1[2 * i + 1]); pw_[3][i] = cvt_pk_bf16(P1[8 + 2 * i], P1[8 + 2 * i + 1]); } \
        __builtin_amdgcn_sched_barrier(0); \
        _Pragma("unroll") for (int ks = 0; ks < 4; ++ks) { \
            vc_[2 * ks] = __builtin_bit_cast(s16x4, __builtin_amdgcn_ds_read_tr16_b64_v4i16((LAS s16x4*)(Vb_ + 4096 + ks * 1024))); \
            vc_[2 * ks + 1] = __builtin_bit_cast(s16x4, __builtin_amdgcn_ds_read_tr16_b64_v4i16((LAS s16x4*)(Vb_ + 4096 + ks * 1024 + 512))); } \
        _Pragma("unroll") for (int ks = 0; ks < 4; ++ks) { \
            const bf16x8 va = {va_[2 * ks][0], va_[2 * ks][1], va_[2 * ks][2], va_[2 * ks][3], va_[2 * ks + 1][0], va_[2 * ks + 1][1], va_[2 * ks + 1][2], va_[2 * ks + 1][3]}; \
            o0 = __builtin_amdgcn_mfma_f32_32x32x16_bf16(va, __builtin_bit_cast(bf16x8, pw_[ks]), o0, 0, 0, 0); } \
        __builtin_amdgcn_sched_barrier(0); \
        _Pragma("unroll") for (int ks = 0; ks < 4; ++ks) { \
            const bf16x8 vbb = {vc_[2 * ks][0], vc_[2 * ks][1], vc_[2 * ks][2], vc_[2 * ks][3], vc_[2 * ks + 1][0], vc_[2 * ks + 1][1], vc_[2 * ks + 1][2], vc_[2 * ks + 1][3]}; \
            o1 = __builtin_amdgcn_mfma_f32_32x32x16_bf16(vbb, __builtin_bit_cast(bf16x8, pw_[ks]), o1, 0, 0, 0); } \
        __builtin_amdgcn_sched_barrier(0); } while (0)
#define AT_STEP(C0, C1, N0, N1, jj) do { \
        const bool dma_ = (jj) + 4 < ntiles; \
        if (dma_) AT_DMA((jj) + 4); \
        const bool pend_ = (jj) + 1 < wnt; \
        if (pend_) AT_QKM(N0, N1); \
        if ((jj) < wnt) AT_SMPV(C0, C1, N0, N1, jj, pend_); \
        if ((jj) + 2 < wnt) AT_KLOAD(C0, C1, (jj) + 2); \
        if (dma_) AT_WAITBAR(2); else AT_WAITBAR(0); } while (0)
    int sj = 0, jbase = 0;
#define AT_SLOTOF(s_, k_) (((s_) + (k_) * AT_SLOT) >= 5 * AT_SLOT ? ((s_) + (k_) * AT_SLOT) - 5 * AT_SLOT : ((s_) + (k_) * AT_SLOT))
    AT_DMA(0);
    if (ntiles > 1) AT_DMA(1);
    if (ntiles > 2) AT_DMA(2);
    if (ntiles > 3) { AT_DMA(3); AT_WAITBAR(2); } else AT_WAITBAR(0);
    f32x16 pa0, pa1, pb0, pb1;
    AT_KLOAD(pa0, pa1, 0); AT_QKM(pa0, pa1);
    if (1 < wnt) AT_KLOAD(pb0, pb1, 1);
#pragma unroll 1
    for (int jj = 0; jj < ntiles; jj += 2) {
        jbase = jj;
        AT_STEP(pa0, pa1, pb0, pb1, jj);
        if (jj + 1 < ntiles) AT_STEP(pb0, pb1, pa0, pa1, jj + 1);
        sj = AT_SLOTOF(sj, 2);
    }
#undef AT_SLOTOF
#undef AT_KLOAD
#undef AT_QKM
#undef AT_MX3
#undef AT_QX
#undef AT_DMA
#undef AT_WAITBAR
#undef AT_SMPV
#undef AT_STEP
    const float ltot = xadd32(lrun);
    const float inv = 1.f / ltot;
    float sq = 0.f;
#pragma unroll
    for (int r = 0; r < 16; ++r) { o0[r] *= inv; o1[r] *= inv; sq += o0[r] * o0[r] + o1[r] * o1[r]; }
    sq = xadd32(sq);
    const bool st = qt >= 0 || qrel < 16;
    if (st) {
        bf16_t* op = mixed + (size_t)qrow * DM + MX_ATT + h * 64;
#pragma unroll
        for (int g = 0; g < 4; ++g) { u32x2 w0, w1; w0.x = cvt_pk_bf16(o0[4 * g], o0[4 * g + 1]); w0.y = cvt_pk_bf16(o0[4 * g + 2], o0[4 * g + 3]); w1.x = cvt_pk_bf16(o1[4 * g], o1[4 * g + 1]); w1.y = cvt_pk_bf16(o1[4 * g + 2], o1[4 * g + 3]);
            *(u32x2*)(op + 8 * g + 4 * hi) = w0; *(u32x2*)(op + 32 + 8 * g + 4 * hi) = w1; }
        if (hi == 0) ssqa[(size_t)qrow * 8 + h] = sq;
    }
    __syncthreads();
}

__device__ __forceinline__ void conv_unit(LAS unsigned char* lds, const int tid, const bf16_t* proj, bf16_t* mixed, const float* cw, const float* cb, const float* lg, const float* lb, int b, int tbase, int nsub, int nvalid) {
    const int lane = tid & 63; const int w = __builtin_amdgcn_readfirstlane(tid >> 6);
    LAS float* ub = (LAS float*)lds;
    const int cp = tid & 127, rg = tid >> 7;
#pragma unroll 1
    for (int sb = 0; sb < nsub; ++sb) {
        const int t0 = tbase + 64 * sb;
        {
            u32x2 av[12], gv[12];
#pragma unroll
            for (int it = 0; it < 12; ++it) { const int idx = tid + 512 * it; const int rr = idx >> 6, cq4 = (idx & 63) * 4; const int t = t0 - 30 + rr; av[it] = (u32x2){0u, 0u}; gv[it] = (u32x2){0u, 0u};
                if (rr < 94 && t >= 0 && t < NMETA + SEQ) { const bf16_t* p = proj + (size_t)rowof(b, t) * PJ + cq4; av[it] = *(const u32x2*)p; gv[it] = *(const u32x2*)(p + 256); } }
#pragma unroll
            for (int it = 0; it < 12; ++it) { const int idx = tid + 512 * it; const int rr = idx >> 6, cq4 = (idx & 63) * 4; f32x4 u;
                u[0] = bflo(av[it].x) * sigmoidf_(bflo(gv[it].x)); u[1] = bfhi(av[it].x) * sigmoidf_(bfhi(gv[it].x)); u[2] = bflo(av[it].y) * sigmoidf_(bflo(gv[it].y)); u[3] = bfhi(av[it].y) * sigmoidf_(bfhi(gv[it].y));
                if (rr < 94) *(LAS f32x4*)(ub + rr * 256 + cq4) = u; }
        }
        f32x2 wv[31];
#pragma unroll
        for (int j = 0; j < 31; ++j) wv[j] = *(const f32x2*)(cw + j * 256 + 2 * cp);
        __syncthreads();
        f32x2 acc[16];
#pragma unroll
        for (int i = 0; i < 16; ++i) acc[i] = (f32x2){0.f, 0.f};
#pragma unroll
        for (int rr = 0; rr < 46; ++rr) { const f32x2 uv = *(const LAS f32x2*)(ub + (16 * rg + rr) * 256 + 2 * cp);
#pragma unroll
            for (int i = 0; i < 16; ++i) if (rr - i >= 0 && rr - i <= 30) acc[i] += wv[rr - i] * uv; }
        __syncthreads();
        { const f32x2 bb = *(const f32x2*)(cb + 2 * cp);
#pragma unroll
        for (int i = 0; i < 16; ++i) *(LAS f32x2*)(ub + (16 * rg + i) * 256 + 2 * cp) = acc[i] + bb; }
        const f32x4 g4 = *(const f32x4*)(lg + 4 * lane), b4 = *(const f32x4*)(lb + 4 * lane);
        __syncthreads();
#pragma unroll
        for (int i = 0; i < 8; ++i) { const int rr = 8 * w + i; const f32x4 y = *(const LAS f32x4*)(ub + rr * 256 + 4 * lane);
            const float mu = wave_sum((y[0] + y[1]) + (y[2] + y[3])) * (1.f / 256.f);
            const f32x4 d = y - mu; const float var = wave_sum((d[0] * d[0] + d[1] * d[1]) + (d[2] * d[2] + d[3] * d[3])) * (1.f / 256.f);
            const float rs = rsqrtf(var + EPS); f32x4 o;
#pragma unroll
            for (int e = 0; e < 4; ++e) o[e] = siluf_(d[e] * rs * g4[e] + b4[e]);
            if (rr < nvalid) { u32x2 wv2; wv2.x = cvt_pk_bf16(o[0], o[1]); wv2.y = cvt_pk_bf16(o[2], o[3]); *(u32x2*)(mixed + (size_t)rowof(b, t0 + rr) * DM + MX_CONV + 4 * lane) = wv2; } }
        __syncthreads();
    }
}

struct S5P { const float *lre, *lim, *ldt, *bre, *bim, *cre, *cim, *dsk, *gw, *gb; };
__device__ __forceinline__ float gelu_tanh(float x) { const float u = 0.7978845608028654f * (x + 0.044715f * x * x * x); const float e = fast_exp2(2.f * LOG2E * u); const float th = 1.f - 2.f * fast_rcp(e + 1.f); return 0.5f * x * (1.f + th); }
constexpr size_t S5T_BYTES = 163840;
constexpr int S5_KT = 0, S5_WS = 8704, S5_WC = 74240, S5_MD = 139776, S5_MC = 142848;
constexpr int S5L_KT = 0, S5L_W = 8704, S5L_EX = 78336, S5L_MD = 82944, S5L_MC = 86016, S5L_CIN = 102656;
__device__ __forceinline__ void s5_tables_block(LAS unsigned char* lds, const int tid, const S5P& P, int g, unsigned char* tbl) {
    typedef float f2 __attribute__((ext_vector_type(2)));
    LAS f2* pw = (LAS f2*)lds;
    LAS f2* Bb = (LAS f2*)(lds + 8704);
    LAS f2* Cc = (LAS f2*)(lds + 16896);
    if (tid < 64) {
        const int p = tid;
        const float dt = expf(P.ldt[g]);
        const float lr = P.lre[g * 64 + p], li = P.lim[g * 64 + p];
        const float mag = expf(lr * dt);
        const double turns = (double)li * (double)dt * 0.15915494309189535; const float fr = (float)(turns - floor(turns));
        const float ar = mag * __builtin_amdgcn_cosf(fr), ai = mag * __builtin_amdgcn_sinf(fr);
        const float nr = ar - 1.f, ni = ai, den = lr * lr + li * li;
        const float fre = (nr * lr + ni * li) / den, fim = (ni * lr - nr * li) / den;
        float xr = 1.f, xi = 0.f;
        for (int t = 0; t <= 16; ++t) { pw[t * 64 + p] = (f2){xr, xi}; const float nxr = xr * ar - xi * ai, nxi = xr * ai + xi * ar; xr = nxr; xi = nxi; }
        const f2 M = pw[16 * 64 + p];
        float* MD = (float*)(tbl + S5_MD); float* MC = (float*)(tbl + S5_MC);
        float mr = M.x, mi = M.y;
        for (int k = 0; k < 6; ++k) { MD[(k * 64 + p) * 2] = mr; MD[(k * 64 + p) * 2 + 1] = mi; const float n1 = mr * mr - mi * mi, n2 = 2.f * mr * mi; mr = n1; mi = n2; }
        xr = 1.f; xi = 0.f;
        for (int c = 0; c < 32; ++c) { MC[(c * 64 + p) * 2] = xr; MC[(c * 64 + p) * 2 + 1] = xi; const float nxr = xr * M.x - xi * M.y, nxi = xr * M.y + xi * M.x; xr = nxr; xi = nxi; }
        for (int h = 0; h < 16; ++h) { const float br = P.bre[(g * 64 + p) * 16 + h], bi = P.bim[(g * 64 + p) * 16 + h]; Bb[p * 16 + h] = (f2){fre * br - fim * bi, fre * bi + fim * br}; }
    }
    for (int e = tid; e < 1024; e += 512) Cc[e] = (f2){P.cre[g * 1024 + e], P.cim[g * 1024 + e]};
    __syncthreads();
    bf16_t* KT = (bf16_t*)(tbl + S5_KT); bf16_t* WSg = (bf16_t*)(tbl + S5_WS); bf16_t* WCg = (bf16_t*)(tbl + S5_WC);
    for (int e = tid; e < 17 * 256; e += 512) {
        const int t1 = e >> 8, h = (e >> 4) & 15, h2 = e & 15; float acc = 0.f;
        if (t1 > 0) { const int tau = t1 - 1;
            for (int p = 0; p < 64; ++p) { const f2 a = pw[tau * 64 + p], bb = Bb[p * 16 + h2], c = Cc[h * 64 + p]; const float zr = a.x * bb.x - a.y * bb.y, zi = a.x * bb.y + a.y * bb.x; acc += c.x * zr - c.y * zi; }
            if (tau == 0 && h == h2) acc += P.dsk[g * 16 + h]; }
        KT[e] = (bf16_t)f2bf(acc);
    }
    for (int e = tid; e < 128 * 256; e += 512) {
        const int r = e >> 8, ri = r >> 6, p = r & 63, q = e & 255, j = q >> 4, h2 = q & 15;
        const f2 a = pw[(15 - j) * 64 + p], bb = Bb[p * 16 + h2]; const float zr = a.x * bb.x - a.y * bb.y, zi = a.x * bb.y + a.y * bb.x;
        WSg[e] = (bf16_t)f2bf(ri ? zi : zr);
    }
    for (int e = tid; e < 256 * 128; e += 512) {
        const int row = e >> 7, i = row >> 4, h = row & 15, q = e & 127; const int blk = q >> 5, sq_ = (q >> 4) & 1, hh = (q >> 3) & 1, j = q & 7;
        const int n = 32 * blk + 16 * sq_ + 8 * (j >> 2) + 4 * hh + (j & 3); const int ri = n >> 6, p = n & 63;
        const f2 a = pw[(i + 1) * 64 + p], c = Cc[h * 64 + p]; const float zr = c.x * a.x - c.y * a.y, zi = c.x * a.y + c.y * a.x;
        WCg[e] = (bf16_t)f2bf(ri ? -zi : zr);
    }
    __syncthreads();
}

__device__ __forceinline__ void s5_unit(unsigned long long* tsp, LAS unsigned char* lds, const int tid, const unsigned char* tbl, const float* gw, const float* gb, const bf16_t* proj, bf16_t* mixed, float* ssqs, int b, int g) {
    typedef float f2 __attribute__((ext_vector_type(2)));
    const int lane = tid & 63, c = lane & 31, hi = lane >> 5; const int w = __builtin_amdgcn_readfirstlane(tid >> 6);
    TS(30);
    for (int q = tid; q < 544; q += 512) *(LAS u32x4*)(lds + S5L_KT + q * 16) = *(const u32x4*)(tbl + S5_KT + q * 16);
#pragma unroll
    for (int it = 0; it < 8; ++it) { const int q = tid + 512 * it; *(LAS u32x4*)(lds + S5L_W + (q >> 5) * 528 + (q & 31) * 16) = *(const u32x4*)(tbl + S5_WS + q * 16); }
    if (tid < 192) *(LAS u32x4*)(lds + S5L_MD + tid * 16) = *(const u32x4*)(tbl + S5_MD + tid * 16);
#pragma unroll
    for (int it = 0; it < 4; ++it) { const int q = tid + 512 * it; *(LAS u32x2*)(lds + S5L_MC + (q >> 6) * 520 + (q & 63) * 8) = *(const u32x2*)(tbl + S5_MC + q * 8); }
    __syncthreads();
    TS(31);
    const bf16_t* ubase = proj + PU + 16 * g + 8 * hi;
    const LAS unsigned char* mdb = lds + S5L_MD + hi * 32;
    const LAS unsigned char* mcb = lds + S5L_MC + c * 520 + hi * 32;
    LAS float* EX = (LAS float*)(lds + S5L_EX) + 4 * hi;
    const LAS unsigned char* wsb = lds + S5L_W + c * 528 + hi * 16;
    const LAS unsigned char* wcb = lds + S5L_W + c * 272 + hi * 16;
    f32x16 sa[4];
#pragma unroll
    for (int k = 0; k < 4; ++k) sa[k] = (f32x16){};
    {
        const int cc = 32 * w + c;
        const GAS bf16_t* up = (const GAS bf16_t*)(ubase + (size_t)rowof(b, 16 * cc) * PJ);
#pragma unroll
        for (int s0 = 0; s0 < 16; s0 += 8) {
            bf16x8 uf[8];
#pragma unroll
            for (int s = 0; s < 8; ++s) { uf[s] = *(const GAS bf16x8*)up; up += PJ; asm volatile("" : "+v"(up)); }
            __builtin_amdgcn_sched_barrier(0);
#pragma unroll
            for (int s = 0; s < 8; ++s) {
#pragma unroll
                for (int blk = 0; blk < 4; ++blk) { const bf16x8 A = *(const LAS bf16x8*)(wsb + blk * (32 * 528) + (s0 + s) * 32); sa[blk] = __builtin_amdgcn_mfma_f32_32x32x16_bf16(A, uf[s], sa[blk], 0, 0, 0); }
                __builtin_amdgcn_sched_barrier(0); }
        }
    }
    TS(32);
    float sr[2][16], si[2][16];
#pragma unroll
    for (int pb = 0; pb < 2; ++pb)
#pragma unroll
        for (int r = 0; r < 16; ++r) { sr[pb][r] = sa[pb][r]; si[pb][r] = sa[2 + pb][r]; }
#pragma unroll
    for (int k = 0; k < 4; ++k) {
        const LAS unsigned char* mdk = mdb + k * 512; asm volatile("" : "+v"(mdk));
#pragma unroll
        for (int pb = 0; pb < 2; ++pb)
#pragma unroll
            for (int r = 0; r < 16; ++r) { const f2 m = *(const LAS f2*)(mdk + (32 * pb + (r & 3) + 8 * (r >> 2)) * 8);
                float yr, yi;
                if (k == 0) { yr = dpp_mov0<0x111>(sr[pb][r]); yi = dpp_mov0<0x111>(si[pb][r]); } else if (k == 1) { yr = dpp_mov0<0x112>(sr[pb][r]); yi = dpp_mov0<0x112>(si[pb][r]); }
                else if (k == 2) { yr = dpp_mov0<0x114>(sr[pb][r]); yi = dpp_mov0<0x114>(si[pb][r]); } else { yr = dpp_mov0<0x118>(sr[pb][r]); yi = dpp_mov0<0x118>(si[pb][r]); }
                sr[pb][r] += m.x * yr - m.y * yi; si[pb][r] += m.x * yi + m.y * yr; asm volatile("" : "+v"(sr[pb][r]), "+v"(si[pb][r]));
                if ((r & 3) == 3) { asm volatile("" ::: "memory"); __builtin_amdgcn_sched_barrier(0); } }
    }
    {
        const LAS unsigned char* mcu = lds + S5L_MC + ((c & 15) + 1) * 520 + hi * 32; asm volatile("" : "+v"(mcu));
#pragma unroll
        for (int pb = 0; pb < 2; ++pb)
#pragma unroll
            for (int r = 0; r < 16; ++r) { const f2 m = *(const LAS f2*)(mcu + (32 * pb + (r & 3) + 8 * (r >> 2)) * 8);
                const float yr = dpp_mov0m<0x142, 0xA>(sr[pb][r]), yi = dpp_mov0m<0x142, 0xA>(si[pb][r]);
                sr[pb][r] += m.x * yr - m.y * yi; si[pb][r] += m.x * yi + m.y * yr; asm volatile("" : "+v"(sr[pb][r]), "+v"(si[pb][r]));
                if ((r & 3) == 3) { asm volatile("" ::: "memory"); __builtin_amdgcn_sched_barrier(0); } }
    }
    TS(33);
    if (c == 31) {
#pragma unroll
        for (int pb = 0; pb < 2; ++pb)
#pragma unroll
            for (int r = 0; r < 16; ++r) { const int p0 = 32 * pb + (r & 3) + 8 * (r >> 2); EX[w * 128 + p0] = sr[pb][r]; EX[w * 128 + 64 + p0] = si[pb][r]; }
    }
    __syncthreads();
    if (w == 0) {
        LAS float* CIN = (LAS float*)(lds + S5L_CIN); const LAS float* EXp = (const LAS float*)(lds + S5L_EX);
        const f2 m = *(const LAS f2*)(lds + S5L_MD + (5 * 64 + lane) * 8); float cr_ = 0.f, ci_ = 0.f;
#pragma unroll
        for (int t = 0; t < 8; ++t) { CIN[t * 128 + lane] = cr_; CIN[t * 128 + 64 + lane] = ci_; const float er = EXp[t * 128 + lane], ei = EXp[t * 128 + 64 + lane];
            const float nr = m.x * cr_ - m.y * ci_ + er, ni = m.x * ci_ + m.y * cr_ + ei; cr_ = nr; ci_ = ni; }
        CIN[8 * 128 + lane] = cr_; CIN[8 * 128 + 64 + lane] = ci_;
    }
#pragma unroll
    for (int it = 0; it < 8; ++it) { const int q = tid + 512 * it; *(LAS u32x4*)(lds + S5L_W + (q >> 4) * 272 + (q & 15) * 16) = *(const u32x4*)(tbl + S5_WC + q * 16); }
    __syncthreads();
    TS(34);
    const int npass = 2;
#pragma unroll 1
    for (int pass = 0; pass < npass; ++pass) {
        if (pass == 1) TS(35);
        const int nprev = pass == 0 ? w : 8;
        const int cc = pass == 0 ? 32 * w + c : 256;
        if (pass == 1) {
#pragma unroll
            for (int pb = 0; pb < 2; ++pb)
#pragma unroll
                for (int r = 0; r < 16; ++r) { sr[pb][r] = 0.f; si[pb][r] = 0.f; }
        }
        {
            const LAS float* cinp = (const LAS float*)(lds + S5L_CIN) + nprev * 128 + 4 * hi; asm volatile("" : "+v"(cinp));
            const LAS unsigned char* mcb2 = mcb; asm volatile("" : "+v"(mcb2));
#pragma unroll
            for (int pb = 0; pb < 2; ++pb)
#pragma unroll
                for (int r = 0; r < 16; ++r) { const f2 m = *(const LAS f2*)(mcb2 + (32 * pb + (r & 3) + 8 * (r >> 2)) * 8);
                    float xr = dpp_mov0<0x138>(sr[pb][r]), xi = dpp_mov0<0x138>(si[pb][r]); if (c == 0) { xr = 0.f; xi = 0.f; }
                    const float cr_ = cinp[32 * pb + (r & 3) + 8 * (r >> 2)], ci_ = cinp[64 + 32 * pb + (r & 3) + 8 * (r >> 2)];
                    sr[pb][r] = xr + m.x * cr_ - m.y * ci_; si[pb][r] = xi + m.x * ci_ + m.y * cr_; asm volatile("" : "+v"(sr[pb][r]), "+v"(si[pb][r]));
                    if ((r & 3) == 3) { asm volatile("" ::: "memory"); __builtin_amdgcn_sched_barrier(0); } }
        }
        bf16x8 xf[4][2];
#pragma unroll
        for (int blk = 0; blk < 4; ++blk)
#pragma unroll
            for (int s = 0; s < 2; ++s) { const float* v = blk < 2 ? &sr[blk][8 * s] : &si[blk - 2][8 * s]; u32x4 t; t.x = cvt_pk_bf16(v[0], v[1]); t.y = cvt_pk_bf16(v[2], v[3]); t.z = cvt_pk_bf16(v[4], v[5]); t.w = cvt_pk_bf16(v[6], v[7]); xf[blk][s] = __builtin_bit_cast(bf16x8, t); }
        const int io = (lane >> 4) & 1, kk = lane & 15;
        bf16x8 Gf0, Gf1;
        { unsigned pkd[4];
    #pragma unroll
          for (int jj = 0; jj < 4; ++jj) { const int j0 = 2 * jj, j1 = 2 * jj + 1; const int h0 = 8 * (j0 >> 2) + 4 * hi + (j0 & 3), h1 = 8 * (j1 >> 2) + 4 * hi + (j1 & 3); pkd[jj] = pk2(gw[h0 * 16 + kk], gw[h1 * 16 + kk]); }
          const u32x4 wv = {pkd[0], pkd[1], pkd[2], pkd[3]}, zz = {0u, 0u, 0u, 0u};
          Gf0 = __builtin_bit_cast(bf16x8, io == 0 ? wv : zz); Gf1 = __builtin_bit_cast(bf16x8, io == 1 ? wv : zz); }
        float gbv[8];
    #pragma unroll
        for (int q = 0; q < 8; ++q) gbv[q] = gb[(q & 3) + 8 * (q >> 2) + 4 * hi];
        const int ktb = S5L_KT + ((lane >> 4) & 1) * 512 + (lane & 15) * 32 + hi * 16;
        const bool stok = pass == 0 ? (cc > 0 || b == 0) : (c == 0);
#pragma unroll
        for (int half = 0; half < 2; ++half) {
            __builtin_amdgcn_sched_barrier(0);
            f32x16 ya[4];
#pragma unroll
            for (int rl = 0; rl < 4; ++rl) ya[rl] = (f32x16){};
            int hi2 = hi; asm volatile("" : "+v"(hi2));
            const GAS bf16_t* up = (const GAS bf16_t*)(proj + PU + 16 * g + 8 * hi2 + (size_t)rowof(b, 16 * cc) * PJ);
#pragma unroll
            for (int s0 = 0; s0 < 8 * half + 8; s0 += 8) {
                bf16x8 uf[8];
#pragma unroll
                for (int s = 0; s < 8; ++s) { uf[s] = *(const GAS bf16x8*)up; up += PJ; asm volatile("" : "+v"(up)); }
                __builtin_amdgcn_sched_barrier(0);
#pragma unroll
                for (int s = 0; s < 8; ++s) {
#pragma unroll
                    for (int rl = 0; rl < 4; ++rl) { const int rb = 4 * half + rl; if (s0 + s <= 2 * rb + 1 && (pass == 0 || rb == w)) { const bf16x8 A = *(const LAS bf16x8*)(lds + ktb + (2 * rb - (s0 + s) + 1) * 512); ya[rl] = __builtin_amdgcn_mfma_f32_32x32x16_bf16(A, uf[s], ya[rl], 0, 0, 0); } }
                    __builtin_amdgcn_sched_barrier(0); }
            }
#pragma unroll
            for (int rl = 0; rl < 4; ++rl) if (pass == 0 || 4 * half + rl == w) {
#pragma unroll
                for (int blk = 0; blk < 4; ++blk)
#pragma unroll
                    for (int s = 0; s < 2; ++s) { const bf16x8 A = *(const LAS bf16x8*)(wcb + (4 * half + rl) * (32 * 272) + (blk * 2 + s) * 32); ya[rl] = __builtin_amdgcn_mfma_f32_32x32x16_bf16(A, xf[blk][s], ya[rl], 0, 0, 0); }
                __builtin_amdgcn_sched_barrier(0);
            }
#pragma unroll
            for (int rl = 0; rl < 4; ++rl) if (pass == 0 || 4 * half + rl == w) {
                const int rb = 4 * half + rl;
                float zg[16];
#pragma unroll
                for (int r = 0; r < 16; ++r) zg[r] = gelu_tanh(ya[rl][r]);
                u32x4 z0, z1; z0.x = cvt_pk_bf16(zg[0], zg[1]); z0.y = cvt_pk_bf16(zg[2], zg[3]); z0.z = cvt_pk_bf16(zg[4], zg[5]); z0.w = cvt_pk_bf16(zg[6], zg[7]);
                z1.x = cvt_pk_bf16(zg[8], zg[9]); z1.y = cvt_pk_bf16(zg[10], zg[11]); z1.z = cvt_pk_bf16(zg[12], zg[13]); z1.w = cvt_pk_bf16(zg[14], zg[15]);
                f32x16 gt = (f32x16){};
                gt = __builtin_amdgcn_mfma_f32_32x32x16_bf16(Gf0, __builtin_bit_cast(bf16x8, z0), gt, 0, 0, 0);
                gt = __builtin_amdgcn_mfma_f32_32x32x16_bf16(Gf1, __builtin_bit_cast(bf16x8, z1), gt, 0, 0, 0);
#pragma unroll
                for (int il = 0; il < 2; ++il) {
                    float o[8]; float sq = 0.f;
#pragma unroll
                    for (int q = 0; q < 8; ++q) { o[q] = zg[8 * il + q] * sigmoidf_(gt[8 * il + q] + gbv[q]); sq += o[q] * o[q]; }
                    sq = xadd32(sq);
                    if (stok) { const int row = rowof(b, 16 * cc + 2 * rb + il); bf16_t* op = mixed + (size_t)row * DM + MX_SSM + 16 * g + 4 * hi;
                        u32x2 w0, w1; w0.x = cvt_pk_bf16(o[0], o[1]); w0.y = cvt_pk_bf16(o[2], o[3]); w1.x = cvt_pk_bf16(o[4], o[5]); w1.y = cvt_pk_bf16(o[6], o[7]);
                        *(u32x2*)op = w0; *(u32x2*)(op + 8) = w1;
                        if (hi == 0) ssqs[(size_t)row * 16 + g] = sq; }
                }
                __builtin_amdgcn_sched_barrier(0);
            }
        }
    }
    TS(36);
    __syncthreads();
}

template <int NG>
__device__ __forceinline__ void router_partial(LAS float* part, const bf16_t* hbuf, const bf16_t* Whi, const bf16_t* Wlo, int row0, bool meta, int g0, int wave, int lane) {
    const int r32 = lane & 31, hh = lane >> 5;
    f32x16 acc[NG];
#pragma unroll
    for (int g = 0; g < NG; ++g) acc[g] = (f32x16){};
    const bf16_t* bh_ = Whi + (size_t)r32 * DM + wave * 128 + 8 * hh; const bf16_t* bl_ = Wlo + (size_t)r32 * DM + wave * 128 + 8 * hh;
#pragma unroll
    for (int half = 0; half < 2; ++half) {
        bf16x8 av[NG][4], bhv[4], blv[4];
#pragma unroll
        for (int ks = 0; ks < 4; ++ks) { bhv[ks] = *(const bf16x8*)(bh_ + 64 * half + 16 * ks); blv[ks] = *(const bf16x8*)(bl_ + 64 * half + 16 * ks); }
#pragma unroll
        for (int g = 0; g < NG; ++g) { const int row = meta ? (r32 < NMETA ? NREAL + r32 : DUMMY_ROW) : row0 + 32 * g + r32;
            const bf16_t* ap = hbuf + (size_t)row * DM + wave * 128 + 64 * half + 8 * hh;
#pragma unroll
            for (int ks = 0; ks < 4; ++ks) av[g][ks] = *(const bf16x8*)(ap + 16 * ks); }
#pragma unroll
        for (int g = 0; g < NG; ++g)
#pragma unroll
            for (int ks = 0; ks < 4; ++ks) { acc[g] = __builtin_amdgcn_mfma_f32_32x32x16_bf16(av[g][ks], bhv[ks], acc[g], 0, 0, 0); acc[g] = __builtin_amdgcn_mfma_f32_32x32x16_bf16(av[g][ks], blv[ks], acc[g], 0, 0, 0); }
        __builtin_amdgcn_sched_barrier(0);
    }
    if (r32 < 20) {
#pragma unroll
        for (int g = 0; g < NG; ++g)
#pragma unroll
            for (int r = 0; r < 16; ++r) part[((wave * 5 + g0 + g) * 32 + crow(r, hh)) * 20 + r32] = acc[g][r];
    }
}

struct Args { const GAS float* in[31]; GAS float* out; GAS unsigned char* ws; int ph_lo, ph_hi; };
constexpr int N_PHASES = 16;
#define PHASE_IDS() int tid; { int ln_; asm volatile("v_mbcnt_lo_u32_b32 %0, -1, 0\n\tv_mbcnt_hi_u32_b32 %0, -1, %0" : "=v"(ln_)); tid = wave0 * 64 + ln_; } unsigned long long wz_ = 0; asm volatile("" : "+s"(wz_)); unsigned char* ws = ws0 + wz_;        const int lane = tid & 63; const int wave = __builtin_amdgcn_readfirstlane(tid >> 6); (void)lane; (void)wave

__global__ void __launch_bounds__(NWAVES * 64, 2) hymba_fwd(Args args) {
    extern __shared__ __attribute__((aligned(16))) unsigned char lds_raw[];
    LAS unsigned char* lds = (LAS unsigned char*)lds_raw;
    volatile LAS unsigned* MISC = (volatile LAS unsigned*)(lds + LDSCTL_OFF);
    LAS int* TB = (LAS int*)(lds + LDSCTL_OFF + 256);
    LAS int* CN = (LAS int*)(lds + LDSCTL_OFF + 512);
    LAS int* HIST = (LAS int*)(lds + LDSCTL_OFF + 768);
    const int wave0 = __builtin_amdgcn_readfirstlane(threadIdx.x >> 6);
    const int G = gridDim.x; const int bx = blockIdx.x; const int vcu = (G % 8 == 0) ? (bx % 8) * (G / 8) + bx / 8 : bx;
    unsigned char* const ws0 = (unsigned char*)args.ws;
    unsigned* const ctl = (unsigned*)(GAS unsigned*)(ws0 + WS_CTL);
    for (int u = threadIdx.x; u < (LDS_BYTES - LDSCTL_OFF) / 4; u += NWAVES * 64) ((LAS unsigned*)(lds + LDSCTL_OFF))[u] = 0u;
    __syncthreads();
    const int lo = args.ph_lo, hi = args.ph_hi;
    XcdBarrier bar; bar.bar = ctl + CW_BAR; bar.x = 0; bar.st = nullptr;
    if (hi - lo > 1) bar = xcd_barrier_post(ctl + CW_BAR, MISC + 8);
#define IN(k) (lo <= (k) && (k) < hi)
#define SEAM(k) do { if (IN(k) && IN((k) + 1)) { PHASE_IDS(); xcd_barrier(bar, tid == 0); } STAMP((k) + 1); } while (0)
#define WSP(T, off) ((T*)(ws + (off)))
#define INP(k) ((const float*)args.in[k])
#define STAMP(id) do { if (PROBE_A >= 0 && (int)blockIdx.x == PROBE_BLOCK && ((id) == PROBE_A || (id) == PROBE_B)) { PHASE_IDS(); if (tid == 0) ((unsigned long long*)(ctl + CW_TS))[id] = __builtin_amdgcn_s_memrealtime(); } } while (0)
    STAMP(0);

    for (int rep_ = 0; rep_ < DUP_P0; ++rep_) if (IN(0)) {
        PHASE_IDS();
        bf16_t* WinT = WSP(bf16_t, WS_WIN); bf16_t* WoutT = WSP(bf16_t, WS_WOUT); bf16_t* W13T = WSP(bf16_t, WS_W13); bf16_t* W2C = WSP(bf16_t, WS_W2C); bf16_t* WrT = WSP(bf16_t, WS_WR);
        bf16_t* hbuf = WSP(bf16_t, WS_H); float* ssq1 = WSP(float, WS_SSQ1); float* tinfo = WSP(float, WS_TINFO);
#pragma unroll 1
        for (int lg = vcu; lg < 32; lg += G) { const int l = lg >> 4, g = lg & 15;
            const S5P SP{INP(10) + l * 1024, INP(11) + l * 1024, INP(12) + l * 16, INP(13) + (size_t)l * 16384, INP(14) + (size_t)l * 16384, INP(15) + (size_t)l * 16384, INP(16) + (size_t)l * 16384,
                         INP(17) + l * 256, INP(18) + (size_t)l * 4096, INP(19) + l * 256};
            int tidp = tid; asm volatile("" : "+v"(tidp));
            s5_tables_block(lds, tidp, SP, g, WSP(unsigned char, WS_S5T) + (size_t)lg * S5T_BYTES); }
        LAS float* scr = (LAS float*)(lds + wave * 16384);
        const int gw = vcu * NWAVES + wave, NGW = G * NWAVES;
        constexpr int I_WIN = 16 * 80, I_WOUT = 16 * 32, I_W13 = 16 * 16, I_W2 = 4 * 32, I_WR = 16;
        constexpr int T_WIN = 2 * I_WIN, T_WOUT = 2 * I_WOUT, T_W13 = 32 * I_W13, T_W2 = 32 * I_W2, T_WR = 4 * I_WR;
        constexpr int NITEMS = T_WIN + T_WOUT + T_W13 + T_W2 + T_WR;
        const int nskip = G >= 64 ? 32 : 0; const int igw = (vcu - nskip) * NWAVES + wave, INGW = (G - nskip) * NWAVES;
#pragma unroll 1
        for (int it = igw; it < NITEMS && vcu >= nskip; it += INGW) {
            int r = it;
            if (r < T_WIN) { const int l = r / I_WIN, q = r % I_WIN, kb = q / 80, nb = q % 80; GetWin gt{INP(3) + (size_t)l * DM * DINSRC, INP(2) + l * DM};
                tr_item(gt, WinT + (size_t)l * NIN * DM, DM, 64 * kb, 32 * nb, scr, lane); continue; } r -= T_WIN;
            if (r < T_WOUT) { const int l = r / I_WOUT, q = r % I_WOUT, kb = q / 32, nb = q % 32; GetWout gt{INP(21) + (size_t)l * DM * DM, INP(9) + l * 512, INP(20) + l * 256};
                tr_item(gt, WoutT + (size_t)l * DM * DM, DM, 64 * kb, 32 * nb, scr, lane); continue; } r -= T_WOUT;
            if (r < T_W13) { const int le = r / I_W13, q = r % I_W13, kb = q / 16, nb = q % 16; const int l = le / 16; GetW13 gt{INP(27) + (size_t)le * DM * 256, INP(28) + (size_t)le * DM * 256, INP(22) + l * DM};
                tr_item(gt, W13T + (size_t)le * 512 * DM, DM, 64 * kb, 32 * nb, scr, lane); continue; } r -= T_W13;
            if (r < T_W2) { const int le = r / I_W2, q = r % I_W2, kb = q / 32, nb = q % 32; GetW2 gt{INP(29) + (size_t)le * 256 * DM};
                tr_item(gt, W2C + (size_t)le * DM * 256, 256, 64 * kb, 32 * nb, scr, lane); continue; } r -= T_W2;
            { const int lh = r / I_WR, kb = r % I_WR; const int l = lh >> 1, lo_ = lh & 1; GetWr gt{INP(23) + (size_t)l * DM * 4, INP(25) + (size_t)l * DM * 16, INP(22) + l * DM, lo_};
                tr_item(gt, WrT + (size_t)lh * 32 * DM, DM, 64 * kb, 0, scr, lane); }
        }
#pragma unroll 1
        for (int r0 = 2 * gw; r0 < MROWS; r0 += 2 * NGW) {
            f32x4 v[2][4];
#pragma unroll
            for (int q = 0; q < 2; ++q) { const int r = r0 + q;
#pragma unroll
                for (int j = 0; j < 4; ++j) { if (r < NREAL) v[q][j] = *(const f32x4*)(INP(0) + (size_t)r * DM + 4 * lane + 256 * j); else if (r < NTOK) v[q][j] = *(const f32x4*)(INP(1) + (size_t)(r - NREAL) * DM + 4 * lane + 256 * j); else v[q][j] = (f32x4){0.f, 0.f, 0.f, 0.f}; } }
#pragma unroll
            for (int q = 0; q < 2; ++q) { const int r = r0 + q; float s = 0.f;
#pragma unroll
                for (int j = 0; j < 4; ++j) { u32x2 w; w.x = pk2(v[q][j][0], v[q][j][1]); w.y = pk2(v[q][j][2], v[q][j][3]); *(u32x2*)(hbuf + (size_t)r * DM + 4 * lane + 256 * j) = w;
                    s += bflo(w.x) * bflo(w.x) + bfhi(w.x) * bfhi(w.x) + bflo(w.y) * bflo(w.y) + bfhi(w.y) * bfhi(w.y); }
                s = wave_sum(s);
                if (lane < 16) ssq1[(size_t)r * 16 + lane] = lane == 0 ? s : 0.f;
                if (r >= NTOK && lane < 4) tinfo[(size_t)r * 4 + lane] = 0.f; }
        }
    }
    SEAM(0);

#pragma unroll 1
    for (int l = 0; l < DEPTH; ++l) {
        const int P = 1 + 7 * l;
        for (int rep_ = 0; rep_ < DUP_G1; ++rep_) if (IN(P)) {
            PHASE_IDS();
            bf16_t* hbuf = WSP(bf16_t, WS_H); bf16_t* proj = WSP(bf16_t, WS_PROJ); float* flog = WSP(float, WS_FLOG); const float* ssq1 = WSP(float, WS_SSQ1);
            const bf16_t* Win = WSP(bf16_t, WS_WIN) + (size_t)l * NIN * DM; const float* fb = INP(4) + l * 8;
            DenseOrder S; S.init(hbuf, Win, NREAL, NIN, DM, DM, G, bx);
            EpiProj E{proj, flog, ssq1, fb};
            pg8::gemm_phase<EpiProj, DenseOrder, true, false>(lds, tid, DM, DM, S, E);
#pragma unroll 1
            for (int cb = bx; cb < NIN / 64; cb += G) {
                const f32x2 v = meta_gemm64<false>(lds, tid, hbuf + (size_t)NREAL * DM, Win, DM, cb * 64, nullptr, nullptr);
                const int mm = tid >> 5, cp = tid & 31, row = NREAL + mm;
                const float rs = row_rstd_all(ssq1, row, 1.f / DM);
                if (cb < 36) *(unsigned*)(proj + (size_t)row * PJ + cb * 64 + 2 * cp) = cvt_pk_bf16(v.x * rs, v.y * rs);
                else if (cb == 36 && cp < 4) { f32x2 o; const float f0 = v.x * rs + fb[2 * cp], f1 = v.y * rs + fb[2 * cp + 1]; o.x = -log2f(1.f + exp2f(-f0 * LOG2E)); o.y = -log2f(1.f + exp2f(-f1 * LOG2E)); *(f32x2*)(flog + (size_t)row * 8 + 2 * cp) = o; }
            }
        }
        SEAM(P);
        for (int rep_ = 0; rep_ < DUP_MIX; ++rep_) if (IN(P + 1)) {
            PHASE_IDS();
            const bf16_t* proj = WSP(bf16_t, WS_PROJ); bf16_t* mixed = WSP(bf16_t, WS_MIX); const float* flog = WSP(float, WS_FLOG); float* ssqa = WSP(float, WS_SSQA); float* ssqs = WSP(float, WS_SSQS);
            for (int repa_ = 0; repa_ < DUP_ATT; ++repa_)
#pragma unroll 1
            for (int vc = vcu; vc < 256; vc += G) {
                int bh = vc >> 2; asm volatile("" : "+s"(bh));
                const int b = bh >> 3, h = bh & 7;
                attn_prefix(lds, tid, flog, b, h);
#pragma unroll 1
                for (int i = 0; i < 4; ++i) { const int s = (vc & 3) * 2 + (i >> 1); int qt = (i & 1) ? 15 - s : s; asm volatile("" : "+s"(qt)); int tid3 = tid; asm volatile("" : "+v"(tid3)); attn_unit(lds, tid3, proj, mixed, ssqa, b, h, qt); }
            }
#pragma unroll 1
            for (int vc = vcu; vc < 8; vc += G) { int hh = vc; asm volatile("" : "+s"(hh)); int tid3 = tid; asm volatile("" : "+v"(tid3)); attn_prefix(lds, tid3, flog, 0, hh); attn_unit(lds, tid3, proj, mixed, ssqa, 0, hh, -1); }
            STAMP(20 + l * 4);
            const float* cw = INP(5) + (size_t)l * 31 * 256; const float* cbp = INP(6) + l * 256; const float* clg = INP(7) + l * 256; const float* clb = INP(8) + l * 256;
            for (int repc_ = 0; repc_ < DUP_CS; ++repc_)
#pragma unroll 1
            for (int vc = vcu; vc < 256; vc += G) {
                int tid2 = tid; asm volatile("" : "+v"(tid2));
                if ((vc & 1) == 0) { const int ci = vc >> 1;
                    conv_unit(lds, tid2, proj, mixed, cw, cbp, clg, clb, ci >> 4, NMETA + 256 * (ci & 15), 4, 64);
                } else {
                    if (vc == 1) conv_unit(lds, tid2, proj, mixed, cw, cbp, clg, clb, 0, 0, 1, 16);
                    int ug = vc >> 1; asm volatile("" : "+s"(ug));
                    s5_unit((unsigned long long*)(ctl + CW_TS), lds, tid2, WSP(unsigned char, WS_S5T) + (size_t)(l * 16 + (ug & 15)) * S5T_BYTES, INP(18) + (size_t)l * 4096 + (ug & 15) * 256, INP(19) + l * 256 + (ug & 15) * 16, proj, mixed, ssqs, ug >> 4, ug & 15);
                }
            }
        }
        if (IN(P + 1)) STAMP(21 + l * 4);
        SEAM(P + 1);
        if (IN(P + 3)) {
            PHASE_IDS();
            bf16_t* hbuf = WSP(bf16_t, WS_H); const bf16_t* mixed = WSP(bf16_t, WS_MIX); float* ssq2 = WSP(float, WS_SSQ2); const bf16_t* Wo = WSP(bf16_t, WS_WOUT) + (size_t)l * DM * DM;
            DenseOrder S; S.init(mixed, Wo, NREAL, DM, DM, DM, G, bx);
            EpiRes<false> E{hbuf, ssq2, CN, nullptr};
            HookNorm HK{WSP(float, WS_SSQA), WSP(float, WS_SSQS)};
            pg8::gemm_phase<EpiRes<false>, DenseOrder, true, false, false, HookNorm>(lds, tid, DM, DM, S, E, HK);
            STAMP(40 + 2 * l);
#pragma unroll 1
            for (int cb = bx; cb < DM / 64; cb += G) {
                const f32x2 v = meta_gemm64<true>(lds, tid, mixed + (size_t)NREAL * DM, Wo, DM, cb * 64, WSP(float, WS_SSQA), WSP(float, WS_SSQS));
                const int mm = tid >> 5, cp = tid & 31, row = NREAL + mm;
                unsigned* p = (unsigned*)(hbuf + (size_t)row * DM + cb * 64 + 2 * cp); const unsigned o = *p;
                const unsigned wv = cvt_pk_bf16(bflo(o) + v.x, bfhi(o) + v.y); *p = wv;
                const float sq = half32_sum(bflo(wv) * bflo(wv) + bfhi(wv) * bfhi(wv));
                if (cp == 0) ssq2[(size_t)row * 16 + cb] = sq;
            }
        }
        if (IN(P + 3)) STAMP(41 + 2 * l);
        SEAM(P + 3);
        if (IN(P + 4)) {
            PHASE_IDS();
            const bf16_t* hbuf = WSP(bf16_t, WS_H); const float* ssq2 = WSP(float, WS_SSQ2); float* tinfo = WSP(float, WS_TINFO); int* list = WSP(int, WS_LIST);
            unsigned* gcnt = ctl + CW_CNT + l * 32;
            const bf16_t* Whi = WSP(bf16_t, WS_WR) + (size_t)(2 * l) * 32 * DM; const bf16_t* Wlo = Whi + (size_t)32 * DM;
            LAS float* part = (LAS float*)lds;
            LAS float* fin = (LAS float*)(lds + 106496);
            const float* bg = INP(24) + l * 4; const float* be = INP(26) + l * 16;
#pragma unroll 1
            for (int rb = bx; rb < 256; rb += G) {
                const int ng = rb == 255 ? 5 : 4;
                router_partial<4>(part, hbuf, Whi, Wlo, rb * 128, false, 0, wave, lane);
                if (ng == 5) router_partial<1>(part, hbuf, Whi, Wlo, 0, true, 4, wave, lane);
                __syncthreads();
                for (int e = tid; e < ng * 32 * 20; e += 512) { const int g = e / 640, q = e % 640; float sum = 0.f;
#pragma unroll
                    for (int ww = 0; ww < 8; ++ww) sum += part[(ww * 5 + g) * 640 + q];
                    fin[g * 640 + q] = sum; }
                __syncthreads();
                int cls = 0, posl = 0, tok = 0; bool valid = false; float rstd = 0.f, gA = 0.f, gB = 0.f;
                if (tid < ng * 32) {
                    tok = tid < 128 ? rb * 128 + tid : NREAL + (tid - 128); valid = tid < 128 || tid < 128 + NMETA;
                    if (valid) {
                        float s_ = 0.f;
#pragma unroll
                        for (int q = 0; q < 4; ++q) { const f32x4 v = *(const f32x4*)(ssq2 + (size_t)tok * 16 + 4 * q); s_ += (v.x + v.y) + (v.z + v.w); }
                        rstd = rsqrtf(s_ * (1.f / DM) + EPS);
                        const LAS float* lgp = fin + tid * 20;
                        float lg[4];
#pragma unroll
                        for (int i = 0; i < 4; ++i) lg[i] = lgp[i] * rstd + bg[i];
                        int gs = 0; float mx = lg[0];
#pragma unroll
                        for (int i = 1; i < 4; ++i) if (lg[i] > mx) { mx = lg[i]; gs = i; }
                        float se = 0.f;
#pragma unroll
                        for (int i = 0; i < 4; ++i) se += expf(lg[i] - mx);
                        const float pg = 1.f / se;
                        float le[4];
#pragma unroll
                        for (int i = 0; i < 4; ++i) le[i] = lgp[4 + 4 * gs + i] * rstd + be[4 * gs + i];
                        int i1 = 0; float v1 = le[0];
#pragma unroll
                        for (int i = 1; i < 4; ++i) if (le[i] > v1) { v1 = le[i]; i1 = i; }
                        int i2 = -1; float v2 = -INFINITY;
#pragma unroll
                        for (int i = 0; i < 4; ++i) if (i != i1 && le[i] > v2) { v2 = le[i]; i2 = i; }
                        const float w1 = pg / (1.f + expf(v2 - v1)), w2 = pg - w1;
                        const int a_ = i1 < i2 ? i1 : i2, bb = i1 < i2 ? i2 : i1;
                        gA = i1 < i2 ? w1 : w2; gB = i1 < i2 ? w2 : w1;
                        cls = gs * 6 + (a_ == 0 ? bb - 1 : (a_ == 1 ? bb + 1 : 5));
                        posl = __hip_atomic_fetch_add(&HIST[cls], 1, __ATOMIC_RELAXED, __HIP_MEMORY_SCOPE_WORKGROUP);
                    }
                }
                __syncthreads();
                if (tid < NCLS) { const int n = HIST[tid]; HIST[32 + tid] = n ? (int)__hip_atomic_fetch_add(gcnt + tid, (unsigned)n, __ATOMIC_RELAXED, __HIP_MEMORY_SCOPE_AGENT) : 0; }
                __syncthreads();
                if (valid) { const int pos = HIST[32 + cls] + posl; list[(size_t)cls * NTOK + pos] = tok; *(f32x4*)(tinfo + (size_t)tok * 4) = (f32x4){rstd, gA, gB, 0.f}; }
                __syncthreads();
                if (tid < NCLS) HIST[tid] = 0;
                __syncthreads();
            }
        }
        SEAM(P + 4);
        if (IN(P + 5) || IN(P + 6)) {
            unsigned* gcnt = ctl + CW_CNT + l * 32;
            PHASE_IDS();
            if (tid == 0) { int run = 0; for (int c = 0; c < NCLS; ++c) { const int n = (int)__hip_atomic_load(gcnt + c, __ATOMIC_RELAXED, __HIP_MEMORY_SCOPE_AGENT); CN[c] = n; TB[c] = run; run += (n + 255) >> 8; } TB[NCLS] = run; }
            __syncthreads();
        }
        for (int rep_ = 0; rep_ < DUP_E1; ++rep_) if (IN(P + 5)) {
            PHASE_IDS();
            const int* list = WSP(int, WS_LIST);
            ExpertOrder S{TB, CN, list, (const char*)WSP(bf16_t, WS_H), (const char*)WSP(bf16_t, WS_W13), G, bx, 1, l};
            EpiE1 E{WSP(bf16_t, WS_H1), WSP(float, WS_TINFO), CN, list};
            pg8::gemm_phase<EpiE1, ExpertOrder, true, true>(lds, tid, DM, DM, S, E);
        }
        SEAM(P + 5);
        if (IN(P + 6)) {
            PHASE_IDS();
            const int* list = WSP(int, WS_LIST);
            ExpertOrder S{TB, CN, list, (const char*)WSP(bf16_t, WS_H1), (const char*)WSP(bf16_t, WS_W2C), G, bx, 2, l};
            EpiRes<true> E{WSP(bf16_t, WS_H), WSP(float, WS_SSQ1), CN, list};
            pg8::gemm_phase<EpiRes<true>, ExpertOrder, true, false, true>(lds, tid, 512, 256, S, E);
        }
        SEAM(P + 6);
    }
    if (IN(15)) {
        PHASE_IDS();
        const bf16_t* hbuf = WSP(bf16_t, WS_H); const float* ssq1 = WSP(float, WS_SSQ1);
        const int gw = vcu * NWAVES + wave, NGW = G * NWAVES; const float* gF = INP(30);
        f32x4 gv[4];
#pragma unroll
        for (int j = 0; j < 4; ++j) gv[j] = *(const f32x4*)(gF + 4 * lane + 256 * j);
#pragma unroll 1
        for (int r = gw; r < NREAL; r += NGW) {
            float s = lane < 16 ? ssq1[(size_t)r * 16 + lane] : 0.f; s = wave_sum(s);
            const float rs = rsqrtf(s * (1.f / DM) + EPS);
#pragma unroll
            for (int j = 0; j < 4; ++j) { const u32x2 w = *(const u32x2*)(hbuf + (size_t)r * DM + 4 * lane + 256 * j);
                f32x4 o; o[0] = bflo(w.x) * rs * gv[j][0]; o[1] = bfhi(w.x) * rs * gv[j][1]; o[2] = bflo(w.y) * rs * gv[j][2]; o[3] = bfhi(w.y) * rs * gv[j][3];
                if (PROBE_A >= 0 && r == 0 && lane == 0 && j == 0) { const unsigned long long ta = __hip_atomic_load((unsigned long long*)(ctl + CW_TS) + (PROBE_A < 0 ? 0 : PROBE_A), __ATOMIC_RELAXED, __HIP_MEMORY_SCOPE_AGENT), tb = __hip_atomic_load((unsigned long long*)(ctl + CW_TS) + (PROBE_B < 0 ? 0 : PROBE_B), __ATOMIC_RELAXED, __HIP_MEMORY_SCOPE_AGENT); o[0] += (float)(long long)(tb - ta) * (0.01f / PROBE_SCALE); }
                *(f32x4*)(((float*)args.out) + (size_t)r * DM + 4 * lane + 256 * j) = o; }
        }
    }
#undef IN
#undef SEAM
#undef WSP
}

extern "C" void kernel_launch(void* const* d_in, const int* in_sizes, int n_in, void* d_out, int out_size, void* d_ws, size_t ws_size, hipStream_t stream) {
    static int grid = 0;
    if (grid == 0) {
        if (n_in != 31 || out_size != NREAL * DM || ws_size < WS_END) { fprintf(stderr, "kernel_launch: unexpected shapes (n_in %d, out %d, ws %zu)\n", n_in, out_size, ws_size); grid = -1; return; }
        int dev = 0, cus = 0, per_cu = 0;
        if (hipGetDevice(&dev) != hipSuccess || hipDeviceGetAttribute(&cus, hipDeviceAttributeMultiprocessorCount, dev) != hipSuccess) { grid = -1; return; }
        if (hipFuncSetAttribute((const void*)hymba_fwd, hipFuncAttributeMaxDynamicSharedMemorySize, LDS_BYTES) != hipSuccess) { fprintf(stderr, "kernel_launch: hipFuncSetAttribute failed\n"); grid = -1; return; }
        if (hipOccupancyMaxActiveBlocksPerMultiprocessor(&per_cu, (const void*)hymba_fwd, NWAVES * 64, LDS_BYTES) != hipSuccess || per_cu < 1) { fprintf(stderr, "kernel_launch: occupancy query says %d\n", per_cu); }
        (void)hipGetLastError();
        grid = cus;
    }
    if (grid < 0) return;
    (void)in_sizes;
    if (hipMemsetAsync((char*)d_ws + WS_CTL, 0, CTL_BYTES, stream) != hipSuccess) return;
    Args a{};
    for (int i = 0; i < 31; ++i) a.in[i] = (const GAS float*)d_in[i];
    a.out = (GAS float*)d_out; a.ws = (GAS unsigned char*)d_ws;
#if MK_PER_PHASE
    for (int p = 0; p < N_PHASES; ++p) { a.ph_lo = p; a.ph_hi = p + 1; hipLaunchKernelGGL(hymba_fwd, dim3(grid), dim3(NWAVES * 64), LDS_BYTES, stream, a); }
#else
    a.ph_lo = 0; a.ph_hi = N_PHASES;
    hipLaunchKernelGGL(hymba_fwd, dim3(grid), dim3(NWAVES * 64), LDS_BYTES, stream, a);
#endif
}
```
